# Optimizing an MI355X kernel written in HIP

```python
import jax
import jax.numpy as jnp
from jax import lax
import numpy as np

D_MODEL = 1024
BATCH = 1
SEQ = 16384
DEPTH = 2

GRID_W = 64
CTX_LEN = 256
N_GROUPS = 4
GROUP_W = D_MODEL // N_GROUPS
D_MIX = N_GROUPS * GROUP_W
CONV_W = 3
CHUNK = 128
CMLP_HEADS = 4
CMLP_HD = GROUP_W // CMLP_HEADS
ATT_HEADS = 4
ATT_KV_HEADS = 2
ATT_GROUP = ATT_HEADS // ATT_KV_HEADS
ATT_HD = GROUP_W // ATT_HEADS
Q_BLOCK = 128
ROPE_THETA = 10000.0
ML_HEADS = 4
ML_HD = GROUP_W // ML_HEADS
ML_CHUNK = 128
ML_FGATE_BIAS = 3.0
N_EXPERTS = 16
EXPERT_FF = 2 * D_MODEL
CAPACITY_FACTOR = 2
MOD_PARTS = 6
EPS = 1e-6

IN_LAYOUT = (
    ('conv_x', GROUP_W), ('conv_b', GROUP_W), ('conv_c', GROUP_W),
    ('cmlp_u', GROUP_W), ('cmlp_v', GROUP_W),
    ('att_q', ATT_HEADS * ATT_HD), ('att_k', ATT_KV_HEADS * ATT_HD), ('att_v', ATT_KV_HEADS * ATT_HD),
    ('ml_q', GROUP_W), ('ml_k', GROUP_W), ('ml_v', GROUP_W), ('ml_o', GROUP_W),
    ('ml_i', 2 * ML_HEADS), ('ml_f', 2 * ML_HEADS),
)
D_IN = sum(s for _, s in IN_LAYOUT)

kernel_name = 'hybrid_diffusion_prefix_block'


def rmsnorm(x, g):
    xf = x.astype(jnp.float32)
    y = xf * lax.rsqrt(jnp.mean(xf * xf, axis=-1, keepdims=True) + EPS)
    return (y * g.astype(jnp.float32)).astype(x.dtype)


def modulate(h, shift, scale):
    return h * (1 + scale) + shift


def split_in(z):
    sizes = [s for _, s in IN_LAYOUT]
    parts = jnp.split(z, np.cumsum(sizes)[:-1].tolist(), axis=-1)
    return {name: part for (name, _), part in zip(IN_LAYOUT, parts)}


def axial_rope_tables(rows):
    pos = jnp.arange(rows * GRID_W)
    row, col = pos // GRID_W, pos % GRID_W
    axis_dim = ATT_HD // 2
    inv_freq = ROPE_THETA ** (-jnp.arange(0, axis_dim, 2, dtype=jnp.float32) / axis_dim)

    def axis_angles(p):
        a = p.astype(jnp.float32)[:, None] * inv_freq[None, :]
        return jnp.concatenate([a, a], axis=-1)

    ang = jnp.concatenate([axis_angles(row), axis_angles(col)], axis=-1)
    return jnp.cos(ang), jnp.sin(ang)


def rotate_half_axial(x):
    axis_dim = ATT_HD // 2
    quarter = axis_dim // 2

    def rh(s):
        return jnp.concatenate([-s[..., quarter:], s[..., :quarter]], axis=-1)

    return jnp.concatenate([rh(x[..., :axis_dim]), rh(x[..., axis_dim:])], axis=-1)


def apply_rope(x, cos, sin):
    xf = x.astype(jnp.float32)
    return (xf * cos + rotate_half_axial(xf) * sin).astype(x.dtype)


def short_conv_mixer(xin, gate_b, gate_c, conv_w):
    y = gate_c * xin
    y = lax.conv_general_dilated(
        y, conv_w[:, None, :], window_strides=(1,), padding=[(CONV_W // 2, CONV_W // 2)],
        dimension_numbers=('NWC', 'WIO', 'NWC'), feature_group_count=GROUP_W)
    return gate_b * y


def chunk_token_mlp(u, v, norm_g, ws, bs):
    b, l, _ = v.shape
    vn = rmsnorm(v, norm_g).reshape(b, l // CHUNK, CHUNK, CMLP_HEADS, CMLP_HD)
    mixed = jnp.einsum('hts,bcshd->bcthd', ws, vn) + bs.T[None, None, :, :, None]
    return u * mixed.reshape(b, l, GROUP_W)


def attn_qkv(pq, pk, pv, q_norm_g, k_norm_g):
    b, l, _ = pq.shape
    q = rmsnorm(pq.reshape(b, l, ATT_HEADS, ATT_HD), q_norm_g).transpose(0, 2, 1, 3)
    k = rmsnorm(pk.reshape(b, l, ATT_KV_HEADS, ATT_HD), k_norm_g).transpose(0, 2, 1, 3)
    v = pv.reshape(b, l, ATT_KV_HEADS, ATT_HD).transpose(0, 2, 1, 3)
    return q, k, v


def gqa_attend(q, k, v):
    s = jnp.einsum('bkgqd,bksd->bkgqs', q, k).astype(jnp.float32) * (ATT_HD ** -0.5)
    p = jax.nn.softmax(s, axis=-1).astype(v.dtype)
    return jnp.einsum('bkgqs,bksd->bkgqd', p, v)


def context_attention(q, k, v):
    b, _, l, _ = q.shape
    o = gqa_attend(q.reshape(b, ATT_KV_HEADS, ATT_GROUP, l, ATT_HD), k, v)
    return o.transpose(0, 3, 1, 2, 4).reshape(b, l, ATT_HEADS * ATT_HD)


def latent_attention(q, k, v, k_ctx, v_ctx):
    b, _, n, _ = q.shape
    k_all = jnp.concatenate([k_ctx, k], axis=2)
    v_all = jnp.concatenate([v_ctx, v], axis=2)
    nb = n // Q_BLOCK
    qb = q.reshape(b, ATT_KV_HEADS, ATT_GROUP, nb, Q_BLOCK, ATT_HD).transpose(3, 0, 1, 2, 4, 5)
    out = lax.map(lambda qblk: gqa_attend(qblk, k_all, v_all), qb)
    return out.transpose(1, 0, 4, 2, 3, 5).reshape(b, n, ATT_HEADS * ATT_HD)


def mlstm_heads(t):
    b, l, _ = t.shape
    return t.reshape(b, l, ML_HEADS, ML_HD).transpose(0, 2, 1, 3).astype(jnp.float32)


def mlstm_inputs(pq, pk, pv, pi, pf, igate_b, fgate_b):
    q = mlstm_heads(pq)
    k = mlstm_heads(pk) * (ML_HD ** -0.5)
    v = mlstm_heads(pv)
    li = (pi.astype(jnp.float32) + igate_b.astype(jnp.float32)).transpose(0, 2, 1)
    lf = jax.nn.log_sigmoid(pf.astype(jnp.float32) + fgate_b.astype(jnp.float32)).transpose(0, 2, 1)
    fwd = (li[:, :ML_HEADS], lf[:, :ML_HEADS])
    bwd = (li[:, ML_HEADS:], lf[:, ML_HEADS:])
    return q, k, v, fwd, bwd


def zero_state(b):
    return (jnp.zeros((b, ML_HEADS, ML_HD, ML_HD), jnp.float32),
            jnp.zeros((b, ML_HEADS, ML_HD), jnp.float32),
            jnp.zeros((b, ML_HEADS), jnp.float32))


def flip_seq(t):
    return jnp.flip(t, axis=2)


def to_chunks(t):
    b, h, l = t.shape[:3]
    return t.reshape(b, h, l // ML_CHUNK, ML_CHUNK, *t.shape[3:])


def mlstm_chunk_states(k, v, li, lf, state0):
    b_cum = jnp.cumsum(lf, axis=-1)
    b_last = b_cum[..., -1]
    a = b_last[..., None] - b_cum + li
    m_loc = jnp.max(a, axis=-1)
    w = jnp.exp(a - m_loc[..., None])
    c_loc = jnp.einsum('bhcs,bhcsv,bhcsk->bhcvk', w, v, k)
    n_loc = jnp.einsum('bhcs,bhcsk->bhck', w, k)

    def step(carry, inp):
        c_prev, n_prev, m_prev = carry
        bl, ml, cl, nl = inp
        m_new = jnp.maximum(bl + m_prev, ml)
        d_old = jnp.exp(bl + m_prev - m_new)
        d_loc = jnp.exp(ml - m_new)
        c_new = d_old[..., None, None] * c_prev + d_loc[..., None, None] * cl
        n_new = d_old[..., None] * n_prev + d_loc[..., None] * nl
        return (c_new, n_new, m_new), (c_prev, n_prev, m_prev)

    xs = tuple(jnp.moveaxis(t, 2, 0) for t in (b_last, m_loc, c_loc, n_loc))
    final, prev = lax.scan(step, state0, xs)
    prev = tuple(jnp.moveaxis(t, 0, 2) for t in prev)
    return b_cum, prev, final


def mlstm_chunk_outputs(q, k, v, li, b_cum, prev):
    c_prev, n_prev, m_prev = prev
    L = q.shape[-2]
    lower = jnp.tril(jnp.ones((L, L), dtype=bool))
    dmat = b_cum[..., :, None] - b_cum[..., None, :] + li[..., None, :]
    dmat = jnp.where(lower, dmat, -jnp.inf)
    inter = b_cum + m_prev[..., None]
    m_t = jnp.maximum(inter, jnp.max(dmat, axis=-1))
    s = jnp.einsum('bhctd,bhcsd->bhcts', q, k) * jnp.exp(dmat - m_t[..., None])
    w_inter = jnp.exp(inter - m_t)
    num = jnp.einsum('bhcts,bhcsd->bhctd', s, v) + w_inter[..., None] * jnp.einsum('bhcvk,bhctk->bhctv', c_prev, q)
    den = jnp.sum(s, axis=-1) + w_inter * jnp.einsum('bhck,bhctk->bhct', n_prev, q)
    return num / jnp.maximum(jnp.abs(den), jnp.exp(-m_t))[..., None]


def mlstm_scan(q, k, v, li, lf, state0):
    qc, kc, vc, lic, lfc = (to_chunks(t) for t in (q, k, v, li, lf))
    b_cum, prev, final = mlstm_chunk_states(kc, vc, lic, lfc, state0)
    h = mlstm_chunk_outputs(qc, kc, vc, lic, b_cum, prev)
    return h.reshape(q.shape), final


def mlstm_final_state(k, v, li, lf, state0):
    return mlstm_chunk_states(to_chunks(k), to_chunks(v), to_chunks(li), to_chunks(lf), state0)[2]


def mlstm_merge(h_f, h_b, po, norm_g):
    b, _, l, _ = h_f.shape
    hs = h_f + h_b
    hs = hs * lax.rsqrt(jnp.mean(hs * hs, axis=-1, keepdims=True) + EPS)
    hs = hs.transpose(0, 2, 1, 3).reshape(b, l, GROUP_W) * norm_g.astype(jnp.float32)
    return (jax.nn.sigmoid(po.astype(jnp.float32)) * hs).astype(po.dtype)


def expert_choice_ffn(h, router_w, w1, w3, w2):
    b, n, _ = h.shape
    cap = CAPACITY_FACTOR * n // N_EXPERTS
    aff = jax.nn.softmax(jnp.einsum('bnd,de->bne', h, router_w).astype(jnp.float32), axis=-1)
    gate, idx = lax.top_k(jnp.swapaxes(aff, 1, 2), cap)
    bidx = jnp.arange(b)[:, None, None]
    xs = h[bidx, idx]
    hid = jax.nn.silu(jnp.einsum('becd,edf->becf', xs, w1)) * jnp.einsum('becd,edf->becf', xs, w3)
    ys = jnp.einsum('becf,efd->becd', hid, w2) * gate[..., None].astype(h.dtype)
    return jnp.zeros_like(h).at[bidx, idx].add(ys)


def local_mixers(p, conv_w, cmlp_norm_g, cmlp_ws, cmlp_bs):
    conv_out = short_conv_mixer(p['conv_x'], p['conv_b'], p['conv_c'], conv_w)
    cmlp_out = chunk_token_mlp(p['cmlp_u'], p['cmlp_v'], cmlp_norm_g, cmlp_ws, cmlp_bs)
    return conv_out, cmlp_out


def layer_forward(x, xc, c, c_ctx, cos, sin, ada_w, ada_b, norm1_g, w_in, conv_w, cmlp_norm_g, cmlp_ws,
                  cmlp_bs, q_norm_g, k_norm_g, ml_igate_b, ml_fgate_b, ml_norm_g, w_out, norm2_g, router_w,
                  exp_w1, exp_w3, exp_w2, update_ctx):
    bsz = x.shape[0]
    mod = (jax.nn.silu(c) @ ada_w + ada_b)[:, None, :]
    mod_c = (jax.nn.silu(c_ctx) @ ada_w + ada_b)[None, None, :]
    shift1, scale1, gate1, shift2, scale2, gate2 = jnp.split(mod, MOD_PARTS, axis=-1)
    cshift1, cscale1, cgate1, cshift2, cscale2, cgate2 = jnp.split(mod_c, MOD_PARTS, axis=-1)

    pc = split_in(modulate(rmsnorm(xc, norm1_g), cshift1, cscale1) @ w_in)
    qc, kc, vc = attn_qkv(pc['att_q'], pc['att_k'], pc['att_v'], q_norm_g, k_norm_g)
    mq_c, mk_c, mv_c, (li_cf, lf_cf), (li_cb, lf_cb) = mlstm_inputs(
        pc['ml_q'], pc['ml_k'], pc['ml_v'], pc['ml_i'], pc['ml_f'], ml_igate_b, ml_fgate_b)
    state0 = zero_state(bsz)
    if update_ctx:
        hcf, st_f = mlstm_scan(mq_c, mk_c, mv_c, li_cf, lf_cf, state0)
        hcb, st_b = mlstm_scan(flip_seq(mq_c), flip_seq(mk_c), flip_seq(mv_c), flip_seq(li_cb), flip_seq(lf_cb), state0)
        conv_c, cmlp_c = local_mixers(pc, conv_w, cmlp_norm_g, cmlp_ws, cmlp_bs)
        att_c = context_attention(qc, kc, vc)
        ml_c = mlstm_merge(hcf, flip_seq(hcb), pc['ml_o'], ml_norm_g)
        mix_c = jnp.concatenate([conv_c, cmlp_c, att_c.astype(xc.dtype), ml_c.astype(xc.dtype)], axis=-1) @ w_out
        xc_new = xc + cgate1 * mix_c
        hc2 = modulate(rmsnorm(xc_new, norm2_g), cshift2, cscale2)
        xc_new = xc_new + cgate2 * expert_choice_ffn(hc2, router_w, exp_w1, exp_w3, exp_w2)
    else:
        st_f = mlstm_final_state(mk_c, mv_c, li_cf, lf_cf, state0)
        st_b = mlstm_final_state(flip_seq(mk_c), flip_seq(mv_c), flip_seq(li_cb), flip_seq(lf_cb), state0)
        xc_new = xc

    p = split_in(modulate(rmsnorm(x, norm1_g), shift1, scale1) @ w_in)
    conv_x, cmlp_x = local_mixers(p, conv_w, cmlp_norm_g, cmlp_ws, cmlp_bs)
    q, k, v = attn_qkv(p['att_q'], p['att_k'], p['att_v'], q_norm_g, k_norm_g)
    q = apply_rope(q, cos, sin)
    k = apply_rope(k, cos, sin)
    att_x = latent_attention(q, k, v, kc, vc)
    mq, mk, mv, (li_f, lf_f), (li_b, lf_b) = mlstm_inputs(
        p['ml_q'], p['ml_k'], p['ml_v'], p['ml_i'], p['ml_f'], ml_igate_b, ml_fgate_b)
    hf, _ = mlstm_scan(mq, mk, mv, li_f, lf_f, st_f)
    hb, _ = mlstm_scan(flip_seq(mq), flip_seq(mk), flip_seq(mv), flip_seq(li_b), flip_seq(lf_b), st_b)
    ml_x = mlstm_merge(hf, flip_seq(hb), p['ml_o'], ml_norm_g)
    mix = jnp.concatenate([conv_x, cmlp_x, att_x.astype(x.dtype), ml_x.astype(x.dtype)], axis=-1) @ w_out
    x = x + gate1 * mix
    h2 = modulate(rmsnorm(x, norm2_g), shift2, scale2)
    x = x + gate2 * expert_choice_ffn(h2, router_w, exp_w1, exp_w3, exp_w2)
    return x, xc_new


def setup_inputs(seed: int = 0) -> dict:
    key = jax.random.key(seed)
    ks = jax.random.split(key, 24)
    f32 = jnp.float32
    L = DEPTH

    def nrm(k, shape, scale):
        return jax.random.normal(k, shape, f32) * scale

    def gain(k, shape):
        return 1.0 + 0.01 * jax.random.normal(k, shape, f32)

    return {
        'x': nrm(ks[0], (BATCH, SEQ, D_MODEL), 1.0),
        'c': nrm(ks[1], (BATCH, D_MODEL), 1.0),
        'ctx': nrm(ks[2], (BATCH, CTX_LEN, D_MODEL), 1.0),
        'c_ctx': nrm(ks[3], (D_MODEL,), 1.0),
        'ada_w': nrm(ks[4], (L, D_MODEL, MOD_PARTS * D_MODEL), 0.3 * D_MODEL ** -0.5),
        'ada_b': nrm(ks[5], (L, MOD_PARTS * D_MODEL), 0.01),
        'norm1_g': gain(ks[6], (L, D_MODEL)),
        'w_in': nrm(ks[7], (L, D_MODEL, D_IN), D_MODEL ** -0.5),
        'conv_w': nrm(ks[8], (L, CONV_W, GROUP_W), CONV_W ** -0.5),
        'cmlp_norm_g': gain(ks[9], (L, GROUP_W)),
        'cmlp_ws': nrm(ks[10], (L, CMLP_HEADS, CHUNK, CHUNK), CHUNK ** -0.5),
        'cmlp_bs': gain(ks[11], (L, CMLP_HEADS, CHUNK)),
        'q_norm_g': gain(ks[12], (L, ATT_HD)),
        'k_norm_g': gain(ks[13], (L, ATT_HD)),
        'ml_igate_b': nrm(ks[14], (L, 2 * ML_HEADS), 0.1),
        'ml_fgate_b': ML_FGATE_BIAS + nrm(ks[15], (L, 2 * ML_HEADS), 0.1),
        'ml_norm_g': gain(ks[16], (L, GROUP_W)),
        'w_out': nrm(ks[17], (L, D_MIX, D_MODEL), D_MIX ** -0.5),
        'norm2_g': gain(ks[18], (L, D_MODEL)),
        'router_w': nrm(ks[19], (L, D_MODEL, N_EXPERTS), D_MODEL ** -0.5),
        'exp_w1': nrm(ks[20], (L, N_EXPERTS, D_MODEL, EXPERT_FF), D_MODEL ** -0.5),
        'exp_w3': nrm(ks[21], (L, N_EXPERTS, D_MODEL, EXPERT_FF), D_MODEL ** -0.5),
        'exp_w2': nrm(ks[22], (L, N_EXPERTS, EXPERT_FF, D_MODEL), EXPERT_FF ** -0.5),
        'final_norm_g': gain(ks[23], (D_MODEL,)),
    }


def reference(x, c, ctx, c_ctx, ada_w, ada_b, norm1_g, w_in, conv_w, cmlp_norm_g, cmlp_ws, cmlp_bs,
              q_norm_g, k_norm_g, ml_igate_b, ml_fgate_b, ml_norm_g, w_out, norm2_g, router_w,
              exp_w1, exp_w3, exp_w2, final_norm_g):
    rows = x.shape[1] // GRID_W
    cos, sin = axial_rope_tables(rows)
    xc = ctx
    for l in range(DEPTH):
        x, xc = layer_forward(
            x, xc, c, c_ctx, cos, sin, ada_w[l], ada_b[l], norm1_g[l], w_in[l], conv_w[l], cmlp_norm_g[l],
            cmlp_ws[l], cmlp_bs[l], q_norm_g[l], k_norm_g[l], ml_igate_b[l], ml_fgate_b[l], ml_norm_g[l],
            w_out[l], norm2_g[l], router_w[l], exp_w1[l], exp_w3[l], exp_w2[l], update_ctx=(l < DEPTH - 1))
    return rmsnorm(x, final_norm_g)
```

```cpp
#include <hip/hip_runtime.h>
#include <hip/hip_bf16.h>
#include <hip/hip_cooperative_groups.h>
#include <cstdio>
#include <cstdint>
#include <cmath>
namespace cg = cooperative_groups;
namespace pg8 {
#define PG8_LAS __attribute__((address_space(3)))
typedef unsigned short bf16_t;
typedef short bf16x8 __attribute__((ext_vector_type(8)));
typedef float f32x4 __attribute__((ext_vector_type(4)));
typedef unsigned u32x4 __attribute__((ext_vector_type(4)));
constexpr int BM = 256, BK = 64, HALF = 128, HTB = HALF * BK * 2, STAGE_BYTES = 8 * HTB, NXCD = 8, WGM = 8;

__host__ __device__ __forceinline__ int lds_byte(int r, int c) { const int st = (r >> 4) * 2 + (c >> 5), rr = r & 15, cc = c & 31, ob = rr * 64 + cc * 2; return st * 1024 + (ob ^ (((ob >> 9) & 1) << 5)); }
__host__ __device__ __forceinline__ void stage_rc(int b, int& R, int& C) { const int st = b / 1024, sb = b % 1024, swz = sb ^ (((sb >> 9) & 1) << 5); R = (st >> 1) * 16 + swz / 64; C = (st & 1) * 32 + (swz % 64) / 2; }
__host__ __device__ __forceinline__ int perm32(int rho) { const int n = rho >> 4, i = rho & 15; return 8 * (i >> 2) + 4 * n + (i & 3); }

struct Unit { int pm, pn; };
struct Gemm { const bf16_t* A; const bf16_t* Bt; int M, N, K; const int* gidx; };

struct StaticOrder {
    int nM, nN, nwg, G, c, pm0;
    __host__ __device__ void init(int M, int N, int G_, int c_, int pm0_ = 0) { nM = M / BM; nN = N / BM; nwg = nM * nN; G = G_; c = c_; pm0 = pm0_; }
    __host__ __device__ bool next(int i, Unit& u) const {
        const long L = (long)i * G + c; if (L >= nwg) return false;
        int wgid = (int)L; { const int q = nwg / NXCD, r = nwg % NXCD, xcd = wgid % NXCD, off = wgid / NXCD; wgid = (xcd < r ? xcd * (q + 1) : r * (q + 1) + (xcd - r) * q) + off; }
        const int nig = WGM * nN, gid = wgid / nig, fm = gid * WGM, gsz = (nM - fm) < WGM ? (nM - fm) : WGM;
        u.pm = pm0 + fm + ((wgid % nig) % gsz); u.pn = (wgid % nig) / gsz; return true;
    }
};
struct MoeOrder {
    int npm, npn, total, G, c;
    __host__ __device__ void init(int npm_, int npn_, int G_, int c_) { npm = npm_; npn = npn_; total = 16 * npm_ * npn_; G = G_; c = c_; }
    __host__ __device__ bool next(int i, Unit& u) const {
        const long L = (long)i * G + c; if (L >= total) return false;
        const int per = npm * npn, e = (int)L / per, rem = (int)L % per, pn = rem / npm, pm = rem % npm;
        u.pm = e * 9 + pm; u.pn = e * npn + pn; return true;
    }
};

__device__ __forceinline__ unsigned cvt_pk_bf16(float lo, float hi) { unsigned r; asm volatile("v_cvt_pk_bf16_f32 %0, %1, %2" : "=v"(r) : "v"(lo), "v"(hi)); return r; }

struct EpiBf16 {
    static constexpr bool PERM = true;
    bf16_t* O; int ldc;
    __device__ __forceinline__ void operator()(const f32x4 (&acc)[2][2][4][2], const Unit& u, int wr, int wc, int fr, int fq) const {
        const int row0 = u.pm * BM + wr * 64 + fr; const int col0 = u.pn * BM + wc * 32 + 8 * fq;
#pragma unroll
        for (int ai = 0; ai < 2; ++ai)
#pragma unroll
            for (int m = 0; m < 4; ++m) { bf16_t* rowp = O + (size_t)(row0 + ai * HALF + m * 16) * ldc + col0;
#pragma unroll
                for (int bj = 0; bj < 2; ++bj) { const f32x4 v0 = acc[ai][bj][m][0], v1 = acc[ai][bj][m][1];
                    u32x4 w; w.x = cvt_pk_bf16(v0[0], v0[1]); w.y = cvt_pk_bf16(v0[2], v0[3]); w.z = cvt_pk_bf16(v1[0], v1[1]); w.w = cvt_pk_bf16(v1[2], v1[3]);
                    *(u32x4*)(rowp + bj * HALF) = w; } }
    }
};
struct EpiResid {
    static constexpr bool PERM = false;
    const float* baseC; const float* baseL; float* out; const float* gateC; const float* gateL;
    __device__ __forceinline__ void operator()(const f32x4 (&acc)[2][2][4][2], const Unit& u, int wr, int wc, int fr, int fq) const {
        const int rl = wr * 64 + fr, col0 = u.pn * BM + wc * 32 + 4 * fq;
        const float* bp = (u.pm == 0) ? baseC : baseL + (size_t)(u.pm - 1) * BM * 1024;
        const float* gp = (u.pm == 0) ? gateC : gateL;
        f32x4 gv[2][2];
#pragma unroll
        for (int bj = 0; bj < 2; ++bj)
#pragma unroll
            for (int n = 0; n < 2; ++n) gv[bj][n] = *(const f32x4*)(gp + col0 + bj * HALF + n * 16);
#pragma unroll
        for (int ai = 0; ai < 2; ++ai)
#pragma unroll
            for (int m = 0; m < 4; ++m) { const int r = rl + ai * HALF + m * 16; const float* brow = bp + (size_t)r * 1024 + col0; float* orow = out + ((size_t)u.pm * BM + r) * 1024 + col0;
#pragma unroll
                for (int bj = 0; bj < 2; ++bj)
#pragma unroll
                    for (int n = 0; n < 2; ++n) { const f32x4 b = *(const f32x4*)(brow + bj * HALF + n * 16); *(f32x4*)(orow + bj * HALF + n * 16) = b + gv[bj][n] * acc[ai][bj][m][n]; } }
    }
};
struct EpiSwiGLU {
    static constexpr bool PERM = true;
    bf16_t* O;
    __device__ __forceinline__ void operator()(const f32x4 (&acc)[2][2][4][2], const Unit& u, int wr, int wc, int fr, int fq) const {
        const int row0 = u.pm * BM + wr * 64 + fr; const int col0 = (u.pn & 15) * HALF + wc * 32 + 8 * fq;
#pragma unroll
        for (int ai = 0; ai < 2; ++ai)
#pragma unroll
            for (int m = 0; m < 4; ++m) { bf16_t* rowp = O + (size_t)(row0 + ai * HALF + m * 16) * 2048 + col0; float h[8];
#pragma unroll
                for (int n = 0; n < 2; ++n)
#pragma unroll
                    for (int j = 0; j < 4; ++j) { const float a = acc[ai][0][m][n][j], b = acc[ai][1][m][n][j]; h[n * 4 + j] = a * b * __builtin_amdgcn_rcpf(1.0f + __builtin_amdgcn_exp2f(-1.4426950408889634f * a)); }
                u32x4 w; w.x = cvt_pk_bf16(h[0], h[1]); w.y = cvt_pk_bf16(h[2], h[3]); w.z = cvt_pk_bf16(h[4], h[5]); w.w = cvt_pk_bf16(h[6], h[7]);
                *(u32x4*)rowp = w; }
    }
};
struct EpiGateRow {
    static constexpr bool PERM = true;
    bf16_t* O; const float* gate;
    __device__ __forceinline__ void operator()(const f32x4 (&acc)[2][2][4][2], const Unit& u, int wr, int wc, int fr, int fq) const {
        const int row0 = u.pm * BM + wr * 64 + fr; const int col0 = (u.pn & 3) * BM + wc * 32 + 8 * fq;
#pragma unroll
        for (int ai = 0; ai < 2; ++ai)
#pragma unroll
            for (int m = 0; m < 4; ++m) { const int r = row0 + ai * HALF + m * 16; const float gt = gate[r]; bf16_t* rowp = O + (size_t)r * 1024 + col0;
#pragma unroll
                for (int bj = 0; bj < 2; ++bj) { const f32x4 v0 = acc[ai][bj][m][0] * gt, v1 = acc[ai][bj][m][1] * gt;
                    u32x4 w; w.x = cvt_pk_bf16(v0[0], v0[1]); w.y = cvt_pk_bf16(v0[2], v0[3]); w.z = cvt_pk_bf16(v1[0], v1[1]); w.w = cvt_pk_bf16(v1[2], v1[3]);
                    *(u32x4*)(rowp + bj * HALF) = w; } }
    }
};

template <class Epi, class Sched, bool ALIGN_EPI, bool GATHER>
__device__ __forceinline__ void gemm_phase(PG8_LAS unsigned char* lds, const Gemm g, const Sched& S, const Epi& E, const int tid) {
    const int wid = __builtin_amdgcn_readfirstlane(tid >> 6), lane = tid & 63, wr = wid >> 2, wc = wid & 3, fr = lane & 15, fq = lane >> 4;
    const int K = g.K, nt = K / BK;
    unsigned voffA[2], voffB[2]; int RA[2];
#pragma unroll
    for (int i = 0; i < 2; ++i) { int R, C; stage_rc(tid * 16 + i * 8192, R, C); const int Rb = Epi::PERM ? ((R & ~31) + perm32(R & 31)) : R;
        voffA[i] = GATHER ? (unsigned)(C * 2) : (unsigned)(R * K + C) * 2u; voffB[i] = (unsigned)(Rb * K + C) * 2u; RA[i] = R; }
    const size_t kstep = (size_t)(BK * 2);
    const size_t hstep = (size_t)HALF * K * 2;
    const size_t tstep = 2 * hstep;
    const unsigned ldsw = (unsigned)wid * 1024u;
    const int aoff = lds_byte(wr * 64 + fr, fq * 8), boff = lds_byte(wc * 32 + fr, fq * 8);
#define PG8_SA(b, h) (((b) * 2 + (h)) * HTB)
#define PG8_SB(b, h) ((4 + (b) * 2 + (h)) * HTB)
#define PG8_STAGE(bufoff, gbase, voff) do { _Pragma("unroll") for (int _i = 0; _i < 2; ++_i) \
        __builtin_amdgcn_global_load_lds((const unsigned*)((const char*)(gbase) + (voff)[_i]), (PG8_LAS unsigned*)(lds + (bufoff) + ldsw + _i * 8192), 16, 0, 0); } while (0)
#define PG8_LDA(dst, b, h) do { _Pragma("unroll") for (int m = 0; m < 4; ++m) _Pragma("unroll") for (int k = 0; k < 2; ++k) dst[m][k] = *(const PG8_LAS bf16x8*)(lds + PG8_SA(b, h) + aoff + m * 2048 + k * 1024); } while (0)
#define PG8_LDB(dst, b, h) do { _Pragma("unroll") for (int n = 0; n < 2; ++n) _Pragma("unroll") for (int k = 0; k < 2; ++k) dst[n][k] = *(const PG8_LAS bf16x8*)(lds + PG8_SB(b, h) + boff + n * 2048 + k * 1024); } while (0)
#define PG8_MMA(ai, bj, At, Bt) do { __builtin_amdgcn_s_setprio(1); _Pragma("unroll") for (int m = 0; m < 4; ++m) _Pragma("unroll") for (int n = 0; n < 2; ++n) _Pragma("unroll") for (int k = 0; k < 2; ++k) \
        acc[ai][bj][m][n] = __builtin_amdgcn_mfma_f32_16x16x32_bf16(Bt[n][k], At[m][k], acc[ai][bj][m][n], 0, 0, 0); __builtin_amdgcn_s_setprio(0); } while (0)
#define PG8_WAIT_V(n) asm volatile("s_waitcnt vmcnt(" #n ")" ::: "memory")
#define PG8_WAIT_L(n) asm volatile("s_waitcnt lgkmcnt(" #n ")" ::: "memory")
#define PG8_BAR __builtin_amdgcn_s_barrier()
#define PG8_SCHED __builtin_amdgcn_sched_barrier(0)
    Unit cur, nxt; int ui = 0;
    if (!S.next(0, cur)) return;
    f32x4 acc[2][2][4][2];
#pragma unroll
    for (int a = 0; a < 2; ++a)
#pragma unroll
        for (int b = 0; b < 2; ++b)
#pragma unroll
            for (int m = 0; m < 4; ++m)
#pragma unroll
                for (int n = 0; n < 2; ++n) acc[a][b][m][n] = (f32x4){0.f, 0.f, 0.f, 0.f};
    bf16x8 At[4][2], B0[2][2], B1[2][2];
    unsigned gC0[2], gC1[2], gN0[2], gN1[2];
    const char* cA; const char* cB = (const char*)g.Bt + (size_t)cur.pn * tstep;
    if constexpr (GATHER) {
        cA = (const char*)g.A;
#pragma unroll
        for (int i = 0; i < 2; ++i) { gC0[i] = (unsigned)g.gidx[cur.pm * BM + RA[i]] * (unsigned)(K * 2) + voffA[i]; gC1[i] = (unsigned)g.gidx[cur.pm * BM + HALF + RA[i]] * (unsigned)(K * 2) + voffA[i]; gN0[i] = gC0[i]; gN1[i] = gC1[i]; }
    } else { cA = (const char*)g.A + (size_t)cur.pm * tstep; }
#define PG8_STA0(bufoff, ptr) do { if constexpr (GATHER) PG8_STAGE(bufoff, ptr, gC0); else PG8_STAGE(bufoff, ptr, voffA); } while (0)
#define PG8_STA1(bufoff, ptr) do { if constexpr (GATHER) PG8_STAGE(bufoff, ptr, gC1); else PG8_STAGE(bufoff, (ptr) + hstep, voffA); } while (0)
#define PG8_STX0(bufoff, ptr) do { if constexpr (GATHER) PG8_STAGE(bufoff, ptr, gX0); else PG8_STAGE(bufoff, ptr, voffA); } while (0)
#define PG8_STX1(bufoff, ptr) do { if constexpr (GATHER) PG8_STAGE(bufoff, ptr, gX1); else PG8_STAGE(bufoff, (ptr) + hstep, voffA); } while (0)
    PG8_STAGE(PG8_SB(0, 0), cB, voffB); PG8_STAGE(PG8_SB(0, 1), cB + hstep, voffB); PG8_STA0(PG8_SA(0, 0), cA); PG8_STA1(PG8_SA(0, 1), cA);
    if (wr == 1) PG8_BAR;
    PG8_WAIT_V(2); PG8_BAR;
    PG8_STAGE(PG8_SB(1, 0), cB + kstep, voffB); PG8_STA0(PG8_SA(1, 0), cA + kstep); PG8_STAGE(PG8_SB(1, 1), cB + hstep + kstep, voffB);
    PG8_WAIT_V(6); PG8_BAR;
    for (;;) {
        const bool has_next = S.next(ui + 1, nxt);
        const char* nA; const char* nB = has_next ? (const char*)g.Bt + (size_t)nxt.pn * tstep : cB;
        if constexpr (GATHER) {
            nA = cA;
            if (has_next) {
#pragma unroll
                for (int i = 0; i < 2; ++i) { gN0[i] = (unsigned)g.gidx[nxt.pm * BM + RA[i]] * (unsigned)(K * 2) + voffA[i]; gN1[i] = (unsigned)g.gidx[nxt.pm * BM + HALF + RA[i]] * (unsigned)(K * 2) + voffA[i]; }
            }
        } else { nA = has_next ? (const char*)g.A + (size_t)nxt.pm * tstep : cA; }
        for (int t = 0; t < nt; t += 2) {
            const bool last = (t == nt - 2);
            const char* a1 = cA + (size_t)(t + 1) * kstep;
            const char* a2 = last ? nA : cA + (size_t)(t + 2) * kstep; const char* b2 = last ? nB : cB + (size_t)(t + 2) * kstep;
            const char* a3 = a2 + kstep; const char* b3 = b2 + kstep;
            unsigned gX0[2], gX1[2];
            if constexpr (GATHER) {
#pragma unroll
                for (int i = 0; i < 2; ++i) { gX0[i] = last ? gN0[i] : gC0[i]; gX1[i] = last ? gN1[i] : gC1[i]; }
            }
            PG8_LDB(B0, 0, 0); PG8_LDB(B1, 0, 1); PG8_SCHED; PG8_LDA(At, 0, 0); PG8_STA1(PG8_SA(1, 1), a1);
            PG8_WAIT_V(8); PG8_WAIT_L(0); PG8_BAR; PG8_MMA(0, 0, At, B0); PG8_MMA(0, 1, At, B1); PG8_BAR; PG8_SCHED;
            PG8_LDA(At, 0, 1); PG8_STAGE(PG8_SB(0, 0), b2, voffB); PG8_STAGE(PG8_SB(0, 1), b2 + hstep, voffB); PG8_STX0(PG8_SA(0, 0), a2);
            PG8_WAIT_V(8); PG8_WAIT_L(0); PG8_BAR; PG8_MMA(1, 0, At, B0); PG8_MMA(1, 1, At, B1); PG8_BAR; PG8_SCHED;
            PG8_LDB(B0, 1, 0); PG8_LDB(B1, 1, 1); PG8_SCHED; PG8_LDA(At, 1, 0); PG8_STX1(PG8_SA(0, 1), a2);
            PG8_WAIT_V(8); PG8_WAIT_L(0); PG8_BAR; PG8_MMA(0, 0, At, B0); PG8_MMA(0, 1, At, B1); PG8_BAR; PG8_SCHED;
            PG8_LDA(At, 1, 1); PG8_STAGE(PG8_SB(1, 0), b3, voffB); PG8_STAGE(PG8_SB(1, 1), b3 + hstep, voffB); PG8_STX0(PG8_SA(1, 0), a3);
            PG8_WAIT_V(8); PG8_WAIT_L(0); PG8_BAR; PG8_MMA(1, 0, At, B0); PG8_MMA(1, 1, At, B1); PG8_BAR; PG8_SCHED;
        }
        if constexpr (ALIGN_EPI) { if (wr == 0) PG8_BAR; }
        E(acc, cur, wr, wc, fr, fq);
        if (!has_next) break;
#pragma unroll
        for (int a = 0; a < 2; ++a)
#pragma unroll
            for (int b = 0; b < 2; ++b)
#pragma unroll
                for (int m = 0; m < 4; ++m)
#pragma unroll
                    for (int n = 0; n < 2; ++n) acc[a][b][m][n] = (f32x4){0.f, 0.f, 0.f, 0.f};
        cur = nxt; cA = nA; cB = nB; ++ui;
        if constexpr (GATHER) {
#pragma unroll
            for (int i = 0; i < 2; ++i) { gC0[i] = gN0[i]; gC1[i] = gN1[i]; }
        }
        if constexpr (ALIGN_EPI) { if (wr == 1) PG8_BAR; }
    }
    PG8_WAIT_V(0);
    if constexpr (!ALIGN_EPI) { if (wr == 0) PG8_BAR; }
    PG8_BAR;
#undef PG8_SA
#undef PG8_SB
#undef PG8_STAGE
#undef PG8_STA0
#undef PG8_STA1
#undef PG8_STX0
#undef PG8_STX1
#undef PG8_LDA
#undef PG8_LDB
#undef PG8_MMA
#undef PG8_WAIT_V
#undef PG8_WAIT_L
#undef PG8_BAR
#undef PG8_SCHED
}
}
namespace attn_body {
using bf16=__hip_bfloat16;
using bf16x8=__attribute__((ext_vector_type(8)))short;
using s16x4=__attribute__((ext_vector_type(4)))short;
using f32x16=__attribute__((ext_vector_type(16)))float;
using u32x4=__attribute__((ext_vector_type(4)))unsigned;
constexpr int D=64,QP=256,KP=128,VP=128,OP=1024;
constexpr int NW=8,QBLK=32,QB=QBLK*NW,KVBLK=64;
__device__ __forceinline__ int crow(int r,int hi){return (r&3)+8*(r>>2)+4*hi;}
#define SBAR() __builtin_amdgcn_sched_barrier(0)
__device__ __forceinline__ void cmask(f32x16&p0,f32x16&p1,int jb,int qrel,int hi){
  const float NEG=-INFINITY; int kb=64*jb+4*hi;
  #pragma unroll
  for(int r=0;r<16;++r){int kv=kb+(r&3)+8*(r>>2); if(kv>qrel)p0[r]=NEG; if(kv+32>qrel)p1[r]=NEG;}
}

constexpr int NSLOT=3, SLOTB=8192;
constexpr int LDS_K=0, LDS_V=NSLOT*SLOTB, LDS_WS=2*NSLOT*SLOTB, LDS_OST=LDS_WS+NW*64*4, LDS_BYTES=LDS_OST+NW*4096;
constexpr float C2=0.125f*1.4426950408889634f;
__device__ __forceinline__ void glds16(const void*gsrc,unsigned lds_dst){unsigned keep;
  asm volatile("s_mov_b32 %0, m0\n\ts_mov_b32 m0, %2\n\ts_nop 0\n\tglobal_load_lds_dwordx4 %1, off\n\ts_mov_b32 m0, %0":"=&s"(keep):"v"(gsrc),"s"(lds_dst):"memory");}
__device__ __forceinline__ float max3f(float a,float b,float c){float r;asm("v_max3_f32 %0, %1, %2, %3":"=v"(r):"v"(a),"v"(b),"v"(c));return r;}
__device__ __forceinline__ float max2f(float a,float b){float r;asm("v_max_f32_e32 %0, %1, %2":"=v"(r):"v"(a),"v"(b));return r;}
__device__ __forceinline__ float fadd_s(float a,float b){float r;asm("v_add_f32_e32 %0, %1, %2":"=v"(r):"v"(a),"v"(b));return r;}
__device__ __forceinline__ float fsub_s(float a,float b){float r;asm("v_sub_f32_e32 %0, %1, %2":"=v"(r):"v"(a),"v"(b));return r;}
typedef float f32x2_t __attribute__((ext_vector_type(2))); typedef __bf16 bf16x2_t __attribute__((ext_vector_type(2)));
__device__ __forceinline__ unsigned cvtpk_s(float lo,float hi){f32x2_t v={lo,hi};bf16x2_t b=__builtin_convertvector(v,bf16x2_t);return __builtin_bit_cast(unsigned,b);}
#define WAIT_BAR(N) asm volatile("s_waitcnt vmcnt(" #N ") lgkmcnt(0)\n\ts_barrier":::"memory")

__device__ __forceinline__ void qkt(f32x16&p0,f32x16&p1,const char*Kslot,const bf16x8*qr,const f32x16&negm,int r32,int hi){
  const char*kb=Kslot+hi*1024+r32*16;
  #pragma unroll
  for(int d0=0;d0<4;++d0){
    const bf16x8 b0=*reinterpret_cast<const bf16x8*>(kb+d0*2048);
    const bf16x8 b1=*reinterpret_cast<const bf16x8*>(kb+d0*2048+512);
    if(d0==0){p0=__builtin_amdgcn_mfma_f32_32x32x16_bf16(b0,qr[0],negm,0,0,0);p1=__builtin_amdgcn_mfma_f32_32x32x16_bf16(b1,qr[0],negm,0,0,0);}
    else{p0=__builtin_amdgcn_mfma_f32_32x32x16_bf16(b0,qr[d0],p0,0,0,0);p1=__builtin_amdgcn_mfma_f32_32x32x16_bf16(b1,qr[d0],p1,0,0,0);}}
}
typedef __attribute__((address_space(3))) const char* lds_cptr;
typedef short v4i16_t __attribute__((ext_vector_type(4)));
__device__ __forceinline__ void kload8(bf16x8*kf,lds_cptr kp){
  kf[0]=*(const __attribute__((address_space(3))) bf16x8*)(kp);      kf[1]=*(const __attribute__((address_space(3))) bf16x8*)(kp+512);
  kf[2]=*(const __attribute__((address_space(3))) bf16x8*)(kp+2048); kf[3]=*(const __attribute__((address_space(3))) bf16x8*)(kp+2560);
  kf[4]=*(const __attribute__((address_space(3))) bf16x8*)(kp+4096); kf[5]=*(const __attribute__((address_space(3))) bf16x8*)(kp+4608);
  kf[6]=*(const __attribute__((address_space(3))) bf16x8*)(kp+6144); kf[7]=*(const __attribute__((address_space(3))) bf16x8*)(kp+6656);
}
__device__ __forceinline__ void kload2(bf16x8*kf,lds_cptr kp,int j){ kf[2*j]=*(const __attribute__((address_space(3))) bf16x8*)(kp+j*2048); kf[2*j+1]=*(const __attribute__((address_space(3))) bf16x8*)(kp+j*2048+512); }
__device__ __forceinline__ s16x4 vtr(lds_cptr p){ return __builtin_bit_cast(s16x4,__builtin_amdgcn_ds_read_tr16_b64_v4i16((__attribute__((address_space(3))) v4i16_t*)p)); }
__device__ __forceinline__ float rowmax(const f32x16&p0,const f32x16&p1){
  float a=max3f(p0[0],p0[1],p1[0]),b=max3f(p0[2],p0[3],p1[1]);a=max3f(a,p1[2],p1[3]);
  #pragma unroll
  for(int r=4;r<16;r+=4){a=max3f(a,p0[r],p0[r+1]);b=max3f(b,p0[r+2],p0[r+3]);a=max3f(a,p1[r],p1[r+1]);b=max3f(b,p1[r+2],p1[r+3]);}
  const float m=max2f(a,b);
  auto rr=__builtin_amdgcn_permlane32_swap(__float_as_uint(m),__float_as_uint(m),false,false);
  return max2f(__uint_as_float(rr[0]),__uint_as_float(rr[1]));
}
__device__ __forceinline__ void pv(f32x16*o,int vb,bf16x8 pa0,bf16x8 pa1,bf16x8 pa2,bf16x8 pa3){
  #pragma unroll
  for(int d0=0;d0<2;++d0){s16x4 lo[4],hi[4];
    #pragma unroll
    for(int ks=0;ks<4;++ks){
      asm volatile("ds_read_b64_tr_b16 %0,%1 offset:%c2":"=&v"(lo[ks]):"v"(vb),"i"(d0*4096+ks*1024):"memory");
      asm volatile("ds_read_b64_tr_b16 %0,%1 offset:%c2":"=&v"(hi[ks]):"v"(vb),"i"(d0*4096+ks*1024+512):"memory");}
    asm volatile("s_waitcnt lgkmcnt(0)":::"memory");SBAR();
    #define PK(k) (bf16x8){lo[k][0],lo[k][1],lo[k][2],lo[k][3],hi[k][0],hi[k][1],hi[k][2],hi[k][3]}
    o[d0]=__builtin_amdgcn_mfma_f32_32x32x16_bf16(pa0,PK(0),o[d0],0,0,0);
    o[d0]=__builtin_amdgcn_mfma_f32_32x32x16_bf16(pa1,PK(1),o[d0],0,0,0);
    o[d0]=__builtin_amdgcn_mfma_f32_32x32x16_bf16(pa2,PK(2),o[d0],0,0,0);
    o[d0]=__builtin_amdgcn_mfma_f32_32x32x16_bf16(pa3,PK(3),o[d0],0,0,0);
    #undef PK
  }
}

#ifndef ATTN_STORE16
#define ATTN_STORE16(p,v) (*(u32x4*)(p)=(v))
#endif
template<int THRL> __device__ __forceinline__ void attn_unit(const bf16*Qu,const bf16*__restrict__ Kh,const bf16*__restrict__ Vh,bf16*Ou,const int NT,char*shm,const int tid){
  const int lane=tid&63,r32=lane&31,hi=lane>>5; const int wid=__builtin_amdgcn_readfirstlane(tid>>6);
  const bf16*Qw=Qu+(long)(wid*QBLK)*QP;
  const unsigned lds0=(unsigned)(uintptr_t)shm;
  float*wsf=(float*)(shm+LDS_WS)+wid*64;
  const bf16*ksrc=Kh+(long)lane*KP+wid*8;
  const bf16*vsrc=Vh+(long)(16*(wid&3)+(lane>>2))*VP+(wid>>2)*32+(lane&3)*8;
  const unsigned kdst=lds0+LDS_K+wid*1024, vdst=lds0+LDS_V+wid*1024;
  #define DMA_K(t,slot) glds16(ksrc+(long)(t)*KVBLK*KP,(unsigned)__builtin_amdgcn_readfirstlane(kdst+(slot)))
  #define DMA_V(t,slot) glds16(vsrc+(long)(t)*KVBLK*VP,(unsigned)__builtin_amdgcn_readfirstlane(vdst+(slot)))
  const int vb0=(int)(lds0+LDS_V)+((lane>>4)&1)*32+(lane&3)*8+(4*hi+((lane&15)>>2))*64;
  const char*Kbase=shm+LDS_K; bf16x8 kf[8];
  const lds_cptr shm3=(lds_cptr)shm; const lds_cptr kp0=shm3+LDS_K+hi*1024+r32*16; const lds_cptr vp0=shm3+LDS_V+((lane>>4)&1)*32+(lane&3)*8+(4*hi+((lane&15)>>2))*64;
  DMA_K(0,0);DMA_V(0,0);DMA_K(1,SLOTB);
  bf16x8 qr[4];
  #pragma unroll
  for(int d0=0;d0<4;++d0)qr[d0]=*reinterpret_cast<const bf16x8*>(&Qw[(long)r32*QP+d0*16+hi*8]);
  float mhat=0.f,l_reg=0.f;f32x16 o[2];o[0]=f32x16{};o[1]=f32x16{};f32x16 negm=f32x16{};asm volatile("":"+v"(negm));
  #define CMASK(P0,P1,t) do{}while(0)
  bool resc=false;
  #define START(P0,P1) do{ const float rm=rowmax(P0,P1); resc=false; \
    { const float dl=rm; mhat=fadd_s(mhat,dl); \
      _Pragma("unroll") for(int r=0;r<16;++r){P0[r]=fsub_s(P0[r],dl);P1[r]=fsub_s(P1[r],dl);} \
      _Pragma("unroll") for(int r=0;r<16;++r)negm[r]=-mhat; asm volatile("":"+v"(negm)); } \
    _Pragma("unroll") for(int r=0;r<16;++r)P0[r]=__builtin_amdgcn_exp2f(P0[r]); }while(0)
  #define RESC() do{ if(resc){ asm volatile("s_waitcnt lgkmcnt(0)":::"memory"); \
      _Pragma("unroll") for(int d_=0;d_<2;++d_) _Pragma("unroll") for(int r=0;r<16;++r)o[d_][r]*=wsf[crow(r,hi)]; } }while(0)
  f32x16 pA0,pA1,pB0,pB1;
  int sl_prev=0,sl_cur=0,sl_next=SLOTB;
  #define ROT() do{sl_prev=sl_cur;sl_cur=sl_next;sl_next=(sl_next==(NSLOT-1)*SLOTB)?0:sl_next+SLOTB;}while(0)
  DMA_K(2,2*SLOTB);
  WAIT_BAR(3);
  qkt(pA0,pA1,Kbase,qr,negm,r32,hi);asm volatile("s_nop 15\n\ts_nop 7":"+v"(pA0),"+v"(pA1));CMASK(pA0,pA1,0);
  START(pA0,pA1);
  _Pragma("unroll") for(int r=0;r<16;++r)pA1[r]=__builtin_amdgcn_exp2f(pA1[r]);
  WAIT_BAR(0);
  DMA_K(3,0);DMA_V(1,SLOTB);
  ROT();
  kload8(kf,kp0+sl_cur);
  WAIT_BAR(2);
  s16x4 vlo[8],vhi[8]; u32x4 pw0,pw1,pw2,pw3;
  #define PKW(P,B) cvtpk_s(P[B],P[B+1])
  #define PAF(k) __builtin_bit_cast(bf16x8,pw##k)
  #define VFR(i) (bf16x8){vlo[i][0],vlo[i][1],vlo[i][2],vlo[i][3],vhi[i][0],vhi[i][1],vhi[i][2],vhi[i][3]}
  #define PIN(x) asm volatile("":"+v"(x))
  #define MX3(a,b,c) __builtin_fmaxf(__builtin_fmaxf((a),(b)),(c))
  #define GAPA(MF,A0,A1,A2,A3,W0,W1,PW) do{ MF; sacc+=A0; sacc+=A1; sacc+=A2; sacc+=A3; PIN(sacc); W0; W1; PIN(PW); SBAR(); }while(0)
  #define EX(v) __builtin_amdgcn_exp2f(v)
  #define GAPB(MF,X,B) do{ MF; X[B]=EX(X[B]); X[B+1]=EX(X[B+1]); X[B+2]=EX(X[B+2]); X[B+3]=EX(X[B+3]); PIN(X); SBAR(); }while(0)
  #define VRD(i) do{ vlo[i]=vtr(vp_+(((i)>>2)*4096+((i)&3)*1024)); vhi[i]=vtr(vp_+(((i)>>2)*4096+((i)&3)*1024+512)); }while(0)
  #define KRD(G,j) do{ if(G){ kload2(kf,kp0+sl_next,j); SBAR(); } }while(0)
  #define STEP(C0,C1,P0,P1,t,GK,GV,GL) do{ SBAR(); \
    const lds_cptr vp_=vp0+sl_prev; \
    VRD(0); SBAR(); float sacc=(P0[0]+P0[1]); \
    GAPA(C0=__builtin_amdgcn_mfma_f32_32x32x16_bf16(kf[0],qr[0],negm,0,0,0), P0[2],P0[3],P0[4],P0[5],     pw0[0]=PKW(P0,0), pw0[1]=PKW(P0,2), pw0); \
    VRD(4); SBAR(); GAPA(C1=__builtin_amdgcn_mfma_f32_32x32x16_bf16(kf[1],qr[0],negm,0,0,0), P0[6],P0[7],P0[8],P0[9],     pw0[2]=PKW(P0,4), pw0[3]=PKW(P0,6), pw0); \
    VRD(1); SBAR(); GAPA(C0=__builtin_amdgcn_mfma_f32_32x32x16_bf16(kf[2],qr[1],C0,0,0,0),   P0[10],P0[11],P0[12],P0[13], pw1[0]=PKW(P0,8), pw1[1]=PKW(P0,10), pw1); \
    VRD(5); SBAR(); GAPA(C1=__builtin_amdgcn_mfma_f32_32x32x16_bf16(kf[3],qr[1],C1,0,0,0),   P0[14],P0[15],P1[0],P1[1],   pw1[2]=PKW(P0,12),pw1[3]=PKW(P0,14), pw1); \
    VRD(2); SBAR(); GAPA(C0=__builtin_amdgcn_mfma_f32_32x32x16_bf16(kf[4],qr[2],C0,0,0,0),   P1[2],P1[3],P1[4],P1[5],     pw2[0]=PKW(P1,0), pw2[1]=PKW(P1,2), pw2); \
    VRD(6); SBAR(); GAPA(C1=__builtin_amdgcn_mfma_f32_32x32x16_bf16(kf[5],qr[2],C1,0,0,0),   P1[6],P1[7],P1[8],P1[9],     pw2[2]=PKW(P1,4), pw2[3]=PKW(P1,6), pw2); \
    VRD(3); SBAR(); GAPA(C0=__builtin_amdgcn_mfma_f32_32x32x16_bf16(kf[6],qr[3],C0,0,0,0),   P1[10],P1[11],P1[12],P1[13], pw3[0]=PKW(P1,8), pw3[1]=PKW(P1,10), pw3); \
    VRD(7); SBAR(); GAPA(C1=__builtin_amdgcn_mfma_f32_32x32x16_bf16(kf[7],qr[3],C1,0,0,0),   P1[14],P1[15],0.f,0.f,       pw3[2]=PKW(P1,12),pw3[3]=PKW(P1,14), pw3); \
    l_reg+=sacc; \
    if(GK){DMA_K((t)+3,sl_cur);} if(GV){DMA_V((t)+1,sl_next);} \
    CMASK(C0,C1,t); \
    { float a=MX3(C0[0],C0[1],C1[0]),b=MX3(C0[2],C0[3],C1[1]); a=MX3(a,C1[2],C1[3]); \
      _Pragma("unroll") for(int r=4;r<16;r+=4){a=MX3(a,C0[r],C0[r+1]);b=MX3(b,C0[r+2],C0[r+3]);a=MX3(a,C1[r],C1[r+1]);b=MX3(b,C1[r+2],C1[r+3]);} \
      float rm=__builtin_fmaxf(a,b); { auto rr=__builtin_amdgcn_permlane32_swap(__float_as_uint(rm),__float_as_uint(rm),false,false); rm=__builtin_fmaxf(__uint_as_float(rr[0]),__uint_as_float(rr[1])); } \
      resc=false; \
      if(__builtin_expect(__any(rm>(float)THRL),0)){ const float dl=__builtin_fmaxf(rm,0.f); mhat+=dl; \
        _Pragma("unroll") for(int r=0;r<16;++r){C0[r]-=dl;C1[r]-=dl;} \
        _Pragma("unroll") for(int r=0;r<16;++r)negm[r]=-mhat; asm volatile("":"+v"(negm)); \
        const float f=__builtin_amdgcn_exp2f(-dl); l_reg*=f; if(hi==0)wsf[r32]=f; resc=true; } } \
    SBAR(); \
    GAPB(o[0]=__builtin_amdgcn_mfma_f32_32x32x16_bf16(PAF(0),VFR(0),o[0],0,0,0), C0,0); \
    GAPB(o[1]=__builtin_amdgcn_mfma_f32_32x32x16_bf16(PAF(0),VFR(4),o[1],0,0,0), C0,4); \
    KRD(GL,0); GAPB(o[0]=__builtin_amdgcn_mfma_f32_32x32x16_bf16(PAF(1),VFR(1),o[0],0,0,0), C0,8); \
    KRD(GL,1); GAPB(o[1]=__builtin_amdgcn_mfma_f32_32x32x16_bf16(PAF(1),VFR(5),o[1],0,0,0), C0,12); \
    KRD(GL,2); GAPB(o[0]=__builtin_amdgcn_mfma_f32_32x32x16_bf16(PAF(2),VFR(2),o[0],0,0,0), C1,0); \
    KRD(GL,3); GAPB(o[1]=__builtin_amdgcn_mfma_f32_32x32x16_bf16(PAF(2),VFR(6),o[1],0,0,0), C1,4); \
    GAPB(o[0]=__builtin_amdgcn_mfma_f32_32x32x16_bf16(PAF(3),VFR(3),o[0],0,0,0), C1,8); \
    GAPB(o[1]=__builtin_amdgcn_mfma_f32_32x32x16_bf16(PAF(3),VFR(7),o[1],0,0,0), C1,12); \
    }while(0)
  int t=1;
  #undef CMASK
  #define CMASK(P0,P1,t) do{}while(0)
  for(;t+5<NT;t+=2){
    STEP(pB0,pB1,pA0,pA1,t,true,true,true);     WAIT_BAR(2); RESC(); ROT();
    STEP(pA0,pA1,pB0,pB1,t+1,true,true,true);   WAIT_BAR(2); RESC(); ROT();
  }
  #undef CMASK
  #define CMASK(P0,P1,t) do{}while(0)
  #define ENDW(tt) do{ if((tt)+3<NT){WAIT_BAR(2);} else if((tt)+2<NT){WAIT_BAR(1);} else {WAIT_BAR(0);} }while(0)
  for(;t+1<NT;t+=2){
    STEP(pB0,pB1,pA0,pA1,t,(t+3<NT),(t+1<NT),(t+1<NT));       ENDW(t);   RESC(); ROT();
    STEP(pA0,pA1,pB0,pB1,t+1,(t+4<NT),(t+2<NT),(t+2<NT));     ENDW(t+1); RESC(); ROT();
  }
  STEP(pB0,pB1,pA0,pA1,NT-1,false,false,false); RESC();
  { float sacc=pB0[0]+pB0[1]; _Pragma("unroll") for(int r=2;r<16;++r)sacc+=pB0[r]; _Pragma("unroll") for(int r=0;r<16;++r)sacc+=pB1[r]; l_reg+=sacc;
    pw0=(u32x4){PKW(pB0,0),PKW(pB0,2),PKW(pB0,4),PKW(pB0,6)};pw1=(u32x4){PKW(pB0,8),PKW(pB0,10),PKW(pB0,12),PKW(pB0,14)};pw2=(u32x4){PKW(pB1,0),PKW(pB1,2),PKW(pB1,4),PKW(pB1,6)};pw3=(u32x4){PKW(pB1,8),PKW(pB1,10),PKW(pB1,12),PKW(pB1,14)};
    SBAR(); pv(o,vb0+sl_cur,PAF(0),PAF(1),PAF(2),PAF(3)); }
  #undef PKW
  #undef PAF
  #undef VFR
  #undef PIN
  #undef MX3
  #undef GAPA
  #undef GAPB
  #undef EX
  #undef VRD
  #undef KRD
  #undef STEP
  #undef ENDW
  {auto rr=__builtin_amdgcn_permlane32_swap(__float_as_uint(l_reg),__float_as_uint(l_reg),false,false);l_reg=__uint_as_float(rr[0])+__uint_as_float(rr[1]);}
  if(hi==0)wsf[32+r32]=l_reg;asm volatile("s_waitcnt lgkmcnt(0)":::"memory");
  float rli[16];
  #pragma unroll
  for(int r=0;r<16;++r)rli[r]=__builtin_amdgcn_rcpf(wsf[32+crow(r,hi)]);
  bf16*Ow=Ou+(long)(wid*QBLK)*OP;
  { bf16*stg=(bf16*)(shm+LDS_OST)+wid*2048;
    #pragma unroll
    for(int r=0;r<16;++r){const int orow=crow(r,hi);
      #pragma unroll
      for(int d0=0;d0<2;++d0)stg[orow*64+d0*32+r32]=__float2bfloat16(o[d0][r]*rli[r]);}
    asm volatile("s_waitcnt lgkmcnt(0)":::"memory");
    #pragma unroll
    for(int i=0;i<4;++i){const int row=i*8+(lane>>3),ch=lane&7; const u32x4 v=*(const u32x4*)(stg+row*64+ch*8); ATTN_STORE16(Ow+(long)row*OP+ch*8,v);} }
  asm volatile("s_waitcnt lgkmcnt(0)\n\ts_barrier":::"memory");
  #undef DMA_K
  #undef DMA_V
  #undef CMASK
  #undef START
  #undef RESC
  #undef ROT
}
constexpr int ATTN_LDS_BYTES=LDS_BYTES;
#undef SBAR
#undef WAIT_BAR
}
constexpr int NWAVES = 8, NTHR = 512;
constexpr int DM = 1024, SEQL = 16384, CTXL = 256, R = SEQL + CTXL;
constexpr int DIN = 2832, NZ = 2816;
constexpr int NEXP = 16, FF = 2048, CAPL = 2048, CAPC = 32, ESLOTS = 2304;
constexpr int NCHUNK = R / 128;
constexpr float EPSN = 1e-6f;
constexpr int ZC_CONVX = 0, ZC_CONVB = 256, ZC_CONVC = 512, ZC_CU = 768, ZC_CV = 1024, ZC_Q = 1280, ZC_K = 1536, ZC_V = 1664, ZC_MQ = 1792, ZC_MK = 2048, ZC_MV = 2304, ZC_MO = 2560;

constexpr size_t MiB = 1u << 20;
constexpr size_t WS_CTL = 0;
constexpr size_t WS_MOD = 1 * MiB;
constexpr size_t WS_ROPE = WS_MOD + 256 * 1024;
constexpr size_t WS_WIN = 2 * MiB;
constexpr size_t WS_WOUT = 14 * MiB;
constexpr size_t WS_W13 = 18 * MiB;
constexpr size_t WS_W2 = 274 * MiB;
constexpr size_t WS_XW = 402 * MiB;
constexpr size_t WS_H = 467 * MiB;
constexpr size_t WS_H2 = 500 * MiB;
constexpr size_t WS_MIX = 533 * MiB;
constexpr size_t WS_Z = 566 * MiB;
constexpr size_t WS_QB = 656 * MiB;
constexpr size_t WS_KB = 665 * MiB;
constexpr size_t WS_VB = 670 * MiB;
constexpr size_t WS_G = 675 * MiB;
constexpr size_t WS_CLOC = 677 * MiB;
constexpr size_t WS_NLOC = 694 * MiB;
constexpr size_t WS_SCAL = WS_NLOC + 512 * 1024;
constexpr size_t WS_AFF = 695 * MiB;
constexpr size_t WS_IDX = 697 * MiB;
constexpr size_t WS_GATE = WS_IDX + 512 * 1024;
constexpr size_t WS_SLOT = 698 * MiB;
constexpr size_t WS_HID = 700 * MiB;
constexpr size_t WS_Y = 844 * MiB;
constexpr size_t WS_END = 916 * MiB;
static_assert(WS_WIN + (size_t)2 * NZ * DM * 2 <= WS_WOUT && WS_Z + (size_t)R * NZ * 2 <= WS_QB && WS_QB + (size_t)R * 256 * 2 <= WS_KB && WS_KB + (size_t)R * 128 * 2 <= WS_VB && WS_VB + (size_t)R * 128 * 2 <= WS_G, "ws map");
static_assert(WS_G + (size_t)R * 16 * 4 <= WS_CLOC && WS_CLOC + (size_t)NCHUNK * 8 * 4096 * 4 <= WS_NLOC && WS_XW + (size_t)R * DM * 4 <= WS_H && WS_H + (size_t)R * DM * 2 <= WS_H2 && WS_MIX + (size_t)R * DM * 2 <= WS_Z, "ws map");
static_assert(WS_HID + (size_t)16 * ESLOTS * FF * 2 <= WS_Y && WS_Y + (size_t)16 * ESLOTS * DM * 2 <= WS_END && WS_AFF + (size_t)16 * R * 4 <= WS_IDX && WS_SLOT + (size_t)R * 16 * 4 <= WS_HID, "ws map");

constexpr int LDS_BYTES = 147456;

typedef unsigned short bf16;
typedef unsigned v4u __attribute__((ext_vector_type(4)));
typedef unsigned v2u __attribute__((ext_vector_type(2)));
typedef float f32x4 __attribute__((ext_vector_type(4)));
typedef float f32x2 __attribute__((ext_vector_type(2)));
typedef short bf16x8 __attribute__((ext_vector_type(8)));
typedef __bf16 bf16x2_t __attribute__((ext_vector_type(2)));

__device__ __forceinline__ unsigned pk2(float lo, float hi) { f32x2 v = {lo, hi}; bf16x2_t b = __builtin_convertvector(v, bf16x2_t); return __builtin_bit_cast(unsigned, b); }
__device__ __forceinline__ float bf_lo(unsigned w) { return __uint_as_float(w << 16); }
__device__ __forceinline__ float bf_hi(unsigned w) { return __uint_as_float(w & 0xffff0000u); }
__device__ __forceinline__ float bf2f(bf16 h) { return __uint_as_float((unsigned)h << 16); }
__device__ __forceinline__ bf16 f2bf(float f) { return (bf16)(pk2(f, 0.f) & 0xffffu); }
__device__ __forceinline__ float wave_sum(float v) {
#pragma unroll
    for (int o = 32; o > 0; o >>= 1) v += __shfl_xor(v, o);
    return v;
}
__device__ __forceinline__ float wave_max(float v) {
#pragma unroll
    for (int o = 32; o > 0; o >>= 1) v = fmaxf(v, __shfl_xor(v, o));
    return v;
}

struct Args {
    const float *x, *c, *ctx, *c_ctx, *ada_w, *ada_b, *norm1_g, *w_in, *conv_w, *cmlp_norm_g, *cmlp_ws, *cmlp_bs, *q_norm_g, *k_norm_g, *ml_igate_b, *ml_fgate_b, *ml_norm_g, *w_out, *norm2_g, *router_w, *exp_w1, *exp_w3, *exp_w2, *final_norm_g;
    float* out; unsigned char* ws; int ph_lo, ph_hi;
};
typedef const __attribute__((address_space(4))) Args* KArgs;
struct Ctx { KArgs a; unsigned char* lds; int tid, lane, wave, G, bid, vcu; };
#define BLOCK_SYNC() __syncthreads()

__device__ __forceinline__ void transpose_item(const float* W, int ld, int K, bf16* WT, int k0, int n0, int drow0, float* scr, int lane) {
#pragma unroll 8
    for (int i = 0; i < 32; ++i) { const int kk = 2 * i + (lane >> 5); scr[kk * 33 + (lane & 31)] = W[(size_t)(k0 + kk) * ld + n0 + (lane & 31)]; }
    asm volatile("s_waitcnt lgkmcnt(0)" ::: "memory");
    const int c = lane & 7;
#pragma unroll
    for (int j = 0; j < 4; ++j) { const int n = (lane >> 3) + 8 * j; const float* s = scr + (8 * c) * 33 + n;
        v4u o; o.x = pk2(s[0 * 33], s[1 * 33]); o.y = pk2(s[2 * 33], s[3 * 33]); o.z = pk2(s[4 * 33], s[5 * 33]); o.w = pk2(s[6 * 33], s[7 * 33]);
        *(v4u*)(WT + (size_t)(drow0 + n) * K + k0 + 8 * c) = o; }
    asm volatile("s_waitcnt lgkmcnt(0)" ::: "memory");
}
constexpr int CV_WIN = 16 * 88, CV_WOUT = 16 * 32, CV_EXP = 3072, CV_LAYER = CV_WIN + CV_WOUT + 16 * CV_EXP, CV_TOTAL = 2 * CV_LAYER;
__device__ __forceinline__ void convert_item(Ctx& C, int it, float* scr) {
    const int l = it / CV_LAYER; int r = it % CV_LAYER;
    if (r < CV_WIN) { const int kb = r / 88, nb = r % 88; transpose_item(C.a->w_in + (size_t)l * DM * DIN, DIN, DM, ((bf16*)(C.a->ws + WS_WIN)) + (size_t)l * NZ * DM, kb * 64, nb * 32, nb * 32, scr, C.lane); return; }
    r -= CV_WIN;
    if (r < CV_WOUT) { const int kb = r / 32, nb = r % 32; transpose_item(C.a->w_out + (size_t)l * DM * DM, DM, DM, ((bf16*)(C.a->ws + WS_WOUT)) + (size_t)l * DM * DM, kb * 64, nb * 32, nb * 32, scr, C.lane); return; }
    r -= CV_WOUT;
    const int e = r / CV_EXP, s = r % CV_EXP; const size_t le = (size_t)(l * NEXP + e);
    if (s < 2048) { const int which = s >> 10, q = s & 1023, kb = q / 64, nb = q % 64, n0 = nb * 32;
        const float* W = (which ? C.a->exp_w3 : C.a->exp_w1) + le * DM * FF;
        transpose_item(W, FF, DM, ((bf16*)(C.a->ws + WS_W13)) + le * 4096 * DM, kb * 64, n0, (n0 >> 7) * 256 + which * 128 + (n0 & 127), scr, C.lane); return; }
    { const int q = s - 2048, kb = q / 32, nb = q % 32; transpose_item(C.a->exp_w2 + le * FF * DM, DM, FF, ((bf16*)(C.a->ws + WS_W2)) + le * DM * FF, kb * 64, nb * 32, nb * 32, scr, C.lane); }
}
__device__ __forceinline__ void phase_init(Ctx& C) {
    float* lf = (float*)C.lds;
    for (int m = C.bid; m < 192; m += C.G) {
        const int l = m / 96, j0 = (m % 96) * 64;
        float* sc = lf; float* red = lf + 2048;
        for (int i = C.tid; i < 2048; i += NTHR) { const float v = (i < 1024) ? C.a->c[i] : C.a->c_ctx[i - 1024]; sc[i] = v / (1.0f + __expf(-v)); }
        BLOCK_SYNC();
        const float* W = C.a->ada_w + (size_t)l * DM * 6144 + j0 + C.lane;
        float a0 = 0.f, a1 = 0.f;
#pragma unroll 8
        for (int k = C.wave * 128; k < C.wave * 128 + 128; ++k) { const float w = W[(size_t)k * 6144]; a0 += sc[k] * w; a1 += sc[1024 + k] * w; }
        red[(C.wave * 2 + 0) * 64 + C.lane] = a0; red[(C.wave * 2 + 1) * 64 + C.lane] = a1;
        BLOCK_SYNC();
        if (C.tid < 128) { const int s = C.tid >> 6, j = C.tid & 63; float t = 0.f;
#pragma unroll
            for (int w = 0; w < 8; ++w) t += red[(w * 2 + s) * 64 + j];
            ((float*)(C.a->ws + WS_MOD))[(size_t)(l * 2 + s) * 6144 + j0 + j] = t + C.a->ada_b[l * 6144 + j0 + j]; }
        BLOCK_SYNC();
    }
    if (C.bid == C.G - 1) {
        for (int i = C.tid; i < 4096; i += NTHR) { const int pos = i >> 4, f = i & 15;
            const float inv = powf(10000.0f, -(float)(2 * f) / 32.0f); const float ang = (float)pos * inv;
            ((float*)(C.a->ws + WS_ROPE))[2 * i] = (float)cos((double)ang); ((float*)(C.a->ws + WS_ROPE))[2 * i + 1] = (float)sin((double)ang); }
    }
    BLOCK_SYNC();
    float* scr = lf + C.wave * (64 * 33);
    const int gw = C.bid * NWAVES + C.wave, NGW = C.G * NWAVES;
    for (int it = gw; it < CV_TOTAL; it += NGW) convert_item(C, it, scr);
}

__device__ __forceinline__ void stage_m16(Ctx& C, const float* src, int ld, int off, float* M16) {
    for (int c = C.tid; c < 1024; c += NTHR) { const f32x4* p = (const f32x4*)(src + (size_t)c * ld + off);
#pragma unroll
        for (int q = 0; q < 4; ++q) { const f32x4 v = p[q]; M16[(q * 4 + 0) * 1024 + c] = v[0]; M16[(q * 4 + 1) * 1024 + c] = v[1]; M16[(q * 4 + 2) * 1024 + c] = v[2]; M16[(q * 4 + 3) * 1024 + c] = v[3]; } }
    BLOCK_SYNC();
}
__device__ __forceinline__ void norm_mod_row(f32x4 (&v)[4], const float* g, const float* shift, const float* scale, bf16* orow, int lane) {
    float ss = 0.f;
#pragma unroll
    for (int j = 0; j < 4; ++j) ss += (v[j][0] * v[j][0] + v[j][1] * v[j][1]) + (v[j][2] * v[j][2] + v[j][3] * v[j][3]);
    const float rstd = rsqrtf(wave_sum(ss) * (1.0f / 1024.0f) + EPSN);
#pragma unroll
    for (int j = 0; j < 4; ++j) { const int c = 4 * lane + 256 * j;
        const f32x4 gv = *(const f32x4*)(g + c), sc = *(const f32x4*)(scale + c), sh = *(const f32x4*)(shift + c);
        const f32x4 h = (v[j] * rstd * gv) * (sc + 1.0f) + sh; v[j] = h;
        v2u w; w.x = pk2(h[0], h[1]); w.y = pk2(h[2], h[3]); *(v2u*)(orow + c) = w; }
}
__device__ __forceinline__ float dot16(const f32x4 (&v)[4], const float* M16, int lane) {
    float o = 0.f;
#pragma unroll 2
    for (int e = 0; e < 16; ++e) { float s = 0.f;
#pragma unroll
        for (int j = 0; j < 4; ++j) { const f32x4 w = *(const f32x4*)(M16 + e * 1024 + 4 * lane + 256 * j); s += (v[j][0] * w[0] + v[j][1] * w[1]) + (v[j][2] * w[2] + v[j][3] * w[3]); }
        s = wave_sum(s); o = (lane == e) ? s : o; }
    return o;
}
__device__ __forceinline__ void row_A(Ctx& C, f32x4 (&v)[4], int r, int l, const float* M16) {
    const float* modp = ((float*)(C.a->ws + WS_MOD)) + (size_t)(l * 2 + (r < CTXL ? 1 : 0)) * 6144;
    norm_mod_row(v, C.a->norm1_g + l * DM, modp, modp + 1024, ((bf16*)(C.a->ws + WS_H)) + (size_t)r * DM, C.lane);
    const float o = dot16(v, M16, C.lane);
    if (C.lane < 16) ((float*)(C.a->ws + WS_G))[(size_t)r * 16 + C.lane] = o;
}
__device__ __forceinline__ void phase_A0(Ctx& C) {
    float* M16 = (float*)C.lds; stage_m16(C, C.a->w_in, DIN, NZ, M16);
    const int gw = C.bid * NWAVES + C.wave, NGW = C.G * NWAVES;
    for (int r = gw; r < R; r += NGW) {
        const float* src = (r < CTXL) ? C.a->ctx + (size_t)r * DM : C.a->x + (size_t)(r - CTXL) * DM;
        f32x4 v[4];
#pragma unroll
        for (int j = 0; j < 4; ++j) v[j] = ((const f32x4*)src)[C.lane + 64 * j];
        row_A(C, v, r, 0, M16);
    }
}
__device__ __forceinline__ void phase_G(Ctx& C, int l) {
    float* M16 = (float*)C.lds; stage_m16(C, C.a->router_w + (size_t)l * DM * 16, 16, 0, M16);
    const int gw = C.bid * NWAVES + C.wave, NGW = C.G * NWAVES; const int r0 = (l == 0) ? 0 : CTXL;
    for (int r = r0 + gw; r < R; r += NGW) {
        f32x4 v[4];
#pragma unroll
        for (int j = 0; j < 4; ++j) v[j] = ((const f32x4*)(((float*)(C.a->ws + WS_XW)) + (size_t)r * DM))[C.lane + 64 * j];
        const float* modp = ((float*)(C.a->ws + WS_MOD)) + (size_t)(l * 2 + (r < CTXL ? 1 : 0)) * 6144;
        norm_mod_row(v, C.a->norm2_g + l * DM, modp + 3 * 1024, modp + 4 * 1024, ((bf16*)(C.a->ws + WS_H2)) + (size_t)r * DM, C.lane);
        const float lg = dot16(v, M16, C.lane);
        float mx = lg;
#pragma unroll
        for (int o2 = 1; o2 < 16; o2 <<= 1) mx = fmaxf(mx, __shfl_xor(mx, o2));
        const float o = expf(lg - mx); float sum = o;
#pragma unroll
        for (int o2 = 1; o2 < 16; o2 <<= 1) sum += __shfl_xor(sum, o2);
        if (C.lane < 16) ((float*)(C.a->ws + WS_AFF))[(size_t)C.lane * R + r] = o / sum;
    }
}
__device__ __forceinline__ void phase_K(Ctx& C, int l) {
    float* M16 = (float*)C.lds;
    if (l == 0) stage_m16(C, C.a->w_in + (size_t)DM * DIN, DIN, NZ, M16);
    const int gw = C.bid * NWAVES + C.wave, NGW = C.G * NWAVES; const int r0 = (l == 0) ? 0 : CTXL;
    for (int r = r0 + gw; r < R; r += NGW) {
        f32x4 v[4], acc[4];
#pragma unroll
        for (int j = 0; j < 4; ++j) { v[j] = ((const f32x4*)(((float*)(C.a->ws + WS_XW)) + (size_t)r * DM))[C.lane + 64 * j]; acc[j] = (f32x4){0.f, 0.f, 0.f, 0.f}; }
        const int myslot = (C.lane < 16) ? ((int*)(C.a->ws + WS_SLOT))[(size_t)r * 16 + C.lane] : -1;
        for (int e = 0; e < 16; ++e) {
            const int sl = __shfl(myslot, e);
            if (sl >= 0) { const bf16* yr = ((bf16*)(C.a->ws + WS_Y)) + ((size_t)e * ESLOTS + sl) * DM;
#pragma unroll
                for (int j = 0; j < 4; ++j) { const v2u w = *(const v2u*)(yr + 4 * C.lane + 256 * j); acc[j][0] += bf_lo(w.x); acc[j][1] += bf_hi(w.x); acc[j][2] += bf_lo(w.y); acc[j][3] += bf_hi(w.y); } }
        }
        const float* g2 = ((float*)(C.a->ws + WS_MOD)) + (size_t)(l * 2 + (r < CTXL ? 1 : 0)) * 6144 + 5 * 1024;
#pragma unroll
        for (int j = 0; j < 4; ++j) { const f32x4 gg = *(const f32x4*)(g2 + 4 * C.lane + 256 * j); v[j] = v[j] + gg * acc[j]; }
        if (l == 0) {
#pragma unroll
            for (int j = 0; j < 4; ++j) ((f32x4*)(((float*)(C.a->ws + WS_XW)) + (size_t)r * DM))[C.lane + 64 * j] = v[j];
            row_A(C, v, r, 1, M16);
        } else {
            float ss = 0.f;
#pragma unroll
            for (int j = 0; j < 4; ++j) ss += (v[j][0] * v[j][0] + v[j][1] * v[j][1]) + (v[j][2] * v[j][2] + v[j][3] * v[j][3]);
            const float rstd = rsqrtf(wave_sum(ss) * (1.0f / 1024.0f) + EPSN);
#pragma unroll
            for (int j = 0; j < 4; ++j) { const f32x4 gv = *(const f32x4*)(C.a->final_norm_g + 4 * C.lane + 256 * j); ((f32x4*)(C.a->out + (size_t)(r - CTXL) * DM))[C.lane + 64 * j] = v[j] * rstd * gv; }
        }
    }
}
#define MFMA16(a, b, c) __builtin_amdgcn_mfma_f32_16x16x32_bf16(a, b, c, 0, 0, 0)
__device__ __forceinline__ float logsigmoidf(float x) { return fminf(x, 0.f) - log1pf(expf(-fabsf(x))); }
constexpr float C2Q = 0.125f * 1.4426950408889634f;

__device__ __forceinline__ void item_conv_prep(const Ctx& C0, int l, int c) {
    Ctx C = C0; { int t_ = C.tid; asm volatile("" : "+v"(t_)); C.tid = t_; C.lane = t_ & 63; }
    const int rbase = c * 128; const int slo = (rbase < CTXL) ? 0 : CTXL, shi = (rbase < CTXL) ? CTXL : R;
    const float* cw = C.a->conv_w + l * 3 * 256;
    for (int idx = C.tid; idx < 128 * 32; idx += NTHR) {
        const int row = idx >> 5, ch0 = (idx & 31) * 8, r = rbase + row; const bf16* z = ((bf16*)(C.a->ws + WS_Z)) + (size_t)r * NZ;
        const v4u zero = {0u, 0u, 0u, 0u};
        const bool hm = (r - 1 >= slo), hp = (r + 1 < shi);
        const v4u xm = hm ? *(const v4u*)(z - NZ + ZC_CONVX + ch0) : zero, cm = hm ? *(const v4u*)(z - NZ + ZC_CONVC + ch0) : zero;
        const v4u x0 = *(const v4u*)(z + ZC_CONVX + ch0), c0 = *(const v4u*)(z + ZC_CONVC + ch0), b0 = *(const v4u*)(z + ZC_CONVB + ch0);
        const v4u xp = hp ? *(const v4u*)(z + NZ + ZC_CONVX + ch0) : zero, cp = hp ? *(const v4u*)(z + NZ + ZC_CONVC + ch0) : zero;
        float o[8];
#pragma unroll
        for (int q = 0; q < 4; ++q) {
            const int ch = ch0 + 2 * q;
            const float w0a = cw[ch], w1a = cw[256 + ch], w2a = cw[512 + ch], w0b = cw[ch + 1], w1b = cw[256 + ch + 1], w2b = cw[512 + ch + 1];
            const float ya = w0a * (bf_lo(xm[q]) * bf_lo(cm[q])) + w1a * (bf_lo(x0[q]) * bf_lo(c0[q])) + w2a * (bf_lo(xp[q]) * bf_lo(cp[q]));
            const float yb = w0b * (bf_hi(xm[q]) * bf_hi(cm[q])) + w1b * (bf_hi(x0[q]) * bf_hi(c0[q])) + w2b * (bf_hi(xp[q]) * bf_hi(cp[q]));
            o[2 * q] = bf_lo(b0[q]) * ya; o[2 * q + 1] = bf_hi(b0[q]) * yb; }
        v4u w; w.x = pk2(o[0], o[1]); w.y = pk2(o[2], o[3]); w.z = pk2(o[4], o[5]); w.w = pk2(o[6], o[7]);
        *(v4u*)(((bf16*)(C.a->ws + WS_MIX)) + (size_t)r * DM + ch0) = w;
    }
    for (int it = 0; it < 12; ++it) {
        const int task = it * 64 + (C.tid >> 3), sub = C.tid & 7, row = task / 6, hd = task % 6, r = rbase + row;
        const v4u zx = *(const v4u*)(((bf16*)(C.a->ws + WS_Z)) + (size_t)r * NZ + ZC_Q + hd * 64 + sub * 8);
        float y[8];
#pragma unroll
        for (int q = 0; q < 4; ++q) { y[2 * q] = bf_lo(zx[q]); y[2 * q + 1] = bf_hi(zx[q]); }
        float ss = 0.f;
#pragma unroll
        for (int e = 0; e < 8; ++e) ss += y[e] * y[e];
        ss += __shfl_xor(ss, 1); ss += __shfl_xor(ss, 2); ss += __shfl_xor(ss, 4);
        const float rstd = rsqrtf(ss * (1.0f / 64.0f) + EPSN);
        const float* gn = ((hd < 4) ? C.a->q_norm_g : C.a->k_norm_g) + l * 64 + sub * 8;
#pragma unroll
        for (int e = 0; e < 8; ++e) y[e] = y[e] * rstd * gn[e];
        float o[8];
        if (r >= CTXL) {
            const int p = r - CTXL, pos = (sub < 4) ? (p >> 6) : (p & 63); const float* rt = ((float*)(C.a->ws + WS_ROPE)) + (size_t)(pos * 16 + 8 * (sub & 1)) * 2; const bool first = ((sub & 2) == 0);
#pragma unroll
            for (int e = 0; e < 8; ++e) { const float pr = __shfl_xor(y[e], 2); const float cs = rt[2 * e], sn = rt[2 * e + 1]; o[e] = first ? (y[e] * cs - pr * sn) : (y[e] * cs + pr * sn); }
        } else {
#pragma unroll
            for (int e = 0; e < 8; ++e) { (void)__shfl_xor(y[e], 2); o[e] = y[e]; }
        }
        const float scl = (hd < 4) ? C2Q : 1.0f;
        v4u w; w.x = pk2(o[0] * scl, o[1] * scl); w.y = pk2(o[2] * scl, o[3] * scl); w.z = pk2(o[4] * scl, o[5] * scl); w.w = pk2(o[6] * scl, o[7] * scl);
        if (hd < 4) *(v4u*)(((bf16*)(C.a->ws + WS_QB)) + (size_t)r * 256 + hd * 64 + sub * 8) = w; else *(v4u*)(((bf16*)(C.a->ws + WS_KB)) + (size_t)r * 128 + (hd - 4) * 64 + sub * 8) = w;
    }
    for (int idx = C.tid; idx < 128 * 16; idx += NTHR) { const int row = idx >> 4, ch = (idx & 15) * 8, r = rbase + row; *(v4u*)(((bf16*)(C.a->ws + WS_VB)) + (size_t)r * 128 + ch) = *(const v4u*)(((bf16*)(C.a->ws + WS_Z)) + (size_t)r * NZ + ZC_V + ch); }
}

__device__ __forceinline__ void item_cmlp(const Ctx& C0, int l, int c) {
    Ctx C = C0; { int t_ = C.tid; asm volatile("" : "+v"(t_)); C.tid = t_; C.lane = t_ & 63; }
    constexpr int LD = 136;
    bf16* VNT = (bf16*)C.lds;
    bf16* WSB = VNT + 256 * LD;
    const int rbase = c * 128; const float* gn = C.a->cmlp_norm_g + l * 256;
    for (int i = 0; i < 16; ++i) {
        const int row = C.wave * 16 + i, r = rbase + row; const bf16* z = ((bf16*)(C.a->ws + WS_Z)) + (size_t)r * NZ + ZC_CV;
        float x[4]; float ss = 0.f;
#pragma unroll
        for (int q = 0; q < 4; ++q) { x[q] = bf2f(z[C.lane + 64 * q]); ss += x[q] * x[q]; }
        const float rstd = rsqrtf(wave_sum(ss) * (1.0f / 256.0f) + EPSN);
#pragma unroll
        for (int q = 0; q < 4; ++q) VNT[(C.lane + 64 * q) * LD + row] = f2bf(x[q] * rstd * gn[C.lane + 64 * q]);
    }
    for (int h = 0; h < 4; ++h) {
        BLOCK_SYNC();
        const float* wsrc = C.a->cmlp_ws + (size_t)(l * 4 + h) * 128 * 128;
#pragma unroll
        for (int it = 0; it < 8; ++it) { const int idx = (it * NTHR + C.tid) * 4, t = idx >> 7, s = idx & 127; const f32x4 w = *(const f32x4*)(wsrc + idx);
            v2u o; o.x = pk2(w[0], w[1]); o.y = pk2(w[2], w[3]); *(v2u*)(WSB + t * LD + s) = o; }
        BLOCK_SYNC();
        const int t0 = C.wave * 16, fr = C.lane & 15, fq = C.lane >> 4;
        f32x4 acc[4];
#pragma unroll
        for (int n = 0; n < 4; ++n) acc[n] = (f32x4){0.f, 0.f, 0.f, 0.f};
#pragma unroll
        for (int ks = 0; ks < 4; ++ks) { const bf16x8 a = *(const bf16x8*)(WSB + (t0 + fr) * LD + ks * 32 + 8 * fq);
#pragma unroll
            for (int n = 0; n < 4; ++n) { const bf16x8 b = *(const bf16x8*)(VNT + (h * 64 + 16 * n + fr) * LD + ks * 32 + 8 * fq); acc[n] = MFMA16(a, b, acc[n]); } }
        const float* bs = C.a->cmlp_bs + (size_t)(l * 4 + h) * 128;
#pragma unroll
        for (int j = 0; j < 4; ++j) { const int t = t0 + 4 * fq + j, r = rbase + t; const float bb = bs[t];
#pragma unroll
            for (int n = 0; n < 4; ++n) { const int col = h * 64 + 16 * n + fr; const float u = bf2f(((bf16*)(C.a->ws + WS_Z))[(size_t)r * NZ + ZC_CU + col]); ((bf16*)(C.a->ws + WS_MIX))[(size_t)r * DM + 256 + col] = f2bf(u * (acc[n][j] + bb)); } }
    }
}

__device__ __forceinline__ void load_gates(const Ctx& C, int l, int c, int h, float* liF, float* lfF, float* liB, float* lfB) {
    if (C.tid < 128) { const int r = c * 128 + C.tid; const float* g = ((float*)(C.a->ws + WS_G)) + (size_t)r * 16;
        liF[C.tid] = g[h] + C.a->ml_igate_b[l * 8 + h]; liB[C.tid] = g[4 + h] + C.a->ml_igate_b[l * 8 + 4 + h];
        lfF[C.tid] = logsigmoidf(g[8 + h] + C.a->ml_fgate_b[l * 8 + h]); lfB[C.tid] = logsigmoidf(g[12 + h] + C.a->ml_fgate_b[l * 8 + 4 + h]); }
}
__device__ __forceinline__ void item_mlstate(const Ctx& C0, int l, int c, int h) {
    Ctx C = C0; { int t_ = C.tid; asm volatile("" : "+v"(t_)); C.tid = t_; C.lane = t_ & 63; }
    constexpr int LD = 136;
    bf16* KT = (bf16*)C.lds; bf16* VTF = KT + 64 * LD; bf16* VTB = VTF + 64 * LD;
    float* fv = (float*)(VTB + 64 * LD);
    float *liF = fv, *lfF = fv + 128, *liB = fv + 256, *lfB = fv + 384, *aF = fv + 512, *aB = fv + 640, *sc = fv + 768;
    load_gates(C, l, c, h, liF, lfF, liB, lfB);
    BLOCK_SYNC();
    if (C.tid < 128) { const int t = C.tid; float b = 0.f; for (int u = 0; u <= t; ++u) b += lfF[u]; float tot = b; for (int u = t + 1; u < 128; ++u) tot += lfF[u];
        aF[t] = tot - b + liF[t]; if (t == 0) sc[2] = tot; }
    else if (C.tid < 256) { const int t = C.tid - 128; float b = 0.f; for (int u = 127; u >= t; --u) b += lfB[u]; float tot = b; for (int u = t - 1; u >= 0; --u) tot += lfB[u];
        aB[t] = tot - b + liB[t]; if (t == 0) sc[3] = tot; }
    BLOCK_SYNC();
    if (C.wave == 0) { const float m = wave_max(fmaxf(aF[C.lane], aF[C.lane + 64])); if (C.lane == 0) sc[0] = m; }
    if (C.wave == 1) { const float m = wave_max(fmaxf(aB[C.lane], aB[C.lane + 64])); if (C.lane == 0) sc[1] = m; }
    BLOCK_SYNC();
    { const int s = C.tid >> 2, part = C.tid & 3, r = c * 128 + s; const float wF = expf(aF[s] - sc[0]), wB = expf(aB[s] - sc[1]);
        const bf16* z = ((bf16*)(C.a->ws + WS_Z)) + (size_t)r * NZ + h * 64 + part * 16;
#pragma unroll
        for (int q2 = 0; q2 < 2; ++q2) { const v4u kk = *(const v4u*)(z + ZC_MK + q2 * 8), vv = *(const v4u*)(z + ZC_MV + q2 * 8);
#pragma unroll
            for (int q = 0; q < 4; ++q) { const int d = part * 16 + q2 * 8 + 2 * q;
                KT[d * LD + s] = f2bf(bf_lo(kk[q]) * 0.125f); KT[(d + 1) * LD + s] = f2bf(bf_hi(kk[q]) * 0.125f);
                const float v0 = bf_lo(vv[q]), v1 = bf_hi(vv[q]);
                VTF[d * LD + s] = f2bf(v0 * wF); VTF[(d + 1) * LD + s] = f2bf(v1 * wF); VTB[d * LD + s] = f2bf(v0 * wB); VTB[(d + 1) * LD + s] = f2bf(v1 * wB); } } }
    BLOCK_SYNC();
    const int dir = C.wave >> 2, v0 = 16 * (C.wave & 3), fr = C.lane & 15, fq = C.lane >> 4; const bf16* VT = dir ? VTB : VTF;
    f32x4 acc[4];
#pragma unroll
    for (int n = 0; n < 4; ++n) acc[n] = (f32x4){0.f, 0.f, 0.f, 0.f};
#pragma unroll
    for (int ks = 0; ks < 4; ++ks) { const bf16x8 a = *(const bf16x8*)(VT + (v0 + fr) * LD + ks * 32 + 8 * fq);
#pragma unroll
        for (int n = 0; n < 4; ++n) { const bf16x8 b = *(const bf16x8*)(KT + (16 * n + fr) * LD + ks * 32 + 8 * fq); acc[n] = MFMA16(a, b, acc[n]); } }
    const size_t sidx = (size_t)(c * 4 + h) * 2 + dir; float* co = ((float*)(C.a->ws + WS_CLOC)) + sidx * 4096;
#pragma unroll
    for (int n = 0; n < 4; ++n)
#pragma unroll
        for (int j = 0; j < 4; ++j) co[(v0 + 4 * fq + j) * 64 + 16 * n + fr] = acc[n][j];
    if (C.tid < 128) { const int d2 = C.tid >> 6, k = C.tid & 63; const float* a = d2 ? aB : aF; const float m = sc[d2]; float s = 0.f;
        for (int u = 0; u < 128; ++u) s += expf(a[u] - m) * bf2f(KT[k * LD + u]);
        ((float*)(C.a->ws + WS_NLOC))[((size_t)(c * 4 + h) * 2 + d2) * 64 + k] = s; }
    if (C.tid < 2) { const size_t si = (size_t)(c * 4 + h) * 2 + C.tid; ((float*)(C.a->ws + WS_SCAL))[si] = sc[C.tid]; ((float*)(C.a->ws + (WS_SCAL + 1040 * 4)))[si] = sc[2 + C.tid]; }
}
__device__ __forceinline__ void phase_C(Ctx& C, int l) {
    for (int it = C.bid; it < NCHUNK * 6; it += C.G) {
        const int c = it / 6, ty = it % 6;
        if (ty == 0) item_conv_prep(C, l, c);
        else if (ty == 1) { if (l == 0 || c >= 2) item_cmlp(C, l, c); }
        else item_mlstate(C, l, c, ty - 2);
        BLOCK_SYNC();
    }
}

__device__ __forceinline__ int chain_chunk(int dir, int i) { return dir == 0 ? i : (i == 0 ? 1 : (i == 1 ? 0 : NCHUNK + 1 - i)); }
__device__ __forceinline__ void phase_D(Ctx& C) {
    float* fv = (float*)C.lds; float *bl = fv, *ml = fv + 136, *mp = fv + 272, *dold = fv + 408, *dloc = fv + 544;
    for (int it = C.bid; it < 64; it += C.G) {
        const int chain = it >> 3, rg = it & 7, h = chain >> 1, dir = chain & 1;
        if (C.tid < NCHUNK) { const int c = chain_chunk(dir, C.tid); const size_t si = (size_t)(c * 4 + h) * 2 + dir; bl[C.tid] = ((float*)(C.a->ws + (WS_SCAL + 1040 * 4)))[si]; ml[C.tid] = ((float*)(C.a->ws + WS_SCAL))[si]; }
        BLOCK_SYNC();
        if (C.tid == 0) { float m = 0.f; for (int i = 0; i < NCHUNK; ++i) { mp[i] = m; m = fmaxf(bl[i] + m, ml[i]); } mp[NCHUNK] = m; }
        BLOCK_SYNC();
        if (C.tid < NCHUNK) { const int i = C.tid; dold[i] = expf(bl[i] + mp[i] - mp[i + 1]); dloc[i] = expf(ml[i] - mp[i + 1]);
            if (rg == 0) { const int c = chain_chunk(dir, i); ((float*)(C.a->ws + (WS_SCAL + 2080 * 4)))[(size_t)(c * 4 + h) * 2 + dir] = mp[i]; } }
        BLOCK_SYNC();
        { const int e = (rg * 8 + (C.tid >> 6)) * 64 + (C.tid & 63); float st = 0.f;
            for (int i0 = 0; i0 < NCHUNK; i0 += 10) { float L[10];
#pragma unroll
                for (int u = 0; u < 10; ++u) { const int c = chain_chunk(dir, i0 + u); L[u] = ((float*)(C.a->ws + WS_CLOC))[((size_t)(c * 4 + h) * 2 + dir) * 4096 + e]; }
#pragma unroll
                for (int u = 0; u < 10; ++u) { const int c = chain_chunk(dir, i0 + u); ((float*)(C.a->ws + WS_CLOC))[((size_t)(c * 4 + h) * 2 + dir) * 4096 + e] = st; st = dold[i0 + u] * st + dloc[i0 + u] * L[u]; } } }
        if (rg == 0 && C.tid < 64) { float st = 0.f;
            for (int i = 0; i < NCHUNK; ++i) { const int c = chain_chunk(dir, i); float* p = ((float*)(C.a->ws + WS_NLOC)) + ((size_t)(c * 4 + h) * 2 + dir) * 64 + C.tid; const float L = *p; *p = st; st = dold[i] * st + dloc[i] * L; } }
        BLOCK_SYNC();
    }
}
__device__ __forceinline__ void item_mlout(const Ctx& C0, int l, int c, int h) {
    Ctx C = C0; { int t_ = C.tid; asm volatile("" : "+v"(t_)); C.tid = t_; C.lane = t_ & 63; }
    constexpr int LQ = 72, LA = 264;
    bf16* QS = (bf16*)C.lds;
    bf16* KS = QS + 128 * LQ;
    bf16* A2 = KS + 128 * LQ;
    bf16* B2T = A2 + 128 * LA;
    float* fv = (float*)(B2T + 64 * LA);
    float *liF = fv, *lfF = fv + 128, *liB = fv + 256, *lfB = fv + 384, *gF = fv + 512, *gB = fv + 640, *rowF = fv + 768, *rowB = fv + 896,
          *wiF = fv + 1024, *wiB = fv + 1152, *emF = fv + 1280, *emB = fv + 1408, *cF = fv + 1536, *cB = fv + 1664, *nP = fv + 1792;
    const int rbase = c * 128; const size_t siF = (size_t)(c * 4 + h) * 2, siB = siF + 1;
    load_gates(C, l, c, h, liF, lfF, liB, lfB);
#pragma unroll
    for (int it = 0; it < 2; ++it) { const int idx = it * NTHR + C.tid, t = idx >> 3, ch = (idx & 7) * 8; const bf16* z = ((bf16*)(C.a->ws + WS_Z)) + (size_t)(rbase + t) * NZ + h * 64 + ch;
        *(v4u*)(QS + t * LQ + ch) = *(const v4u*)(z + ZC_MQ);
        const v4u kk = *(const v4u*)(z + ZC_MK); v4u ko;
#pragma unroll
        for (int q = 0; q < 4; ++q) ko[q] = pk2(bf_lo(kk[q]) * 0.125f, bf_hi(kk[q]) * 0.125f);
        *(v4u*)(KS + t * LQ + ch) = ko; }
    { const int s = C.tid >> 2, part = C.tid & 3; const bf16* z = ((bf16*)(C.a->ws + WS_Z)) + (size_t)(rbase + s) * NZ + ZC_MV + h * 64 + part * 16;
#pragma unroll
        for (int q2 = 0; q2 < 2; ++q2) { const v4u vv = *(const v4u*)(z + q2 * 8);
#pragma unroll
            for (int q = 0; q < 4; ++q) { const int d = part * 16 + q2 * 8 + 2 * q; B2T[d * LA + s] = (bf16)(vv[q] & 0xffffu); B2T[(d + 1) * LA + s] = (bf16)(vv[q] >> 16); } } }
#pragma unroll
    for (int it = 0; it < 4; ++it) { const int idx = (it * NTHR + C.tid) * 4, dir = idx >> 12, e = idx & 4095, v = e >> 6, k = e & 63;
        const f32x4 cv = *(const f32x4*)(((float*)(C.a->ws + WS_CLOC)) + (siF + dir) * 4096 + e); v2u o; o.x = pk2(cv[0], cv[1]); o.y = pk2(cv[2], cv[3]); *(v2u*)(B2T + v * LA + 128 + dir * 64 + k) = o; }
    if (C.tid < 128) nP[C.tid] = ((float*)(C.a->ws + WS_NLOC))[siF * 64 + C.tid];
    const float mpF = ((float*)(C.a->ws + (WS_SCAL + 2080 * 4)))[siF], mpB = ((float*)(C.a->ws + (WS_SCAL + 2080 * 4)))[siB];
    BLOCK_SYNC();
    if (C.tid < 128) { const int t = C.tid; float b = 0.f, pm = -INFINITY; for (int u = 0; u <= t; ++u) { b += lfF[u]; pm = fmaxf(pm, liF[u] - b); }
        gF[t] = liF[t] - b; const float mx = fmaxf(mpF, pm); rowF[t] = -mx; wiF[t] = expf(mpF - mx); emF[t] = expf(-(b + mx));
        float nq = 0.f; for (int k = 0; k < 64; ++k) nq += nP[k] * bf2f(QS[t * LQ + k]); cF[t] = nq; }
    else if (C.tid < 256) { const int t = C.tid - 128; float b = 0.f, pm = -INFINITY; for (int u = 127; u >= t; --u) { b += lfB[u]; pm = fmaxf(pm, liB[u] - b); }
        gB[t] = liB[t] - b; const float mx = fmaxf(mpB, pm); rowB[t] = -mx; wiB[t] = expf(mpB - mx); emB[t] = expf(-(b + mx));
        float nq = 0.f; for (int k = 0; k < 64; ++k) nq += nP[64 + k] * bf2f(QS[t * LQ + k]); cB[t] = nq; }
    BLOCK_SYNC();
    const int t0 = C.wave * 16, fr = C.lane & 15, fq = C.lane >> 4;
    {
        f32x4 S[8];
#pragma unroll
        for (int n = 0; n < 8; ++n) S[n] = (f32x4){0.f, 0.f, 0.f, 0.f};
#pragma unroll
        for (int ks = 0; ks < 2; ++ks) { const bf16x8 a = *(const bf16x8*)(QS + (t0 + fr) * LQ + ks * 32 + 8 * fq);
#pragma unroll
            for (int n = 0; n < 8; ++n) { const bf16x8 b = *(const bf16x8*)(KS + (16 * n + fr) * LQ + ks * 32 + 8 * fq); S[n] = MFMA16(a, b, S[n]); } }
        float gf[8], gb[8];
#pragma unroll
        for (int n = 0; n < 8; ++n) { gf[n] = gF[16 * n + fr]; gb[n] = gB[16 * n + fr]; }
#pragma unroll
        for (int j = 0; j < 4; ++j) { const int t = t0 + 4 * fq + j; const float rF_ = rowF[t], rB_ = rowB[t];
            float pf[8], pb[8]; float sF = 0.f, sB = 0.f;
#pragma unroll
            for (int n = 0; n < 8; ++n) { const int s = 16 * n + fr; const float sv = S[n][j];
                pf[n] = (s <= t) ? sv * expf(rF_ + gf[n]) : 0.f; pb[n] = (s >= t) ? sv * expf(rB_ + gb[n]) : 0.f; sF += pf[n]; sB += pb[n]; }
#pragma unroll
            for (int o = 1; o < 16; o <<= 1) { sF += __shfl_xor(sF, o); sB += __shfl_xor(sB, o); }
            const float wf = wiF[t], wb = wiB[t];
            const float denF = sF + wf * cF[t], denB = sB + wb * cB[t];
            const float rf = 1.0f / fmaxf(fabsf(denF), emF[t]), rb = 1.0f / fmaxf(fabsf(denB), emB[t]);
#pragma unroll
            for (int n = 0; n < 8; ++n) A2[t * LA + 16 * n + fr] = f2bf(pf[n] * rf + pb[n] * rb);
            S[0][j] = wf * rf; S[1][j] = wb * rb;
        }
        BLOCK_SYNC();
        if (fr == 0) {
#pragma unroll
            for (int j = 0; j < 4; ++j) { const int t = t0 + 4 * fq + j; cF[t] = S[0][j]; cB[t] = S[1][j]; } }
    }
    BLOCK_SYNC();
#pragma unroll
    for (int it = 0; it < 2; ++it) { const int idx = it * NTHR + C.tid, t = idx >> 3, ch = (idx & 7) * 8; const v4u qq = *(const v4u*)(QS + t * LQ + ch); const float sf = cF[t], sb = cB[t]; v4u of, ob;
#pragma unroll
        for (int q = 0; q < 4; ++q) { const float a = bf_lo(qq[q]), b = bf_hi(qq[q]); of[q] = pk2(a * sf, b * sf); ob[q] = pk2(a * sb, b * sb); }
        *(v4u*)(A2 + t * LA + 128 + ch) = of; *(v4u*)(A2 + t * LA + 192 + ch) = ob; }
    BLOCK_SYNC();
    f32x4 acc[4];
#pragma unroll
    for (int n = 0; n < 4; ++n) acc[n] = (f32x4){0.f, 0.f, 0.f, 0.f};
#pragma unroll
    for (int ks = 0; ks < 8; ++ks) { const bf16x8 a = *(const bf16x8*)(A2 + (t0 + fr) * LA + ks * 32 + 8 * fq);
#pragma unroll
        for (int n = 0; n < 4; ++n) { const bf16x8 b = *(const bf16x8*)(B2T + (16 * n + fr) * LA + ks * 32 + 8 * fq); acc[n] = MFMA16(a, b, acc[n]); } }
    const float* ng = C.a->ml_norm_g + l * 256 + h * 64;
#pragma unroll
    for (int j = 0; j < 4; ++j) { const int t = t0 + 4 * fq + j, r = rbase + t; float ss = 0.f;
#pragma unroll
        for (int n = 0; n < 4; ++n) ss += acc[n][j] * acc[n][j];
#pragma unroll
        for (int o = 1; o < 16; o <<= 1) ss += __shfl_xor(ss, o);
        const float rstd = rsqrtf(ss * (1.0f / 64.0f) + EPSN);
#pragma unroll
        for (int n = 0; n < 4; ++n) { const int d = 16 * n + fr; const float po = bf2f(((bf16*)(C.a->ws + WS_Z))[(size_t)r * NZ + ZC_MO + h * 64 + d]);
            ((bf16*)(C.a->ws + WS_MIX))[(size_t)r * DM + 768 + h * 64 + d] = f2bf(acc[n][j] * rstd * ng[d] / (1.0f + expf(-po))); } }
}

__device__ __forceinline__ void item_topk(const Ctx& C0, int e, int set) {
    Ctx C = C0; { int t_ = C.tid; asm volatile("" : "+v"(t_)); C.tid = t_; C.lane = t_ & 63; }
    unsigned* lv = (unsigned*)C.lds;
    unsigned* hist = lv + 32 * 512;
    unsigned* sh = hist + 256;
    unsigned* wtot = sh + 8;
    const int n = set ? CTXL : SEQL, cap = set ? CAPC : CAPL, rowoff = set ? 0 : CTXL;
    const float* aff = ((float*)(C.a->ws + WS_AFF)) + (size_t)e * R + rowoff;
    const int base = C.tid * 32;
#pragma unroll
    for (int q = 0; q < 8; ++q) { v4u w = {0u, 0u, 0u, 0u}; if (base + 4 * q < n) w = *(const v4u*)(aff + base + 4 * q);
        lv[(4 * q + 0) * 512 + C.tid] = w.x; lv[(4 * q + 1) * 512 + C.tid] = w.y; lv[(4 * q + 2) * 512 + C.tid] = w.z; lv[(4 * q + 3) * 512 + C.tid] = w.w; }
    unsigned prefix = 0u, kk = (unsigned)cap;
    for (int pass = 0; pass < 4; ++pass) {
        const int shift = 24 - 8 * pass; const unsigned himask = (pass == 0) ? 0u : (0xffffffffu << (shift + 8));
        if (C.tid < 256) hist[C.tid] = 0u;
        BLOCK_SYNC();
#pragma unroll 4
        for (int i = 0; i < 32; ++i) { const unsigned v = lv[i * 512 + C.tid]; if ((v & himask) == prefix) atomicAdd(&hist[(v >> shift) & 255u], 1u); }
        BLOCK_SYNC();
        if (C.tid < 256) { unsigned s = 0u; for (int b = C.tid; b < 256; ++b) s += hist[b]; const unsigned above = s - hist[C.tid];
            if (s >= kk && above < kk) { sh[0] = prefix | ((unsigned)C.tid << shift); sh[1] = kk - above; } }
        BLOCK_SYNC();
        prefix = sh[0]; kk = sh[1];
        BLOCK_SYNC();
    }
    const unsigned T = prefix, need_eq = kk;
    unsigned cgt = 0u, ceq = 0u;
#pragma unroll 4
    for (int i = 0; i < 32; ++i) { const unsigned v = lv[i * 512 + C.tid]; cgt += (v > T) ? 1u : 0u; ceq += (v == T) ? 1u : 0u; }
    unsigned igt = cgt, ieq = ceq;
#pragma unroll
    for (int o = 1; o < 64; o <<= 1) { const unsigned a = __shfl_up(igt, o), b = __shfl_up(ieq, o); if (C.lane >= o) { igt += a; ieq += b; } }
    if (C.lane == 63) { wtot[C.wave] = igt; wtot[8 + C.wave] = ieq; }
    BLOCK_SYNC();
    unsigned ogt = igt - cgt, oeq = ieq - ceq;
    for (int w = 0; w < C.wave; ++w) { ogt += wtot[w]; oeq += wtot[8 + w]; }
    const int slot0 = set ? CAPL : 0;
    int* IDXp = ((int*)(C.a->ws + WS_IDX)) + e * ESLOTS; float* GATEp = ((float*)(C.a->ws + WS_GATE)) + e * ESLOTS; int* SLOTp = ((int*)(C.a->ws + WS_SLOT)) + (size_t)rowoff * 16 + e;
#pragma unroll 2
    for (int i = 0; i < 32; ++i) {
        const int tok = base + i; const unsigned v = lv[i * 512 + C.tid];
        const bool gt = v > T, eq = v == T; const bool sel = gt || (eq && oeq < need_eq);
        if (tok < n) {
            int slot = -1;
            if (sel) { slot = slot0 + (int)(ogt + (oeq < need_eq ? oeq : need_eq)); IDXp[slot] = rowoff + tok; GATEp[slot] = __uint_as_float(v); }
            SLOTp[(size_t)tok * 16] = slot;
        }
        ogt += gt ? 1u : 0u; oeq += eq ? 1u : 0u;
    }
    if (set) { for (int s = CAPL + CAPC + C.tid; s < ESLOTS; s += NTHR) { IDXp[s] = 0; GATEp[s] = 0.f; } }
    BLOCK_SYNC();
}
__device__ __forceinline__ void phase_H(Ctx& C, int l) {
    const int nitems = (l == 0) ? 32 : 16;
    for (int it = C.bid; it < nitems; it += C.G) item_topk(C, it & 15, it >> 4);
}
__device__ __forceinline__ void phase_E(Ctx& C, int l) {
    const int c0 = (l == 0) ? 0 : 2;
#ifndef NO_MLOUT
    for (int it = C.bid; it < (NCHUNK - c0) * 4; it += C.G) { item_mlout(C, l, c0 + it / 4, it % 4); BLOCK_SYNC(); }
#endif
#ifndef NO_ATTN
    using abf = attn_body::bf16;
    {
        for (int u = C.vcu; u < 256; u += C.G) { const int h = u >> 6, qb = u & 63; const size_t qrow = (size_t)CTXL + (size_t)qb * 256;
            attn_body::attn_unit<8>((const abf*)(((bf16*)(C.a->ws + WS_QB)) + qrow * 256 + h * 64), (const abf*)(((bf16*)(C.a->ws + WS_KB)) + (h >> 1) * 64), (const abf*)(((bf16*)(C.a->ws + WS_VB)) + (h >> 1) * 64), (abf*)(((bf16*)(C.a->ws + WS_MIX)) + qrow * DM + 512 + h * 64), R / 64, (char*)C.lds, C.tid); }
        if (l == 0) for (int u = C.bid; u < 4; u += C.G) { const int h = u;
            attn_body::attn_unit<8>((const abf*)(((bf16*)(C.a->ws + WS_QB)) + h * 64), (const abf*)(((bf16*)(C.a->ws + WS_KB)) + (h >> 1) * 64), (const abf*)(((bf16*)(C.a->ws + WS_VB)) + (h >> 1) * 64), (abf*)(((bf16*)(C.a->ws + WS_MIX)) + 512 + h * 64), CTXL / 64, (char*)C.lds, C.tid); }
    }
#endif
}

#ifndef ONLY_KIND
#define ONLY_KIND -1
#endif
#define KSEL(x) (ONLY_KIND == -1 || ONLY_KIND == (x))
constexpr int N_PHASES = 22;
template <int ph> __device__ __forceinline__ void run_phase(Ctx& C, PG8_LAS unsigned char* ldsg) {
        if constexpr (ph == 0) { if (KSEL(100)) phase_init(C); }
        else if constexpr (ph == 1) { if (KSEL(101)) phase_A0(C); }
        else {
            constexpr int l = (ph - 2) / 10, k = (ph - 2) % 10;
            if constexpr (k == 0) { if (KSEL(0)) {
                pg8::Gemm g{((bf16*)(C.a->ws + WS_H)), ((bf16*)(C.a->ws + WS_WIN)) + (size_t)l * NZ * DM, R, NZ, DM, nullptr}; pg8::StaticOrder S; S.init(R, NZ, C.G, C.bid);
                pg8::EpiBf16 E{((bf16*)(C.a->ws + WS_Z)), NZ};
                pg8::gemm_phase<pg8::EpiBf16, pg8::StaticOrder, true, false>(ldsg, g, S, E, C.tid); }
            } else if constexpr (k == 1) { if (KSEL(1)) phase_C(C, l); }
            else if constexpr (k == 2) { if (KSEL(2)) phase_D(C); }
            else if constexpr (k == 3) { if (KSEL(3)) phase_E(C, l); }
            else if constexpr (k == 4) { if (KSEL(4)) {
                const int pm0 = (l == 0) ? 0 : 1; const int rows = R - pm0 * 256;
                pg8::Gemm g{((bf16*)(C.a->ws + WS_MIX)), ((bf16*)(C.a->ws + WS_WOUT)) + (size_t)l * DM * DM, rows, DM, DM, nullptr}; pg8::StaticOrder S; S.init(rows, DM, C.G, C.bid, pm0);
                const float* modL = ((float*)(C.a->ws + WS_MOD)) + (size_t)(l * 2 + 0) * 6144 + 2 * 1024; const float* modC = ((float*)(C.a->ws + WS_MOD)) + (size_t)(l * 2 + 1) * 6144 + 2 * 1024;
                pg8::EpiResid E{(l == 0) ? C.a->ctx : ((float*)(C.a->ws + WS_XW)), (l == 0) ? C.a->x : ((float*)(C.a->ws + WS_XW)) + (size_t)CTXL * DM, ((float*)(C.a->ws + WS_XW)), modC, modL};
                pg8::gemm_phase<pg8::EpiResid, pg8::StaticOrder, true, false>(ldsg, g, S, E, C.tid); }
            } else if constexpr (k == 5) { if (KSEL(5)) phase_G(C, l); }
            else if constexpr (k == 6) { if (KSEL(6)) phase_H(C, l); }
            else if constexpr (k == 7) { if (KSEL(7)) {
                pg8::Gemm g{((bf16*)(C.a->ws + WS_H2)), ((bf16*)(C.a->ws + WS_W13)) + (size_t)l * NEXP * 4096 * DM, NEXP * ESLOTS, NEXP * 4096, DM, ((int*)(C.a->ws + WS_IDX))}; pg8::MoeOrder S; S.init((l == 0) ? 9 : 8, 16, C.G, C.vcu);
                pg8::EpiSwiGLU E{((bf16*)(C.a->ws + WS_HID))};
                pg8::gemm_phase<pg8::EpiSwiGLU, pg8::MoeOrder, true, true>(ldsg, g, S, E, C.tid); }
            } else if constexpr (k == 8) { if (KSEL(8)) {
                pg8::Gemm g{((bf16*)(C.a->ws + WS_HID)), ((bf16*)(C.a->ws + WS_W2)) + (size_t)l * NEXP * DM * FF, NEXP * ESLOTS, NEXP * DM, FF, nullptr}; pg8::MoeOrder S; S.init((l == 0) ? 9 : 8, 4, C.G, C.vcu);
                pg8::EpiGateRow E{((bf16*)(C.a->ws + WS_Y)), ((float*)(C.a->ws + WS_GATE))};
                pg8::gemm_phase<pg8::EpiGateRow, pg8::MoeOrder, true, false>(ldsg, g, S, E, C.tid); }
            } else { if (KSEL(9)) phase_K(C, l); }
        }
}
__global__ void __launch_bounds__(NTHR, 2) hybrid_fwd(Args args) {
    extern __shared__ __attribute__((aligned(16))) unsigned char lds[];
    cg::grid_group grid = cg::this_grid();
    Ctx C; C.lds = lds;
    PG8_LAS unsigned char* ldsg = (PG8_LAS unsigned char*)lds;

    const int ph_lo = args.ph_lo, ph_hi = args.ph_hi;
#define RUN_PHASE(PH) do { if (ph_lo <= (PH) && (PH) < ph_hi) { constexpr int ph = (PH); \
        { KArgs ka = (KArgs)__builtin_amdgcn_kernarg_segment_ptr(); asm volatile("" : "+s"(ka)); C.a = ka; } \
        { int tid_ = threadIdx.x; asm volatile("" : "+v"(tid_)); C.tid = tid_; C.lane = tid_ & 63; C.wave = __builtin_amdgcn_readfirstlane(tid_ >> 6); } \
        { int g_ = gridDim.x, b_ = blockIdx.x; asm volatile("" : "+s"(g_), "+s"(b_)); C.G = g_; C.bid = b_; C.vcu = (g_ % 8 == 0) ? (b_ % 8) * (g_ / 8) + b_ / 8 : b_; } \
        run_phase<ph>(C, ldsg); if ((PH) + 1 < ph_hi) grid.sync(); } } while (0)
    RUN_PHASE(0); RUN_PHASE(1); RUN_PHASE(2); RUN_PHASE(3); RUN_PHASE(4); RUN_PHASE(5); RUN_PHASE(6); RUN_PHASE(7); RUN_PHASE(8); RUN_PHASE(9); RUN_PHASE(10); RUN_PHASE(11);
    RUN_PHASE(12); RUN_PHASE(13); RUN_PHASE(14); RUN_PHASE(15); RUN_PHASE(16); RUN_PHASE(17); RUN_PHASE(18); RUN_PHASE(19); RUN_PHASE(20); RUN_PHASE(21);
#undef RUN_PHASE
}

extern "C" void kernel_launch(void* const* d_in, const int* in_sizes, int n_in, void* d_out, int out_size, void* d_ws, size_t ws_size, hipStream_t stream) {
    static int grid = 0;
    if (grid == 0) {
        if (n_in != 24 || ws_size < WS_END) { fprintf(stderr, "kernel_launch: unexpected inputs (%d) or workspace (%zu < %zu)\n", n_in, ws_size, (size_t)WS_END); grid = -1; return; }
        int dev = 0, cus = 0, per_cu = 0;
        hipGetDevice(&dev); hipDeviceGetAttribute(&cus, hipDeviceAttributeMultiprocessorCount, dev);
        hipFuncSetAttribute((const void*)hybrid_fwd, hipFuncAttributeMaxDynamicSharedMemorySize, LDS_BYTES);
        hipOccupancyMaxActiveBlocksPerMultiprocessor(&per_cu, (const void*)hybrid_fwd, NTHR, LDS_BYTES);
        if (per_cu < 1) { fprintf(stderr, "kernel_launch: occupancy query says %d blocks per CU\n", per_cu); per_cu = 1; }
        (void)hipGetLastError();
        grid = cus;
        if (grid > 256) grid = 256;
    }
    if (grid < 0) return;
    hipMemsetAsync((char*)d_ws + WS_CTL, 0, 64 * 1024, stream);
    Args a{};
    const float** ap = (const float**)&a;
    for (int i = 0; i < 24; ++i) ap[i] = (const float*)d_in[i];
    a.out = (float*)d_out; a.ws = (unsigned char*)d_ws;
#ifndef MK_PER_PHASE
    a.ph_lo = 0; a.ph_hi = N_PHASES;
    void* kargs[] = {&a};
    hipError_t e = hipLaunchCooperativeKernel((const void*)hybrid_fwd, dim3(grid), dim3(NTHR), kargs, LDS_BYTES, stream);
    if (e != hipSuccess) fprintf(stderr, "cooperative launch failed: %s (grid %d)\n", hipGetErrorString(e), grid);
#else
    for (int p = 0; p < N_PHASES; ++p) { a.ph_lo = p; a.ph_hi = p + 1; void* kargs[] = {&a};
        hipError_t e = hipLaunchCooperativeKernel((const void*)hybrid_fwd, dim3(grid), dim3(NTHR), kargs, LDS_BYTES, stream);
        if (e != hipSuccess) { fprintf(stderr, "launch %d failed: %s\n", p, hipGetErrorString(e)); break; } }
#endif
}
```

```cpp
#include <hip/hip_runtime.h>
#include <hip/hip_bf16.h>
#include <hip/hip_cooperative_groups.h>
#include <cstdio>
#include <cstdint>
#include <cmath>
namespace cg = cooperative_groups;
namespace pg8 {
#define PG8_LAS __attribute__((address_space(3)))
typedef unsigned short bf16_t;
typedef short bf16x8 __attribute__((ext_vector_type(8)));
typedef float f32x4 __attribute__((ext_vector_type(4)));
typedef unsigned u32x4 __attribute__((ext_vector_type(4)));
constexpr int BM = 256, BK = 64, HALF = 128, HTB = HALF * BK * 2, STAGE_BYTES = 8 * HTB, NXCD = 8, WGM = 8;

__host__ __device__ __forceinline__ int lds_byte(int r, int c) { const int st = (r >> 4) * 2 + (c >> 5), rr = r & 15, cc = c & 31, ob = rr * 64 + cc * 2; return st * 1024 + (ob ^ (((ob >> 9) & 1) << 5)); }
__host__ __device__ __forceinline__ void stage_rc(int b, int& R, int& C) { const int st = b / 1024, sb = b % 1024, swz = sb ^ (((sb >> 9) & 1) << 5); R = (st >> 1) * 16 + swz / 64; C = (st & 1) * 32 + (swz % 64) / 2; }
__host__ __device__ __forceinline__ int perm32(int rho) { const int n = rho >> 4, i = rho & 15; return 8 * (i >> 2) + 4 * n + (i & 3); }

struct Unit { int pm, pn; };
struct Gemm { const bf16_t* A; const bf16_t* Bt; int M, N, K; const int* gidx; };

struct StaticOrder {
    int nM, nN, nwg, G, c, pm0;
    __host__ __device__ void init(int M, int N, int G_, int c_, int pm0_ = 0) { nM = M / BM; nN = N / BM; nwg = nM * nN; G = G_; c = c_; pm0 = pm0_; }
    __host__ __device__ bool next(int i, Unit& u) const {
        const long L = (long)i * G + c; if (L >= nwg) return false;
        int wgid = (int)L; { const int q = nwg / NXCD, r = nwg % NXCD, xcd = wgid % NXCD, off = wgid / NXCD; wgid = (xcd < r ? xcd * (q + 1) : r * (q + 1) + (xcd - r) * q) + off; }
        const int nig = WGM * nN, gid = wgid / nig, fm = gid * WGM, gsz = (nM - fm) < WGM ? (nM - fm) : WGM;
        u.pm = pm0 + fm + ((wgid % nig) % gsz); u.pn = (wgid % nig) / gsz; return true;
    }
};
struct MoeOrder {
    int npm, npn, total, G, c;
    __host__ __device__ void init(int npm_, int npn_, int G_, int c_) { npm = npm_; npn = npn_; total = 16 * npm_ * npn_; G = G_; c = c_; }
    __host__ __device__ bool next(int i, Unit& u) const {
        const long L = (long)i * G + c; if (L >= total) return false;
        const int per = npm * npn, e = (int)L / per, rem = (int)L % per, pn = rem / npm, pm = rem % npm;
        u.pm = e * 9 + pm; u.pn = e * npn + pn; return true;
    }
};

__device__ __forceinline__ unsigned cvt_pk_bf16(float lo, float hi) { unsigned r; asm volatile("v_cvt_pk_bf16_f32 %0, %1, %2" : "=v"(r) : "v"(lo), "v"(hi)); return r; }

struct EpiBf16 {
    static constexpr bool PERM = true;
    bf16_t* O; int ldc;
    __device__ __forceinline__ void operator()(const f32x4 (&acc)[2][2][4][2], const Unit& u, int wr, int wc, int fr, int fq) const {
        const int row0 = u.pm * BM + wr * 64 + fr; const int col0 = u.pn * BM + wc * 32 + 8 * fq;
#pragma unroll
        for (int ai = 0; ai < 2; ++ai)
#pragma unroll
            for (int m = 0; m < 4; ++m) { bf16_t* rowp = O + (size_t)(row0 + ai * HALF + m * 16) * ldc + col0;
#pragma unroll
                for (int bj = 0; bj < 2; ++bj) { const f32x4 v0 = acc[ai][bj][m][0], v1 = acc[ai][bj][m][1];
                    u32x4 w; w.x = cvt_pk_bf16(v0[0], v0[1]); w.y = cvt_pk_bf16(v0[2], v0[3]); w.z = cvt_pk_bf16(v1[0], v1[1]); w.w = cvt_pk_bf16(v1[2], v1[3]);
                    *(u32x4*)(rowp + bj * HALF) = w; } }
    }
};
struct EpiResid {
    static constexpr bool PERM = false;
    const float* baseC; const float* baseL; float* out; const float* gateC; const float* gateL;
    __device__ __forceinline__ void operator()(const f32x4 (&acc)[2][2][4][2], const Unit& u, int wr, int wc, int fr, int fq) const {
        const int rl = wr * 64 + fr, col0 = u.pn * BM + wc * 32 + 4 * fq;
        const float* bp = (u.pm == 0) ? baseC : baseL + (size_t)(u.pm - 1) * BM * 1024;
        const float* gp = (u.pm == 0) ? gateC : gateL;
        f32x4 gv[2][2];
#pragma unroll
        for (int bj = 0; bj < 2; ++bj)
#pragma unroll
            for (int n = 0; n < 2; ++n) gv[bj][n] = *(const f32x4*)(gp + col0 + bj * HALF + n * 16);
#pragma unroll
        for (int ai = 0; ai < 2; ++ai)
#pragma unroll
            for (int m = 0; m < 4; ++m) { const int r = rl + ai * HALF + m * 16; const float* brow = bp + (size_t)r * 1024 + col0; float* orow = out + ((size_t)u.pm * BM + r) * 1024 + col0;
#pragma unroll
                for (int bj = 0; bj < 2; ++bj)
#pragma unroll
                    for (int n = 0; n < 2; ++n) { const f32x4 b = *(const f32x4*)(brow + bj * HALF + n * 16); *(f32x4*)(orow + bj * HALF + n * 16) = b + gv[bj][n] * acc[ai][bj][m][n]; } }
    }
};
struct EpiSwiGLU {
    static constexpr bool PERM = true;
    bf16_t* O;
    __device__ __forceinline__ void operator()(const f32x4 (&acc)[2][2][4][2], const Unit& u, int wr, int wc, int fr, int fq) const {
        const int row0 = u.pm * BM + wr * 64 + fr; const int col0 = (u.pn & 15) * HALF + wc * 32 + 8 * fq;
#pragma unroll
        for (int ai = 0; ai < 2; ++ai)
#pragma unroll
            for (int m = 0; m < 4; ++m) { bf16_t* rowp = O + (size_t)(row0 + ai * HALF + m * 16) * 2048 + col0; float h[8];
#pragma unroll
                for (int n = 0; n < 2; ++n)
#pragma unroll
                    for (int j = 0; j < 4; ++j) { const float a = acc[ai][0][m][n][j], b = acc[ai][1][m][n][j]; h[n * 4 + j] = a * b * __builtin_amdgcn_rcpf(1.0f + __builtin_amdgcn_exp2f(-1.4426950408889634f * a)); }
                u32x4 w; w.x = cvt_pk_bf16(h[0], h[1]); w.y = cvt_pk_bf16(h[2], h[3]); w.z = cvt_pk_bf16(h[4], h[5]); w.w = cvt_pk_bf16(h[6], h[7]);
                *(u32x4*)rowp = w; }
    }
};
struct EpiGateRow {
    static constexpr bool PERM = true;
    bf16_t* O; const float* gate;
    __device__ __forceinline__ void operator()(const f32x4 (&acc)[2][2][4][2], const Unit& u, int wr, int wc, int fr, int fq) const {
        const int row0 = u.pm * BM + wr * 64 + fr; const int col0 = (u.pn & 3) * BM + wc * 32 + 8 * fq;
#pragma unroll
        for (int ai = 0; ai < 2; ++ai)
#pragma unroll
            for (int m = 0; m < 4; ++m) { const int r = row0 + ai * HALF + m * 16; const float gt = gate[r]; bf16_t* rowp = O + (size_t)r * 1024 + col0;
#pragma unroll
                for (int bj = 0; bj < 2; ++bj) { const f32x4 v0 = acc[ai][bj][m][0] * gt, v1 = acc[ai][bj][m][1] * gt;
                    u32x4 w; w.x = cvt_pk_bf16(v0[0], v0[1]); w.y = cvt_pk_bf16(v0[2], v0[3]); w.z = cvt_pk_bf16(v1[0], v1[1]); w.w = cvt_pk_bf16(v1[2], v1[3]);
                    *(u32x4*)(rowp + bj * HALF) = w; } }
    }
};

template <class Epi, class Sched, bool ALIGN_EPI, bool GATHER>
__device__ __forceinline__ void gemm_phase(PG8_LAS unsigned char* lds, const Gemm g, const Sched& S, const Epi& E, const int tid) {
    const int wid = __builtin_amdgcn_readfirstlane(tid >> 6), lane = tid & 63, wr = wid >> 2, wc = wid & 3, fr = lane & 15, fq = lane >> 4;
    const int K = g.K, nt = K / BK;
    unsigned voffA[2], voffB[2]; int RA[2];
#pragma unroll
    for (int i = 0; i < 2; ++i) { int R, C; stage_rc(tid * 16 + i * 8192, R, C); const int Rb = Epi::PERM ? ((R & ~31) + perm32(R & 31)) : R;
        voffA[i] = GATHER ? (unsigned)(C * 2) : (unsigned)(R * K + C) * 2u; voffB[i] = (unsigned)(Rb * K + C) * 2u; RA[i] = R; }
    const size_t kstep = (size_t)(BK * 2);
    const size_t hstep = (size_t)HALF * K * 2;
    const size_t tstep = 2 * hstep;
    const unsigned ldsw = (unsigned)wid * 1024u;
    const int aoff = lds_byte(wr * 64 + fr, fq * 8), boff = lds_byte(wc * 32 + fr, fq * 8);
#define PG8_SA(b, h) (((b) * 2 + (h)) * HTB)
#define PG8_SB(b, h) ((4 + (b) * 2 + (h)) * HTB)
#define PG8_STAGE(bufoff, gbase, voff) do { _Pragma("unroll") for (int _i = 0; _i < 2; ++_i) \
        __builtin_amdgcn_global_load_lds((const unsigned*)((const char*)(gbase) + (voff)[_i]), (PG8_LAS unsigned*)(lds + (bufoff) + ldsw + _i * 8192), 16, 0, 0); } while (0)
#define PG8_LDA(dst, b, h) do { _Pragma("unroll") for (int m = 0; m < 4; ++m) _Pragma("unroll") for (int k = 0; k < 2; ++k) dst[m][k] = *(const PG8_LAS bf16x8*)(lds + PG8_SA(b, h) + aoff + m * 2048 + k * 1024); } while (0)
#define PG8_LDB(dst, b, h) do { _Pragma("unroll") for (int n = 0; n < 2; ++n) _Pragma("unroll") for (int k = 0; k < 2; ++k) dst[n][k] = *(const PG8_LAS bf16x8*)(lds + PG8_SB(b, h) + boff + n * 2048 + k * 1024); } while (0)
#define PG8_MMA(ai, bj, At, Bt) do { __builtin_amdgcn_s_setprio(1); _Pragma("unroll") for (int m = 0; m < 4; ++m) _Pragma("unroll") for (int n = 0; n < 2; ++n) _Pragma("unroll") for (int k = 0; k < 2; ++k) \
        acc[ai][bj][m][n] = __builtin_amdgcn_mfma_f32_16x16x32_bf16(Bt[n][k], At[m][k], acc[ai][bj][m][n], 0, 0, 0); __builtin_amdgcn_s_setprio(0); } while (0)
#define PG8_WAIT_V(n) asm volatile("s_waitcnt vmcnt(" #n ")" ::: "memory")
#define PG8_WAIT_L(n) asm volatile("s_waitcnt lgkmcnt(" #n ")" ::: "memory")
#define PG8_BAR __builtin_amdgcn_s_barrier()
#define PG8_SCHED __builtin_amdgcn_sched_barrier(0)
    Unit cur, nxt; int ui = 0;
    if (!S.next(0, cur)) return;
    f32x4 acc[2][2][4][2];
#pragma unroll
    for (int a = 0; a < 2; ++a)
#pragma unroll
        for (int b = 0; b < 2; ++b)
#pragma unroll
            for (int m = 0; m < 4; ++m)
#pragma unroll
                for (int n = 0; n < 2; ++n) acc[a][b][m][n] = (f32x4){0.f, 0.f, 0.f, 0.f};
    bf16x8 At[4][2], B0[2][2], B1[2][2];
    unsigned gC0[2], gC1[2], gN0[2], gN1[2];
    const char* cA; const char* cB = (const char*)g.Bt + (size_t)cur.pn * tstep;
    if constexpr (GATHER) {
        cA = (const char*)g.A;
#pragma unroll
        for (int i = 0; i < 2; ++i) { gC0[i] = (unsigned)g.gidx[cur.pm * BM + RA[i]] * (unsigned)(K * 2) + voffA[i]; gC1[i] = (unsigned)g.gidx[cur.pm * BM + HALF + RA[i]] * (unsigned)(K * 2) + voffA[i]; gN0[i] = gC0[i]; gN1[i] = gC1[i]; }
    } else { cA = (const char*)g.A + (size_t)cur.pm * tstep; }
#define PG8_STA0(bufoff, ptr) do { if constexpr (GATHER) PG8_STAGE(bufoff, ptr, gC0); else PG8_STAGE(bufoff, ptr, voffA); } while (0)
#define PG8_STA1(bufoff, ptr) do { if constexpr (GATHER) PG8_STAGE(bufoff, ptr, gC1); else PG8_STAGE(bufoff, (ptr) + hstep, voffA); } while (0)
#define PG8_STX0(bufoff, ptr) do { if constexpr (GATHER) PG8_STAGE(bufoff, ptr, gX0); else PG8_STAGE(bufoff, ptr, voffA); } while (0)
#define PG8_STX1(bufoff, ptr) do { if constexpr (GATHER) PG8_STAGE(bufoff, ptr, gX1); else PG8_STAGE(bufoff, (ptr) + hstep, voffA); } while (0)
    PG8_STAGE(PG8_SB(0, 0), cB, voffB); PG8_STAGE(PG8_SB(0, 1), cB + hstep, voffB); PG8_STA0(PG8_SA(0, 0), cA); PG8_STA1(PG8_SA(0, 1), cA);
    if (wr == 1) PG8_BAR;
    PG8_WAIT_V(2); PG8_BAR;
    PG8_STAGE(PG8_SB(1, 0), cB + kstep, voffB); PG8_STA0(PG8_SA(1, 0), cA + kstep); PG8_STAGE(PG8_SB(1, 1), cB + hstep + kstep, voffB);
    PG8_WAIT_V(6); PG8_BAR;
    for (;;) {
        const bool has_next = S.next(ui + 1, nxt);
        const char* nA; const char* nB = has_next ? (const char*)g.Bt + (size_t)nxt.pn * tstep : cB;
        if constexpr (GATHER) {
            nA = cA;
            if (has_next) {
#pragma unroll
                for (int i = 0; i < 2; ++i) { gN0[i] = (unsigned)g.gidx[nxt.pm * BM + RA[i]] * (unsigned)(K * 2) + voffA[i]; gN1[i] = (unsigned)g.gidx[nxt.pm * BM + HALF + RA[i]] * (unsigned)(K * 2) + voffA[i]; }
            }
        } else { nA = has_next ? (const char*)g.A + (size_t)nxt.pm * tstep : cA; }
        for (int t = 0; t < nt; t += 2) {
            const bool last = (t == nt - 2);
            const char* a1 = cA + (size_t)(t + 1) * kstep;
            const char* a2 = last ? nA : cA + (size_t)(t + 2) * kstep; const char* b2 = last ? nB : cB + (size_t)(t + 2) * kstep;
            const char* a3 = a2 + kstep; const char* b3 = b2 + kstep;
            unsigned gX0[2], gX1[2];
            if constexpr (GATHER) {
#pragma unroll
                for (int i = 0; i < 2; ++i) { gX0[i] = last ? gN0[i] : gC0[i]; gX1[i] = last ? gN1[i] : gC1[i]; }
            }
            PG8_LDB(B0, 0, 0); PG8_LDB(B1, 0, 1); PG8_SCHED; PG8_LDA(At, 0, 0); PG8_STA1(PG8_SA(1, 1), a1);
            PG8_WAIT_V(8); PG8_WAIT_L(0); PG8_BAR; PG8_MMA(0, 0, At, B0); PG8_MMA(0, 1, At, B1); PG8_BAR; PG8_SCHED;
            PG8_LDA(At, 0, 1); PG8_STAGE(PG8_SB(0, 0), b2, voffB); PG8_STAGE(PG8_SB(0, 1), b2 + hstep, voffB); PG8_STX0(PG8_SA(0, 0), a2);
            PG8_WAIT_V(8); PG8_WAIT_L(0); PG8_BAR; PG8_MMA(1, 0, At, B0); PG8_MMA(1, 1, At, B1); PG8_BAR; PG8_SCHED;
            PG8_LDB(B0, 1, 0); PG8_LDB(B1, 1, 1); PG8_SCHED; PG8_LDA(At, 1, 0); PG8_STX1(PG8_SA(0, 1), a2);
            PG8_WAIT_V(8); PG8_WAIT_L(0); PG8_BAR; PG8_MMA(0, 0, At, B0); PG8_MMA(0, 1, At, B1); PG8_BAR; PG8_SCHED;
            PG8_LDA(At, 1, 1); PG8_STAGE(PG8_SB(1, 0), b3, voffB); PG8_STAGE(PG8_SB(1, 1), b3 + hstep, voffB); PG8_STX0(PG8_SA(1, 0), a3);
            PG8_WAIT_V(8); PG8_WAIT_L(0); PG8_BAR; PG8_MMA(1, 0, At, B0); PG8_MMA(1, 1, At, B1); PG8_BAR; PG8_SCHED;
        }
        if constexpr (ALIGN_EPI) { if (wr == 0) PG8_BAR; }
        E(acc, cur, wr, wc, fr, fq);
        if (!has_next) break;
#pragma unroll
        for (int a = 0; a < 2; ++a)
#pragma unroll
            for (int b = 0; b < 2; ++b)
#pragma unroll
                for (int m = 0; m < 4; ++m)
#pragma unroll
                    for (int n = 0; n < 2; ++n) acc[a][b][m][n] = (f32x4){0.f, 0.f, 0.f, 0.f};
        cur = nxt; cA = nA; cB = nB; ++ui;
        if constexpr (GATHER) {
#pragma unroll
            for (int i = 0; i < 2; ++i) { gC0[i] = gN0[i]; gC1[i] = gN1[i]; }
        }
        if constexpr (ALIGN_EPI) { if (wr == 1) PG8_BAR; }
    }
    PG8_WAIT_V(0);
    if constexpr (!ALIGN_EPI) { if (wr == 0) PG8_BAR; }
    PG8_BAR;
#undef PG8_SA
#undef PG8_SB
#undef PG8_STAGE
#undef PG8_STA0
#undef PG8_STA1
#undef PG8_STX0
#undef PG8_STX1
#undef PG8_LDA
#undef PG8_LDB
#undef PG8_MMA
#undef PG8_WAIT_V
#undef PG8_WAIT_L
#undef PG8_BAR
#undef PG8_SCHED
}
}
namespace attn_body {
using bf16=__hip_bfloat16;
using bf16x8=__attribute__((ext_vector_type(8)))short;
using s16x4=__attribute__((ext_vector_type(4)))short;
using f32x16=__attribute__((ext_vector_type(16)))float;
using u32x4=__attribute__((ext_vector_type(4)))unsigned;
constexpr int D=64,QP=256,KP=128,VP=128,OP=1024;
constexpr int NW=8,QBLK=32,QB=QBLK*NW,KVBLK=64;
__device__ __forceinline__ int crow(int r,int hi){return (r&3)+8*(r>>2)+4*hi;}
#define SBAR() __builtin_amdgcn_sched_barrier(0)
__device__ __forceinline__ void cmask(f32x16&p0,f32x16&p1,int jb,int qrel,int hi){
  const float NEG=-INFINITY; int kb=64*jb+4*hi;
  #pragma unroll
  for(int r=0;r<16;++r){int kv=kb+(r&3)+8*(r>>2); if(kv>qrel)p0[r]=NEG; if(kv+32>qrel)p1[r]=NEG;}
}

constexpr int NSLOT=3, SLOTB=8192;
constexpr int LDS_K=0, LDS_V=NSLOT*SLOTB, LDS_WS=2*NSLOT*SLOTB, LDS_OST=LDS_WS+NW*64*4, LDS_BYTES=LDS_OST+NW*4096;
constexpr float C2=0.125f*1.4426950408889634f;
__device__ __forceinline__ void glds16(const void*gsrc,unsigned lds_dst){unsigned keep;
  asm volatile("s_mov_b32 %0, m0\n\ts_mov_b32 m0, %2\n\ts_nop 0\n\tglobal_load_lds_dwordx4 %1, off\n\ts_mov_b32 m0, %0":"=&s"(keep):"v"(gsrc),"s"(lds_dst):"memory");}
__device__ __forceinline__ float max3f(float a,float b,float c){float r;asm("v_max3_f32 %0, %1, %2, %3":"=v"(r):"v"(a),"v"(b),"v"(c));return r;}
__device__ __forceinline__ float max2f(float a,float b){float r;asm("v_max_f32_e32 %0, %1, %2":"=v"(r):"v"(a),"v"(b));return r;}
__device__ __forceinline__ float fadd_s(float a,float b){float r;asm("v_add_f32_e32 %0, %1, %2":"=v"(r):"v"(a),"v"(b));return r;}
__device__ __forceinline__ float fsub_s(float a,float b){float r;asm("v_sub_f32_e32 %0, %1, %2":"=v"(r):"v"(a),"v"(b));return r;}
typedef float f32x2_t __attribute__((ext_vector_type(2))); typedef __bf16 bf16x2_t __attribute__((ext_vector_type(2)));
__device__ __forceinline__ unsigned cvtpk_s(float lo,float hi){f32x2_t v={lo,hi};bf16x2_t b=__builtin_convertvector(v,bf16x2_t);return __builtin_bit_cast(unsigned,b);}
#define WAIT_BAR(N) asm volatile("s_waitcnt vmcnt(" #N ") lgkmcnt(0)\n\ts_barrier":::"memory")

__device__ __forceinline__ void qkt(f32x16&p0,f32x16&p1,const char*Kslot,const bf16x8*qr,const f32x16&negm,int r32,int hi){
  const char*kb=Kslot+hi*1024+r32*16;
  #pragma unroll
  for(int d0=0;d0<4;++d0){
    const bf16x8 b0=*reinterpret_cast<const bf16x8*>(kb+d0*2048);
    const bf16x8 b1=*reinterpret_cast<const bf16x8*>(kb+d0*2048+512);
    if(d0==0){p0=__builtin_amdgcn_mfma_f32_32x32x16_bf16(b0,qr[0],negm,0,0,0);p1=__builtin_amdgcn_mfma_f32_32x32x16_bf16(b1,qr[0],negm,0,0,0);}
    else{p0=__builtin_amdgcn_mfma_f32_32x32x16_bf16(b0,qr[d0],p0,0,0,0);p1=__builtin_amdgcn_mfma_f32_32x32x16_bf16(b1,qr[d0],p1,0,0,0);}}
}
typedef __attribute__((address_space(3))) const char* lds_cptr;
typedef short v4i16_t __attribute__((ext_vector_type(4)));
__device__ __forceinline__ void kload8(bf16x8*kf,lds_cptr kp){
  kf[0]=*(const __attribute__((address_space(3))) bf16x8*)(kp);      kf[1]=*(const __attribute__((address_space(3))) bf16x8*)(kp+512);
  kf[2]=*(const __attribute__((address_space(3))) bf16x8*)(kp+2048); kf[3]=*(const __attribute__((address_space(3))) bf16x8*)(kp+2560);
  kf[4]=*(const __attribute__((address_space(3))) bf16x8*)(kp+4096); kf[5]=*(const __attribute__((address_space(3))) bf16x8*)(kp+4608);
  kf[6]=*(const __attribute__((address_space(3))) bf16x8*)(kp+6144); kf[7]=*(const __attribute__((address_space(3))) bf16x8*)(kp+6656);
}
__device__ __forceinline__ void kload2(bf16x8*kf,lds_cptr kp,int j){ kf[2*j]=*(const __attribute__((address_space(3))) bf16x8*)(kp+j*2048); kf[2*j+1]=*(const __attribute__((address_space(3))) bf16x8*)(kp+j*2048+512); }
__device__ __forceinline__ s16x4 vtr(lds_cptr p){ return __builtin_bit_cast(s16x4,__builtin_amdgcn_ds_read_tr16_b64_v4i16((__attribute__((address_space(3))) v4i16_t*)p)); }
__device__ __forceinline__ float rowmax(const f32x16&p0,const f32x16&p1){
  float a=max3f(p0[0],p0[1],p1[0]),b=max3f(p0[2],p0[3],p1[1]);a=max3f(a,p1[2],p1[3]);
  #pragma unroll
  for(int r=4;r<16;r+=4){a=max3f(a,p0[r],p0[r+1]);b=max3f(b,p0[r+2],p0[r+3]);a=max3f(a,p1[r],p1[r+1]);b=max3f(b,p1[r+2],p1[r+3]);}
  const float m=max2f(a,b);
  auto rr=__builtin_amdgcn_permlane32_swap(__float_as_uint(m),__float_as_uint(m),false,false);
  return max2f(__uint_as_float(rr[0]),__uint_as_float(rr[1]));
}
__device__ __forceinline__ void pv(f32x16*o,int vb,bf16x8 pa0,bf16x8 pa1,bf16x8 pa2,bf16x8 pa3){
  #pragma unroll
  for(int d0=0;d0<2;++d0){s16x4 lo[4],hi[4];
    #pragma unroll
    for(int ks=0;ks<4;++ks){
      asm volatile("ds_read_b64_tr_b16 %0,%1 offset:%c2":"=&v"(lo[ks]):"v"(vb),"i"(d0*4096+ks*1024):"memory");
      asm volatile("ds_read_b64_tr_b16 %0,%1 offset:%c2":"=&v"(hi[ks]):"v"(vb),"i"(d0*4096+ks*1024+512):"memory");}
    asm volatile("s_waitcnt lgkmcnt(0)":::"memory");SBAR();
    #define PK(k) (bf16x8){lo[k][0],lo[k][1],lo[k][2],lo[k][3],hi[k][0],hi[k][1],hi[k][2],hi[k][3]}
    o[d0]=__builtin_amdgcn_mfma_f32_32x32x16_bf16(pa0,PK(0),o[d0],0,0,0);
    o[d0]=__builtin_amdgcn_mfma_f32_32x32x16_bf16(pa1,PK(1),o[d0],0,0,0);
    o[d0]=__builtin_amdgcn_mfma_f32_32x32x16_bf16(pa2,PK(2),o[d0],0,0,0);
    o[d0]=__builtin_amdgcn_mfma_f32_32x32x16_bf16(pa3,PK(3),o[d0],0,0,0);
    #undef PK
  }
}

#ifndef ATTN_STORE16
#define ATTN_STORE16(p,v) (*(u32x4*)(p)=(v))
#endif
template<int THRL> __device__ __forceinline__ void attn_unit(const bf16*Qu,const bf16*__restrict__ Kh,const bf16*__restrict__ Vh,bf16*Ou,const int NT,char*shm,const int tid){
  const int lane=tid&63,r32=lane&31,hi=lane>>5; const int wid=__builtin_amdgcn_readfirstlane(tid>>6);
  const bf16*Qw=Qu+(long)(wid*QBLK)*QP;
  const unsigned lds0=(unsigned)(uintptr_t)shm;
  float*wsf=(float*)(shm+LDS_WS)+wid*64;
  const bf16*ksrc=Kh+(long)lane*KP+wid*8;
  const bf16*vsrc=Vh+(long)(16*(wid&3)+(lane>>2))*VP+(wid>>2)*32+(lane&3)*8;
  const unsigned kdst=lds0+LDS_K+wid*1024, vdst=lds0+LDS_V+wid*1024;
  #define DMA_K(t,slot) glds16(ksrc+(long)(t)*KVBLK*KP,(unsigned)__builtin_amdgcn_readfirstlane(kdst+(slot)))
  #define DMA_V(t,slot) glds16(vsrc+(long)(t)*KVBLK*VP,(unsigned)__builtin_amdgcn_readfirstlane(vdst+(slot)))
  const int vb0=(int)(lds0+LDS_V)+((lane>>4)&1)*32+(lane&3)*8+(4*hi+((lane&15)>>2))*64;
  const char*Kbase=shm+LDS_K; bf16x8 kf[8];
  const lds_cptr shm3=(lds_cptr)shm; const lds_cptr kp0=shm3+LDS_K+hi*1024+r32*16; const lds_cptr vp0=shm3+LDS_V+((lane>>4)&1)*32+(lane&3)*8+(4*hi+((lane&15)>>2))*64;
  DMA_K(0,0);DMA_V(0,0);DMA_K(1,SLOTB);
  bf16x8 qr[4];
  #pragma unroll
  for(int d0=0;d0<4;++d0)qr[d0]=*reinterpret_cast<const bf16x8*>(&Qw[(long)r32*QP+d0*16+hi*8]);
  float mhat=0.f,l_reg=0.f;f32x16 o[2];o[0]=f32x16{};o[1]=f32x16{};f32x16 negm=f32x16{};asm volatile("":"+v"(negm));
  #define CMASK(P0,P1,t) do{}while(0)
  bool resc=false;
  #define START(P0,P1) do{ const float rm=rowmax(P0,P1); resc=false; \
    { const float dl=rm; mhat=fadd_s(mhat,dl); \
      _Pragma("unroll") for(int r=0;r<16;++r){P0[r]=fsub_s(P0[r],dl);P1[r]=fsub_s(P1[r],dl);} \
      _Pragma("unroll") for(int r=0;r<16;++r)negm[r]=-mhat; asm volatile("":"+v"(negm)); } \
    _Pragma("unroll") for(int r=0;r<16;++r)P0[r]=__builtin_amdgcn_exp2f(P0[r]); }while(0)
  #define RESC() do{ if(resc){ asm volatile("s_waitcnt lgkmcnt(0)":::"memory"); \
      _Pragma("unroll") for(int d_=0;d_<2;++d_) _Pragma("unroll") for(int r=0;r<16;++r)o[d_][r]*=wsf[crow(r,hi)]; } }while(0)
  f32x16 pA0,pA1,pB0,pB1;
  int sl_prev=0,sl_cur=0,sl_next=SLOTB;
  #define ROT() do{sl_prev=sl_cur;sl_cur=sl_next;sl_next=(sl_next==(NSLOT-1)*SLOTB)?0:sl_next+SLOTB;}while(0)
  DMA_K(2,2*SLOTB);
  WAIT_BAR(3);
  qkt(pA0,pA1,Kbase,qr,negm,r32,hi);asm volatile("s_nop 15\n\ts_nop 7":"+v"(pA0),"+v"(pA1));CMASK(pA0,pA1,0);
  START(pA0,pA1);
  _Pragma("unroll") for(int r=0;r<16;++r)pA1[r]=__builtin_amdgcn_exp2f(pA1[r]);
  WAIT_BAR(0);
  DMA_K(3,0);DMA_V(1,SLOTB);
  ROT();
  kload8(kf,kp0+sl_cur);
  WAIT_BAR(2);
  s16x4 vlo[8],vhi[8]; u32x4 pw0,pw1,pw2,pw3;
  #define PKW(P,B) cvtpk_s(P[B],P[B+1])
  #define PAF(k) __builtin_bit_cast(bf16x8,pw##k)
  #define VFR(i) (bf16x8){vlo[i][0],vlo[i][1],vlo[i][2],vlo[i][3],vhi[i][0],vhi[i][1],vhi[i][2],vhi[i][3]}
  #define PIN(x) asm volatile("":"+v"(x))
  #define MX3(a,b,c) __builtin_fmaxf(__builtin_fmaxf((a),(b)),(c))
  #define GAPA(MF,A0,A1,A2,A3,W0,W1,PW) do{ MF; sacc+=A0; sacc+=A1; sacc+=A2; sacc+=A3; PIN(sacc); W0; W1; PIN(PW); SBAR(); }while(0)
  #define EX(v) __builtin_amdgcn_exp2f(v)
  #define GAPB(MF,X,B) do{ MF; X[B]=EX(X[B]); X[B+1]=EX(X[B+1]); X[B+2]=EX(X[B+2]); X[B+3]=EX(X[B+3]); PIN(X); SBAR(); }while(0)
  #define VRD(i) do{ vlo[i]=vtr(vp_+(((i)>>2)*4096+((i)&3)*1024)); vhi[i]=vtr(vp_+(((i)>>2)*4096+((i)&3)*1024+512)); }while(0)
  #define KRD(G,j) do{ if(G){ kload2(kf,kp0+sl_next,j); SBAR(); } }while(0)
  #define STEP(C0,C1,P0,P1,t,GK,GV,GL) do{ SBAR(); \
    const lds_cptr vp_=vp0+sl_prev; \
    VRD(0); SBAR(); float sacc=(P0[0]+P0[1]); \
    GAPA(C0=__builtin_amdgcn_mfma_f32_32x32x16_bf16(kf[0],qr[0],negm,0,0,0), P0[2],P0[3],P0[4],P0[5],     pw0[0]=PKW(P0,0), pw0[1]=PKW(P0,2), pw0); \
    VRD(4); SBAR(); GAPA(C1=__builtin_amdgcn_mfma_f32_32x32x16_bf16(kf[1],qr[0],negm,0,0,0), P0[6],P0[7],P0[8],P0[9],     pw0[2]=PKW(P0,4), pw0[3]=PKW(P0,6), pw0); \
    VRD(1); SBAR(); GAPA(C0=__builtin_amdgcn_mfma_f32_32x32x16_bf16(kf[2],qr[1],C0,0,0,0),   P0[10],P0[11],P0[12],P0[13], pw1[0]=PKW(P0,8), pw1[1]=PKW(P0,10), pw1); \
    VRD(5); SBAR(); GAPA(C1=__builtin_amdgcn_mfma_f32_32x32x16_bf16(kf[3],qr[1],C1,0,0,0),   P0[14],P0[15],P1[0],P1[1],   pw1[2]=PKW(P0,12),pw1[3]=PKW(P0,14), pw1); \
    VRD(2); SBAR(); GAPA(C0=__builtin_amdgcn_mfma_f32_32x32x16_bf16(kf[4],qr[2],C0,0,0,0),   P1[2],P1[3],P1[4],P1[5],     pw2[0]=PKW(P1,0), pw2[1]=PKW(P1,2), pw2); \
    VRD(6); SBAR(); GAPA(C1=__builtin_amdgcn_mfma_f32_32x32x16_bf16(kf[5],qr[2],C1,0,0,0),   P1[6],P1[7],P1[8],P1[9],     pw2[2]=PKW(P1,4), pw2[3]=PKW(P1,6), pw2); \
    VRD(3); SBAR(); GAPA(C0=__builtin_amdgcn_mfma_f32_32x32x16_bf16(kf[6],qr[3],C0,0,0,0),   P1[10],P1[11],P1[12],P1[13], pw3[0]=PKW(P1,8), pw3[1]=PKW(P1,10), pw3); \
    VRD(7); SBAR(); GAPA(C1=__builtin_amdgcn_mfma_f32_32x32x16_bf16(kf[7],qr[3],C1,0,0,0),   P1[14],P1[15],0.f,0.f,       pw3[2]=PKW(P1,12),pw3[3]=PKW(P1,14), pw3); \
    l_reg+=sacc; \
    if(GK){DMA_K((t)+3,sl_cur);} if(GV){DMA_V((t)+1,sl_next);} \
    CMASK(C0,C1,t); \
    { float a=MX3(C0[0],C0[1],C1[0]),b=MX3(C0[2],C0[3],C1[1]); a=MX3(a,C1[2],C1[3]); \
      _Pragma("unroll") for(int r=4;r<16;r+=4){a=MX3(a,C0[r],C0[r+1]);b=MX3(b,C0[r+2],C0[r+3]);a=MX3(a,C1[r],C1[r+1]);b=MX3(b,C1[r+2],C1[r+3]);} \
      float rm=__builtin_fmaxf(a,b); { auto rr=__builtin_amdgcn_permlane32_swap(__float_as_uint(rm),__float_as_uint(rm),false,false); rm=__builtin_fmaxf(__uint_as_float(rr[0]),__uint_as_float(rr[1])); } \
      resc=false; \
      if(__builtin_expect(__any(rm>(float)THRL),0)){ const float dl=__builtin_fmaxf(rm,0.f); mhat+=dl; \
        _Pragma("unroll") for(int r=0;r<16;++r){C0[r]-=dl;C1[r]-=dl;} \
        _Pragma("unroll") for(int r=0;r<16;++r)negm[r]=-mhat; asm volatile("":"+v"(negm)); \
        const float f=__builtin_amdgcn_exp2f(-dl); l_reg*=f; if(hi==0)wsf[r32]=f; resc=true; } } \
    SBAR(); \
    GAPB(o[0]=__builtin_amdgcn_mfma_f32_32x32x16_bf16(PAF(0),VFR(0),o[0],0,0,0), C0,0); \
    GAPB(o[1]=__builtin_amdgcn_mfma_f32_32x32x16_bf16(PAF(0),VFR(4),o[1],0,0,0), C0,4); \
    KRD(GL,0); GAPB(o[0]=__builtin_amdgcn_mfma_f32_32x32x16_bf16(PAF(1),VFR(1),o[0],0,0,0), C0,8); \
    KRD(GL,1); GAPB(o[1]=__builtin_amdgcn_mfma_f32_32x32x16_bf16(PAF(1),VFR(5),o[1],0,0,0), C0,12); \
    KRD(GL,2); GAPB(o[0]=__builtin_amdgcn_mfma_f32_32x32x16_bf16(PAF(2),VFR(2),o[0],0,0,0), C1,0); \
    KRD(GL,3); GAPB(o[1]=__builtin_amdgcn_mfma_f32_32x32x16_bf16(PAF(2),VFR(6),o[1],0,0,0), C1,4); \
    GAPB(o[0]=__builtin_amdgcn_mfma_f32_32x32x16_bf16(PAF(3),VFR(3),o[0],0,0,0), C1,8); \
    GAPB(o[1]=__builtin_amdgcn_mfma_f32_32x32x16_bf16(PAF(3),VFR(7),o[1],0,0,0), C1,12); \
    }while(0)
  int t=1;
  #undef CMASK
  #define CMASK(P0,P1,t) do{}while(0)
  for(;t+5<NT;t+=2){
    STEP(pB0,pB1,pA0,pA1,t,true,true,true);     WAIT_BAR(2); RESC(); ROT();
    STEP(pA0,pA1,pB0,pB1,t+1,true,true,true);   WAIT_BAR(2); RESC(); ROT();
  }
  #undef CMASK
  #define CMASK(P0,P1,t) do{}while(0)
  #define ENDW(tt) do{ if((tt)+3<NT){WAIT_BAR(2);} else if((tt)+2<NT){WAIT_BAR(1);} else {WAIT_BAR(0);} }while(0)
  for(;t+1<NT;t+=2){
    STEP(pB0,pB1,pA0,pA1,t,(t+3<NT),(t+1<NT),(t+1<NT));       ENDW(t);   RESC(); ROT();
    STEP(pA0,pA1,pB0,pB1,t+1,(t+4<NT),(t+2<NT),(t+2<NT));     ENDW(t+1); RESC(); ROT();
  }
  STEP(pB0,pB1,pA0,pA1,NT-1,false,false,false); RESC();
  { float sacc=pB0[0]+pB0[1]; _Pragma("unroll") for(int r=2;r<16;++r)sacc+=pB0[r]; _Pragma("unroll") for(int r=0;r<16;++r)sacc+=pB1[r]; l_reg+=sacc;
    pw0=(u32x4){PKW(pB0,0),PKW(pB0,2),PKW(pB0,4),PKW(pB0,6)};pw1=(u32x4){PKW(pB0,8),PKW(pB0,10),PKW(pB0,12),PKW(pB0,14)};pw2=(u32x4){PKW(pB1,0),PKW(pB1,2),PKW(pB1,4),PKW(pB1,6)};pw3=(u32x4){PKW(pB1,8),PKW(pB1,10),PKW(pB1,12),PKW(pB1,14)};
    SBAR(); pv(o,vb0+sl_cur,PAF(0),PAF(1),PAF(2),PAF(3)); }
  #undef PKW
  #undef PAF
  #undef VFR
  #undef PIN
  #undef MX3
  #undef GAPA
  #undef GAPB
  #undef EX
  #undef VRD
  #undef KRD
  #undef STEP
  #undef ENDW
  {auto rr=__builtin_amdgcn_permlane32_swap(__float_as_uint(l_reg),__float_as_uint(l_reg),false,false);l_reg=__uint_as_float(rr[0])+__uint_as_float(rr[1]);}
  if(hi==0)wsf[32+r32]=l_reg;asm volatile("s_waitcnt lgkmcnt(0)":::"memory");
  float rli[16];
  #pragma unroll
  for(int r=0;r<16;++r)rli[r]=__builtin_amdgcn_rcpf(wsf[32+crow(r,hi)]);
  bf16*Ow=Ou+(long)(wid*QBLK)*OP;
  { bf16*stg=(bf16*)(shm+LDS_OST)+wid*2048;
    #pragma unroll
    for(int r=0;r<16;++r){const int orow=crow(r,hi);
      #pragma unroll
      for(int d0=0;d0<2;++d0)stg[orow*64+d0*32+r32]=__float2bfloat16(o[d0][r]*rli[r]);}
    asm volatile("s_waitcnt lgkmcnt(0)":::"memory");
    #pragma unroll
    for(int i=0;i<4;++i){const int row=i*8+(lane>>3),ch=lane&7; const u32x4 v=*(const u32x4*)(stg+row*64+ch*8); ATTN_STORE16(Ow+(long)row*OP+ch*8,v);} }
  asm volatile("s_waitcnt lgkmcnt(0)\n\ts_barrier":::"memory");
  #undef DMA_K
  #undef DMA_V
  #undef CMASK
  #undef START
  #undef RESC
  #undef ROT
}
constexpr int ATTN_LDS_BYTES=LDS_BYTES;
#undef SBAR
#undef WAIT_BAR
}
constexpr int NWAVES = 8, NTHR = 512;
constexpr int DM = 1024, SEQL = 16384, CTXL = 256, R = SEQL + CTXL;
constexpr int DIN = 2832, NZ = 2816;
constexpr int NEXP = 16, FF = 2048, CAPL = 2048, CAPC = 32, ESLOTS = 2304;
constexpr int NCHUNK = R / 128;
constexpr float EPSN = 1e-6f;
constexpr int ZC_CONVX = 0, ZC_CONVB = 256, ZC_CONVC = 512, ZC_CU = 768, ZC_CV = 1024, ZC_Q = 1280, ZC_K = 1536, ZC_V = 1664, ZC_MQ = 1792, ZC_MK = 2048, ZC_MV = 2304, ZC_MO = 2560;

constexpr size_t MiB = 1u << 20;
constexpr size_t WS_CTL = 0;
constexpr size_t WS_MOD = 1 * MiB;
constexpr size_t WS_ROPE = WS_MOD + 256 * 1024;
constexpr size_t WS_WIN = 2 * MiB;
constexpr size_t WS_WOUT = 14 * MiB;
constexpr size_t WS_W13 = 18 * MiB;
constexpr size_t WS_W2 = 274 * MiB;
constexpr size_t WS_XW = 402 * MiB;
constexpr size_t WS_H = 467 * MiB;
constexpr size_t WS_H2 = 500 * MiB;
constexpr size_t WS_MIX = 533 * MiB;
constexpr size_t WS_Z = 566 * MiB;
constexpr size_t WS_QB = 656 * MiB;
constexpr size_t WS_KB = 665 * MiB;
constexpr size_t WS_VB = 670 * MiB;
constexpr size_t WS_G = 675 * MiB;
constexpr size_t WS_CLOC = 677 * MiB;
constexpr size_t WS_NLOC = 694 * MiB;
constexpr size_t WS_SCAL = WS_NLOC + 512 * 1024;
constexpr size_t WS_AFF = 695 * MiB;
constexpr size_t WS_IDX = 697 * MiB;
constexpr size_t WS_GATE = WS_IDX + 512 * 1024;
constexpr size_t WS_SLOT = 698 * MiB;
constexpr size_t WS_HID = 700 * MiB;
constexpr size_t WS_Y = 844 * MiB;
constexpr size_t WS_END = 916 * MiB;
static_assert(WS_WIN + (size_t)2 * NZ * DM * 2 <= WS_WOUT && WS_Z + (size_t)R * NZ * 2 <= WS_QB && WS_QB + (size_t)R * 256 * 2 <= WS_KB && WS_KB + (size_t)R * 128 * 2 <= WS_VB && WS_VB + (size_t)R * 128 * 2 <= WS_G, "ws map");
static_assert(WS_G + (size_t)R * 16 * 4 <= WS_CLOC && WS_CLOC + (size_t)NCHUNK * 8 * 4096 * 4 <= WS_NLOC && WS_XW + (size_t)R * DM * 4 <= WS_H && WS_H + (size_t)R * DM * 2 <= WS_H2 && WS_MIX + (size_t)R * DM * 2 <= WS_Z, "ws map");
static_assert(WS_HID + (size_t)16 * ESLOTS * FF * 2 <= WS_Y && WS_Y + (size_t)16 * ESLOTS * DM * 2 <= WS_END && WS_AFF + (size_t)16 * R * 4 <= WS_IDX && WS_SLOT + (size_t)R * 16 * 4 <= WS_HID, "ws map");

constexpr int LDS_BYTES = 147456;

typedef unsigned short bf16;
typedef unsigned v4u __attribute__((ext_vector_type(4)));
typedef unsigned v2u __attribute__((ext_vector_type(2)));
typedef float f32x4 __attribute__((ext_vector_type(4)));
typedef float f32x2 __attribute__((ext_vector_type(2)));
typedef short bf16x8 __attribute__((ext_vector_type(8)));
typedef __bf16 bf16x2_t __attribute__((ext_vector_type(2)));

__device__ __forceinline__ unsigned pk2(float lo, float hi) { f32x2 v = {lo, hi}; bf16x2_t b = __builtin_convertvector(v, bf16x2_t); return __builtin_bit_cast(unsigned, b); }
__device__ __forceinline__ float bf_lo(unsigned w) { return __uint_as_float(w << 16); }
__device__ __forceinline__ float bf_hi(unsigned w) { return __uint_as_float(w & 0xffff0000u); }
__device__ __forceinline__ float bf2f(bf16 h) { return __uint_as_float((unsigned)h << 16); }
__device__ __forceinline__ bf16 f2bf(float f) { return (bf16)(pk2(f, 0.f) & 0xffffu); }
__device__ __forceinline__ float wave_sum(float v) {
#pragma unroll
    for (int o = 32; o > 0; o >>= 1) v += __shfl_xor(v, o);
    return v;
}
__device__ __forceinline__ float wave_max(float v) {
#pragma unroll
    for (int o = 32; o > 0; o >>= 1) v = fmaxf(v, __shfl_xor(v, o));
    return v;
}

struct Args {
    const float *x, *c, *ctx, *c_ctx, *ada_w, *ada_b, *norm1_g, *w_in, *conv_w, *cmlp_norm_g, *cmlp_ws, *cmlp_bs, *q_norm_g, *k_norm_g, *ml_igate_b, *ml_fgate_b, *ml_norm_g, *w_out, *norm2_g, *router_w, *exp_w1, *exp_w3, *exp_w2, *final_norm_g;
    float* out; unsigned char* ws; int ph_lo, ph_hi;
};
typedef const __attribute__((address_space(4))) Args* KArgs;
struct Ctx { KArgs a; unsigned char* lds; int tid, lane, wave, G, bid, vcu; };
#define BLOCK_SYNC() __syncthreads()

__device__ __forceinline__ void transpose_item(const float* W, int ld, int K, bf16* WT, int k0, int n0, int drow0, float* scr, int lane) {
#pragma unroll 8
    for (int i = 0; i < 32; ++i) { const int kk = 2 * i + (lane >> 5); scr[kk * 33 + (lane & 31)] = W[(size_t)(k0 + kk) * ld + n0 + (lane & 31)]; }
    asm volatile("s_waitcnt lgkmcnt(0)" ::: "memory");
    const int c = lane & 7;
#pragma unroll
    for (int j = 0; j < 4; ++j) { const int n = (lane >> 3) + 8 * j; const float* s = scr + (8 * c) * 33 + n;
        v4u o; o.x = pk2(s[0 * 33], s[1 * 33]); o.y = pk2(s[2 * 33], s[3 * 33]); o.z = pk2(s[4 * 33], s[5 * 33]); o.w = pk2(s[6 * 33], s[7 * 33]);
        *(v4u*)(WT + (size_t)(drow0 + n) * K + k0 + 8 * c) = o; }
    asm volatile("s_waitcnt lgkmcnt(0)" ::: "memory");
}
constexpr int CV_WIN = 16 * 88, CV_WOUT = 16 * 32, CV_EXP = 3072, CV_LAYER = CV_WIN + CV_WOUT + 16 * CV_EXP, CV_TOTAL = 2 * CV_LAYER;
__device__ __forceinline__ void convert_item(Ctx& C, int it, float* scr) {
    const int l = it / CV_LAYER; int r = it % CV_LAYER;
    if (r < CV_WIN) { const int kb = r / 88, nb = r % 88; transpose_item(C.a->w_in + (size_t)l * DM * DIN, DIN, DM, ((bf16*)(C.a->ws + WS_WIN)) + (size_t)l * NZ * DM, kb * 64, nb * 32, nb * 32, scr, C.lane); return; }
    r -= CV_WIN;
    if (r < CV_WOUT) { const int kb = r / 32, nb = r % 32; transpose_item(C.a->w_out + (size_t)l * DM * DM, DM, DM, ((bf16*)(C.a->ws + WS_WOUT)) + (size_t)l * DM * DM, kb * 64, nb * 32, nb * 32, scr, C.lane); return; }
    r -= CV_WOUT;
    const int e = r / CV_EXP, s = r % CV_EXP; const size_t le = (size_t)(l * NEXP + e);
    if (s < 2048) { const int which = s >> 10, q = s & 1023, kb = q / 64, nb = q % 64, n0 = nb * 32;
        const float* W = (which ? C.a->exp_w3 : C.a->exp_w1) + le * DM * FF;
        transpose_item(W, FF, DM, ((bf16*)(C.a->ws + WS_W13)) + le * 4096 * DM, kb * 64, n0, (n0 >> 7) * 256 + which * 128 + (n0 & 127), scr, C.lane); return; }
    { const int q = s - 2048, kb = q / 32, nb = q % 32; transpose_item(C.a->exp_w2 + le * FF * DM, DM, FF, ((bf16*)(C.a->ws + WS_W2)) + le * DM * FF, kb * 64, nb * 32, nb * 32, scr, C.lane); }
}
__device__ __forceinline__ void phase_init(Ctx& C) {
    float* lf = (float*)C.lds;
    for (int m = C.bid; m < 192; m += C.G) {
        const int l = m / 96, j0 = (m % 96) * 64;
        float* sc = lf; float* red = lf + 2048;
        for (int i = C.tid; i < 2048; i += NTHR) { const float v = (i < 1024) ? C.a->c[i] : C.a->c_ctx[i - 1024]; sc[i] = v / (1.0f + __expf(-v)); }
        BLOCK_SYNC();
        const float* W = C.a->ada_w + (size_t)l * DM * 6144 + j0 + C.lane;
        float a0 = 0.f, a1 = 0.f;
#pragma unroll 8
        for (int k = C.wave * 128; k < C.wave * 128 + 128; ++k) { const float w = W[(size_t)k * 6144]; a0 += sc[k] * w; a1 += sc[1024 + k] * w; }
        red[(C.wave * 2 + 0) * 64 + C.lane] = a0; red[(C.wave * 2 + 1) * 64 + C.lane] = a1;
        BLOCK_SYNC();
        if (C.tid < 128) { const int s = C.tid >> 6, j = C.tid & 63; float t = 0.f;
#pragma unroll
            for (int w = 0; w < 8; ++w) t += red[(w * 2 + s) * 64 + j];
            ((float*)(C.a->ws + WS_MOD))[(size_t)(l * 2 + s) * 6144 + j0 + j] = t + C.a->ada_b[l * 6144 + j0 + j]; }
        BLOCK_SYNC();
    }
    if (C.bid == C.G - 1) {
        for (int i = C.tid; i < 4096; i += NTHR) { const int pos = i >> 4, f = i & 15;
            const float inv = powf(10000.0f, -(float)(2 * f) / 32.0f); const float ang = (float)pos * inv;
            ((float*)(C.a->ws + WS_ROPE))[2 * i] = (float)cos((double)ang); ((float*)(C.a->ws + WS_ROPE))[2 * i + 1] = (float)sin((double)ang); }
    }
    BLOCK_SYNC();
    float* scr = lf + C.wave * (64 * 33);
    const int gw = C.bid * NWAVES + C.wave, NGW = C.G * NWAVES;
    for (int it = gw; it < CV_TOTAL; it += NGW) convert_item(C, it, scr);
}

__device__ __forceinline__ void stage_m16(Ctx& C, const float* src, int ld, int off, float* M16) {
    for (int c = C.tid; c < 1024; c += NTHR) { const f32x4* p = (const f32x4*)(src + (size_t)c * ld + off);
#pragma unroll
        for (int q = 0; q < 4; ++q) { const f32x4 v = p[q]; M16[(q * 4 + 0) * 1024 + c] = v[0]; M16[(q * 4 + 1) * 1024 + c] = v[1]; M16[(q * 4 + 2) * 1024 + c] = v[2]; M16[(q * 4 + 3) * 1024 + c] = v[3]; } }
    BLOCK_SYNC();
}
__device__ __forceinline__ void norm_mod_row(f32x4 (&v)[4], const float* g, const float* shift, const float* scale, bf16* orow, int lane) {
    float ss = 0.f;
#pragma unroll
    for (int j = 0; j < 4; ++j) ss += (v[j][0] * v[j][0] + v[j][1] * v[j][1]) + (v[j][2] * v[j][2] + v[j][3] * v[j][3]);
    const float rstd = rsqrtf(wave_sum(ss) * (1.0f / 1024.0f) + EPSN);
#pragma unroll
    for (int j = 0; j < 4; ++j) { const int c = 4 * lane + 256 * j;
        const f32x4 gv = *(const f32x4*)(g + c), sc = *(const f32x4*)(scale + c), sh = *(const f32x4*)(shift + c);
        const f32x4 h = (v[j] * rstd * gv) * (sc + 1.0f) + sh; v[j] = h;
        v2u w; w.x = pk2(h[0], h[1]); w.y = pk2(h[2], h[3]); *(v2u*)(orow + c) = w; }
}
__device__ __forceinline__ float dot16(const f32x4 (&v)[4], const float* M16, int lane) {
    float o = 0.f;
#pragma unroll 2
    for (int e = 0; e < 16; ++e) { float s = 0.f;
#pragma unroll
        for (int j = 0; j < 4; ++j) { const f32x4 w = *(const f32x4*)(M16 + e * 1024 + 4 * lane + 256 * j); s += (v[j][0] * w[0] + v[j][1] * w[1]) + (v[j][2] * w[2] + v[j][3] * w[3]); }
        s = wave_sum(s); o = (lane == e) ? s : o; }
    return o;
}
__device__ __forceinline__ void row_A(Ctx& C, f32x4 (&v)[4], int r, int l, const float* M16) {
    const float* modp = ((float*)(C.a->ws + WS_MOD)) + (size_t)(l * 2 + (r < CTXL ? 1 : 0)) * 6144;
    norm_mod_row(v, C.a->norm1_g + l * DM, modp, modp + 1024, ((bf16*)(C.a->ws + WS_H)) + (size_t)r * DM, C.lane);
    const float o = dot16(v, M16, C.lane);
    if (C.lane < 16) ((float*)(C.a->ws + WS_G))[(size_t)r * 16 + C.lane] = o;
}
__device__ __forceinline__ void phase_A0(Ctx& C) {
    float* M16 = (float*)C.lds; stage_m16(C, C.a->w_in, DIN, NZ, M16);
    const int gw = C.bid * NWAVES + C.wave, NGW = C.G * NWAVES;
    for (int r = gw; r < R; r += NGW) {
        const float* src = (r < CTXL) ? C.a->ctx + (size_t)r * DM : C.a->x + (size_t)(r - CTXL) * DM;
        f32x4 v[4];
#pragma unroll
        for (int j = 0; j < 4; ++j) v[j] = ((const f32x4*)src)[C.lane + 64 * j];
        row_A(C, v, r, 0, M16);
    }
}
__device__ __forceinline__ void phase_G(Ctx& C, int l) {
    float* M16 = (float*)C.lds; stage_m16(C, C.a->router_w + (size_t)l * DM * 16, 16, 0, M16);
    const int gw = C.bid * NWAVES + C.wave, NGW = C.G * NWAVES; const int r0 = (l == 0) ? 0 : CTXL;
    for (int r = r0 + gw; r < R; r += NGW) {
        f32x4 v[4];
#pragma unroll
        for (int j = 0; j < 4; ++j) v[j] = ((const f32x4*)(((float*)(C.a->ws + WS_XW)) + (size_t)r * DM))[C.lane + 64 * j];
        const float* modp = ((float*)(C.a->ws + WS_MOD)) + (size_t)(l * 2 + (r < CTXL ? 1 : 0)) * 6144;
        norm_mod_row(v, C.a->norm2_g + l * DM, modp + 3 * 1024, modp + 4 * 1024, ((bf16*)(C.a->ws + WS_H2)) + (size_t)r * DM, C.lane);
        const float lg = dot16(v, M16, C.lane);
        float mx = lg;
#pragma unroll
        for (int o2 = 1; o2 < 16; o2 <<= 1) mx = fmaxf(mx, __shfl_xor(mx, o2));
        const float o = expf(lg - mx); float sum = o;
#pragma unroll
        for (int o2 = 1; o2 < 16; o2 <<= 1) sum += __shfl_xor(sum, o2);
        if (C.lane < 16) ((float*)(C.a->ws + WS_AFF))[(size_t)C.lane * R + r] = o / sum;
    }
}
__device__ __forceinline__ void phase_K(Ctx& C, int l) {
    float* M16 = (float*)C.lds;
    if (l == 0) stage_m16(C, C.a->w_in + (size_t)DM * DIN, DIN, NZ, M16);
    const int gw = C.bid * NWAVES + C.wave, NGW = C.G * NWAVES; const int r0 = (l == 0) ? 0 : CTXL;
    for (int r = r0 + gw; r < R; r += NGW) {
        f32x4 v[4], acc[4];
#pragma unroll
        for (int j = 0; j < 4; ++j) { v[j] = ((const f32x4*)(((float*)(C.a->ws + WS_XW)) + (size_t)r * DM))[C.lane + 64 * j]; acc[j] = (f32x4){0.f, 0.f, 0.f, 0.f}; }
        const int myslot = (C.lane < 16) ? ((int*)(C.a->ws + WS_SLOT))[(size_t)r * 16 + C.lane] : -1;
        for (int e = 0; e < 16; ++e) {
            const int sl = __shfl(myslot, e);
            if (sl >= 0) { const bf16* yr = ((bf16*)(C.a->ws + WS_Y)) + ((size_t)e * ESLOTS + sl) * DM;
#pragma unroll
                for (int j = 0; j < 4; ++j) { const v2u w = *(const v2u*)(yr + 4 * C.lane + 256 * j); acc[j][0] += bf_lo(w.x); acc[j][1] += bf_hi(w.x); acc[j][2] += bf_lo(w.y); acc[j][3] += bf_hi(w.y); } }
        }
        const float* g2 = ((float*)(C.a->ws + WS_MOD)) + (size_t)(l * 2 + (r < CTXL ? 1 : 0)) * 6144 + 5 * 1024;
#pragma unroll
        for (int j = 0; j < 4; ++j) { const f32x4 gg = *(const f32x4*)(g2 + 4 * C.lane + 256 * j); v[j] = v[j] + gg * acc[j]; }
        if (l == 0) {
#pragma unroll
            for (int j = 0; j < 4; ++j) ((f32x4*)(((float*)(C.a->ws + WS_XW)) + (size_t)r * DM))[C.lane + 64 * j] = v[j];
            row_A(C, v, r, 1, M16);
        } else {
            float ss = 0.f;
#pragma unroll
            for (int j = 0; j < 4; ++j) ss += (v[j][0] * v[j][0] + v[j][1] * v[j][1]) + (v[j][2] * v[j][2] + v[j][3] * v[j][3]);
            const float rstd = rsqrtf(wave_sum(ss) * (1.0f / 1024.0f) + EPSN);
#pragma unroll
            for (int j = 0; j < 4; ++j) { const f32x4 gv = *(const f32x4*)(C.a->final_norm_g + 4 * C.lane + 256 * j); ((f32x4*)(C.a->out + (size_t)(r - CTXL) * DM))[C.lane + 64 * j] = v[j] * rstd * gv; }
        }
    }
}
#define MFMA16(a, b, c) __builtin_amdgcn_mfma_f32_16x16x32_bf16(a, b, c, 0, 0, 0)
__device__ __forceinline__ float logsigmoidf(float x) { return fminf(x, 0.f) - log1pf(expf(-fabsf(x))); }
constexpr float C2Q = 0.125f * 1.4426950408889634f;

__device__ __forceinline__ void item_conv_prep(const Ctx& C0, int l, int c) {
    Ctx C = C0; { int t_ = C.tid; asm volatile("" : "+v"(t_)); C.tid = t_; C.lane = t_ & 63; }
    const int rbase = c * 128; const int slo = (rbase < CTXL) ? 0 : CTXL, shi = (rbase < CTXL) ? CTXL : R;
    const float* cw = C.a->conv_w + l * 3 * 256;
    for (int idx = C.tid; idx < 128 * 32; idx += NTHR) {
        const int row = idx >> 5, ch0 = (idx & 31) * 8, r = rbase + row; const bf16* z = ((bf16*)(C.a->ws + WS_Z)) + (size_t)r * NZ;
        const v4u zero = {0u, 0u, 0u, 0u};
        const bool hm = (r - 1 >= slo), hp = (r + 1 < shi);
        const v4u xm = hm ? *(const v4u*)(z - NZ + ZC_CONVX + ch0) : zero, cm = hm ? *(const v4u*)(z - NZ + ZC_CONVC + ch0) : zero;
        const v4u x0 = *(const v4u*)(z + ZC_CONVX + ch0), c0 = *(const v4u*)(z + ZC_CONVC + ch0), b0 = *(const v4u*)(z + ZC_CONVB + ch0);
        const v4u xp = hp ? *(const v4u*)(z + NZ + ZC_CONVX + ch0) : zero, cp = hp ? *(const v4u*)(z + NZ + ZC_CONVC + ch0) : zero;
        float o[8];
#pragma unroll
        for (int q = 0; q < 4; ++q) {
            const int ch = ch0 + 2 * q;
            const float w0a = cw[ch], w1a = cw[256 + ch], w2a = cw[512 + ch], w0b = cw[ch + 1], w1b = cw[256 + ch + 1], w2b = cw[512 + ch + 1];
            const float ya = w0a * (bf_lo(xm[q]) * bf_lo(cm[q])) + w1a * (bf_lo(x0[q]) * bf_lo(c0[q])) + w2a * (bf_lo(xp[q]) * bf_lo(cp[q]));
            const float yb = w0b * (bf_hi(xm[q]) * bf_hi(cm[q])) + w1b * (bf_hi(x0[q]) * bf_hi(c0[q])) + w2b * (bf_hi(xp[q]) * bf_hi(cp[q]));
            o[2 * q] = bf_lo(b0[q]) * ya; o[2 * q + 1] = bf_hi(b0[q]) * yb; }
        v4u w; w.x = pk2(o[0], o[1]); w.y = pk2(o[2], o[3]); w.z = pk2(o[4], o[5]); w.w = pk2(o[6], o[7]);
        *(v4u*)(((bf16*)(C.a->ws + WS_MIX)) + (size_t)r * DM + ch0) = w;
    }
    for (int it = 0; it < 12; ++it) {
        const int task = it * 64 + (C.tid >> 3), sub = C.tid & 7, row = task / 6, hd = task % 6, r = rbase + row;
        const v4u zx = *(const v4u*)(((bf16*)(C.a->ws + WS_Z)) + (size_t)r * NZ + ZC_Q + hd * 64 + sub * 8);
        float y[8];
#pragma unroll
        for (int q = 0; q < 4; ++q) { y[2 * q] = bf_lo(zx[q]); y[2 * q + 1] = bf_hi(zx[q]); }
        float ss = 0.f;
#pragma unroll
        for (int e = 0; e < 8; ++e) ss += y[e] * y[e];
        ss += __shfl_xor(ss, 1); ss += __shfl_xor(ss, 2); ss += __shfl_xor(ss, 4);
        const float rstd = rsqrtf(ss * (1.0f / 64.0f) + EPSN);
        const float* gn = ((hd < 4) ? C.a->q_norm_g : C.a->k_norm_g) + l * 64 + sub * 8;
#pragma unroll
        for (int e = 0; e < 8; ++e) y[e] = y[e] * rstd * gn[e];
        float o[8];
        if (r >= CTXL) {
            const int p = r - CTXL, pos = (sub < 4) ? (p >> 6) : (p & 63); const float* rt = ((float*)(C.a->ws + WS_ROPE)) + (size_t)(pos * 16 + 8 * (sub & 1)) * 2; const bool first = ((sub & 2) == 0);
#pragma unroll
            for (int e = 0; e < 8; ++e) { const float pr = __shfl_xor(y[e], 2); const float cs = rt[2 * e], sn = rt[2 * e + 1]; o[e] = first ? (y[e] * cs - pr * sn) : (y[e] * cs + pr * sn); }
        } else {
#pragma unroll
            for (int e = 0; e < 8; ++e) { (void)__shfl_xor(y[e], 2); o[e] = y[e]; }
        }
        const float scl = (hd < 4) ? C2Q : 1.0f;
        v4u w; w.x = pk2(o[0] * scl, o[1] * scl); w.y = pk2(o[2] * scl, o[3] * scl); w.z = pk2(o[4] * scl, o[5] * scl); w.w = pk2(o[6] * scl, o[7] * scl);
        if (hd < 4) *(v4u*)(((bf16*)(C.a->ws + WS_QB)) + (size_t)r * 256 + hd * 64 + sub * 8) = w; else *(v4u*)(((bf16*)(C.a->ws + WS_KB)) + (size_t)r * 128 + (hd - 4) * 64 + sub * 8) = w;
    }
    for (int idx = C.tid; idx < 128 * 16; idx += NTHR) { const int row = idx >> 4, ch = (idx & 15) * 8, r = rbase + row; *(v4u*)(((bf16*)(C.a->ws + WS_VB)) + (size_t)r * 128 + ch) = *(const v4u*)(((bf16*)(C.a->ws + WS_Z)) + (size_t)r * NZ + ZC_V + ch); }
}

__device__ __forceinline__ void item_cmlp(const Ctx& C0, int l, int c) {
    Ctx C = C0; { int t_ = C.tid; asm volatile("" : "+v"(t_)); C.tid = t_; C.lane = t_ & 63; }
    constexpr int LD = 136;
    bf16* VNT = (bf16*)C.lds;
    bf16* WSB = VNT + 256 * LD;
    const int rbase = c * 128; const float* gn = C.a->cmlp_norm_g + l * 256;
    for (int i = 0; i < 16; ++i) {
        const int row = C.wave * 16 + i, r = rbase + row; const bf16* z = ((bf16*)(C.a->ws + WS_Z)) + (size_t)r * NZ + ZC_CV;
        float x[4]; float ss = 0.f;
#pragma unroll
        for (int q = 0; q < 4; ++q) { x[q] = bf2f(z[C.lane + 64 * q]); ss += x[q] * x[q]; }
        const float rstd = rsqrtf(wave_sum(ss) * (1.0f / 256.0f) + EPSN);
#pragma unroll
        for (int q = 0; q < 4; ++q) VNT[(C.lane + 64 * q) * LD + row] = f2bf(x[q] * rstd * gn[C.lane + 64 * q]);
    }
    for (int h = 0; h < 4; ++h) {
        BLOCK_SYNC();
        const float* wsrc = C.a->cmlp_ws + (size_t)(l * 4 + h) * 128 * 128;
#pragma unroll
        for (int it = 0; it < 8; ++it) { const int idx = (it * NTHR + C.tid) * 4, t = idx >> 7, s = idx & 127; const f32x4 w = *(const f32x4*)(wsrc + idx);
            v2u o; o.x = pk2(w[0], w[1]); o.y = pk2(w[2], w[3]); *(v2u*)(WSB + t * LD + s) = o; }
        BLOCK_SYNC();
        const int t0 = C.wave * 16, fr = C.lane & 15, fq = C.lane >> 4;
        f32x4 acc[4];
#pragma unroll
        for (int n = 0; n < 4; ++n) acc[n] = (f32x4){0.f, 0.f, 0.f, 0.f};
#pragma unroll
        for (int ks = 0; ks < 4; ++ks) { const bf16x8 a = *(const bf16x8*)(WSB + (t0 + fr) * LD + ks * 32 + 8 * fq);
#pragma unroll
            for (int n = 0; n < 4; ++n) { const bf16x8 b = *(const bf16x8*)(VNT + (h * 64 + 16 * n + fr) * LD + ks * 32 + 8 * fq); acc[n] = MFMA16(a, b, acc[n]); } }
        const float* bs = C.a->cmlp_bs + (size_t)(l * 4 + h) * 128;
#pragma unroll
        for (int j = 0; j < 4; ++j) { const int t = t0 + 4 * fq + j, r = rbase + t; const float bb = bs[t];
#pragma unroll
            for (int n = 0; n < 4; ++n) { const int col = h * 64 + 16 * n + fr; const float u = bf2f(((bf16*)(C.a->ws + WS_Z))[(size_t)r * NZ + ZC_CU + col]); ((bf16*)(C.a->ws + WS_MIX))[(size_t)r * DM + 256 + col] = f2bf(u * (acc[n][j] + bb)); } }
    }
}

__device__ __forceinline__ void load_gates(const Ctx& C, int l, int c, int h, float* liF, float* lfF, float* liB, float* lfB) {
    if (C.tid < 128) { const int r = c * 128 + C.tid; const float* g = ((float*)(C.a->ws + WS_G)) + (size_t)r * 16;
        liF[C.tid] = g[h] + C.a->ml_igate_b[l * 8 + h]; liB[C.tid] = g[4 + h] + C.a->ml_igate_b[l * 8 + 4 + h];
        lfF[C.tid] = logsigmoidf(g[8 + h] + C.a->ml_fgate_b[l * 8 + h]); lfB[C.tid] = logsigmoidf(g[12 + h] + C.a->ml_fgate_b[l * 8 + 4 + h]); }
}
__device__ __forceinline__ void item_mlstate(const Ctx& C0, int l, int c, int h) {
    Ctx C = C0; { int t_ = C.tid; asm volatile("" : "+v"(t_)); C.tid = t_; C.lane = t_ & 63; }
    constexpr int LD = 136;
    bf16* KT = (bf16*)C.lds; bf16* VTF = KT + 64 * LD; bf16* VTB = VTF + 64 * LD;
    float* fv = (float*)(VTB + 64 * LD);
    float *liF = fv, *lfF = fv + 128, *liB = fv + 256, *lfB = fv + 384, *aF = fv + 512, *aB = fv + 640, *sc = fv + 768;
    load_gates(C, l, c, h, liF, lfF, liB, lfB);
    BLOCK_SYNC();
    if (C.tid < 128) { const int t = C.tid; float b = 0.f; for (int u = 0; u <= t; ++u) b += lfF[u]; float tot = b; for (int u = t + 1; u < 128; ++u) tot += lfF[u];
        aF[t] = tot - b + liF[t]; if (t == 0) sc[2] = tot; }
    else if (C.tid < 256) { const int t = C.tid - 128; float b = 0.f; for (int u = 127; u >= t; --u) b += lfB[u]; float tot = b; for (int u = t - 1; u >= 0; --u) tot += lfB[u];
        aB[t] = tot - b + liB[t]; if (t == 0) sc[3] = tot; }
    BLOCK_SYNC();
    if (C.wave == 0) { const float m = wave_max(fmaxf(aF[C.lane], aF[C.lane + 64])); if (C.lane == 0) sc[0] = m; }
    if (C.wave == 1) { const float m = wave_max(fmaxf(aB[C.lane], aB[C.lane + 64])); if (C.lane == 0) sc[1] = m; }
    BLOCK_SYNC();
    { const int s = C.tid >> 2, part = C.tid & 3, r = c * 128 + s; const float wF = expf(aF[s] - sc[0]), wB = expf(aB[s] - sc[1]);
        const bf16* z = ((bf16*)(C.a->ws + WS_Z)) + (size_t)r * NZ + h * 64 + part * 16;
#pragma unroll
        for (int q2 = 0; q2 < 2; ++q2) { const v4u kk = *(const v4u*)(z + ZC_MK + q2 * 8), vv = *(const v4u*)(z + ZC_MV + q2 * 8);
#pragma unroll
            for (int q = 0; q < 4; ++q) { const int d = part * 16 + q2 * 8 + 2 * q;
                KT[d * LD + s] = f2bf(bf_lo(kk[q]) * 0.125f); KT[(d + 1) * LD + s] = f2bf(bf_hi(kk[q]) * 0.125f);
                const float v0 = bf_lo(vv[q]), v1 = bf_hi(vv[q]);
                VTF[d * LD + s] = f2bf(v0 * wF); VTF[(d + 1) * LD + s] = f2bf(v1 * wF); VTB[d * LD + s] = f2bf(v0 * wB); VTB[(d + 1) * LD + s] = f2bf(v1 * wB); } } }
    BLOCK_SYNC();
    const int dir = C.wave >> 2, v0 = 16 * (C.wave & 3), fr = C.lane & 15, fq = C.lane >> 4; const bf16* VT = dir ? VTB : VTF;
    f32x4 acc[4];
#pragma unroll
    for (int n = 0; n < 4; ++n) acc[n] = (f32x4){0.f, 0.f, 0.f, 0.f};
#pragma unroll
    for (int ks = 0; ks < 4; ++ks) { const bf16x8 a = *(const bf16x8*)(VT + (v0 + fr) * LD + ks * 32 + 8 * fq);
#pragma unroll
        for (int n = 0; n < 4; ++n) { const bf16x8 b = *(const bf16x8*)(KT + (16 * n + fr) * LD + ks * 32 + 8 * fq); acc[n] = MFMA16(a, b, acc[n]); } }
    const size_t sidx = (size_t)(c * 4 + h) * 2 + dir; float* co = ((float*)(C.a->ws + WS_CLOC)) + sidx * 4096;
#pragma unroll
    for (int n = 0; n < 4; ++n)
#pragma unroll
        for (int j = 0; j < 4; ++j) co[(v0 + 4 * fq + j) * 64 + 16 * n + fr] = acc[n][j];
    if (C.tid < 128) { const int d2 = C.tid >> 6, k = C.tid & 63; const float* a = d2 ? aB : aF; const float m = sc[d2]; float s = 0.f;
        for (int u = 0; u < 128; ++u) s += expf(a[u] - m) * bf2f(KT[k * LD + u]);
        ((float*)(C.a->ws + WS_NLOC))[((size_t)(c * 4 + h) * 2 + d2) * 64 + k] = s; }
    if (C.tid < 2) { const size_t si = (size_t)(c * 4 + h) * 2 + C.tid; ((float*)(C.a->ws + WS_SCAL))[si] = sc[C.tid]; ((float*)(C.a->ws + (WS_SCAL + 1040 * 4)))[si] = sc[2 + C.tid]; }
}
__device__ __forceinline__ void phase_C(Ctx& C, int l) {
    for (int it = C.bid; it < NCHUNK * 6; it += C.G) {
        const int c = it / 6, ty = it % 6;
        if (ty == 0) item_conv_prep(C, l, c);
        else if (ty == 1) { if (l == 0 || c >= 2) item_cmlp(C, l, c); }
        else item_mlstate(C, l, c, ty - 2);
        BLOCK_SYNC();
    }
}

__device__ __forceinline__ int chain_chunk(int dir, int i) { return dir == 0 ? i : (i == 0 ? 1 : (i == 1 ? 0 : NCHUNK + 1 - i)); }
__device__ __forceinline__ void phase_D(Ctx& C) {
    float* fv = (float*)C.lds; float *bl = fv, *ml = fv + 136, *mp = fv + 272, *dold = fv + 408, *dloc = fv + 544;
    for (int it = C.bid; it < 64; it += C.G) {
        const int chain = it >> 3, rg = it & 7, h = chain >> 1, dir = chain & 1;
        if (C.tid < NCHUNK) { const int c = chain_chunk(dir, C.tid); const size_t si = (size_t)(c * 4 + h) * 2 + dir; bl[C.tid] = ((float*)(C.a->ws + (WS_SCAL + 1040 * 4)))[si]; ml[C.tid] = ((float*)(C.a->ws + WS_SCAL))[si]; }
        BLOCK_SYNC();
        if (C.tid == 0) { float m = 0.f; for (int i = 0; i < NCHUNK; ++i) { mp[i] = m; m = fmaxf(bl[i] + m, ml[i]); } mp[NCHUNK] = m; }
        BLOCK_SYNC();
        if (C.tid < NCHUNK) { const int i = C.tid; dold[i] = expf(bl[i] + mp[i] - mp[i + 1]); dloc[i] = expf(ml[i] - mp[i + 1]);
            if (rg == 0) { const int c = chain_chunk(dir, i); ((float*)(C.a->ws + (WS_SCAL + 2080 * 4)))[(size_t)(c * 4 + h) * 2 + dir] = mp[i]; } }
        BLOCK_SYNC();
        { const int e = (rg * 8 + (C.tid >> 6)) * 64 + (C.tid & 63); float st = 0.f;
            for (int i0 = 0; i0 < NCHUNK; i0 += 10) { float L[10];
#pragma unroll
                for (int u = 0; u < 10; ++u) { const int c = chain_chunk(dir, i0 + u); L[u] = ((float*)(C.a->ws + WS_CLOC))[((size_t)(c * 4 + h) * 2 + dir) * 4096 + e]; }
#pragma unroll
                for (int u = 0; u < 10; ++u) { const int c = chain_chunk(dir, i0 + u); ((float*)(C.a->ws + WS_CLOC))[((size_t)(c * 4 + h) * 2 + dir) * 4096 + e] = st; st = dold[i0 + u] * st + dloc[i0 + u] * L[u]; } } }
        if (rg == 0 && C.tid < 64) { float st = 0.f;
            for (int i = 0; i < NCHUNK; ++i) { const int c = chain_chunk(dir, i); float* p = ((float*)(C.a->ws + WS_NLOC)) + ((size_t)(c * 4 + h) * 2 + dir) * 64 + C.tid; const float L = *p; *p = st; st = dold[i] * st + dloc[i] * L; } }
        BLOCK_SYNC();
    }
}
__device__ __forceinline__ void item_mlout(const Ctx& C0, int l, int c, int h) {
    Ctx C = C0; { int t_ = C.tid; asm volatile("" : "+v"(t_)); C.tid = t_; C.lane = t_ & 63; }
    constexpr int LQ = 72, LA = 264;
    bf16* QS = (bf16*)C.lds;
    bf16* KS = QS + 128 * LQ;
    bf16* A2 = KS + 128 * LQ;
    bf16* B2T = A2 + 128 * LA;
    float* fv = (float*)(B2T + 64 * LA);
    float *liF = fv, *lfF = fv + 128, *liB = fv + 256, *lfB = fv + 384, *gF = fv + 512, *gB = fv + 640, *rowF = fv + 768, *rowB = fv + 896,
          *wiF = fv + 1024, *wiB = fv + 1152, *emF = fv + 1280, *emB = fv + 1408, *cF = fv + 1536, *cB = fv + 1664, *nP = fv + 1792;
    const int rbase = c * 128; const size_t siF = (size_t)(c * 4 + h) * 2, siB = siF + 1;
    load_gates(C, l, c, h, liF, lfF, liB, lfB);
#pragma unroll
    for (int it = 0; it < 2; ++it) { const int idx = it * NTHR + C.tid, t = idx >> 3, ch = (idx & 7) * 8; const bf16* z = ((bf16*)(C.a->ws + WS_Z)) + (size_t)(rbase + t) * NZ + h * 64 + ch;
        *(v4u*)(QS + t * LQ + ch) = *(const v4u*)(z + ZC_MQ);
        const v4u kk = *(const v4u*)(z + ZC_MK); v4u ko;
#pragma unroll
        for (int q = 0; q < 4; ++q) ko[q] = pk2(bf_lo(kk[q]) * 0.125f, bf_hi(kk[q]) * 0.125f);
        *(v4u*)(KS + t * LQ + ch) = ko; }
    { const int s = C.tid >> 2, part = C.tid & 3; const bf16* z = ((bf16*)(C.a->ws + WS_Z)) + (size_t)(rbase + s) * NZ + ZC_MV + h * 64 + part * 16;
#pragma unroll
        for (int q2 = 0; q2 < 2; ++q2) { const v4u vv = *(const v4u*)(z + q2 * 8);
#pragma unroll
            for (int q = 0; q < 4; ++q) { const int d = part * 16 + q2 * 8 + 2 * q; B2T[d * LA + s] = (bf16)(vv[q] & 0xffffu); B2T[(d + 1) * LA + s] = (bf16)(vv[q] >> 16); } } }
#pragma unroll
    for (int it = 0; it < 4; ++it) { const int idx = (it * NTHR + C.tid) * 4, dir = idx >> 12, e = idx & 4095, v = e >> 6, k = e & 63;
        const f32x4 cv = *(const f32x4*)(((float*)(C.a->ws + WS_CLOC)) + (siF + dir) * 4096 + e); v2u o; o.x = pk2(cv[0], cv[1]); o.y = pk2(cv[2], cv[3]); *(v2u*)(B2T + v * LA + 128 + dir * 64 + k) = o; }
    if (C.tid < 128) nP[C.tid] = ((float*)(C.a->ws + WS_NLOC))[siF * 64 + C.tid];
    const float mpF = ((float*)(C.a->ws + (WS_SCAL + 2080 * 4)))[siF], mpB = ((float*)(C.a->ws + (WS_SCAL + 2080 * 4)))[siB];
    BLOCK_SYNC();
    if (C.tid < 128) { const int t = C.tid; float b = 0.f, pm = -INFINITY; for (int u = 0; u <= t; ++u) { b += lfF[u]; pm = fmaxf(pm, liF[u] - b); }
        gF[t] = liF[t] - b; const float mx = fmaxf(mpF, pm); rowF[t] = -mx; wiF[t] = expf(mpF - mx); emF[t] = expf(-(b + mx));
        float nq = 0.f; for (int k = 0; k < 64; ++k) nq += nP[k] * bf2f(QS[t * LQ + k]); cF[t] = nq; }
    else if (C.tid < 256) { const int t = C.tid - 128; float b = 0.f, pm = -INFINITY; for (int u = 127; u >= t; --u) { b += lfB[u]; pm = fmaxf(pm, liB[u] - b); }
        gB[t] = liB[t] - b; const float mx = fmaxf(mpB, pm); rowB[t] = -mx; wiB[t] = expf(mpB - mx); emB[t] = expf(-(b + mx));
        float nq = 0.f; for (int k = 0; k < 64; ++k) nq += nP[64 + k] * bf2f(QS[t * LQ + k]); cB[t] = nq; }
    BLOCK_SYNC();
    const int t0 = C.wave * 16, fr = C.lane & 15, fq = C.lane >> 4;
    {
        f32x4 S[8];
#pragma unroll
        for (int n = 0; n < 8; ++n) S[n] = (f32x4){0.f, 0.f, 0.f, 0.f};
#pragma unroll
        for (int ks = 0; ks < 2; ++ks) { const bf16x8 a = *(const bf16x8*)(QS + (t0 + fr) * LQ + ks * 32 + 8 * fq);
#pragma unroll
            for (int n = 0; n < 8; ++n) { const bf16x8 b = *(const bf16x8*)(KS + (16 * n + fr) * LQ + ks * 32 + 8 * fq); S[n] = MFMA16(a, b, S[n]); } }
        float gf[8], gb[8];
#pragma unroll
        for (int n = 0; n < 8; ++n) { gf[n] = gF[16 * n + fr]; gb[n] = gB[16 * n + fr]; }
#pragma unroll
        for (int j = 0; j < 4; ++j) { const int t = t0 + 4 * fq + j; const float rF_ = rowF[t], rB_ = rowB[t];
            float pf[8], pb[8]; float sF = 0.f, sB = 0.f;
#pragma unroll
            for (int n = 0; n < 8; ++n) { const int s = 16 * n + fr; const float sv = S[n][j];
                pf[n] = (s <= t) ? sv * expf(rF_ + gf[n]) : 0.f; pb[n] = (s >= t) ? sv * expf(rB_ + gb[n]) : 0.f; sF += pf[n]; sB += pb[n]; }
#pragma unroll
            for (int o = 1; o < 16; o <<= 1) { sF += __shfl_xor(sF, o); sB += __shfl_xor(sB, o); }
            const float wf = wiF[t], wb = wiB[t];
            const float denF = sF + wf * cF[t], denB = sB + wb * cB[t];
            const float rf = 1.0f / fmaxf(fabsf(denF), emF[t]), rb = 1.0f / fmaxf(fabsf(denB), emB[t]);
#pragma unroll
            for (int n = 0; n < 8; ++n) A2[t * LA + 16 * n + fr] = f2bf(pf[n] * rf + pb[n] * rb);
            S[0][j] = wf * rf; S[1][j] = wb * rb;
        }
        BLOCK_SYNC();
        if (fr == 0) {
#pragma unroll
            for (int j = 0; j < 4; ++j) { const int t = t0 + 4 * fq + j; cF[t] = S[0][j]; cB[t] = S[1][j]; } }
    }
    BLOCK_SYNC();
#pragma unroll
    for (int it = 0; it < 2; ++it) { const int idx = it * NTHR + C.tid, t = idx >> 3, ch = (idx & 7) * 8; const v4u qq = *(const v4u*)(QS + t * LQ + ch); const float sf = cF[t], sb = cB[t]; v4u of, ob;
#pragma unroll
        for (int q = 0; q < 4; ++q) { const float a = bf_lo(qq[q]), b = bf_hi(qq[q]); of[q] = pk2(a * sf, b * sf); ob[q] = pk2(a * sb, b * sb); }
        *(v4u*)(A2 + t * LA + 128 + ch) = of; *(v4u*)(A2 + t * LA + 192 + ch) = ob; }
    BLOCK_SYNC();
    f32x4 acc[4];
#pragma unroll
    for (int n = 0; n < 4; ++n) acc[n] = (f32x4){0.f, 0.f, 0.f, 0.f};
#pragma unroll
    for (int ks = 0; ks < 8; ++ks) { const bf16x8 a = *(const bf16x8*)(A2 + (t0 + fr) * LA + ks * 32 + 8 * fq);
#pragma unroll
        for (int n = 0; n < 4; ++n) { const bf16x8 b = *(const bf16x8*)(B2T + (16 * n + fr) * LA + ks * 32 + 8 * fq); acc[n] = MFMA16(a, b, acc[n]); } }
    const float* ng = C.a->ml_norm_g + l * 256 + h * 64;
#pragma unroll
    for (int j = 0; j < 4; ++j) { const int t = t0 + 4 * fq + j, r = rbase + t; float ss = 0.f;
#pragma unroll
        for (int n = 0; n < 4; ++n) ss += acc[n][j] * acc[n][j];
#pragma unroll
        for (int o = 1; o < 16; o <<= 1) ss += __shfl_xor(ss, o);
        const float rstd = rsqrtf(ss * (1.0f / 64.0f) + EPSN);
#pragma unroll
        for (int n = 0; n < 4; ++n) { const int d = 16 * n + fr; const float po = bf2f(((bf16*)(C.a->ws + WS_Z))[(size_t)r * NZ + ZC_MO + h * 64 + d]);
            ((bf16*)(C.a->ws + WS_MIX))[(size_t)r * DM + 768 + h * 64 + d] = f2bf(acc[n][j] * rstd * ng[d] / (1.0f + expf(-po))); } }
}

__device__ __forceinline__ void item_topk(const Ctx& C0, int e, int set) {
    Ctx C = C0; { int t_ = C.tid; asm volatile("" : "+v"(t_)); C.tid = t_; C.lane = t_ & 63; }
    unsigned* lv = (unsigned*)C.lds;
    unsigned* hist = lv + 32 * 512;
    unsigned* sh = hist + 256;
    unsigned* wtot = sh + 8;
    const int n = set ? CTXL : SEQL, cap = set ? CAPC : CAPL, rowoff = set ? 0 : CTXL;
    const float* aff = ((float*)(C.a->ws + WS_AFF)) + (size_t)e * R + rowoff;
    const int base = C.tid * 32;
#pragma unroll
    for (int q = 0; q < 8; ++q) { v4u w = {0u, 0u, 0u, 0u}; if (base + 4 * q < n) w = *(const v4u*)(aff + base + 4 * q);
        lv[(4 * q + 0) * 512 + C.tid] = w.x; lv[(4 * q + 1) * 512 + C.tid] = w.y; lv[(4 * q + 2) * 512 + C.tid] = w.z; lv[(4 * q + 3) * 512 + C.tid] = w.w; }
    unsigned prefix = 0u, kk = (unsigned)cap;
    for (int pass = 0; pass < 4; ++pass) {
        const int shift = 24 - 8 * pass; const unsigned himask = (pass == 0) ? 0u : (0xffffffffu << (shift + 8));
        if (C.tid < 256) hist[C.tid] = 0u;
        BLOCK_SYNC();
#pragma unroll 4
        for (int i = 0; i < 32; ++i) { const unsigned v = lv[i * 512 + C.tid]; if ((v & himask) == prefix) atomicAdd(&hist[(v >> shift) & 255u], 1u); }
        BLOCK_SYNC();
        if (C.tid < 256) { unsigned s = 0u; for (int b = C.tid; b < 256; ++b) s += hist[b]; const unsigned above = s - hist[C.tid];
            if (s >= kk && above < kk) { sh[0] = prefix | ((unsigned)C.tid << shift); sh[1] = kk - above; } }
        BLOCK_SYNC();
        prefix = sh[0]; kk = sh[1];
        BLOCK_SYNC();
    }
    const unsigned T = prefix, need_eq = kk;
    unsigned cgt = 0u, ceq = 0u;
#pragma unroll 4
    for (int i = 0; i < 32; ++i) { const unsigned v = lv[i * 512 + C.tid]; cgt += (v > T) ? 1u : 0u; ceq += (v == T) ? 1u : 0u; }
    unsigned igt = cgt, ieq = ceq;
#pragma unroll
    for (int o = 1; o < 64; o <<= 1) { const unsigned a = __shfl_up(igt, o), b = __shfl_up(ieq, o); if (C.lane >= o) { igt += a; ieq += b; } }
    if (C.lane == 63) { wtot[C.wave] = igt; wtot[8 + C.wave] = ieq; }
    BLOCK_SYNC();
    unsigned ogt = igt - cgt, oeq = ieq - ceq;
    for (int w = 0; w < C.wave; ++w) { ogt += wtot[w]; oeq += wtot[8 + w]; }
    const int slot0 = set ? CAPL : 0;
    int* IDXp = ((int*)(C.a->ws + WS_IDX)) + e * ESLOTS; float* GATEp = ((float*)(C.a->ws + WS_GATE)) + e * ESLOTS; int* SLOTp = ((int*)(C.a->ws + WS_SLOT)) + (size_t)rowoff * 16 + e;
#pragma unroll 2
    for (int i = 0; i < 32; ++i) {
        const int tok = base + i; const unsigned v = lv[i * 512 + C.tid];
        const bool gt = v > T, eq = v == T; const bool sel = gt || (eq && oeq < need_eq);
        if (tok < n) {
            int slot = -1;
            if (sel) { slot = slot0 + (int)(ogt + (oeq < need_eq ? oeq : need_eq)); IDXp[slot] = rowoff + tok; GATEp[slot] = __uint_as_float(v); }
            SLOTp[(size_t)tok * 16] = slot;
        }
        ogt += gt ? 1u : 0u; oeq += eq ? 1u : 0u;
    }
    if (set) { for (int s = CAPL + CAPC + C.tid; s < ESLOTS; s += NTHR) { IDXp[s] = 0; GATEp[s] = 0.f; } }
    BLOCK_SYNC();
}
__device__ __forceinline__ void phase_H(Ctx& C, int l) {
    const int nitems = (l == 0) ? 32 : 16;
    for (int it = C.bid; it < nitems; it += C.G) item_topk(C, it & 15, it >> 4);
}
#define LAS __attribute__((address_space(3)))
#define XB_TMO      128
#define XB_XCNT(j)  (256  + 64 * (j))
#define XB_XSUB(j)  (1280 + 64 * (j))
#define XB_XGEN(j)  (2304 + 64 * (j))
#define XB_TOP      3328
#define XB_TOPGEN   3392
#define XCD_BAR_WORDS 3456
#define XB_SPIN_CAP (1u << 18)

__device__ __forceinline__ unsigned xb_ld(unsigned* p)              { return __hip_atomic_load(p, __ATOMIC_RELAXED, __HIP_MEMORY_SCOPE_AGENT); }
__device__ __forceinline__ unsigned xb_add(unsigned* p, unsigned v) { return __hip_atomic_fetch_add(p, v, __ATOMIC_RELAXED, __HIP_MEMORY_SCOPE_AGENT); }
__device__ __forceinline__ unsigned xb_xcc_id() { return (unsigned)__builtin_amdgcn_s_getreg((3 << 11) | 20) & 0xFu; }
#define XB_SPIN(cond, bar) do { unsigned _sp = 0; while (cond) { __builtin_amdgcn_s_sleep(1); \
    if ((++_sp & 255u) == 0u) { if (xb_ld(&(bar)[XB_TMO])) break; if (_sp > XB_SPIN_CAP) { atomicAdd(&(bar)[XB_TMO], 1u); break; } } } } while (0)

struct XcdBarrier {
    unsigned* bar; unsigned x;
    volatile LAS unsigned* st;
};

__device__ __forceinline__ XcdBarrier xcd_barrier_post(unsigned* bar, volatile LAS unsigned* st) {
    XcdBarrier b; b.bar = bar; b.x = xb_xcc_id(); b.st = st;
    if (threadIdx.x == 0) (void)xb_add(&bar[XB_XCNT(b.x)], 1u);
    return b;
}
__device__ __forceinline__ void xcd_barrier_complete(unsigned* bar, unsigned x, unsigned& nloc, unsigned& nx) {
    const unsigned G = gridDim.x * gridDim.y * gridDim.z;
    unsigned sum, cnt, mine, sp = 0u;
    for (;;) {
        sum = 0u; cnt = 0u; mine = 0u;
#pragma unroll
        for (unsigned j = 0; j < 16; ++j) { const unsigned c = xb_ld(&bar[XB_XCNT(j)]); sum += c; cnt += (c > 0u) ? 1u : 0u; mine = (j == x) ? c : mine; }
        if (sum == G) break;
        __builtin_amdgcn_s_sleep(1);
        if ((++sp & 255u) == 0u) { if (xb_ld(&bar[XB_TMO])) break; if (sp > XB_SPIN_CAP) { atomicAdd(&bar[XB_TMO], 1u); break; } }
    }
    nloc = mine > 0u ? mine : 1u; nx = cnt > 0u ? cnt : 1u;
}

__device__ __forceinline__ void xcd_barrier(const XcdBarrier& b) {
    asm volatile("s_waitcnt vmcnt(0)" ::: "memory");
    __syncthreads();
    if (threadIdx.x == 0) {
        unsigned* bar = b.bar;
        __builtin_amdgcn_s_waitcnt(0);
        unsigned nloc = b.st[0], nx = b.st[1];
        if (nloc == 0u) { xcd_barrier_complete(bar, b.x, nloc, nx); b.st[0] = nloc; b.st[1] = nx; }
        const unsigned old = xb_add(&bar[XB_XSUB(b.x)], 1u);
        const unsigned gen = old / nloc;
        if (old + 1u == (gen + 1u) * nloc) {
            __builtin_amdgcn_fence(__ATOMIC_RELEASE, "agent");
            asm volatile("s_waitcnt vmcnt(0)" ::: "memory");
            const unsigned og = xb_add(&bar[XB_TOP], 1u);
            const unsigned tg = og / nx;
            if (og + 1u == (tg + 1u) * nx) xb_add(&bar[XB_TOPGEN], 1u);
            else XB_SPIN(xb_ld(&bar[XB_TOPGEN]) == tg, bar);
            __builtin_amdgcn_fence(__ATOMIC_ACQUIRE, "agent");
            xb_add(&bar[XB_XGEN(b.x)], 1u);
            asm volatile("s_waitcnt vmcnt(0)" ::: "memory");
        } else {
            XB_SPIN(xb_ld(&bar[XB_XGEN(b.x)]) == gen, bar);
            __builtin_amdgcn_fence(__ATOMIC_ACQUIRE, "agent");
            asm volatile("s_waitcnt vmcnt(0)" ::: "memory");
        }
    }
    __syncthreads();
}

__device__ __forceinline__ void phase_E(Ctx& C, int l) {
    const int c0 = (l == 0) ? 0 : 2;
#ifndef NO_MLOUT
    for (int it = C.bid; it < (NCHUNK - c0) * 4; it += C.G) { item_mlout(C, l, c0 + it / 4, it % 4); BLOCK_SYNC(); }
#endif
#ifndef NO_ATTN
    using abf = attn_body::bf16;
    {
        for (int u = C.vcu; u < 256; u += C.G) { const int h = u >> 6, qb = u & 63; const size_t qrow = (size_t)CTXL + (size_t)qb * 256;
            attn_body::attn_unit<8>((const abf*)(((bf16*)(C.a->ws + WS_QB)) + qrow * 256 + h * 64), (const abf*)(((bf16*)(C.a->ws + WS_KB)) + (h >> 1) * 64), (const abf*)(((bf16*)(C.a->ws + WS_VB)) + (h >> 1) * 64), (abf*)(((bf16*)(C.a->ws + WS_MIX)) + qrow * DM + 512 + h * 64), R / 64, (char*)C.lds, C.tid); }
        if (l == 0) for (int u = C.bid; u < 4; u += C.G) { const int h = u;
            attn_body::attn_unit<8>((const abf*)(((bf16*)(C.a->ws + WS_QB)) + h * 64), (const abf*)(((bf16*)(C.a->ws + WS_KB)) + (h >> 1) * 64), (const abf*)(((bf16*)(C.a->ws + WS_VB)) + (h >> 1) * 64), (abf*)(((bf16*)(C.a->ws + WS_MIX)) + 512 + h * 64), CTXL / 64, (char*)C.lds, C.tid); }
    }
#endif
}

#ifndef ONLY_KIND
#define ONLY_KIND -1
#endif
#define KSEL(x) (ONLY_KIND == -1 || ONLY_KIND == (x))
constexpr int N_PHASES = 22;
template <int ph> __device__ __forceinline__ void run_phase(Ctx& C, PG8_LAS unsigned char* ldsg) {
        if constexpr (ph == 0) { if (KSEL(100)) phase_init(C); }
        else if constexpr (ph == 1) { if (KSEL(101)) phase_A0(C); }
        else {
            constexpr int l = (ph - 2) / 10, k = (ph - 2) % 10;
            if constexpr (k == 0) { if (KSEL(0)) {
                pg8::Gemm g{((bf16*)(C.a->ws + WS_H)), ((bf16*)(C.a->ws + WS_WIN)) + (size_t)l * NZ * DM, R, NZ, DM, nullptr}; pg8::StaticOrder S; S.init(R, NZ, C.G, C.bid);
                pg8::EpiBf16 E{((bf16*)(C.a->ws + WS_Z)), NZ};
                pg8::gemm_phase<pg8::EpiBf16, pg8::StaticOrder, true, false>(ldsg, g, S, E, C.tid); }
            } else if constexpr (k == 1) { if (KSEL(1)) phase_C(C, l); }
            else if constexpr (k == 2) { if (KSEL(2)) phase_D(C); }
            else if constexpr (k == 3) { if (KSEL(3)) phase_E(C, l); }
            else if constexpr (k == 4) { if (KSEL(4)) {
                const int pm0 = (l == 0) ? 0 : 1; const int rows = R - pm0 * 256;
                pg8::Gemm g{((bf16*)(C.a->ws + WS_MIX)), ((bf16*)(C.a->ws + WS_WOUT)) + (size_t)l * DM * DM, rows, DM, DM, nullptr}; pg8::StaticOrder S; S.init(rows, DM, C.G, C.bid, pm0);
                const float* modL = ((float*)(C.a->ws + WS_MOD)) + (size_t)(l * 2 + 0) * 6144 + 2 * 1024; const float* modC = ((float*)(C.a->ws + WS_MOD)) + (size_t)(l * 2 + 1) * 6144 + 2 * 1024;
                pg8::EpiResid E{(l == 0) ? C.a->ctx : ((float*)(C.a->ws + WS_XW)), (l == 0) ? C.a->x : ((float*)(C.a->ws + WS_XW)) + (size_t)CTXL * DM, ((float*)(C.a->ws + WS_XW)), modC, modL};
                pg8::gemm_phase<pg8::EpiResid, pg8::StaticOrder, true, false>(ldsg, g, S, E, C.tid); }
            } else if constexpr (k == 5) { if (KSEL(5)) phase_G(C, l); }
            else if constexpr (k == 6) { if (KSEL(6)) phase_H(C, l); }
            else if constexpr (k == 7) { if (KSEL(7)) {
                pg8::Gemm g{((bf16*)(C.a->ws + WS_H2)), ((bf16*)(C.a->ws + WS_W13)) + (size_t)l * NEXP * 4096 * DM, NEXP * ESLOTS, NEXP * 4096, DM, ((int*)(C.a->ws + WS_IDX))}; pg8::MoeOrder S; S.init((l == 0) ? 9 : 8, 16, C.G, C.vcu);
                pg8::EpiSwiGLU E{((bf16*)(C.a->ws + WS_HID))};
                pg8::gemm_phase<pg8::EpiSwiGLU, pg8::MoeOrder, true, true>(ldsg, g, S, E, C.tid); }
            } else if constexpr (k == 8) { if (KSEL(8)) {
                pg8::Gemm g{((bf16*)(C.a->ws + WS_HID)), ((bf16*)(C.a->ws + WS_W2)) + (size_t)l * NEXP * DM * FF, NEXP * ESLOTS, NEXP * DM, FF, nullptr}; pg8::MoeOrder S; S.init((l == 0) ? 9 : 8, 4, C.G, C.vcu);
                pg8::EpiGateRow E{((bf16*)(C.a->ws + WS_Y)), ((float*)(C.a->ws + WS_GATE))};
                pg8::gemm_phase<pg8::EpiGateRow, pg8::MoeOrder, true, false>(ldsg, g, S, E, C.tid); }
            } else { if (KSEL(9)) phase_K(C, l); }
        }
}
__global__ void __launch_bounds__(NTHR, 2) hybrid_fwd(Args args) {
    extern __shared__ __attribute__((aligned(16))) unsigned char lds[];
    cg::grid_group grid = cg::this_grid();
    Ctx C; C.lds = lds;
    PG8_LAS unsigned char* ldsg = (PG8_LAS unsigned char*)lds;

    const int ph_lo = args.ph_lo, ph_hi = args.ph_hi;
    volatile LAS unsigned* MISC = (volatile LAS unsigned*)((LAS unsigned char*)lds + (LDS_BYTES - 64));
    if (threadIdx.x < 16) MISC[threadIdx.x] = 0u;
    __syncthreads();
    XcdBarrier xbar = xcd_barrier_post((unsigned*)(args.ws + WS_CTL) + 4096, MISC + 8);
#define RUN_PHASE(PH) do { if (ph_lo <= (PH) && (PH) < ph_hi) { constexpr int ph = (PH); \
        { KArgs ka = (KArgs)__builtin_amdgcn_kernarg_segment_ptr(); asm volatile("" : "+s"(ka)); C.a = ka; } \
        { int tid_ = threadIdx.x; asm volatile("" : "+v"(tid_)); C.tid = tid_; C.lane = tid_ & 63; C.wave = __builtin_amdgcn_readfirstlane(tid_ >> 6); } \
        { int g_ = gridDim.x, b_ = blockIdx.x; asm volatile("" : "+s"(g_), "+s"(b_)); C.G = g_; C.bid = b_; C.vcu = (g_ % 8 == 0) ? (b_ % 8) * (g_ / 8) + b_ / 8 : b_; } \
        run_phase<ph>(C, ldsg); if ((PH) + 1 < ph_hi) { if ((PH) == 0) grid.sync(); else xcd_barrier(xbar); } } } while (0)
    RUN_PHASE(0); RUN_PHASE(1); RUN_PHASE(2); RUN_PHASE(3); RUN_PHASE(4); RUN_PHASE(5); RUN_PHASE(6); RUN_PHASE(7); RUN_PHASE(8); RUN_PHASE(9); RUN_PHASE(10); RUN_PHASE(11);
    RUN_PHASE(12); RUN_PHASE(13); RUN_PHASE(14); RUN_PHASE(15); RUN_PHASE(16); RUN_PHASE(17); RUN_PHASE(18); RUN_PHASE(19); RUN_PHASE(20); RUN_PHASE(21);
#undef RUN_PHASE
}

extern "C" void kernel_launch(void* const* d_in, const int* in_sizes, int n_in, void* d_out, int out_size, void* d_ws, size_t ws_size, hipStream_t stream) {
    static int grid = 0;
    if (grid == 0) {
        if (n_in != 24 || ws_size < WS_END) { fprintf(stderr, "kernel_launch: unexpected inputs (%d) or workspace (%zu < %zu)\n", n_in, ws_size, (size_t)WS_END); grid = -1; return; }
        int dev = 0, cus = 0, per_cu = 0;
        hipGetDevice(&dev); hipDeviceGetAttribute(&cus, hipDeviceAttributeMultiprocessorCount, dev);
        hipFuncSetAttribute((const void*)hybrid_fwd, hipFuncAttributeMaxDynamicSharedMemorySize, LDS_BYTES);
        hipOccupancyMaxActiveBlocksPerMultiprocessor(&per_cu, (const void*)hybrid_fwd, NTHR, LDS_BYTES);
        if (per_cu < 1) { fprintf(stderr, "kernel_launch: occupancy query says %d blocks per CU\n", per_cu); per_cu = 1; }
        (void)hipGetLastError();
        grid = cus;
        if (grid > 256) grid = 256;
    }
    if (grid < 0) return;
    hipMemsetAsync((char*)d_ws + WS_CTL, 0, 64 * 1024, stream);
    Args a{};
    const float** ap = (const float**)&a;
    for (int i = 0; i < 24; ++i) ap[i] = (const float*)d_in[i];
    a.out = (float*)d_out; a.ws = (unsigned char*)d_ws;
#ifndef MK_PER_PHASE
    a.ph_lo = 0; a.ph_hi = N_PHASES;
    void* kargs[] = {&a};
    hipError_t e = hipLaunchCooperativeKernel((const void*)hybrid_fwd, dim3(grid), dim3(NTHR), kargs, LDS_BYTES, stream);
    if (e != hipSuccess) fprintf(stderr, "cooperative launch failed: %s (grid %d)\n", hipGetErrorString(e), grid);
#else
    for (int p = 0; p < N_PHASES; ++p) { a.ph_lo = p; a.ph_hi = p + 1; void* kargs[] = {&a};
        hipError_t e = hipLaunchCooperativeKernel((const void*)hybrid_fwd, dim3(grid), dim3(NTHR), kargs, LDS_BYTES, stream);
        if (e != hipSuccess) { fprintf(stderr, "launch %d failed: %s\n", p, hipGetErrorString(e)); break; } }
#endif
}
```

```cpp
#include <hip/hip_runtime.h>
#include <hip/hip_bf16.h>
#include <hip/hip_cooperative_groups.h>
#include <cstdio>
#include <cstdint>
#include <cmath>
namespace cg = cooperative_groups;
namespace pg8 {
#define PG8_LAS __attribute__((address_space(3)))
typedef unsigned short bf16_t;
typedef short bf16x8 __attribute__((ext_vector_type(8)));
typedef float f32x4 __attribute__((ext_vector_type(4)));
typedef unsigned u32x4 __attribute__((ext_vector_type(4)));
constexpr int BM = 256, BK = 64, HALF = 128, HTB = HALF * BK * 2, STAGE_BYTES = 8 * HTB, NXCD = 8, WGM = 8;

__host__ __device__ __forceinline__ int lds_byte(int r, int c) { const int st = (r >> 4) * 2 + (c >> 5), rr = r & 15, cc = c & 31, ob = rr * 64 + cc * 2; return st * 1024 + (ob ^ (((ob >> 9) & 1) << 5)); }
__host__ __device__ __forceinline__ void stage_rc(int b, int& R, int& C) { const int st = b / 1024, sb = b % 1024, swz = sb ^ (((sb >> 9) & 1) << 5); R = (st >> 1) * 16 + swz / 64; C = (st & 1) * 32 + (swz % 64) / 2; }
__host__ __device__ __forceinline__ int perm32(int rho) { const int n = rho >> 4, i = rho & 15; return 8 * (i >> 2) + 4 * n + (i & 3); }

struct Unit { int pm, pn; };
struct Gemm { const bf16_t* A; const bf16_t* Bt; int M, N, K; const int* gidx; };

struct StaticOrder {
    int nM, nN, nwg, G, c, pm0;
    __host__ __device__ void init(int M, int N, int G_, int c_, int pm0_ = 0) { nM = M / BM; nN = N / BM; nwg = nM * nN; G = G_; c = c_; pm0 = pm0_; }
    __host__ __device__ bool next(int i, Unit& u) const {
        const long L = (long)i * G + c; if (L >= nwg) return false;
        int wgid = (int)L; { const int q = nwg / NXCD, r = nwg % NXCD, xcd = wgid % NXCD, off = wgid / NXCD; wgid = (xcd < r ? xcd * (q + 1) : r * (q + 1) + (xcd - r) * q) + off; }
        const int nig = WGM * nN, gid = wgid / nig, fm = gid * WGM, gsz = (nM - fm) < WGM ? (nM - fm) : WGM;
        u.pm = pm0 + fm + ((wgid % nig) % gsz); u.pn = (wgid % nig) / gsz; return true;
    }
};
struct MoeOrder {
    int npm, npn, total, G, c;
    __host__ __device__ void init(int npm_, int npn_, int G_, int c_) { npm = npm_; npn = npn_; total = 16 * npm_ * npn_; G = G_; c = c_; }
    __host__ __device__ bool next(int i, Unit& u) const {
        const long L = (long)i * G + c; if (L >= total) return false;
        const int per = npm * npn, e = (int)L / per, rem = (int)L % per, pn = rem / npm, pm = rem % npm;
        u.pm = e * 9 + pm; u.pn = e * npn + pn; return true;
    }
};

__device__ __forceinline__ unsigned cvt_pk_bf16(float lo, float hi) { unsigned r; asm volatile("v_cvt_pk_bf16_f32 %0, %1, %2" : "=v"(r) : "v"(lo), "v"(hi)); return r; }

struct EpiBf16 {
    static constexpr bool PERM = true;
    bf16_t* O; int ldc;
    __device__ __forceinline__ void operator()(const f32x4 (&acc)[2][2][4][2], const Unit& u, int wr, int wc, int fr, int fq) const {
        const int row0 = u.pm * BM + wr * 64 + fr; const int col0 = u.pn * BM + wc * 32 + 8 * fq;
#pragma unroll
        for (int ai = 0; ai < 2; ++ai)
#pragma unroll
            for (int m = 0; m < 4; ++m) { bf16_t* rowp = O + (size_t)(row0 + ai * HALF + m * 16) * ldc + col0;
#pragma unroll
                for (int bj = 0; bj < 2; ++bj) { const f32x4 v0 = acc[ai][bj][m][0], v1 = acc[ai][bj][m][1];
                    u32x4 w; w.x = cvt_pk_bf16(v0[0], v0[1]); w.y = cvt_pk_bf16(v0[2], v0[3]); w.z = cvt_pk_bf16(v1[0], v1[1]); w.w = cvt_pk_bf16(v1[2], v1[3]);
                    *(u32x4*)(rowp + bj * HALF) = w; } }
    }
};
struct EpiResid {
    static constexpr bool PERM = false;
    const float* baseC; const float* baseL; float* out; const float* gateC; const float* gateL;
    __device__ __forceinline__ void operator()(const f32x4 (&acc)[2][2][4][2], const Unit& u, int wr, int wc, int fr, int fq) const {
        const int rl = wr * 64 + fr, col0 = u.pn * BM + wc * 32 + 4 * fq;
        const float* bp = (u.pm == 0) ? baseC : baseL + (size_t)(u.pm - 1) * BM * 1024;
        const float* gp = (u.pm == 0) ? gateC : gateL;
        f32x4 gv[2][2];
#pragma unroll
        for (int bj = 0; bj < 2; ++bj)
#pragma unroll
            for (int n = 0; n < 2; ++n) gv[bj][n] = *(const f32x4*)(gp + col0 + bj * HALF + n * 16);
#pragma unroll
        for (int ai = 0; ai < 2; ++ai)
#pragma unroll
            for (int m = 0; m < 4; ++m) { const int r = rl + ai * HALF + m * 16; const float* brow = bp + (size_t)r * 1024 + col0; float* orow = out + ((size_t)u.pm * BM + r) * 1024 + col0;
#pragma unroll
                for (int bj = 0; bj < 2; ++bj)
#pragma unroll
                    for (int n = 0; n < 2; ++n) { const f32x4 b = *(const f32x4*)(brow + bj * HALF + n * 16); *(f32x4*)(orow + bj * HALF + n * 16) = b + gv[bj][n] * acc[ai][bj][m][n]; } }
    }
};
struct EpiSwiGLU {
    static constexpr bool PERM = true;
    bf16_t* O;
    __device__ __forceinline__ void operator()(const f32x4 (&acc)[2][2][4][2], const Unit& u, int wr, int wc, int fr, int fq) const {
        const int row0 = u.pm * BM + wr * 64 + fr; const int col0 = (u.pn & 15) * HALF + wc * 32 + 8 * fq;
#pragma unroll
        for (int ai = 0; ai < 2; ++ai)
#pragma unroll
            for (int m = 0; m < 4; ++m) { bf16_t* rowp = O + (size_t)(row0 + ai * HALF + m * 16) * 2048 + col0; float h[8];
#pragma unroll
                for (int n = 0; n < 2; ++n)
#pragma unroll
                    for (int j = 0; j < 4; ++j) { const float a = acc[ai][0][m][n][j], b = acc[ai][1][m][n][j]; h[n * 4 + j] = a * b * __builtin_amdgcn_rcpf(1.0f + __builtin_amdgcn_exp2f(-1.4426950408889634f * a)); }
                u32x4 w; w.x = cvt_pk_bf16(h[0], h[1]); w.y = cvt_pk_bf16(h[2], h[3]); w.z = cvt_pk_bf16(h[4], h[5]); w.w = cvt_pk_bf16(h[6], h[7]);
                *(u32x4*)rowp = w; }
    }
};
struct EpiGateRow {
    static constexpr bool PERM = true;
    bf16_t* O; const float* gate;
    __device__ __forceinline__ void operator()(const f32x4 (&acc)[2][2][4][2], const Unit& u, int wr, int wc, int fr, int fq) const {
        const int row0 = u.pm * BM + wr * 64 + fr; const int col0 = (u.pn & 3) * BM + wc * 32 + 8 * fq;
#pragma unroll
        for (int ai = 0; ai < 2; ++ai)
#pragma unroll
            for (int m = 0; m < 4; ++m) { const int r = row0 + ai * HALF + m * 16; const float gt = gate[r]; bf16_t* rowp = O + (size_t)r * 1024 + col0;
#pragma unroll
                for (int bj = 0; bj < 2; ++bj) { const f32x4 v0 = acc[ai][bj][m][0] * gt, v1 = acc[ai][bj][m][1] * gt;
                    u32x4 w; w.x = cvt_pk_bf16(v0[0], v0[1]); w.y = cvt_pk_bf16(v0[2], v0[3]); w.z = cvt_pk_bf16(v1[0], v1[1]); w.w = cvt_pk_bf16(v1[2], v1[3]);
                    *(u32x4*)(rowp + bj * HALF) = w; } }
    }
};

template <class Epi, class Sched, bool ALIGN_EPI, bool GATHER>
__device__ __forceinline__ void gemm_phase(PG8_LAS unsigned char* lds, const Gemm g, const Sched& S, const Epi& E, const int tid) {
    const int wid = __builtin_amdgcn_readfirstlane(tid >> 6), lane = tid & 63, wr = wid >> 2, wc = wid & 3, fr = lane & 15, fq = lane >> 4;
    const int K = g.K, nt = K / BK;
    unsigned voffA[2], voffB[2]; int RA[2];
#pragma unroll
    for (int i = 0; i < 2; ++i) { int R, C; stage_rc(tid * 16 + i * 8192, R, C); const int Rb = Epi::PERM ? ((R & ~31) + perm32(R & 31)) : R;
        voffA[i] = GATHER ? (unsigned)(C * 2) : (unsigned)(R * K + C) * 2u; voffB[i] = (unsigned)(Rb * K + C) * 2u; RA[i] = R; }
    const size_t kstep = (size_t)(BK * 2);
    const size_t hstep = (size_t)HALF * K * 2;
    const size_t tstep = 2 * hstep;
    const unsigned ldsw = (unsigned)wid * 1024u;
    const int aoff = lds_byte(wr * 64 + fr, fq * 8), boff = lds_byte(wc * 32 + fr, fq * 8);
#define PG8_SA(b, h) (((b) * 2 + (h)) * HTB)
#define PG8_SB(b, h) ((4 + (b) * 2 + (h)) * HTB)
#define PG8_STAGE(bufoff, gbase, voff) do { _Pragma("unroll") for (int _i = 0; _i < 2; ++_i) \
        __builtin_amdgcn_global_load_lds((const unsigned*)((const char*)(gbase) + (voff)[_i]), (PG8_LAS unsigned*)(lds + (bufoff) + ldsw + _i * 8192), 16, 0, 0); } while (0)
#define PG8_LDA(dst, b, h) do { _Pragma("unroll") for (int m = 0; m < 4; ++m) _Pragma("unroll") for (int k = 0; k < 2; ++k) dst[m][k] = *(const PG8_LAS bf16x8*)(lds + PG8_SA(b, h) + aoff + m * 2048 + k * 1024); } while (0)
#define PG8_LDB(dst, b, h) do { _Pragma("unroll") for (int n = 0; n < 2; ++n) _Pragma("unroll") for (int k = 0; k < 2; ++k) dst[n][k] = *(const PG8_LAS bf16x8*)(lds + PG8_SB(b, h) + boff + n * 2048 + k * 1024); } while (0)
#define PG8_MMA(ai, bj, At, Bt) do { __builtin_amdgcn_s_setprio(1); _Pragma("unroll") for (int m = 0; m < 4; ++m) _Pragma("unroll") for (int n = 0; n < 2; ++n) _Pragma("unroll") for (int k = 0; k < 2; ++k) \
        acc[ai][bj][m][n] = __builtin_amdgcn_mfma_f32_16x16x32_bf16(Bt[n][k], At[m][k], acc[ai][bj][m][n], 0, 0, 0); __builtin_amdgcn_s_setprio(0); } while (0)
#define PG8_WAIT_V(n) asm volatile("s_waitcnt vmcnt(" #n ")" ::: "memory")
#define PG8_WAIT_L(n) asm volatile("s_waitcnt lgkmcnt(" #n ")" ::: "memory")
#define PG8_BAR __builtin_amdgcn_s_barrier()
#define PG8_SCHED __builtin_amdgcn_sched_barrier(0)
    Unit cur, nxt; int ui = 0;
    if (!S.next(0, cur)) return;
    f32x4 acc[2][2][4][2];
#pragma unroll
    for (int a = 0; a < 2; ++a)
#pragma unroll
        for (int b = 0; b < 2; ++b)
#pragma unroll
            for (int m = 0; m < 4; ++m)
#pragma unroll
                for (int n = 0; n < 2; ++n) acc[a][b][m][n] = (f32x4){0.f, 0.f, 0.f, 0.f};
    bf16x8 At[4][2], B0[2][2], B1[2][2];
    unsigned gC0[2], gC1[2], gN0[2], gN1[2];
    const char* cA; const char* cB = (const char*)g.Bt + (size_t)cur.pn * tstep;
    if constexpr (GATHER) {
        cA = (const char*)g.A;
#pragma unroll
        for (int i = 0; i < 2; ++i) { gC0[i] = (unsigned)g.gidx[cur.pm * BM + RA[i]] * (unsigned)(K * 2) + voffA[i]; gC1[i] = (unsigned)g.gidx[cur.pm * BM + HALF + RA[i]] * (unsigned)(K * 2) + voffA[i]; gN0[i] = gC0[i]; gN1[i] = gC1[i]; }
    } else { cA = (const char*)g.A + (size_t)cur.pm * tstep; }
#define PG8_STA0(bufoff, ptr) do { if constexpr (GATHER) PG8_STAGE(bufoff, ptr, gC0); else PG8_STAGE(bufoff, ptr, voffA); } while (0)
#define PG8_STA1(bufoff, ptr) do { if constexpr (GATHER) PG8_STAGE(bufoff, ptr, gC1); else PG8_STAGE(bufoff, (ptr) + hstep, voffA); } while (0)
#define PG8_STX0(bufoff, ptr) do { if constexpr (GATHER) PG8_STAGE(bufoff, ptr, gX0); else PG8_STAGE(bufoff, ptr, voffA); } while (0)
#define PG8_STX1(bufoff, ptr) do { if constexpr (GATHER) PG8_STAGE(bufoff, ptr, gX1); else PG8_STAGE(bufoff, (ptr) + hstep, voffA); } while (0)
    PG8_STAGE(PG8_SB(0, 0), cB, voffB); PG8_STAGE(PG8_SB(0, 1), cB + hstep, voffB); PG8_STA0(PG8_SA(0, 0), cA); PG8_STA1(PG8_SA(0, 1), cA);
    if (wr == 1) PG8_BAR;
    PG8_WAIT_V(2); PG8_BAR;
    PG8_STAGE(PG8_SB(1, 0), cB + kstep, voffB); PG8_STA0(PG8_SA(1, 0), cA + kstep); PG8_STAGE(PG8_SB(1, 1), cB + hstep + kstep, voffB);
    PG8_WAIT_V(6); PG8_BAR;
    for (;;) {
        const bool has_next = S.next(ui + 1, nxt);
        const char* nA; const char* nB = has_next ? (const char*)g.Bt + (size_t)nxt.pn * tstep : cB;
        if constexpr (GATHER) {
            nA = cA;
            if (has_next) {
#pragma unroll
                for (int i = 0; i < 2; ++i) { gN0[i] = (unsigned)g.gidx[nxt.pm * BM + RA[i]] * (unsigned)(K * 2) + voffA[i]; gN1[i] = (unsigned)g.gidx[nxt.pm * BM + HALF + RA[i]] * (unsigned)(K * 2) + voffA[i]; }
            }
        } else { nA = has_next ? (const char*)g.A + (size_t)nxt.pm * tstep : cA; }
        for (int t = 0; t < nt; t += 2) {
            const bool last = (t == nt - 2);
            const char* a1 = cA + (size_t)(t + 1) * kstep;
            const char* a2 = last ? nA : cA + (size_t)(t + 2) * kstep; const char* b2 = last ? nB : cB + (size_t)(t + 2) * kstep;
            const char* a3 = a2 + kstep; const char* b3 = b2 + kstep;
            unsigned gX0[2], gX1[2];
            if constexpr (GATHER) {
#pragma unroll
                for (int i = 0; i < 2; ++i) { gX0[i] = last ? gN0[i] : gC0[i]; gX1[i] = last ? gN1[i] : gC1[i]; }
            }
            PG8_LDB(B0, 0, 0); PG8_LDB(B1, 0, 1); PG8_SCHED; PG8_LDA(At, 0, 0); PG8_STA1(PG8_SA(1, 1), a1);
            PG8_WAIT_V(8); PG8_WAIT_L(0); PG8_BAR; PG8_MMA(0, 0, At, B0); PG8_MMA(0, 1, At, B1); PG8_BAR; PG8_SCHED;
            PG8_LDA(At, 0, 1); PG8_STAGE(PG8_SB(0, 0), b2, voffB); PG8_STAGE(PG8_SB(0, 1), b2 + hstep, voffB); PG8_STX0(PG8_SA(0, 0), a2);
            PG8_WAIT_V(8); PG8_WAIT_L(0); PG8_BAR; PG8_MMA(1, 0, At, B0); PG8_MMA(1, 1, At, B1); PG8_BAR; PG8_SCHED;
            PG8_LDB(B0, 1, 0); PG8_LDB(B1, 1, 1); PG8_SCHED; PG8_LDA(At, 1, 0); PG8_STX1(PG8_SA(0, 1), a2);
            PG8_WAIT_V(8); PG8_WAIT_L(0); PG8_BAR; PG8_MMA(0, 0, At, B0); PG8_MMA(0, 1, At, B1); PG8_BAR; PG8_SCHED;
            PG8_LDA(At, 1, 1); PG8_STAGE(PG8_SB(1, 0), b3, voffB); PG8_STAGE(PG8_SB(1, 1), b3 + hstep, voffB); PG8_STX0(PG8_SA(1, 0), a3);
            PG8_WAIT_V(8); PG8_WAIT_L(0); PG8_BAR; PG8_MMA(1, 0, At, B0); PG8_MMA(1, 1, At, B1); PG8_BAR; PG8_SCHED;
        }
        if constexpr (ALIGN_EPI) { if (wr == 0) PG8_BAR; }
        E(acc, cur, wr, wc, fr, fq);
        if (!has_next) break;
#pragma unroll
        for (int a = 0; a < 2; ++a)
#pragma unroll
            for (int b = 0; b < 2; ++b)
#pragma unroll
                for (int m = 0; m < 4; ++m)
#pragma unroll
                    for (int n = 0; n < 2; ++n) acc[a][b][m][n] = (f32x4){0.f, 0.f, 0.f, 0.f};
        cur = nxt; cA = nA; cB = nB; ++ui;
        if constexpr (GATHER) {
#pragma unroll
            for (int i = 0; i < 2; ++i) { gC0[i] = gN0[i]; gC1[i] = gN1[i]; }
        }
        if constexpr (ALIGN_EPI) { if (wr == 1) PG8_BAR; }
    }
    PG8_WAIT_V(0);
    if constexpr (!ALIGN_EPI) { if (wr == 0) PG8_BAR; }
    PG8_BAR;
#undef PG8_SA
#undef PG8_SB
#undef PG8_STAGE
#undef PG8_STA0
#undef PG8_STA1
#undef PG8_STX0
#undef PG8_STX1
#undef PG8_LDA
#undef PG8_LDB
#undef PG8_MMA
#undef PG8_WAIT_V
#undef PG8_WAIT_L
#undef PG8_BAR
#undef PG8_SCHED
}
}
namespace attn_body {
using bf16=__hip_bfloat16;
using bf16x8=__attribute__((ext_vector_type(8)))short;
using s16x4=__attribute__((ext_vector_type(4)))short;
using f32x16=__attribute__((ext_vector_type(16)))float;
using u32x4=__attribute__((ext_vector_type(4)))unsigned;
constexpr int D=64,QP=256,KP=128,VP=128,OP=1024;
constexpr int NW=8,QBLK=32,QB=QBLK*NW,KVBLK=64;
__device__ __forceinline__ int crow(int r,int hi){return (r&3)+8*(r>>2)+4*hi;}
#define SBAR() __builtin_amdgcn_sched_barrier(0)
__device__ __forceinline__ void cmask(f32x16&p0,f32x16&p1,int jb,int qrel,int hi){
  const float NEG=-INFINITY; int kb=64*jb+4*hi;
  #pragma unroll
  for(int r=0;r<16;++r){int kv=kb+(r&3)+8*(r>>2); if(kv>qrel)p0[r]=NEG; if(kv+32>qrel)p1[r]=NEG;}
}

constexpr int NSLOT=3, SLOTB=8192;
constexpr int LDS_K=0, LDS_V=NSLOT*SLOTB, LDS_WS=2*NSLOT*SLOTB, LDS_OST=LDS_WS+NW*64*4, LDS_BYTES=LDS_OST+NW*4096;
constexpr float C2=0.125f*1.4426950408889634f;
__device__ __forceinline__ void glds16(const void*gsrc,unsigned lds_dst){unsigned keep;
  asm volatile("s_mov_b32 %0, m0\n\ts_mov_b32 m0, %2\n\ts_nop 0\n\tglobal_load_lds_dwordx4 %1, off\n\ts_mov_b32 m0, %0":"=&s"(keep):"v"(gsrc),"s"(lds_dst):"memory");}
__device__ __forceinline__ float max3f(float a,float b,float c){float r;asm("v_max3_f32 %0, %1, %2, %3":"=v"(r):"v"(a),"v"(b),"v"(c));return r;}
__device__ __forceinline__ float max2f(float a,float b){float r;asm("v_max_f32_e32 %0, %1, %2":"=v"(r):"v"(a),"v"(b));return r;}
__device__ __forceinline__ float fadd_s(float a,float b){float r;asm("v_add_f32_e32 %0, %1, %2":"=v"(r):"v"(a),"v"(b));return r;}
__device__ __forceinline__ float fsub_s(float a,float b){float r;asm("v_sub_f32_e32 %0, %1, %2":"=v"(r):"v"(a),"v"(b));return r;}
typedef float f32x2_t __attribute__((ext_vector_type(2))); typedef __bf16 bf16x2_t __attribute__((ext_vector_type(2)));
__device__ __forceinline__ unsigned cvtpk_s(float lo,float hi){f32x2_t v={lo,hi};bf16x2_t b=__builtin_convertvector(v,bf16x2_t);return __builtin_bit_cast(unsigned,b);}
#define WAIT_BAR(N) asm volatile("s_waitcnt vmcnt(" #N ") lgkmcnt(0)\n\ts_barrier":::"memory")

__device__ __forceinline__ void qkt(f32x16&p0,f32x16&p1,const char*Kslot,const bf16x8*qr,const f32x16&negm,int r32,int hi){
  const char*kb=Kslot+hi*1024+r32*16;
  #pragma unroll
  for(int d0=0;d0<4;++d0){
    const bf16x8 b0=*reinterpret_cast<const bf16x8*>(kb+d0*2048);
    const bf16x8 b1=*reinterpret_cast<const bf16x8*>(kb+d0*2048+512);
    if(d0==0){p0=__builtin_amdgcn_mfma_f32_32x32x16_bf16(b0,qr[0],negm,0,0,0);p1=__builtin_amdgcn_mfma_f32_32x32x16_bf16(b1,qr[0],negm,0,0,0);}
    else{p0=__builtin_amdgcn_mfma_f32_32x32x16_bf16(b0,qr[d0],p0,0,0,0);p1=__builtin_amdgcn_mfma_f32_32x32x16_bf16(b1,qr[d0],p1,0,0,0);}}
}
typedef __attribute__((address_space(3))) const char* lds_cptr;
typedef short v4i16_t __attribute__((ext_vector_type(4)));
__device__ __forceinline__ void kload8(bf16x8*kf,lds_cptr kp){
  kf[0]=*(const __attribute__((address_space(3))) bf16x8*)(kp);      kf[1]=*(const __attribute__((address_space(3))) bf16x8*)(kp+512);
  kf[2]=*(const __attribute__((address_space(3))) bf16x8*)(kp+2048); kf[3]=*(const __attribute__((address_space(3))) bf16x8*)(kp+2560);
  kf[4]=*(const __attribute__((address_space(3))) bf16x8*)(kp+4096); kf[5]=*(const __attribute__((address_space(3))) bf16x8*)(kp+4608);
  kf[6]=*(const __attribute__((address_space(3))) bf16x8*)(kp+6144); kf[7]=*(const __attribute__((address_space(3))) bf16x8*)(kp+6656);
}
__device__ __forceinline__ void kload2(bf16x8*kf,lds_cptr kp,int j){ kf[2*j]=*(const __attribute__((address_space(3))) bf16x8*)(kp+j*2048); kf[2*j+1]=*(const __attribute__((address_space(3))) bf16x8*)(kp+j*2048+512); }
__device__ __forceinline__ s16x4 vtr(lds_cptr p){ return __builtin_bit_cast(s16x4,__builtin_amdgcn_ds_read_tr16_b64_v4i16((__attribute__((address_space(3))) v4i16_t*)p)); }
__device__ __forceinline__ float rowmax(const f32x16&p0,const f32x16&p1){
  float a=max3f(p0[0],p0[1],p1[0]),b=max3f(p0[2],p0[3],p1[1]);a=max3f(a,p1[2],p1[3]);
  #pragma unroll
  for(int r=4;r<16;r+=4){a=max3f(a,p0[r],p0[r+1]);b=max3f(b,p0[r+2],p0[r+3]);a=max3f(a,p1[r],p1[r+1]);b=max3f(b,p1[r+2],p1[r+3]);}
  const float m=max2f(a,b);
  auto rr=__builtin_amdgcn_permlane32_swap(__float_as_uint(m),__float_as_uint(m),false,false);
  return max2f(__uint_as_float(rr[0]),__uint_as_float(rr[1]));
}
__device__ __forceinline__ void pv(f32x16*o,int vb,bf16x8 pa0,bf16x8 pa1,bf16x8 pa2,bf16x8 pa3){
  #pragma unroll
  for(int d0=0;d0<2;++d0){s16x4 lo[4],hi[4];
    #pragma unroll
    for(int ks=0;ks<4;++ks){
      asm volatile("ds_read_b64_tr_b16 %0,%1 offset:%c2":"=&v"(lo[ks]):"v"(vb),"i"(d0*4096+ks*1024):"memory");
      asm volatile("ds_read_b64_tr_b16 %0,%1 offset:%c2":"=&v"(hi[ks]):"v"(vb),"i"(d0*4096+ks*1024+512):"memory");}
    asm volatile("s_waitcnt lgkmcnt(0)":::"memory");SBAR();
    #define PK(k) (bf16x8){lo[k][0],lo[k][1],lo[k][2],lo[k][3],hi[k][0],hi[k][1],hi[k][2],hi[k][3]}
    o[d0]=__builtin_amdgcn_mfma_f32_32x32x16_bf16(pa0,PK(0),o[d0],0,0,0);
    o[d0]=__builtin_amdgcn_mfma_f32_32x32x16_bf16(pa1,PK(1),o[d0],0,0,0);
    o[d0]=__builtin_amdgcn_mfma_f32_32x32x16_bf16(pa2,PK(2),o[d0],0,0,0);
    o[d0]=__builtin_amdgcn_mfma_f32_32x32x16_bf16(pa3,PK(3),o[d0],0,0,0);
    #undef PK
  }
}

#ifndef ATTN_STORE16
#define ATTN_STORE16(p,v) (*(u32x4*)(p)=(v))
#endif
template<int THRL> __device__ __forceinline__ void attn_unit(const bf16*Qu,const bf16*__restrict__ Kh,const bf16*__restrict__ Vh,bf16*Ou,const int NT,char*shm,const int tid){
  const int lane=tid&63,r32=lane&31,hi=lane>>5; const int wid=__builtin_amdgcn_readfirstlane(tid>>6);
  const bf16*Qw=Qu+(long)(wid*QBLK)*QP;
  const unsigned lds0=(unsigned)(uintptr_t)shm;
  float*wsf=(float*)(shm+LDS_WS)+wid*64;
  const bf16*ksrc=Kh+(long)lane*KP+wid*8;
  const bf16*vsrc=Vh+(long)(16*(wid&3)+(lane>>2))*VP+(wid>>2)*32+(lane&3)*8;
  const unsigned kdst=lds0+LDS_K+wid*1024, vdst=lds0+LDS_V+wid*1024;
  #define DMA_K(t,slot) glds16(ksrc+(long)(t)*KVBLK*KP,(unsigned)__builtin_amdgcn_readfirstlane(kdst+(slot)))
  #define DMA_V(t,slot) glds16(vsrc+(long)(t)*KVBLK*VP,(unsigned)__builtin_amdgcn_readfirstlane(vdst+(slot)))
  const int vb0=(int)(lds0+LDS_V)+((lane>>4)&1)*32+(lane&3)*8+(4*hi+((lane&15)>>2))*64;
  const char*Kbase=shm+LDS_K; bf16x8 kf[8];
  const lds_cptr shm3=(lds_cptr)shm; const lds_cptr kp0=shm3+LDS_K+hi*1024+r32*16; const lds_cptr vp0=shm3+LDS_V+((lane>>4)&1)*32+(lane&3)*8+(4*hi+((lane&15)>>2))*64;
  DMA_K(0,0);DMA_V(0,0);DMA_K(1,SLOTB);
  bf16x8 qr[4];
  #pragma unroll
  for(int d0=0;d0<4;++d0)qr[d0]=*reinterpret_cast<const bf16x8*>(&Qw[(long)r32*QP+d0*16+hi*8]);
  float mhat=0.f,l_reg=0.f;f32x16 o[2];o[0]=f32x16{};o[1]=f32x16{};f32x16 negm=f32x16{};asm volatile("":"+v"(negm));
  #define CMASK(P0,P1,t) do{}while(0)
  bool resc=false;
  #define START(P0,P1) do{ const float rm=rowmax(P0,P1); resc=false; \
    { const float dl=rm; mhat=fadd_s(mhat,dl); \
      _Pragma("unroll") for(int r=0;r<16;++r){P0[r]=fsub_s(P0[r],dl);P1[r]=fsub_s(P1[r],dl);} \
      _Pragma("unroll") for(int r=0;r<16;++r)negm[r]=-mhat; asm volatile("":"+v"(negm)); } \
    _Pragma("unroll") for(int r=0;r<16;++r)P0[r]=__builtin_amdgcn_exp2f(P0[r]); }while(0)
  #define RESC() do{ if(resc){ asm volatile("s_waitcnt lgkmcnt(0)":::"memory"); \
      _Pragma("unroll") for(int d_=0;d_<2;++d_) _Pragma("unroll") for(int r=0;r<16;++r)o[d_][r]*=wsf[crow(r,hi)]; } }while(0)
  f32x16 pA0,pA1,pB0,pB1;
  int sl_prev=0,sl_cur=0,sl_next=SLOTB;
  #define ROT() do{sl_prev=sl_cur;sl_cur=sl_next;sl_next=(sl_next==(NSLOT-1)*SLOTB)?0:sl_next+SLOTB;}while(0)
  DMA_K(2,2*SLOTB);
  WAIT_BAR(3);
  qkt(pA0,pA1,Kbase,qr,negm,r32,hi);asm volatile("s_nop 15\n\ts_nop 7":"+v"(pA0),"+v"(pA1));CMASK(pA0,pA1,0);
  START(pA0,pA1);
  _Pragma("unroll") for(int r=0;r<16;++r)pA1[r]=__builtin_amdgcn_exp2f(pA1[r]);
  WAIT_BAR(0);
  DMA_K(3,0);DMA_V(1,SLOTB);
  ROT();
  kload8(kf,kp0+sl_cur);
  WAIT_BAR(2);
  s16x4 vlo[8],vhi[8]; u32x4 pw0,pw1,pw2,pw3;
  #define PKW(P,B) cvtpk_s(P[B],P[B+1])
  #define PAF(k) __builtin_bit_cast(bf16x8,pw##k)
  #define VFR(i) (bf16x8){vlo[i][0],vlo[i][1],vlo[i][2],vlo[i][3],vhi[i][0],vhi[i][1],vhi[i][2],vhi[i][3]}
  #define PIN(x) asm volatile("":"+v"(x))
  #define MX3(a,b,c) __builtin_fmaxf(__builtin_fmaxf((a),(b)),(c))
  #define GAPA(MF,A0,A1,A2,A3,W0,W1,PW) do{ MF; sacc+=A0; sacc+=A1; sacc+=A2; sacc+=A3; PIN(sacc); W0; W1; PIN(PW); SBAR(); }while(0)
  #define EX(v) __builtin_amdgcn_exp2f(v)
  #define GAPB(MF,X,B) do{ MF; X[B]=EX(X[B]); X[B+1]=EX(X[B+1]); X[B+2]=EX(X[B+2]); X[B+3]=EX(X[B+3]); PIN(X); SBAR(); }while(0)
  #define VRD(i) do{ vlo[i]=vtr(vp_+(((i)>>2)*4096+((i)&3)*1024)); vhi[i]=vtr(vp_+(((i)>>2)*4096+((i)&3)*1024+512)); }while(0)
  #define KRD(G,j) do{ if(G){ kload2(kf,kp0+sl_next,j); SBAR(); } }while(0)
  #define STEP(C0,C1,P0,P1,t,GK,GV,GL) do{ SBAR(); \
    const lds_cptr vp_=vp0+sl_prev; \
    VRD(0); SBAR(); float sacc=(P0[0]+P0[1]); \
    GAPA(C0=__builtin_amdgcn_mfma_f32_32x32x16_bf16(kf[0],qr[0],negm,0,0,0), P0[2],P0[3],P0[4],P0[5],     pw0[0]=PKW(P0,0), pw0[1]=PKW(P0,2), pw0); \
    VRD(4); SBAR(); GAPA(C1=__builtin_amdgcn_mfma_f32_32x32x16_bf16(kf[1],qr[0],negm,0,0,0), P0[6],P0[7],P0[8],P0[9],     pw0[2]=PKW(P0,4), pw0[3]=PKW(P0,6), pw0); \
    VRD(1); SBAR(); GAPA(C0=__builtin_amdgcn_mfma_f32_32x32x16_bf16(kf[2],qr[1],C0,0,0,0),   P0[10],P0[11],P0[12],P0[13], pw1[0]=PKW(P0,8), pw1[1]=PKW(P0,10), pw1); \
    VRD(5); SBAR(); GAPA(C1=__builtin_amdgcn_mfma_f32_32x32x16_bf16(kf[3],qr[1],C1,0,0,0),   P0[14],P0[15],P1[0],P1[1],   pw1[2]=PKW(P0,12),pw1[3]=PKW(P0,14), pw1); \
    VRD(2); SBAR(); GAPA(C0=__builtin_amdgcn_mfma_f32_32x32x16_bf16(kf[4],qr[2],C0,0,0,0),   P1[2],P1[3],P1[4],P1[5],     pw2[0]=PKW(P1,0), pw2[1]=PKW(P1,2), pw2); \
    VRD(6); SBAR(); GAPA(C1=__builtin_amdgcn_mfma_f32_32x32x16_bf16(kf[5],qr[2],C1,0,0,0),   P1[6],P1[7],P1[8],P1[9],     pw2[2]=PKW(P1,4), pw2[3]=PKW(P1,6), pw2); \
    VRD(3); SBAR(); GAPA(C0=__builtin_amdgcn_mfma_f32_32x32x16_bf16(kf[6],qr[3],C0,0,0,0),   P1[10],P1[11],P1[12],P1[13], pw3[0]=PKW(P1,8), pw3[1]=PKW(P1,10), pw3); \
    VRD(7); SBAR(); GAPA(C1=__builtin_amdgcn_mfma_f32_32x32x16_bf16(kf[7],qr[3],C1,0,0,0),   P1[14],P1[15],0.f,0.f,       pw3[2]=PKW(P1,12),pw3[3]=PKW(P1,14), pw3); \
    l_reg+=sacc; \
    if(GK){DMA_K((t)+3,sl_cur);} if(GV){DMA_V((t)+1,sl_next);} \
    CMASK(C0,C1,t); \
    { float a=MX3(C0[0],C0[1],C1[0]),b=MX3(C0[2],C0[3],C1[1]); a=MX3(a,C1[2],C1[3]); \
      _Pragma("unroll") for(int r=4;r<16;r+=4){a=MX3(a,C0[r],C0[r+1]);b=MX3(b,C0[r+2],C0[r+3]);a=MX3(a,C1[r],C1[r+1]);b=MX3(b,C1[r+2],C1[r+3]);} \
      float rm=__builtin_fmaxf(a,b); { auto rr=__builtin_amdgcn_permlane32_swap(__float_as_uint(rm),__float_as_uint(rm),false,false); rm=__builtin_fmaxf(__uint_as_float(rr[0]),__uint_as_float(rr[1])); } \
      resc=false; \
      if(__builtin_expect(__any(rm>(float)THRL),0)){ const float dl=__builtin_fmaxf(rm,0.f); mhat+=dl; \
        _Pragma("unroll") for(int r=0;r<16;++r){C0[r]-=dl;C1[r]-=dl;} \
        _Pragma("unroll") for(int r=0;r<16;++r)negm[r]=-mhat; asm volatile("":"+v"(negm)); \
        const float f=__builtin_amdgcn_exp2f(-dl); l_reg*=f; if(hi==0)wsf[r32]=f; resc=true; } } \
    SBAR(); \
    GAPB(o[0]=__builtin_amdgcn_mfma_f32_32x32x16_bf16(PAF(0),VFR(0),o[0],0,0,0), C0,0); \
    GAPB(o[1]=__builtin_amdgcn_mfma_f32_32x32x16_bf16(PAF(0),VFR(4),o[1],0,0,0), C0,4); \
    KRD(GL,0); GAPB(o[0]=__builtin_amdgcn_mfma_f32_32x32x16_bf16(PAF(1),VFR(1),o[0],0,0,0), C0,8); \
    KRD(GL,1); GAPB(o[1]=__builtin_amdgcn_mfma_f32_32x32x16_bf16(PAF(1),VFR(5),o[1],0,0,0), C0,12); \
    KRD(GL,2); GAPB(o[0]=__builtin_amdgcn_mfma_f32_32x32x16_bf16(PAF(2),VFR(2),o[0],0,0,0), C1,0); \
    KRD(GL,3); GAPB(o[1]=__builtin_amdgcn_mfma_f32_32x32x16_bf16(PAF(2),VFR(6),o[1],0,0,0), C1,4); \
    GAPB(o[0]=__builtin_amdgcn_mfma_f32_32x32x16_bf16(PAF(3),VFR(3),o[0],0,0,0), C1,8); \
    GAPB(o[1]=__builtin_amdgcn_mfma_f32_32x32x16_bf16(PAF(3),VFR(7),o[1],0,0,0), C1,12); \
    }while(0)
  int t=1;
  #undef CMASK
  #define CMASK(P0,P1,t) do{}while(0)
  for(;t+5<NT;t+=2){
    STEP(pB0,pB1,pA0,pA1,t,true,true,true);     WAIT_BAR(2); RESC(); ROT();
    STEP(pA0,pA1,pB0,pB1,t+1,true,true,true);   WAIT_BAR(2); RESC(); ROT();
  }
  #undef CMASK
  #define CMASK(P0,P1,t) do{}while(0)
  #define ENDW(tt) do{ if((tt)+3<NT){WAIT_BAR(2);} else if((tt)+2<NT){WAIT_BAR(1);} else {WAIT_BAR(0);} }while(0)
  for(;t+1<NT;t+=2){
    STEP(pB0,pB1,pA0,pA1,t,(t+3<NT),(t+1<NT),(t+1<NT));       ENDW(t);   RESC(); ROT();
    STEP(pA0,pA1,pB0,pB1,t+1,(t+4<NT),(t+2<NT),(t+2<NT));     ENDW(t+1); RESC(); ROT();
  }
  STEP(pB0,pB1,pA0,pA1,NT-1,false,false,false); RESC();
  { float sacc=pB0[0]+pB0[1]; _Pragma("unroll") for(int r=2;r<16;++r)sacc+=pB0[r]; _Pragma("unroll") for(int r=0;r<16;++r)sacc+=pB1[r]; l_reg+=sacc;
    pw0=(u32x4){PKW(pB0,0),PKW(pB0,2),PKW(pB0,4),PKW(pB0,6)};pw1=(u32x4){PKW(pB0,8),PKW(pB0,10),PKW(pB0,12),PKW(pB0,14)};pw2=(u32x4){PKW(pB1,0),PKW(pB1,2),PKW(pB1,4),PKW(pB1,6)};pw3=(u32x4){PKW(pB1,8),PKW(pB1,10),PKW(pB1,12),PKW(pB1,14)};
    SBAR(); pv(o,vb0+sl_cur,PAF(0),PAF(1),PAF(2),PAF(3)); }
  #undef PKW
  #undef PAF
  #undef VFR
  #undef PIN
  #undef MX3
  #undef GAPA
  #undef GAPB
  #undef EX
  #undef VRD
  #undef KRD
  #undef STEP
  #undef ENDW
  {auto rr=__builtin_amdgcn_permlane32_swap(__float_as_uint(l_reg),__float_as_uint(l_reg),false,false);l_reg=__uint_as_float(rr[0])+__uint_as_float(rr[1]);}
  if(hi==0)wsf[32+r32]=l_reg;asm volatile("s_waitcnt lgkmcnt(0)":::"memory");
  float rli[16];
  #pragma unroll
  for(int r=0;r<16;++r)rli[r]=__builtin_amdgcn_rcpf(wsf[32+crow(r,hi)]);
  bf16*Ow=Ou+(long)(wid*QBLK)*OP;
  { bf16*stg=(bf16*)(shm+LDS_OST)+wid*2048;
    #pragma unroll
    for(int r=0;r<16;++r){const int orow=crow(r,hi);
      #pragma unroll
      for(int d0=0;d0<2;++d0)stg[orow*64+d0*32+r32]=__float2bfloat16(o[d0][r]*rli[r]);}
    asm volatile("s_waitcnt lgkmcnt(0)":::"memory");
    #pragma unroll
    for(int i=0;i<4;++i){const int row=i*8+(lane>>3),ch=lane&7; const u32x4 v=*(const u32x4*)(stg+row*64+ch*8); ATTN_STORE16(Ow+(long)row*OP+ch*8,v);} }
  asm volatile("s_waitcnt lgkmcnt(0)\n\ts_barrier":::"memory");
  #undef DMA_K
  #undef DMA_V
  #undef CMASK
  #undef START
  #undef RESC
  #undef ROT
}
constexpr int ATTN_LDS_BYTES=LDS_BYTES;
#undef SBAR
#undef WAIT_BAR
}
constexpr int NWAVES = 8, NTHR = 512;
constexpr int DM = 1024, SEQL = 16384, CTXL = 256, R = SEQL + CTXL;
constexpr int DIN = 2832, NZ = 2816;
constexpr int NEXP = 16, FF = 2048, CAPL = 2048, CAPC = 32, ESLOTS = 2304;
constexpr int NCHUNK = R / 128;
constexpr float EPSN = 1e-6f;
constexpr int ZC_CONVX = 0, ZC_CONVB = 256, ZC_CONVC = 512, ZC_CU = 768, ZC_CV = 1024, ZC_Q = 1280, ZC_K = 1536, ZC_V = 1664, ZC_MQ = 1792, ZC_MK = 2048, ZC_MV = 2304, ZC_MO = 2560;

constexpr size_t MiB = 1u << 20;
constexpr size_t WS_CTL = 0;
constexpr size_t WS_MOD = 1 * MiB;
constexpr size_t WS_ROPE = WS_MOD + 256 * 1024;
constexpr size_t WS_WIN = 2 * MiB;
constexpr size_t WS_WOUT = 14 * MiB;
constexpr size_t WS_W13 = 18 * MiB;
constexpr size_t WS_W2 = 274 * MiB;
constexpr size_t WS_XW = 402 * MiB;
constexpr size_t WS_H = 467 * MiB;
constexpr size_t WS_H2 = 500 * MiB;
constexpr size_t WS_MIX = 533 * MiB;
constexpr size_t WS_Z = 566 * MiB;
constexpr size_t WS_QB = 656 * MiB;
constexpr size_t WS_KB = 665 * MiB;
constexpr size_t WS_VB = 670 * MiB;
constexpr size_t WS_G = 675 * MiB;
constexpr size_t WS_CLOC = 677 * MiB;
constexpr size_t WS_NLOC = 694 * MiB;
constexpr size_t WS_SCAL = WS_NLOC + 512 * 1024;
constexpr size_t WS_AFF = 695 * MiB;
constexpr size_t WS_IDX = 697 * MiB;
constexpr size_t WS_GATE = WS_IDX + 512 * 1024;
constexpr size_t WS_SLOT = 698 * MiB;
constexpr size_t WS_HID = 700 * MiB;
constexpr size_t WS_Y = 844 * MiB;
constexpr size_t WS_END = 916 * MiB;
static_assert(WS_WIN + (size_t)2 * NZ * DM * 2 <= WS_WOUT && WS_Z + (size_t)R * NZ * 2 <= WS_QB && WS_QB + (size_t)R * 256 * 2 <= WS_KB && WS_KB + (size_t)R * 128 * 2 <= WS_VB && WS_VB + (size_t)R * 128 * 2 <= WS_G, "ws map");
static_assert(WS_G + (size_t)R * 16 * 4 <= WS_CLOC && WS_CLOC + (size_t)NCHUNK * 8 * 4096 * 4 <= WS_NLOC && WS_XW + (size_t)R * DM * 4 <= WS_H && WS_H + (size_t)R * DM * 2 <= WS_H2 && WS_MIX + (size_t)R * DM * 2 <= WS_Z, "ws map");
static_assert(WS_HID + (size_t)16 * ESLOTS * FF * 2 <= WS_Y && WS_Y + (size_t)16 * ESLOTS * DM * 2 <= WS_END && WS_AFF + (size_t)16 * R * 4 <= WS_IDX && WS_SLOT + (size_t)R * 16 * 4 <= WS_HID, "ws map");

constexpr int LDS_BYTES = 147456;

typedef unsigned short bf16;
typedef unsigned v4u __attribute__((ext_vector_type(4)));
typedef unsigned v2u __attribute__((ext_vector_type(2)));
typedef float f32x4 __attribute__((ext_vector_type(4)));
typedef float f32x2 __attribute__((ext_vector_type(2)));
typedef short bf16x8 __attribute__((ext_vector_type(8)));
typedef __bf16 bf16x2_t __attribute__((ext_vector_type(2)));

__device__ __forceinline__ unsigned pk2(float lo, float hi) { f32x2 v = {lo, hi}; bf16x2_t b = __builtin_convertvector(v, bf16x2_t); return __builtin_bit_cast(unsigned, b); }
__device__ __forceinline__ float bf_lo(unsigned w) { return __uint_as_float(w << 16); }
__device__ __forceinline__ float bf_hi(unsigned w) { return __uint_as_float(w & 0xffff0000u); }
__device__ __forceinline__ float bf2f(bf16 h) { return __uint_as_float((unsigned)h << 16); }
__device__ __forceinline__ bf16 f2bf(float f) { return (bf16)(pk2(f, 0.f) & 0xffffu); }
__device__ __forceinline__ float wave_sum(float v) {
#pragma unroll
    for (int o = 32; o > 0; o >>= 1) v += __shfl_xor(v, o);
    return v;
}
__device__ __forceinline__ float wave_max(float v) {
#pragma unroll
    for (int o = 32; o > 0; o >>= 1) v = fmaxf(v, __shfl_xor(v, o));
    return v;
}

struct Args {
    const float *x, *c, *ctx, *c_ctx, *ada_w, *ada_b, *norm1_g, *w_in, *conv_w, *cmlp_norm_g, *cmlp_ws, *cmlp_bs, *q_norm_g, *k_norm_g, *ml_igate_b, *ml_fgate_b, *ml_norm_g, *w_out, *norm2_g, *router_w, *exp_w1, *exp_w3, *exp_w2, *final_norm_g;
    float* out; unsigned char* ws; int ph_lo, ph_hi;
};
typedef const __attribute__((address_space(4))) Args* KArgs;
struct Ctx { KArgs a; unsigned char* lds; int tid, lane, wave, G, bid, vcu; };
#define BLOCK_SYNC() __syncthreads()

__device__ __forceinline__ void transpose_item(const float* W, int ld, int K, bf16* WT, int k0, int n0, int drow0, float* scr, int lane) {
#pragma unroll 8
    for (int i = 0; i < 32; ++i) { const int kk = 2 * i + (lane >> 5); scr[kk * 33 + (lane & 31)] = W[(size_t)(k0 + kk) * ld + n0 + (lane & 31)]; }
    asm volatile("s_waitcnt lgkmcnt(0)" ::: "memory");
    const int c = lane & 7;
#pragma unroll
    for (int j = 0; j < 4; ++j) { const int n = (lane >> 3) + 8 * j; const float* s = scr + (8 * c) * 33 + n;
        v4u o; o.x = pk2(s[0 * 33], s[1 * 33]); o.y = pk2(s[2 * 33], s[3 * 33]); o.z = pk2(s[4 * 33], s[5 * 33]); o.w = pk2(s[6 * 33], s[7 * 33]);
        *(v4u*)(WT + (size_t)(drow0 + n) * K + k0 + 8 * c) = o; }
    asm volatile("s_waitcnt lgkmcnt(0)" ::: "memory");
}
constexpr int CV_WIN = 16 * 88, CV_WOUT = 16 * 32, CV_EXP = 3072, CV_LAYER = CV_WIN + CV_WOUT + 16 * CV_EXP, CV_TOTAL = 2 * CV_LAYER;
__device__ __forceinline__ void convert_item(Ctx& C, int it, float* scr) {
    const int l = it / CV_LAYER; int r = it % CV_LAYER;
    if (r < CV_WIN) { const int kb = r / 88, nb = r % 88; transpose_item(C.a->w_in + (size_t)l * DM * DIN, DIN, DM, ((bf16*)(C.a->ws + WS_WIN)) + (size_t)l * NZ * DM, kb * 64, nb * 32, nb * 32, scr, C.lane); return; }
    r -= CV_WIN;
    if (r < CV_WOUT) { const int kb = r / 32, nb = r % 32; transpose_item(C.a->w_out + (size_t)l * DM * DM, DM, DM, ((bf16*)(C.a->ws + WS_WOUT)) + (size_t)l * DM * DM, kb * 64, nb * 32, nb * 32, scr, C.lane); return; }
    r -= CV_WOUT;
    const int e = r / CV_EXP, s = r % CV_EXP; const size_t le = (size_t)(l * NEXP + e);
    if (s < 2048) { const int which = s >> 10, q = s & 1023, kb = q / 64, nb = q % 64, n0 = nb * 32;
        const float* W = (which ? C.a->exp_w3 : C.a->exp_w1) + le * DM * FF;
        transpose_item(W, FF, DM, ((bf16*)(C.a->ws + WS_W13)) + le * 4096 * DM, kb * 64, n0, (n0 >> 7) * 256 + which * 128 + (n0 & 127), scr, C.lane); return; }
    { const int q = s - 2048, kb = q / 32, nb = q % 32; transpose_item(C.a->exp_w2 + le * FF * DM, DM, FF, ((bf16*)(C.a->ws + WS_W2)) + le * DM * FF, kb * 64, nb * 32, nb * 32, scr, C.lane); }
}
__device__ __forceinline__ void phase_init(Ctx& C) {
    float* lf = (float*)C.lds;
    for (int m = C.bid; m < 192; m += C.G) {
        const int l = m / 96, j0 = (m % 96) * 64;
        float* sc = lf; float* red = lf + 2048;
        for (int i = C.tid; i < 2048; i += NTHR) { const float v = (i < 1024) ? C.a->c[i] : C.a->c_ctx[i - 1024]; sc[i] = v / (1.0f + __expf(-v)); }
        BLOCK_SYNC();
        const float* W = C.a->ada_w + (size_t)l * DM * 6144 + j0 + C.lane;
        float a0 = 0.f, a1 = 0.f;
#pragma unroll 8
        for (int k = C.wave * 128; k < C.wave * 128 + 128; ++k) { const float w = W[(size_t)k * 6144]; a0 += sc[k] * w; a1 += sc[1024 + k] * w; }
        red[(C.wave * 2 + 0) * 64 + C.lane] = a0; red[(C.wave * 2 + 1) * 64 + C.lane] = a1;
        BLOCK_SYNC();
        if (C.tid < 128) { const int s = C.tid >> 6, j = C.tid & 63; float t = 0.f;
#pragma unroll
            for (int w = 0; w < 8; ++w) t += red[(w * 2 + s) * 64 + j];
            ((float*)(C.a->ws + WS_MOD))[(size_t)(l * 2 + s) * 6144 + j0 + j] = t + C.a->ada_b[l * 6144 + j0 + j]; }
        BLOCK_SYNC();
    }
    if (C.bid == C.G - 1) {
        for (int i = C.tid; i < 4096; i += NTHR) { const int pos = i >> 4, f = i & 15;
            const float inv = powf(10000.0f, -(float)(2 * f) / 32.0f); const float ang = (float)pos * inv;
            ((float*)(C.a->ws + WS_ROPE))[2 * i] = (float)cos((double)ang); ((float*)(C.a->ws + WS_ROPE))[2 * i + 1] = (float)sin((double)ang); }
    }
    BLOCK_SYNC();
    float* scr = lf + C.wave * (64 * 33);
    const int gw = C.bid * NWAVES + C.wave, NGW = C.G * NWAVES;
    for (int it = gw; it < CV_TOTAL; it += NGW) convert_item(C, it, scr);
}

__device__ __forceinline__ void stage_m16(Ctx& C, const float* src, int ld, int off, float* M16) {
    for (int c = C.tid; c < 1024; c += NTHR) { const f32x4* p = (const f32x4*)(src + (size_t)c * ld + off);
#pragma unroll
        for (int q = 0; q < 4; ++q) { const f32x4 v = p[q]; M16[(q * 4 + 0) * 1024 + c] = v[0]; M16[(q * 4 + 1) * 1024 + c] = v[1]; M16[(q * 4 + 2) * 1024 + c] = v[2]; M16[(q * 4 + 3) * 1024 + c] = v[3]; } }
    BLOCK_SYNC();
}
__device__ __forceinline__ void norm_mod_row(f32x4 (&v)[4], const float* g, const float* shift, const float* scale, bf16* orow, int lane) {
    float ss = 0.f;
#pragma unroll
    for (int j = 0; j < 4; ++j) ss += (v[j][0] * v[j][0] + v[j][1] * v[j][1]) + (v[j][2] * v[j][2] + v[j][3] * v[j][3]);
    const float rstd = rsqrtf(wave_sum(ss) * (1.0f / 1024.0f) + EPSN);
#pragma unroll
    for (int j = 0; j < 4; ++j) { const int c = 4 * lane + 256 * j;
        const f32x4 gv = *(const f32x4*)(g + c), sc = *(const f32x4*)(scale + c), sh = *(const f32x4*)(shift + c);
        const f32x4 h = (v[j] * rstd * gv) * (sc + 1.0f) + sh; v[j] = h;
        v2u w; w.x = pk2(h[0], h[1]); w.y = pk2(h[2], h[3]); *(v2u*)(orow + c) = w; }
}
__device__ __forceinline__ float dot16(const f32x4 (&v)[4], const float* M16, int lane) {
    float o = 0.f;
#pragma unroll 2
    for (int e = 0; e < 16; ++e) { float s = 0.f;
#pragma unroll
        for (int j = 0; j < 4; ++j) { const f32x4 w = *(const f32x4*)(M16 + e * 1024 + 4 * lane + 256 * j); s += (v[j][0] * w[0] + v[j][1] * w[1]) + (v[j][2] * w[2] + v[j][3] * w[3]); }
        s = wave_sum(s); o = (lane == e) ? s : o; }
    return o;
}
__device__ __forceinline__ void row_A(Ctx& C, f32x4 (&v)[4], int r, int l, const float* M16) {
    const float* modp = ((float*)(C.a->ws + WS_MOD)) + (size_t)(l * 2 + (r < CTXL ? 1 : 0)) * 6144;
    norm_mod_row(v, C.a->norm1_g + l * DM, modp, modp + 1024, ((bf16*)(C.a->ws + WS_H)) + (size_t)r * DM, C.lane);
    const float o = dot16(v, M16, C.lane);
    if (C.lane < 16) ((float*)(C.a->ws + WS_G))[(size_t)r * 16 + C.lane] = o;
}
__device__ __forceinline__ void phase_A0(Ctx& C) {
    float* M16 = (float*)C.lds; stage_m16(C, C.a->w_in, DIN, NZ, M16);
    const int gw = C.bid * NWAVES + C.wave, NGW = C.G * NWAVES;
    for (int r = gw; r < R; r += NGW) {
        const float* src = (r < CTXL) ? C.a->ctx + (size_t)r * DM : C.a->x + (size_t)(r - CTXL) * DM;
        f32x4 v[4];
#pragma unroll
        for (int j = 0; j < 4; ++j) v[j] = ((const f32x4*)src)[C.lane + 64 * j];
        row_A(C, v, r, 0, M16);
    }
}
__device__ __forceinline__ void phase_G(Ctx& C, int l) {
    float* M16 = (float*)C.lds; stage_m16(C, C.a->router_w + (size_t)l * DM * 16, 16, 0, M16);
    const int gw = C.bid * NWAVES + C.wave, NGW = C.G * NWAVES; const int r0 = (l == 0) ? 0 : CTXL;
    for (int r = r0 + gw; r < R; r += NGW) {
        f32x4 v[4];
#pragma unroll
        for (int j = 0; j < 4; ++j) v[j] = ((const f32x4*)(((float*)(C.a->ws + WS_XW)) + (size_t)r * DM))[C.lane + 64 * j];
        const float* modp = ((float*)(C.a->ws + WS_MOD)) + (size_t)(l * 2 + (r < CTXL ? 1 : 0)) * 6144;
        norm_mod_row(v, C.a->norm2_g + l * DM, modp + 3 * 1024, modp + 4 * 1024, ((bf16*)(C.a->ws + WS_H2)) + (size_t)r * DM, C.lane);
        const float lg = dot16(v, M16, C.lane);
        float mx = lg;
#pragma unroll
        for (int o2 = 1; o2 < 16; o2 <<= 1) mx = fmaxf(mx, __shfl_xor(mx, o2));
        const float o = expf(lg - mx); float sum = o;
#pragma unroll
        for (int o2 = 1; o2 < 16; o2 <<= 1) sum += __shfl_xor(sum, o2);
        if (C.lane < 16) ((float*)(C.a->ws + WS_AFF))[(size_t)C.lane * R + r] = o / sum;
    }
}
__device__ __forceinline__ void phase_K(Ctx& C, int l) {
    float* M16 = (float*)C.lds;
    if (l == 0) stage_m16(C, C.a->w_in + (size_t)DM * DIN, DIN, NZ, M16);
    const int gw = C.bid * NWAVES + C.wave, NGW = C.G * NWAVES; const int r0 = (l == 0) ? 0 : CTXL;
    for (int r = r0 + gw; r < R; r += NGW) {
        f32x4 v[4], acc[4];
#pragma unroll
        for (int j = 0; j < 4; ++j) { v[j] = ((const f32x4*)(((float*)(C.a->ws + WS_XW)) + (size_t)r * DM))[C.lane + 64 * j]; acc[j] = (f32x4){0.f, 0.f, 0.f, 0.f}; }
        const int myslot = (C.lane < 16) ? ((int*)(C.a->ws + WS_SLOT))[(size_t)r * 16 + C.lane] : -1;
        for (int e = 0; e < 16; ++e) {
            const int sl = __shfl(myslot, e);
            if (sl >= 0) { const bf16* yr = ((bf16*)(C.a->ws + WS_Y)) + ((size_t)e * ESLOTS + sl) * DM;
#pragma unroll
                for (int j = 0; j < 4; ++j) { const v2u w = *(const v2u*)(yr + 4 * C.lane + 256 * j); acc[j][0] += bf_lo(w.x); acc[j][1] += bf_hi(w.x); acc[j][2] += bf_lo(w.y); acc[j][3] += bf_hi(w.y); } }
        }
        const float* g2 = ((float*)(C.a->ws + WS_MOD)) + (size_t)(l * 2 + (r < CTXL ? 1 : 0)) * 6144 + 5 * 1024;
#pragma unroll
        for (int j = 0; j < 4; ++j) { const f32x4 gg = *(const f32x4*)(g2 + 4 * C.lane + 256 * j); v[j] = v[j] + gg * acc[j]; }
        if (l == 0) {
#pragma unroll
            for (int j = 0; j < 4; ++j) ((f32x4*)(((float*)(C.a->ws + WS_XW)) + (size_t)r * DM))[C.lane + 64 * j] = v[j];
            row_A(C, v, r, 1, M16);
        } else {
            float ss = 0.f;
#pragma unroll
            for (int j = 0; j < 4; ++j) ss += (v[j][0] * v[j][0] + v[j][1] * v[j][1]) + (v[j][2] * v[j][2] + v[j][3] * v[j][3]);
            const float rstd = rsqrtf(wave_sum(ss) * (1.0f / 1024.0f) + EPSN);
#pragma unroll
            for (int j = 0; j < 4; ++j) { const f32x4 gv = *(const f32x4*)(C.a->final_norm_g + 4 * C.lane + 256 * j); ((f32x4*)(C.a->out + (size_t)(r - CTXL) * DM))[C.lane + 64 * j] = v[j] * rstd * gv; }
        }
    }
}
#define MFMA16(a, b, c) __builtin_amdgcn_mfma_f32_16x16x32_bf16(a, b, c, 0, 0, 0)
__device__ __forceinline__ float logsigmoidf(float x) { return fminf(x, 0.f) - log1pf(expf(-fabsf(x))); }
constexpr float C2Q = 0.125f * 1.4426950408889634f;

__device__ __forceinline__ void item_conv_prep(const Ctx& C0, int l, int c) {
    Ctx C = C0; { int t_ = C.tid; asm volatile("" : "+v"(t_)); C.tid = t_; C.lane = t_ & 63; }
    const int rbase = c * 128; const int slo = (rbase < CTXL) ? 0 : CTXL, shi = (rbase < CTXL) ? CTXL : R;
    const float* cw = C.a->conv_w + l * 3 * 256;
    for (int idx = C.tid; idx < 128 * 32; idx += NTHR) {
        const int row = idx >> 5, ch0 = (idx & 31) * 8, r = rbase + row; const bf16* z = ((bf16*)(C.a->ws + WS_Z)) + (size_t)r * NZ;
        const v4u zero = {0u, 0u, 0u, 0u};
        const bool hm = (r - 1 >= slo), hp = (r + 1 < shi);
        const v4u xm = hm ? *(const v4u*)(z - NZ + ZC_CONVX + ch0) : zero, cm = hm ? *(const v4u*)(z - NZ + ZC_CONVC + ch0) : zero;
        const v4u x0 = *(const v4u*)(z + ZC_CONVX + ch0), c0 = *(const v4u*)(z + ZC_CONVC + ch0), b0 = *(const v4u*)(z + ZC_CONVB + ch0);
        const v4u xp = hp ? *(const v4u*)(z + NZ + ZC_CONVX + ch0) : zero, cp = hp ? *(const v4u*)(z + NZ + ZC_CONVC + ch0) : zero;
        float o[8];
#pragma unroll
        for (int q = 0; q < 4; ++q) {
            const int ch = ch0 + 2 * q;
            const float w0a = cw[ch], w1a = cw[256 + ch], w2a = cw[512 + ch], w0b = cw[ch + 1], w1b = cw[256 + ch + 1], w2b = cw[512 + ch + 1];
            const float ya = w0a * (bf_lo(xm[q]) * bf_lo(cm[q])) + w1a * (bf_lo(x0[q]) * bf_lo(c0[q])) + w2a * (bf_lo(xp[q]) * bf_lo(cp[q]));
            const float yb = w0b * (bf_hi(xm[q]) * bf_hi(cm[q])) + w1b * (bf_hi(x0[q]) * bf_hi(c0[q])) + w2b * (bf_hi(xp[q]) * bf_hi(cp[q]));
            o[2 * q] = bf_lo(b0[q]) * ya; o[2 * q + 1] = bf_hi(b0[q]) * yb; }
        v4u w; w.x = pk2(o[0], o[1]); w.y = pk2(o[2], o[3]); w.z = pk2(o[4], o[5]); w.w = pk2(o[6], o[7]);
        *(v4u*)(((bf16*)(C.a->ws + WS_MIX)) + (size_t)r * DM + ch0) = w;
    }
    for (int it = 0; it < 12; ++it) {
        const int task = it * 64 + (C.tid >> 3), sub = C.tid & 7, row = task / 6, hd = task % 6, r = rbase + row;
        const v4u zx = *(const v4u*)(((bf16*)(C.a->ws + WS_Z)) + (size_t)r * NZ + ZC_Q + hd * 64 + sub * 8);
        float y[8];
#pragma unroll
        for (int q = 0; q < 4; ++q) { y[2 * q] = bf_lo(zx[q]); y[2 * q + 1] = bf_hi(zx[q]); }
        float ss = 0.f;
#pragma unroll
        for (int e = 0; e < 8; ++e) ss += y[e] * y[e];
        ss += __shfl_xor(ss, 1); ss += __shfl_xor(ss, 2); ss += __shfl_xor(ss, 4);
        const float rstd = rsqrtf(ss * (1.0f / 64.0f) + EPSN);
        const float* gn = ((hd < 4) ? C.a->q_norm_g : C.a->k_norm_g) + l * 64 + sub * 8;
#pragma unroll
        for (int e = 0; e < 8; ++e) y[e] = y[e] * rstd * gn[e];
        float o[8];
        if (r >= CTXL) {
            const int p = r - CTXL, pos = (sub < 4) ? (p >> 6) : (p & 63); const float* rt = ((float*)(C.a->ws + WS_ROPE)) + (size_t)(pos * 16 + 8 * (sub & 1)) * 2; const bool first = ((sub & 2) == 0);
#pragma unroll
            for (int e = 0; e < 8; ++e) { const float pr = __shfl_xor(y[e], 2); const float cs = rt[2 * e], sn = rt[2 * e + 1]; o[e] = first ? (y[e] * cs - pr * sn) : (y[e] * cs + pr * sn); }
        } else {
#pragma unroll
            for (int e = 0; e < 8; ++e) { (void)__shfl_xor(y[e], 2); o[e] = y[e]; }
        }
        const float scl = (hd < 4) ? C2Q : 1.0f;
        v4u w; w.x = pk2(o[0] * scl, o[1] * scl); w.y = pk2(o[2] * scl, o[3] * scl); w.z = pk2(o[4] * scl, o[5] * scl); w.w = pk2(o[6] * scl, o[7] * scl);
        if (hd < 4) *(v4u*)(((bf16*)(C.a->ws + WS_QB)) + (size_t)r * 256 + hd * 64 + sub * 8) = w; else *(v4u*)(((bf16*)(C.a->ws + WS_KB)) + (size_t)r * 128 + (hd - 4) * 64 + sub * 8) = w;
    }
    for (int idx = C.tid; idx < 128 * 16; idx += NTHR) { const int row = idx >> 4, ch = (idx & 15) * 8, r = rbase + row; *(v4u*)(((bf16*)(C.a->ws + WS_VB)) + (size_t)r * 128 + ch) = *(const v4u*)(((bf16*)(C.a->ws + WS_Z)) + (size_t)r * NZ + ZC_V + ch); }
}

__device__ __forceinline__ void item_cmlp(const Ctx& C0, int l, int c) {
    Ctx C = C0; { int t_ = C.tid; asm volatile("" : "+v"(t_)); C.tid = t_; C.lane = t_ & 63; }
    constexpr int LD = 136;
    bf16* VNT = (bf16*)C.lds;
    bf16* WSB = VNT + 256 * LD;
    const int rbase = c * 128; const float* gn = C.a->cmlp_norm_g + l * 256;
    for (int i = 0; i < 16; ++i) {
        const int row = C.wave * 16 + i, r = rbase + row; const bf16* z = ((bf16*)(C.a->ws + WS_Z)) + (size_t)r * NZ + ZC_CV;
        float x[4]; float ss = 0.f;
#pragma unroll
        for (int q = 0; q < 4; ++q) { x[q] = bf2f(z[C.lane + 64 * q]); ss += x[q] * x[q]; }
        const float rstd = rsqrtf(wave_sum(ss) * (1.0f / 256.0f) + EPSN);
#pragma unroll
        for (int q = 0; q < 4; ++q) VNT[(C.lane + 64 * q) * LD + row] = f2bf(x[q] * rstd * gn[C.lane + 64 * q]);
    }
    for (int h = 0; h < 4; ++h) {
        BLOCK_SYNC();
        const float* wsrc = C.a->cmlp_ws + (size_t)(l * 4 + h) * 128 * 128;
#pragma unroll
        for (int it = 0; it < 8; ++it) { const int idx = (it * NTHR + C.tid) * 4, t = idx >> 7, s = idx & 127; const f32x4 w = *(const f32x4*)(wsrc + idx);
            v2u o; o.x = pk2(w[0], w[1]); o.y = pk2(w[2], w[3]); *(v2u*)(WSB + t * LD + s) = o; }
        BLOCK_SYNC();
        const int t0 = C.wave * 16, fr = C.lane & 15, fq = C.lane >> 4;
        f32x4 acc[4];
#pragma unroll
        for (int n = 0; n < 4; ++n) acc[n] = (f32x4){0.f, 0.f, 0.f, 0.f};
#pragma unroll
        for (int ks = 0; ks < 4; ++ks) { const bf16x8 a = *(const bf16x8*)(WSB + (t0 + fr) * LD + ks * 32 + 8 * fq);
#pragma unroll
            for (int n = 0; n < 4; ++n) { const bf16x8 b = *(const bf16x8*)(VNT + (h * 64 + 16 * n + fr) * LD + ks * 32 + 8 * fq); acc[n] = MFMA16(a, b, acc[n]); } }
        const float* bs = C.a->cmlp_bs + (size_t)(l * 4 + h) * 128;
#pragma unroll
        for (int j = 0; j < 4; ++j) { const int t = t0 + 4 * fq + j, r = rbase + t; const float bb = bs[t];
#pragma unroll
            for (int n = 0; n < 4; ++n) { const int col = h * 64 + 16 * n + fr; const float u = bf2f(((bf16*)(C.a->ws + WS_Z))[(size_t)r * NZ + ZC_CU + col]); ((bf16*)(C.a->ws + WS_MIX))[(size_t)r * DM + 256 + col] = f2bf(u * (acc[n][j] + bb)); } }
    }
}

__device__ __forceinline__ void load_gates(const Ctx& C, int l, int c, int h, float* liF, float* lfF, float* liB, float* lfB) {
    if (C.tid < 128) { const int r = c * 128 + C.tid; const float* g = ((float*)(C.a->ws + WS_G)) + (size_t)r * 16;
        liF[C.tid] = g[h] + C.a->ml_igate_b[l * 8 + h]; liB[C.tid] = g[4 + h] + C.a->ml_igate_b[l * 8 + 4 + h];
        lfF[C.tid] = logsigmoidf(g[8 + h] + C.a->ml_fgate_b[l * 8 + h]); lfB[C.tid] = logsigmoidf(g[12 + h] + C.a->ml_fgate_b[l * 8 + 4 + h]); }
}
__device__ __forceinline__ void item_mlstate(const Ctx& C0, int l, int c, int h) {
    Ctx C = C0; { int t_ = C.tid; asm volatile("" : "+v"(t_)); C.tid = t_; C.lane = t_ & 63; }
    constexpr int LD = 136;
    bf16* KT = (bf16*)C.lds; bf16* VTF = KT + 64 * LD; bf16* VTB = VTF + 64 * LD;
    float* fv = (float*)(VTB + 64 * LD);
    float *liF = fv, *lfF = fv + 128, *liB = fv + 256, *lfB = fv + 384, *aF = fv + 512, *aB = fv + 640, *sc = fv + 768;
    load_gates(C, l, c, h, liF, lfF, liB, lfB);
    BLOCK_SYNC();
    if (C.tid < 128) { const int t = C.tid; float b = 0.f; for (int u = 0; u <= t; ++u) b += lfF[u]; float tot = b; for (int u = t + 1; u < 128; ++u) tot += lfF[u];
        aF[t] = tot - b + liF[t]; if (t == 0) sc[2] = tot; }
    else if (C.tid < 256) { const int t = C.tid - 128; float b = 0.f; for (int u = 127; u >= t; --u) b += lfB[u]; float tot = b; for (int u = t - 1; u >= 0; --u) tot += lfB[u];
        aB[t] = tot - b + liB[t]; if (t == 0) sc[3] = tot; }
    BLOCK_SYNC();
    if (C.wave == 0) { const float m = wave_max(fmaxf(aF[C.lane], aF[C.lane + 64])); if (C.lane == 0) sc[0] = m; }
    if (C.wave == 1) { const float m = wave_max(fmaxf(aB[C.lane], aB[C.lane + 64])); if (C.lane == 0) sc[1] = m; }
    BLOCK_SYNC();
    { const int s = C.tid >> 2, part = C.tid & 3, r = c * 128 + s; const float wF = expf(aF[s] - sc[0]), wB = expf(aB[s] - sc[1]);
        const bf16* z = ((bf16*)(C.a->ws + WS_Z)) + (size_t)r * NZ + h * 64 + part * 16;
#pragma unroll
        for (int q2 = 0; q2 < 2; ++q2) { const v4u kk = *(const v4u*)(z + ZC_MK + q2 * 8), vv = *(const v4u*)(z + ZC_MV + q2 * 8);
#pragma unroll
            for (int q = 0; q < 4; ++q) { const int d = part * 16 + q2 * 8 + 2 * q;
                KT[d * LD + s] = f2bf(bf_lo(kk[q]) * 0.125f); KT[(d + 1) * LD + s] = f2bf(bf_hi(kk[q]) * 0.125f);
                const float v0 = bf_lo(vv[q]), v1 = bf_hi(vv[q]);
                VTF[d * LD + s] = f2bf(v0 * wF); VTF[(d + 1) * LD + s] = f2bf(v1 * wF); VTB[d * LD + s] = f2bf(v0 * wB); VTB[(d + 1) * LD + s] = f2bf(v1 * wB); } } }
    BLOCK_SYNC();
    const int dir = C.wave >> 2, v0 = 16 * (C.wave & 3), fr = C.lane & 15, fq = C.lane >> 4; const bf16* VT = dir ? VTB : VTF;
    f32x4 acc[4];
#pragma unroll
    for (int n = 0; n < 4; ++n) acc[n] = (f32x4){0.f, 0.f, 0.f, 0.f};
#pragma unroll
    for (int ks = 0; ks < 4; ++ks) { const bf16x8 a = *(const bf16x8*)(VT + (v0 + fr) * LD + ks * 32 + 8 * fq);
#pragma unroll
        for (int n = 0; n < 4; ++n) { const bf16x8 b = *(const bf16x8*)(KT + (16 * n + fr) * LD + ks * 32 + 8 * fq); acc[n] = MFMA16(a, b, acc[n]); } }
    const size_t sidx = (size_t)(c * 4 + h) * 2 + dir; float* co = ((float*)(C.a->ws + WS_CLOC)) + sidx * 4096;
#pragma unroll
    for (int n = 0; n < 4; ++n)
#pragma unroll
        for (int j = 0; j < 4; ++j) co[(v0 + 4 * fq + j) * 64 + 16 * n + fr] = acc[n][j];
    if (C.tid < 128) { const int d2 = C.tid >> 6, k = C.tid & 63; const float* a = d2 ? aB : aF; const float m = sc[d2]; float s = 0.f;
        for (int u = 0; u < 128; ++u) s += expf(a[u] - m) * bf2f(KT[k * LD + u]);
        ((float*)(C.a->ws + WS_NLOC))[((size_t)(c * 4 + h) * 2 + d2) * 64 + k] = s; }
    if (C.tid < 2) { const size_t si = (size_t)(c * 4 + h) * 2 + C.tid; ((float*)(C.a->ws + WS_SCAL))[si] = sc[C.tid]; ((float*)(C.a->ws + (WS_SCAL + 1040 * 4)))[si] = sc[2 + C.tid]; }
}
__device__ __forceinline__ void phase_C(Ctx& C, int l) {
    for (int it = C.bid; it < NCHUNK * 6; it += C.G) {
        const int c = it / 6, ty = it % 6;
        if (ty == 0) item_conv_prep(C, l, c);
        else if (ty == 1) { if (l == 0 || c >= 2) item_cmlp(C, l, c); }
        else item_mlstate(C, l, c, ty - 2);
        BLOCK_SYNC();
    }
}

__device__ __forceinline__ int chain_chunk(int dir, int i) { return dir == 0 ? i : (i == 0 ? 1 : (i == 1 ? 0 : NCHUNK + 1 - i)); }
__device__ __forceinline__ void phase_D(Ctx& C) {
    float* fv = (float*)C.lds; float *bl = fv, *ml = fv + 136, *mp = fv + 272, *dold = fv + 408, *dloc = fv + 544, *segA = fv + 680, *segB = fv + 680 + 512;
    for (int it = C.bid; it < 8 * 33; it += C.G) {
        const int chain = it / 33, eb = it % 33, h = chain >> 1, dir = chain & 1; const bool isn = (eb == 32);
        float* basep = isn ? ((float*)(C.a->ws + WS_NLOC)) : ((float*)(C.a->ws + WS_CLOC)) + eb * 128; const size_t cstride = isn ? 64 : 4096;
        if (C.tid < NCHUNK) { const int c = chain_chunk(dir, C.tid); const size_t si = (size_t)(c * 4 + h) * 2 + dir; bl[C.tid] = ((float*)(C.a->ws + (WS_SCAL + 1040 * 4)))[si]; ml[C.tid] = ((float*)(C.a->ws + WS_SCAL))[si]; }
        BLOCK_SYNC();
        if (C.wave == 0) {
            const float b0 = bl[C.lane], b1 = bl[64 + C.lane], b2 = bl[128 + (C.lane & 1)], m0 = ml[C.lane], m1 = ml[64 + C.lane], m2 = ml[128 + (C.lane & 1)];
            float m = 0.f, r0 = 0.f, r1 = 0.f, r2 = 0.f;
#pragma unroll 2
            for (int i = 0; i < 64; ++i) { r0 = (C.lane == i) ? m : r0; m = fmaxf(m + __int_as_float(__builtin_amdgcn_readlane(__float_as_int(b0), i)), __int_as_float(__builtin_amdgcn_readlane(__float_as_int(m0), i))); }
#pragma unroll 2
            for (int i = 0; i < 64; ++i) { r1 = (C.lane == i) ? m : r1; m = fmaxf(m + __int_as_float(__builtin_amdgcn_readlane(__float_as_int(b1), i)), __int_as_float(__builtin_amdgcn_readlane(__float_as_int(m1), i))); }
#pragma unroll
            for (int i = 0; i < 2; ++i) { r2 = (C.lane == i) ? m : r2; m = fmaxf(m + __int_as_float(__builtin_amdgcn_readlane(__float_as_int(b2), i)), __int_as_float(__builtin_amdgcn_readlane(__float_as_int(m2), i))); }
            mp[C.lane] = r0; mp[64 + C.lane] = r1; if (C.lane < 2) mp[128 + C.lane] = r2; if (C.lane == 2) mp[130] = m;
        }
        BLOCK_SYNC();
        if (C.tid < NCHUNK) { const int i = C.tid; dold[i] = expf(bl[i] + mp[i] - mp[i + 1]); dloc[i] = expf(ml[i] - mp[i + 1]);
            if (eb == 0) { const int c = chain_chunk(dir, i); ((float*)(C.a->ws + (WS_SCAL + 2080 * 4)))[(size_t)(c * 4 + h) * 2 + dir] = mp[i]; } }
        BLOCK_SYNC();
        const int seg = C.wave >> 1, el = (C.wave & 1) * 64 + C.lane; const int s0 = (seg < 2) ? seg * 33 : 66 + (seg - 2) * 32, slen = (seg < 2) ? 33 : 32;
        const bool valid = !isn || el < 64;
        float L[33];
#pragma unroll
        for (int u = 0; u < 33; ++u) { L[u] = 0.f; if (valid && u < slen) { const int c = chain_chunk(dir, s0 + u); L[u] = basep[((size_t)(c * 4 + h) * 2 + dir) * cstride + el]; } }
        float st = 0.f, a = 1.f;
#pragma unroll
        for (int u = 0; u < 33; ++u) { if (u < slen) { const float lv = L[u]; L[u] = st; st = dold[s0 + u] * st + dloc[s0 + u] * lv; a *= dold[s0 + u]; } }
        segA[seg * 128 + el] = a; segB[seg * 128 + el] = st;
        BLOCK_SYNC();
        float s = 0.f;
        for (int j = 0; j < seg; ++j) s = segA[j * 128 + el] * s + segB[j * 128 + el];
        a = 1.f;
#pragma unroll
        for (int u = 0; u < 33; ++u) { if (valid && u < slen) { const int c = chain_chunk(dir, s0 + u); basep[((size_t)(c * 4 + h) * 2 + dir) * cstride + el] = L[u] + a * s; a *= dold[s0 + u]; } }
        BLOCK_SYNC();
    }
}
__device__ __forceinline__ void item_mlout(const Ctx& C0, int l, int c, int h) {
    Ctx C = C0; { int t_ = C.tid; asm volatile("" : "+v"(t_)); C.tid = t_; C.lane = t_ & 63; }
    constexpr int LQ = 72, LA = 264;
    bf16* QS = (bf16*)C.lds;
    bf16* KS = QS + 128 * LQ;
    bf16* A2 = KS + 128 * LQ;
    bf16* B2T = A2 + 128 * LA;
    float* fv = (float*)(B2T + 64 * LA);
    float *liF = fv, *lfF = fv + 128, *liB = fv + 256, *lfB = fv + 384, *gF = fv + 512, *gB = fv + 640, *rowF = fv + 768, *rowB = fv + 896,
          *wiF = fv + 1024, *wiB = fv + 1152, *emF = fv + 1280, *emB = fv + 1408, *cF = fv + 1536, *cB = fv + 1664, *nP = fv + 1792;
    const int rbase = c * 128; const size_t siF = (size_t)(c * 4 + h) * 2, siB = siF + 1;
    load_gates(C, l, c, h, liF, lfF, liB, lfB);
#pragma unroll
    for (int it = 0; it < 2; ++it) { const int idx = it * NTHR + C.tid, t = idx >> 3, ch = (idx & 7) * 8; const bf16* z = ((bf16*)(C.a->ws + WS_Z)) + (size_t)(rbase + t) * NZ + h * 64 + ch;
        *(v4u*)(QS + t * LQ + ch) = *(const v4u*)(z + ZC_MQ);
        const v4u kk = *(const v4u*)(z + ZC_MK); v4u ko;
#pragma unroll
        for (int q = 0; q < 4; ++q) ko[q] = pk2(bf_lo(kk[q]) * 0.125f, bf_hi(kk[q]) * 0.125f);
        *(v4u*)(KS + t * LQ + ch) = ko; }
    { const int s = C.tid >> 2, part = C.tid & 3; const bf16* z = ((bf16*)(C.a->ws + WS_Z)) + (size_t)(rbase + s) * NZ + ZC_MV + h * 64 + part * 16;
#pragma unroll
        for (int q2 = 0; q2 < 2; ++q2) { const v4u vv = *(const v4u*)(z + q2 * 8);
#pragma unroll
            for (int q = 0; q < 4; ++q) { const int d = part * 16 + q2 * 8 + 2 * q; B2T[d * LA + s] = (bf16)(vv[q] & 0xffffu); B2T[(d + 1) * LA + s] = (bf16)(vv[q] >> 16); } } }
#pragma unroll
    for (int it = 0; it < 4; ++it) { const int idx = (it * NTHR + C.tid) * 4, dir = idx >> 12, e = idx & 4095, v = e >> 6, k = e & 63;
        const f32x4 cv = *(const f32x4*)(((float*)(C.a->ws + WS_CLOC)) + (siF + dir) * 4096 + e); v2u o; o.x = pk2(cv[0], cv[1]); o.y = pk2(cv[2], cv[3]); *(v2u*)(B2T + v * LA + 128 + dir * 64 + k) = o; }
    if (C.tid < 128) nP[C.tid] = ((float*)(C.a->ws + WS_NLOC))[siF * 64 + C.tid];
    const float mpF = ((float*)(C.a->ws + (WS_SCAL + 2080 * 4)))[siF], mpB = ((float*)(C.a->ws + (WS_SCAL + 2080 * 4)))[siB];
    BLOCK_SYNC();
    if (C.tid < 128) { const int t = C.tid; float b = 0.f, pm = -INFINITY; for (int u = 0; u <= t; ++u) { b += lfF[u]; pm = fmaxf(pm, liF[u] - b); }
        gF[t] = liF[t] - b; const float mx = fmaxf(mpF, pm); rowF[t] = -mx; wiF[t] = expf(mpF - mx); emF[t] = expf(-(b + mx));
        float nq = 0.f; for (int k = 0; k < 64; ++k) nq += nP[k] * bf2f(QS[t * LQ + k]); cF[t] = nq; }
    else if (C.tid < 256) { const int t = C.tid - 128; float b = 0.f, pm = -INFINITY; for (int u = 127; u >= t; --u) { b += lfB[u]; pm = fmaxf(pm, liB[u] - b); }
        gB[t] = liB[t] - b; const float mx = fmaxf(mpB, pm); rowB[t] = -mx; wiB[t] = expf(mpB - mx); emB[t] = expf(-(b + mx));
        float nq = 0.f; for (int k = 0; k < 64; ++k) nq += nP[64 + k] * bf2f(QS[t * LQ + k]); cB[t] = nq; }
    BLOCK_SYNC();
    const int t0 = C.wave * 16, fr = C.lane & 15, fq = C.lane >> 4;
    {
        f32x4 S[8];
#pragma unroll
        for (int n = 0; n < 8; ++n) S[n] = (f32x4){0.f, 0.f, 0.f, 0.f};
#pragma unroll
        for (int ks = 0; ks < 2; ++ks) { const bf16x8 a = *(const bf16x8*)(QS + (t0 + fr) * LQ + ks * 32 + 8 * fq);
#pragma unroll
            for (int n = 0; n < 8; ++n) { const bf16x8 b = *(const bf16x8*)(KS + (16 * n + fr) * LQ + ks * 32 + 8 * fq); S[n] = MFMA16(a, b, S[n]); } }
        float gf[8], gb[8];
#pragma unroll
        for (int n = 0; n < 8; ++n) { gf[n] = gF[16 * n + fr]; gb[n] = gB[16 * n + fr]; }
#pragma unroll
        for (int j = 0; j < 4; ++j) { const int t = t0 + 4 * fq + j; const float rF_ = rowF[t], rB_ = rowB[t];
            float pf[8], pb[8]; float sF = 0.f, sB = 0.f;
#pragma unroll
            for (int n = 0; n < 8; ++n) { const int s = 16 * n + fr; const float sv = S[n][j];
                pf[n] = (s <= t) ? sv * expf(rF_ + gf[n]) : 0.f; pb[n] = (s >= t) ? sv * expf(rB_ + gb[n]) : 0.f; sF += pf[n]; sB += pb[n]; }
#pragma unroll
            for (int o = 1; o < 16; o <<= 1) { sF += __shfl_xor(sF, o); sB += __shfl_xor(sB, o); }
            const float wf = wiF[t], wb = wiB[t];
            const float denF = sF + wf * cF[t], denB = sB + wb * cB[t];
            const float rf = 1.0f / fmaxf(fabsf(denF), emF[t]), rb = 1.0f / fmaxf(fabsf(denB), emB[t]);
#pragma unroll
            for (int n = 0; n < 8; ++n) A2[t * LA + 16 * n + fr] = f2bf(pf[n] * rf + pb[n] * rb);
            S[0][j] = wf * rf; S[1][j] = wb * rb;
        }
        BLOCK_SYNC();
        if (fr == 0) {
#pragma unroll
            for (int j = 0; j < 4; ++j) { const int t = t0 + 4 * fq + j; cF[t] = S[0][j]; cB[t] = S[1][j]; } }
    }
    BLOCK_SYNC();
#pragma unroll
    for (int it = 0; it < 2; ++it) { const int idx = it * NTHR + C.tid, t = idx >> 3, ch = (idx & 7) * 8; const v4u qq = *(const v4u*)(QS + t * LQ + ch); const float sf = cF[t], sb = cB[t]; v4u of, ob;
#pragma unroll
        for (int q = 0; q < 4; ++q) { const float a = bf_lo(qq[q]), b = bf_hi(qq[q]); of[q] = pk2(a * sf, b * sf); ob[q] = pk2(a * sb, b * sb); }
        *(v4u*)(A2 + t * LA + 128 + ch) = of; *(v4u*)(A2 + t * LA + 192 + ch) = ob; }
    BLOCK_SYNC();
    f32x4 acc[4];
#pragma unroll
    for (int n = 0; n < 4; ++n) acc[n] = (f32x4){0.f, 0.f, 0.f, 0.f};
#pragma unroll
    for (int ks = 0; ks < 8; ++ks) { const bf16x8 a = *(const bf16x8*)(A2 + (t0 + fr) * LA + ks * 32 + 8 * fq);
#pragma unroll
        for (int n = 0; n < 4; ++n) { const bf16x8 b = *(const bf16x8*)(B2T + (16 * n + fr) * LA + ks * 32 + 8 * fq); acc[n] = MFMA16(a, b, acc[n]); } }
    const float* ng = C.a->ml_norm_g + l * 256 + h * 64;
#pragma unroll
    for (int j = 0; j < 4; ++j) { const int t = t0 + 4 * fq + j, r = rbase + t; float ss = 0.f;
#pragma unroll
        for (int n = 0; n < 4; ++n) ss += acc[n][j] * acc[n][j];
#pragma unroll
        for (int o = 1; o < 16; o <<= 1) ss += __shfl_xor(ss, o);
        const float rstd = rsqrtf(ss * (1.0f / 64.0f) + EPSN);
#pragma unroll
        for (int n = 0; n < 4; ++n) { const int d = 16 * n + fr; const float po = bf2f(((bf16*)(C.a->ws + WS_Z))[(size_t)r * NZ + ZC_MO + h * 64 + d]);
            ((bf16*)(C.a->ws + WS_MIX))[(size_t)r * DM + 768 + h * 64 + d] = f2bf(acc[n][j] * rstd * ng[d] / (1.0f + expf(-po))); } }
}

__device__ __forceinline__ void item_topk(const Ctx& C0, int e, int set) {
    Ctx C = C0; { int t_ = C.tid; asm volatile("" : "+v"(t_)); C.tid = t_; C.lane = t_ & 63; }
    unsigned* lv = (unsigned*)C.lds;
    unsigned* hist = lv + 32 * 512;
    unsigned* sh = hist + 256;
    unsigned* wtot = sh + 8;
    const int n = set ? CTXL : SEQL, cap = set ? CAPC : CAPL, rowoff = set ? 0 : CTXL;
    const float* aff = ((float*)(C.a->ws + WS_AFF)) + (size_t)e * R + rowoff;
    const int base = C.tid * 32;
#pragma unroll
    for (int q = 0; q < 8; ++q) { v4u w = {0u, 0u, 0u, 0u}; if (base + 4 * q < n) w = *(const v4u*)(aff + base + 4 * q);
        lv[(4 * q + 0) * 512 + C.tid] = w.x; lv[(4 * q + 1) * 512 + C.tid] = w.y; lv[(4 * q + 2) * 512 + C.tid] = w.z; lv[(4 * q + 3) * 512 + C.tid] = w.w; }
    unsigned prefix = 0u, kk = (unsigned)cap;
    for (int pass = 0; pass < 4; ++pass) {
        const int shift = 24 - 8 * pass; const unsigned himask = (pass == 0) ? 0u : (0xffffffffu << (shift + 8));
        if (C.tid < 256) hist[C.tid] = 0u;
        BLOCK_SYNC();
#pragma unroll 4
        for (int i = 0; i < 32; ++i) { const unsigned v = lv[i * 512 + C.tid]; if ((v & himask) == prefix) atomicAdd(&hist[(v >> shift) & 255u], 1u); }
        BLOCK_SYNC();
        if (C.tid < 256) { unsigned s = 0u; for (int b = C.tid; b < 256; ++b) s += hist[b]; const unsigned above = s - hist[C.tid];
            if (s >= kk && above < kk) { sh[0] = prefix | ((unsigned)C.tid << shift); sh[1] = kk - above; } }
        BLOCK_SYNC();
        prefix = sh[0]; kk = sh[1];
        BLOCK_SYNC();
    }
    const unsigned T = prefix, need_eq = kk;
    unsigned cgt = 0u, ceq = 0u;
#pragma unroll 4
    for (int i = 0; i < 32; ++i) { const unsigned v = lv[i * 512 + C.tid]; cgt += (v > T) ? 1u : 0u; ceq += (v == T) ? 1u : 0u; }
    unsigned igt = cgt, ieq = ceq;
#pragma unroll
    for (int o = 1; o < 64; o <<= 1) { const unsigned a = __shfl_up(igt, o), b = __shfl_up(ieq, o); if (C.lane >= o) { igt += a; ieq += b; } }
    if (C.lane == 63) { wtot[C.wave] = igt; wtot[8 + C.wave] = ieq; }
    BLOCK_SYNC();
    unsigned ogt = igt - cgt, oeq = ieq - ceq;
    for (int w = 0; w < C.wave; ++w) { ogt += wtot[w]; oeq += wtot[8 + w]; }
    const int slot0 = set ? CAPL : 0;
    int* IDXp = ((int*)(C.a->ws + WS_IDX)) + e * ESLOTS; float* GATEp = ((float*)(C.a->ws + WS_GATE)) + e * ESLOTS; int* SLOTp = ((int*)(C.a->ws + WS_SLOT)) + (size_t)rowoff * 16 + e;
#pragma unroll 2
    for (int i = 0; i < 32; ++i) {
        const int tok = base + i; const unsigned v = lv[i * 512 + C.tid];
        const bool gt = v > T, eq = v == T; const bool sel = gt || (eq && oeq < need_eq);
        if (tok < n) {
            int slot = -1;
            if (sel) { slot = slot0 + (int)(ogt + (oeq < need_eq ? oeq : need_eq)); IDXp[slot] = rowoff + tok; GATEp[slot] = __uint_as_float(v); }
            SLOTp[(size_t)tok * 16] = slot;
        }
        ogt += gt ? 1u : 0u; oeq += eq ? 1u : 0u;
    }
    if (set) { for (int s = CAPL + CAPC + C.tid; s < ESLOTS; s += NTHR) { IDXp[s] = 0; GATEp[s] = 0.f; } }
    BLOCK_SYNC();
}
__device__ __forceinline__ void phase_H(Ctx& C, int l) {
    const int nitems = (l == 0) ? 32 : 16;
    for (int it = C.bid; it < nitems; it += C.G) item_topk(C, it & 15, it >> 4);
}
#define LAS __attribute__((address_space(3)))
#define XB_TMO      128
#define XB_XCNT(j)  (256  + 64 * (j))
#define XB_XSUB(j)  (1280 + 64 * (j))
#define XB_XGEN(j)  (2304 + 64 * (j))
#define XB_TOP      3328
#define XB_TOPGEN   3392
#define XCD_BAR_WORDS 3456
#define XB_SPIN_CAP (1u << 18)

__device__ __forceinline__ unsigned xb_ld(unsigned* p)              { return __hip_atomic_load(p, __ATOMIC_RELAXED, __HIP_MEMORY_SCOPE_AGENT); }
__device__ __forceinline__ unsigned xb_add(unsigned* p, unsigned v) { return __hip_atomic_fetch_add(p, v, __ATOMIC_RELAXED, __HIP_MEMORY_SCOPE_AGENT); }
__device__ __forceinline__ unsigned xb_xcc_id() { return (unsigned)__builtin_amdgcn_s_getreg((3 << 11) | 20) & 0xFu; }
#define XB_SPIN(cond, bar) do { unsigned _sp = 0; while (cond) { __builtin_amdgcn_s_sleep(1); \
    if ((++_sp & 255u) == 0u) { if (xb_ld(&(bar)[XB_TMO])) break; if (_sp > XB_SPIN_CAP) { atomicAdd(&(bar)[XB_TMO], 1u); break; } } } } while (0)

struct XcdBarrier {
    unsigned* bar; unsigned x;
    volatile LAS unsigned* st;
};

__device__ __forceinline__ XcdBarrier xcd_barrier_post(unsigned* bar, volatile LAS unsigned* st) {
    XcdBarrier b; b.bar = bar; b.x = xb_xcc_id(); b.st = st;
    if (threadIdx.x == 0) (void)xb_add(&bar[XB_XCNT(b.x)], 1u);
    return b;
}
__device__ __forceinline__ void xcd_barrier_complete(unsigned* bar, unsigned x, unsigned& nloc, unsigned& nx) {
    const unsigned G = gridDim.x * gridDim.y * gridDim.z;
    unsigned sum, cnt, mine, sp = 0u;
    for (;;) {
        sum = 0u; cnt = 0u; mine = 0u;
#pragma unroll
        for (unsigned j = 0; j < 16; ++j) { const unsigned c = xb_ld(&bar[XB_XCNT(j)]); sum += c; cnt += (c > 0u) ? 1u : 0u; mine = (j == x) ? c : mine; }
        if (sum == G) break;
        __builtin_amdgcn_s_sleep(1);
        if ((++sp & 255u) == 0u) { if (xb_ld(&bar[XB_TMO])) break; if (sp > XB_SPIN_CAP) { atomicAdd(&bar[XB_TMO], 1u); break; } }
    }
    nloc = mine > 0u ? mine : 1u; nx = cnt > 0u ? cnt : 1u;
}

__device__ __forceinline__ void xcd_barrier(const XcdBarrier& b) {
    asm volatile("s_waitcnt vmcnt(0)" ::: "memory");
    __syncthreads();
    if (threadIdx.x == 0) {
        unsigned* bar = b.bar;
        __builtin_amdgcn_s_waitcnt(0);
        unsigned nloc = b.st[0], nx = b.st[1];
        if (nloc == 0u) { xcd_barrier_complete(bar, b.x, nloc, nx); b.st[0] = nloc; b.st[1] = nx; }
        const unsigned old = xb_add(&bar[XB_XSUB(b.x)], 1u);
        const unsigned gen = old / nloc;
        if (old + 1u == (gen + 1u) * nloc) {
            __builtin_amdgcn_fence(__ATOMIC_RELEASE, "agent");
            asm volatile("s_waitcnt vmcnt(0)" ::: "memory");
            const unsigned og = xb_add(&bar[XB_TOP], 1u);
            const unsigned tg = og / nx;
            if (og + 1u == (tg + 1u) * nx) xb_add(&bar[XB_TOPGEN], 1u);
            else XB_SPIN(xb_ld(&bar[XB_TOPGEN]) == tg, bar);
            __builtin_amdgcn_fence(__ATOMIC_ACQUIRE, "agent");
            xb_add(&bar[XB_XGEN(b.x)], 1u);
            asm volatile("s_waitcnt vmcnt(0)" ::: "memory");
        } else {
            XB_SPIN(xb_ld(&bar[XB_XGEN(b.x)]) == gen, bar);
            __builtin_amdgcn_fence(__ATOMIC_ACQUIRE, "agent");
            asm volatile("s_waitcnt vmcnt(0)" ::: "memory");
        }
    }
    __syncthreads();
}

__device__ __forceinline__ void phase_E(Ctx& C, int l) {
    const int c0 = (l == 0) ? 0 : 2;
#ifndef NO_MLOUT
    for (int it = C.bid; it < (NCHUNK - c0) * 4; it += C.G) { item_mlout(C, l, c0 + it / 4, it % 4); BLOCK_SYNC(); }
#endif
#ifndef NO_ATTN
    using abf = attn_body::bf16;
    {
        for (int u = C.vcu; u < 256; u += C.G) { const int h = u >> 6, qb = u & 63; const size_t qrow = (size_t)CTXL + (size_t)qb * 256;
            attn_body::attn_unit<8>((const abf*)(((bf16*)(C.a->ws + WS_QB)) + qrow * 256 + h * 64), (const abf*)(((bf16*)(C.a->ws + WS_KB)) + (h >> 1) * 64), (const abf*)(((bf16*)(C.a->ws + WS_VB)) + (h >> 1) * 64), (abf*)(((bf16*)(C.a->ws + WS_MIX)) + qrow * DM + 512 + h * 64), R / 64, (char*)C.lds, C.tid); }
        if (l == 0) for (int u = C.bid; u < 4; u += C.G) { const int h = u;
            attn_body::attn_unit<8>((const abf*)(((bf16*)(C.a->ws + WS_QB)) + h * 64), (const abf*)(((bf16*)(C.a->ws + WS_KB)) + (h >> 1) * 64), (const abf*)(((bf16*)(C.a->ws + WS_VB)) + (h >> 1) * 64), (abf*)(((bf16*)(C.a->ws + WS_MIX)) + 512 + h * 64), CTXL / 64, (char*)C.lds, C.tid); }
    }
#endif
}

#ifndef REPEAT_PH
#define REPEAT_PH -1
#endif
#ifndef ONLY_KIND
#define ONLY_KIND -1
#endif
#define KSEL(x) (ONLY_KIND == -1 || ONLY_KIND == (x))
constexpr int N_PHASES = 22;
template <int ph> __device__ __forceinline__ void run_phase(Ctx& C, PG8_LAS unsigned char* ldsg) {
        if constexpr (ph == 0) { if (KSEL(100)) phase_init(C); }
        else if constexpr (ph == 1) { if (KSEL(101)) phase_A0(C); }
        else {
            constexpr int l = (ph - 2) / 10, k = (ph - 2) % 10;
            if constexpr (k == 0) { if (KSEL(0)) {
                pg8::Gemm g{((bf16*)(C.a->ws + WS_H)), ((bf16*)(C.a->ws + WS_WIN)) + (size_t)l * NZ * DM, R, NZ, DM, nullptr}; pg8::StaticOrder S; S.init(R, NZ, C.G, C.bid);
                pg8::EpiBf16 E{((bf16*)(C.a->ws + WS_Z)), NZ};
                pg8::gemm_phase<pg8::EpiBf16, pg8::StaticOrder, true, false>(ldsg, g, S, E, C.tid); }
            } else if constexpr (k == 1) { if (KSEL(1)) phase_C(C, l); }
            else if constexpr (k == 2) { if (KSEL(2)) phase_D(C); }
            else if constexpr (k == 3) { if (KSEL(3)) phase_E(C, l); }
            else if constexpr (k == 4) { if (KSEL(4)) {
                const int pm0 = (l == 0) ? 0 : 1; const int rows = R - pm0 * 256;
                pg8::Gemm g{((bf16*)(C.a->ws + WS_MIX)), ((bf16*)(C.a->ws + WS_WOUT)) + (size_t)l * DM * DM, rows, DM, DM, nullptr}; pg8::StaticOrder S; S.init(rows, DM, C.G, C.bid, pm0);
                const float* modL = ((float*)(C.a->ws + WS_MOD)) + (size_t)(l * 2 + 0) * 6144 + 2 * 1024; const float* modC = ((float*)(C.a->ws + WS_MOD)) + (size_t)(l * 2 + 1) * 6144 + 2 * 1024;
                pg8::EpiResid E{(l == 0) ? C.a->ctx : ((float*)(C.a->ws + WS_XW)), (l == 0) ? C.a->x : ((float*)(C.a->ws + WS_XW)) + (size_t)CTXL * DM, ((float*)(C.a->ws + WS_XW)), modC, modL};
                pg8::gemm_phase<pg8::EpiResid, pg8::StaticOrder, true, false>(ldsg, g, S, E, C.tid); }
            } else if constexpr (k == 5) { if (KSEL(5)) phase_G(C, l); }
            else if constexpr (k == 6) { if (KSEL(6)) phase_H(C, l); }
            else if constexpr (k == 7) { if (KSEL(7)) {
                pg8::Gemm g{((bf16*)(C.a->ws + WS_H2)), ((bf16*)(C.a->ws + WS_W13)) + (size_t)l * NEXP * 4096 * DM, NEXP * ESLOTS, NEXP * 4096, DM, ((int*)(C.a->ws + WS_IDX))}; pg8::MoeOrder S; S.init((l == 0) ? 9 : 8, 16, C.G, C.vcu);
                pg8::EpiSwiGLU E{((bf16*)(C.a->ws + WS_HID))};
                pg8::gemm_phase<pg8::EpiSwiGLU, pg8::MoeOrder, true, true>(ldsg, g, S, E, C.tid); }
            } else if constexpr (k == 8) { if (KSEL(8)) {
                pg8::Gemm g{((bf16*)(C.a->ws + WS_HID)), ((bf16*)(C.a->ws + WS_W2)) + (size_t)l * NEXP * DM * FF, NEXP * ESLOTS, NEXP * DM, FF, nullptr}; pg8::MoeOrder S; S.init((l == 0) ? 9 : 8, 4, C.G, C.vcu);
                pg8::EpiGateRow E{((bf16*)(C.a->ws + WS_Y)), ((float*)(C.a->ws + WS_GATE))};
                pg8::gemm_phase<pg8::EpiGateRow, pg8::MoeOrder, true, false>(ldsg, g, S, E, C.tid); }
            } else { if (KSEL(9)) phase_K(C, l); }
        }
}
__global__ void __launch_bounds__(NTHR, 2) hybrid_fwd(Args args) {
    extern __shared__ __attribute__((aligned(16))) unsigned char lds[];
    cg::grid_group grid = cg::this_grid();
    Ctx C; C.lds = lds;
    PG8_LAS unsigned char* ldsg = (PG8_LAS unsigned char*)lds;

    const int ph_lo = args.ph_lo, ph_hi = args.ph_hi;
    volatile LAS unsigned* MISC = (volatile LAS unsigned*)((LAS unsigned char*)lds + (LDS_BYTES - 64));
    if (threadIdx.x < 16) MISC[threadIdx.x] = 0u;
    __syncthreads();
    XcdBarrier xbar = xcd_barrier_post((unsigned*)(args.ws + WS_CTL) + 4096, MISC + 8);
#define RUN_PHASE(PH) do { if (ph_lo <= (PH) && (PH) < ph_hi) { constexpr int ph = (PH); \
        { KArgs ka = (KArgs)__builtin_amdgcn_kernarg_segment_ptr(); asm volatile("" : "+s"(ka)); C.a = ka; } \
        { int tid_ = threadIdx.x; asm volatile("" : "+v"(tid_)); C.tid = tid_; C.lane = tid_ & 63; C.wave = __builtin_amdgcn_readfirstlane(tid_ >> 6); } \
        { int g_ = gridDim.x, b_ = blockIdx.x; asm volatile("" : "+s"(g_), "+s"(b_)); C.G = g_; C.bid = b_; C.vcu = (g_ % 8 == 0) ? (b_ % 8) * (g_ / 8) + b_ / 8 : b_; } \
        run_phase<ph>(C, ldsg); if ((PH) == REPEAT_PH) { xcd_barrier(xbar); run_phase<ph>(C, ldsg); } if ((PH) + 1 < ph_hi) { if ((PH) == 0) grid.sync(); else xcd_barrier(xbar); } } } while (0)
    RUN_PHASE(0); RUN_PHASE(1); RUN_PHASE(2); RUN_PHASE(3); RUN_PHASE(4); RUN_PHASE(5); RUN_PHASE(6); RUN_PHASE(7); RUN_PHASE(8); RUN_PHASE(9); RUN_PHASE(10); RUN_PHASE(11);
    RUN_PHASE(12); RUN_PHASE(13); RUN_PHASE(14); RUN_PHASE(15); RUN_PHASE(16); RUN_PHASE(17); RUN_PHASE(18); RUN_PHASE(19); RUN_PHASE(20); RUN_PHASE(21);
#undef RUN_PHASE
}

extern "C" void kernel_launch(void* const* d_in, const int* in_sizes, int n_in, void* d_out, int out_size, void* d_ws, size_t ws_size, hipStream_t stream) {
    static int grid = 0;
    if (grid == 0) {
        if (n_in != 24 || ws_size < WS_END) { fprintf(stderr, "kernel_launch: unexpected inputs (%d) or workspace (%zu < %zu)\n", n_in, ws_size, (size_t)WS_END); grid = -1; return; }
        int dev = 0, cus = 0, per_cu = 0;
        hipGetDevice(&dev); hipDeviceGetAttribute(&cus, hipDeviceAttributeMultiprocessorCount, dev);
        hipFuncSetAttribute((const void*)hybrid_fwd, hipFuncAttributeMaxDynamicSharedMemorySize, LDS_BYTES);
        hipOccupancyMaxActiveBlocksPerMultiprocessor(&per_cu, (const void*)hybrid_fwd, NTHR, LDS_BYTES);
        if (per_cu < 1) { fprintf(stderr, "kernel_launch: occupancy query says %d blocks per CU\n", per_cu); per_cu = 1; }
        (void)hipGetLastError();
        grid = cus;
        if (grid > 256) grid = 256;
    }
    if (grid < 0) return;
    hipMemsetAsync((char*)d_ws + WS_CTL, 0, 64 * 1024, stream);
    Args a{};
    const float** ap = (const float**)&a;
    for (int i = 0; i < 24; ++i) ap[i] = (const float*)d_in[i];
    a.out = (float*)d_out; a.ws = (unsigned char*)d_ws;
#ifndef MK_PER_PHASE
    a.ph_lo = 0; a.ph_hi = N_PHASES;
    void* kargs[] = {&a};
    hipError_t e = hipLaunchCooperativeKernel((const void*)hybrid_fwd, dim3(grid), dim3(NTHR), kargs, LDS_BYTES, stream);
    if (e != hipSuccess) fprintf(stderr, "cooperative launch failed: %s (grid %d)\n", hipGetErrorString(e), grid);
#else
    for (int p = 0; p < N_PHASES; ++p) { a.ph_lo = p; a.ph_hi = p + 1; void* kargs[] = {&a};
        hipError_t e = hipLaunchCooperativeKernel((const void*)hybrid_fwd, dim3(grid), dim3(NTHR), kargs, LDS_BYTES, stream);
        if (e != hipSuccess) { fprintf(stderr, "launch %d failed: %s\n", p, hipGetErrorString(e)); break; } }
#endif
}
```

```cpp
#include <hip/hip_runtime.h>
#include <hip/hip_bf16.h>
#include <hip/hip_cooperative_groups.h>
#include <cstdio>
#include <cstdint>
#include <cmath>
namespace cg = cooperative_groups;
namespace pg8 {
#define PG8_LAS __attribute__((address_space(3)))
typedef unsigned short bf16_t;
typedef short bf16x8 __attribute__((ext_vector_type(8)));
typedef float f32x4 __attribute__((ext_vector_type(4)));
typedef unsigned u32x4 __attribute__((ext_vector_type(4)));
constexpr int BM = 256, BK = 64, HALF = 128, HTB = HALF * BK * 2, STAGE_BYTES = 8 * HTB, NXCD = 8, WGM = 8;

__host__ __device__ __forceinline__ int lds_byte(int r, int c) { const int st = (r >> 4) * 2 + (c >> 5), rr = r & 15, cc = c & 31, ob = rr * 64 + cc * 2; return st * 1024 + (ob ^ (((ob >> 9) & 1) << 5)); }
__host__ __device__ __forceinline__ void stage_rc(int b, int& R, int& C) { const int st = b / 1024, sb = b % 1024, swz = sb ^ (((sb >> 9) & 1) << 5); R = (st >> 1) * 16 + swz / 64; C = (st & 1) * 32 + (swz % 64) / 2; }
__host__ __device__ __forceinline__ int perm32(int rho) { const int n = rho >> 4, i = rho & 15; return 8 * (i >> 2) + 4 * n + (i & 3); }

struct Unit { int pm, pn; };
struct Gemm { const bf16_t* A; const bf16_t* Bt; int M, N, K; const int* gidx; };

struct StaticOrder {
    int nM, nN, nwg, G, c, pm0;
    __host__ __device__ void init(int M, int N, int G_, int c_, int pm0_ = 0) { nM = M / BM; nN = N / BM; nwg = nM * nN; G = G_; c = c_; pm0 = pm0_; }
    __host__ __device__ bool next(int i, Unit& u) const {
        const long L = (long)i * G + c; if (L >= nwg) return false;
        int wgid = (int)L; { const int q = nwg / NXCD, r = nwg % NXCD, xcd = wgid % NXCD, off = wgid / NXCD; wgid = (xcd < r ? xcd * (q + 1) : r * (q + 1) + (xcd - r) * q) + off; }
        const int nig = WGM * nN, gid = wgid / nig, fm = gid * WGM, gsz = (nM - fm) < WGM ? (nM - fm) : WGM;
        u.pm = pm0 + fm + ((wgid % nig) % gsz); u.pn = (wgid % nig) / gsz; return true;
    }
};
struct MoeOrder {
    int npm, npn, total, G, c;
    __host__ __device__ void init(int npm_, int npn_, int G_, int c_) { npm = npm_; npn = npn_; total = 16 * npm_ * npn_; G = G_; c = c_; }
    __host__ __device__ bool next(int i, Unit& u) const {
        const long L = (long)i * G + c; if (L >= total) return false;
        const int per = npm * npn, e = (int)L / per, rem = (int)L % per, pn = rem / npm, pm = rem % npm;
        u.pm = e * 9 + pm; u.pn = e * npn + pn; return true;
    }
};

__device__ __forceinline__ unsigned cvt_pk_bf16(float lo, float hi) { unsigned r; asm volatile("v_cvt_pk_bf16_f32 %0, %1, %2" : "=v"(r) : "v"(lo), "v"(hi)); return r; }

struct EpiBf16 {
    static constexpr bool PERM = true;
    bf16_t* O; int ldc;
    __device__ __forceinline__ void operator()(const f32x4 (&acc)[2][2][4][2], const Unit& u, int wr, int wc, int fr, int fq) const {
        const int row0 = u.pm * BM + wr * 64 + fr; const int col0 = u.pn * BM + wc * 32 + 8 * fq;
#pragma unroll
        for (int ai = 0; ai < 2; ++ai)
#pragma unroll
            for (int m = 0; m < 4; ++m) { bf16_t* rowp = O + (size_t)(row0 + ai * HALF + m * 16) * ldc + col0;
#pragma unroll
                for (int bj = 0; bj < 2; ++bj) { const f32x4 v0 = acc[ai][bj][m][0], v1 = acc[ai][bj][m][1];
                    u32x4 w; w.x = cvt_pk_bf16(v0[0], v0[1]); w.y = cvt_pk_bf16(v0[2], v0[3]); w.z = cvt_pk_bf16(v1[0], v1[1]); w.w = cvt_pk_bf16(v1[2], v1[3]);
                    *(u32x4*)(rowp + bj * HALF) = w; } }
    }
};
struct EpiResid {
    static constexpr bool PERM = false;
    const float* baseC; const float* baseL; float* out; const float* gateC; const float* gateL;
    __device__ __forceinline__ void operator()(const f32x4 (&acc)[2][2][4][2], const Unit& u, int wr, int wc, int fr, int fq) const {
        const int rl = wr * 64 + fr, col0 = u.pn * BM + wc * 32 + 4 * fq;
        const float* bp = (u.pm == 0) ? baseC : baseL + (size_t)(u.pm - 1) * BM * 1024;
        const float* gp = (u.pm == 0) ? gateC : gateL;
        f32x4 gv[2][2];
#pragma unroll
        for (int bj = 0; bj < 2; ++bj)
#pragma unroll
            for (int n = 0; n < 2; ++n) gv[bj][n] = *(const f32x4*)(gp + col0 + bj * HALF + n * 16);
#pragma unroll
        for (int ai = 0; ai < 2; ++ai)
#pragma unroll
            for (int m = 0; m < 4; ++m) { const int r = rl + ai * HALF + m * 16; const float* brow = bp + (size_t)r * 1024 + col0; float* orow = out + ((size_t)u.pm * BM + r) * 1024 + col0;
#pragma unroll
                for (int bj = 0; bj < 2; ++bj)
#pragma unroll
                    for (int n = 0; n < 2; ++n) { const f32x4 b = *(const f32x4*)(brow + bj * HALF + n * 16); *(f32x4*)(orow + bj * HALF + n * 16) = b + gv[bj][n] * acc[ai][bj][m][n]; } }
    }
};
struct EpiSwiGLU {
    static constexpr bool PERM = true;
    bf16_t* O;
    __device__ __forceinline__ void operator()(const f32x4 (&acc)[2][2][4][2], const Unit& u, int wr, int wc, int fr, int fq) const {
        const int row0 = u.pm * BM + wr * 64 + fr; const int col0 = (u.pn & 15) * HALF + wc * 32 + 8 * fq;
#pragma unroll
        for (int ai = 0; ai < 2; ++ai)
#pragma unroll
            for (int m = 0; m < 4; ++m) { bf16_t* rowp = O + (size_t)(row0 + ai * HALF + m * 16) * 2048 + col0; float h[8];
#pragma unroll
                for (int n = 0; n < 2; ++n)
#pragma unroll
                    for (int j = 0; j < 4; ++j) { const float a = acc[ai][0][m][n][j], b = acc[ai][1][m][n][j]; h[n * 4 + j] = a * b * __builtin_amdgcn_rcpf(1.0f + __builtin_amdgcn_exp2f(-1.4426950408889634f * a)); }
                u32x4 w; w.x = cvt_pk_bf16(h[0], h[1]); w.y = cvt_pk_bf16(h[2], h[3]); w.z = cvt_pk_bf16(h[4], h[5]); w.w = cvt_pk_bf16(h[6], h[7]);
                *(u32x4*)rowp = w; }
    }
};
struct EpiGateRow {
    static constexpr bool PERM = true;
    bf16_t* O; const float* gate;
    __device__ __forceinline__ void operator()(const f32x4 (&acc)[2][2][4][2], const Unit& u, int wr, int wc, int fr, int fq) const {
        const int row0 = u.pm * BM + wr * 64 + fr; const int col0 = (u.pn & 3) * BM + wc * 32 + 8 * fq;
#pragma unroll
        for (int ai = 0; ai < 2; ++ai)
#pragma unroll
            for (int m = 0; m < 4; ++m) { const int r = row0 + ai * HALF + m * 16; const float gt = gate[r]; bf16_t* rowp = O + (size_t)r * 1024 + col0;
#pragma unroll
                for (int bj = 0; bj < 2; ++bj) { const f32x4 v0 = acc[ai][bj][m][0] * gt, v1 = acc[ai][bj][m][1] * gt;
                    u32x4 w; w.x = cvt_pk_bf16(v0[0], v0[1]); w.y = cvt_pk_bf16(v0[2], v0[3]); w.z = cvt_pk_bf16(v1[0], v1[1]); w.w = cvt_pk_bf16(v1[2], v1[3]);
                    *(u32x4*)(rowp + bj * HALF) = w; } }
    }
};

template <class Epi, class Sched, bool ALIGN_EPI, bool GATHER>
__device__ __forceinline__ void gemm_phase(PG8_LAS unsigned char* lds, const Gemm g, const Sched& S, const Epi& E, const int tid) {
    const int wid = __builtin_amdgcn_readfirstlane(tid >> 6), lane = tid & 63, wr = wid >> 2, wc = wid & 3, fr = lane & 15, fq = lane >> 4;
    const int K = g.K, nt = K / BK;
    unsigned voffA[2], voffB[2]; int RA[2];
#pragma unroll
    for (int i = 0; i < 2; ++i) { int R, C; stage_rc(tid * 16 + i * 8192, R, C); const int Rb = Epi::PERM ? ((R & ~31) + perm32(R & 31)) : R;
        voffA[i] = GATHER ? (unsigned)(C * 2) : (unsigned)(R * K + C) * 2u; voffB[i] = (unsigned)(Rb * K + C) * 2u; RA[i] = R; }
    const size_t kstep = (size_t)(BK * 2);
    const size_t hstep = (size_t)HALF * K * 2;
    const size_t tstep = 2 * hstep;
    const unsigned ldsw = (unsigned)wid * 1024u;
    const int aoff = lds_byte(wr * 64 + fr, fq * 8), boff = lds_byte(wc * 32 + fr, fq * 8);
#define PG8_SA(b, h) (((b) * 2 + (h)) * HTB)
#define PG8_SB(b, h) ((4 + (b) * 2 + (h)) * HTB)
#define PG8_STAGE(bufoff, gbase, voff) do { _Pragma("unroll") for (int _i = 0; _i < 2; ++_i) \
        __builtin_amdgcn_global_load_lds((const unsigned*)((const char*)(gbase) + (voff)[_i]), (PG8_LAS unsigned*)(lds + (bufoff) + ldsw + _i * 8192), 16, 0, 0); } while (0)
#define PG8_LDA(dst, b, h) do { _Pragma("unroll") for (int m = 0; m < 4; ++m) _Pragma("unroll") for (int k = 0; k < 2; ++k) dst[m][k] = *(const PG8_LAS bf16x8*)(lds + PG8_SA(b, h) + aoff + m * 2048 + k * 1024); } while (0)
#define PG8_LDB(dst, b, h) do { _Pragma("unroll") for (int n = 0; n < 2; ++n) _Pragma("unroll") for (int k = 0; k < 2; ++k) dst[n][k] = *(const PG8_LAS bf16x8*)(lds + PG8_SB(b, h) + boff + n * 2048 + k * 1024); } while (0)
#define PG8_MMA(ai, bj, At, Bt) do { __builtin_amdgcn_s_setprio(1); _Pragma("unroll") for (int m = 0; m < 4; ++m) _Pragma("unroll") for (int n = 0; n < 2; ++n) _Pragma("unroll") for (int k = 0; k < 2; ++k) \
        acc[ai][bj][m][n] = __builtin_amdgcn_mfma_f32_16x16x32_bf16(Bt[n][k], At[m][k], acc[ai][bj][m][n], 0, 0, 0); __builtin_amdgcn_s_setprio(0); } while (0)
#define PG8_WAIT_V(n) asm volatile("s_waitcnt vmcnt(" #n ")" ::: "memory")
#define PG8_WAIT_L(n) asm volatile("s_waitcnt lgkmcnt(" #n ")" ::: "memory")
#define PG8_BAR __builtin_amdgcn_s_barrier()
#define PG8_SCHED __builtin_amdgcn_sched_barrier(0)
    Unit cur, nxt; int ui = 0;
    if (!S.next(0, cur)) return;
    f32x4 acc[2][2][4][2];
#pragma unroll
    for (int a = 0; a < 2; ++a)
#pragma unroll
        for (int b = 0; b < 2; ++b)
#pragma unroll
            for (int m = 0; m < 4; ++m)
#pragma unroll
                for (int n = 0; n < 2; ++n) acc[a][b][m][n] = (f32x4){0.f, 0.f, 0.f, 0.f};
    bf16x8 At[4][2], B0[2][2], B1[2][2];
    unsigned gC0[2], gC1[2], gN0[2], gN1[2];
    const char* cA; const char* cB = (const char*)g.Bt + (size_t)cur.pn * tstep;
    if constexpr (GATHER) {
        cA = (const char*)g.A;
#pragma unroll
        for (int i = 0; i < 2; ++i) { gC0[i] = (unsigned)g.gidx[cur.pm * BM + RA[i]] * (unsigned)(K * 2) + voffA[i]; gC1[i] = (unsigned)g.gidx[cur.pm * BM + HALF + RA[i]] * (unsigned)(K * 2) + voffA[i]; gN0[i] = gC0[i]; gN1[i] = gC1[i]; }
    } else { cA = (const char*)g.A + (size_t)cur.pm * tstep; }
#define PG8_STA0(bufoff, ptr) do { if constexpr (GATHER) PG8_STAGE(bufoff, ptr, gC0); else PG8_STAGE(bufoff, ptr, voffA); } while (0)
#define PG8_STA1(bufoff, ptr) do { if constexpr (GATHER) PG8_STAGE(bufoff, ptr, gC1); else PG8_STAGE(bufoff, (ptr) + hstep, voffA); } while (0)
#define PG8_STX0(bufoff, ptr) do { if constexpr (GATHER) PG8_STAGE(bufoff, ptr, gX0); else PG8_STAGE(bufoff, ptr, voffA); } while (0)
#define PG8_STX1(bufoff, ptr) do { if constexpr (GATHER) PG8_STAGE(bufoff, ptr, gX1); else PG8_STAGE(bufoff, (ptr) + hstep, voffA); } while (0)
    PG8_STAGE(PG8_SB(0, 0), cB, voffB); PG8_STAGE(PG8_SB(0, 1), cB + hstep, voffB); PG8_STA0(PG8_SA(0, 0), cA); PG8_STA1(PG8_SA(0, 1), cA);
    if (wr == 1) PG8_BAR;
    PG8_WAIT_V(2); PG8_BAR;
    PG8_STAGE(PG8_SB(1, 0), cB + kstep, voffB); PG8_STA0(PG8_SA(1, 0), cA + kstep); PG8_STAGE(PG8_SB(1, 1), cB + hstep + kstep, voffB);
    PG8_WAIT_V(6); PG8_BAR;
    for (;;) {
        const bool has_next = S.next(ui + 1, nxt);
        const char* nA; const char* nB = has_next ? (const char*)g.Bt + (size_t)nxt.pn * tstep : cB;
        if constexpr (GATHER) {
            nA = cA;
            if (has_next) {
#pragma unroll
                for (int i = 0; i < 2; ++i) { gN0[i] = (unsigned)g.gidx[nxt.pm * BM + RA[i]] * (unsigned)(K * 2) + voffA[i]; gN1[i] = (unsigned)g.gidx[nxt.pm * BM + HALF + RA[i]] * (unsigned)(K * 2) + voffA[i]; }
            }
        } else { nA = has_next ? (const char*)g.A + (size_t)nxt.pm * tstep : cA; }
        for (int t = 0; t < nt; t += 2) {
            const bool last = (t == nt - 2);
            const char* a1 = cA + (size_t)(t + 1) * kstep;
            const char* a2 = last ? nA : cA + (size_t)(t + 2) * kstep; const char* b2 = last ? nB : cB + (size_t)(t + 2) * kstep;
            const char* a3 = a2 + kstep; const char* b3 = b2 + kstep;
            unsigned gX0[2], gX1[2];
            if constexpr (GATHER) {
#pragma unroll
                for (int i = 0; i < 2; ++i) { gX0[i] = last ? gN0[i] : gC0[i]; gX1[i] = last ? gN1[i] : gC1[i]; }
            }
            PG8_LDB(B0, 0, 0); PG8_LDB(B1, 0, 1); PG8_SCHED; PG8_LDA(At, 0, 0); PG8_STA1(PG8_SA(1, 1), a1);
            PG8_WAIT_V(8); PG8_WAIT_L(0); PG8_BAR; PG8_MMA(0, 0, At, B0); PG8_MMA(0, 1, At, B1); PG8_BAR; PG8_SCHED;
            PG8_LDA(At, 0, 1); PG8_STAGE(PG8_SB(0, 0), b2, voffB); PG8_STAGE(PG8_SB(0, 1), b2 + hstep, voffB); PG8_STX0(PG8_SA(0, 0), a2);
            PG8_WAIT_V(8); PG8_WAIT_L(0); PG8_BAR; PG8_MMA(1, 0, At, B0); PG8_MMA(1, 1, At, B1); PG8_BAR; PG8_SCHED;
            PG8_LDB(B0, 1, 0); PG8_LDB(B1, 1, 1); PG8_SCHED; PG8_LDA(At, 1, 0); PG8_STX1(PG8_SA(0, 1), a2);
            PG8_WAIT_V(8); PG8_WAIT_L(0); PG8_BAR; PG8_MMA(0, 0, At, B0); PG8_MMA(0, 1, At, B1); PG8_BAR; PG8_SCHED;
            PG8_LDA(At, 1, 1); PG8_STAGE(PG8_SB(1, 0), b3, voffB); PG8_STAGE(PG8_SB(1, 1), b3 + hstep, voffB); PG8_STX0(PG8_SA(1, 0), a3);
            PG8_WAIT_V(8); PG8_WAIT_L(0); PG8_BAR; PG8_MMA(1, 0, At, B0); PG8_MMA(1, 1, At, B1); PG8_BAR; PG8_SCHED;
        }
        if constexpr (ALIGN_EPI) { if (wr == 0) PG8_BAR; }
        E(acc, cur, wr, wc, fr, fq);
        if (!has_next) break;
#pragma unroll
        for (int a = 0; a < 2; ++a)
#pragma unroll
            for (int b = 0; b < 2; ++b)
#pragma unroll
                for (int m = 0; m < 4; ++m)
#pragma unroll
                    for (int n = 0; n < 2; ++n) acc[a][b][m][n] = (f32x4){0.f, 0.f, 0.f, 0.f};
        cur = nxt; cA = nA; cB = nB; ++ui;
        if constexpr (GATHER) {
#pragma unroll
            for (int i = 0; i < 2; ++i) { gC0[i] = gN0[i]; gC1[i] = gN1[i]; }
        }
        if constexpr (ALIGN_EPI) { if (wr == 1) PG8_BAR; }
    }
    PG8_WAIT_V(0);
    if constexpr (!ALIGN_EPI) { if (wr == 0) PG8_BAR; }
    PG8_BAR;
#undef PG8_SA
#undef PG8_SB
#undef PG8_STAGE
#undef PG8_STA0
#undef PG8_STA1
#undef PG8_STX0
#undef PG8_STX1
#undef PG8_LDA
#undef PG8_LDB
#undef PG8_MMA
#undef PG8_WAIT_V
#undef PG8_WAIT_L
#undef PG8_BAR
#undef PG8_SCHED
}
}
namespace attn_body {
using bf16=__hip_bfloat16;
using bf16x8=__attribute__((ext_vector_type(8)))short;
using s16x4=__attribute__((ext_vector_type(4)))short;
using f32x16=__attribute__((ext_vector_type(16)))float;
using u32x4=__attribute__((ext_vector_type(4)))unsigned;
constexpr int D=64,QP=256,KP=128,VP=128,OP=1024;
constexpr int NW=8,QBLK=32,QB=QBLK*NW,KVBLK=64;
__device__ __forceinline__ int crow(int r,int hi){return (r&3)+8*(r>>2)+4*hi;}
#define SBAR() __builtin_amdgcn_sched_barrier(0)
__device__ __forceinline__ void cmask(f32x16&p0,f32x16&p1,int jb,int qrel,int hi){
  const float NEG=-INFINITY; int kb=64*jb+4*hi;
  #pragma unroll
  for(int r=0;r<16;++r){int kv=kb+(r&3)+8*(r>>2); if(kv>qrel)p0[r]=NEG; if(kv+32>qrel)p1[r]=NEG;}
}

constexpr int NSLOT=3, SLOTB=8192;
constexpr int LDS_K=0, LDS_V=NSLOT*SLOTB, LDS_WS=2*NSLOT*SLOTB, LDS_OST=LDS_WS+NW*64*4, LDS_BYTES=LDS_OST+NW*4096;
constexpr float C2=0.125f*1.4426950408889634f;
__device__ __forceinline__ void glds16(const void*gsrc,unsigned lds_dst){unsigned keep;
  asm volatile("s_mov_b32 %0, m0\n\ts_mov_b32 m0, %2\n\ts_nop 0\n\tglobal_load_lds_dwordx4 %1, off\n\ts_mov_b32 m0, %0":"=&s"(keep):"v"(gsrc),"s"(lds_dst):"memory");}
__device__ __forceinline__ float max3f(float a,float b,float c){float r;asm("v_max3_f32 %0, %1, %2, %3":"=v"(r):"v"(a),"v"(b),"v"(c));return r;}
__device__ __forceinline__ float max2f(float a,float b){float r;asm("v_max_f32_e32 %0, %1, %2":"=v"(r):"v"(a),"v"(b));return r;}
__device__ __forceinline__ float fadd_s(float a,float b){float r;asm("v_add_f32_e32 %0, %1, %2":"=v"(r):"v"(a),"v"(b));return r;}
__device__ __forceinline__ float fsub_s(float a,float b){float r;asm("v_sub_f32_e32 %0, %1, %2":"=v"(r):"v"(a),"v"(b));return r;}
typedef float f32x2_t __attribute__((ext_vector_type(2))); typedef __bf16 bf16x2_t __attribute__((ext_vector_type(2)));
__device__ __forceinline__ unsigned cvtpk_s(float lo,float hi){f32x2_t v={lo,hi};bf16x2_t b=__builtin_convertvector(v,bf16x2_t);return __builtin_bit_cast(unsigned,b);}
#define WAIT_BAR(N) asm volatile("s_waitcnt vmcnt(" #N ") lgkmcnt(0)\n\ts_barrier":::"memory")

__device__ __forceinline__ void qkt(f32x16&p0,f32x16&p1,const char*Kslot,const bf16x8*qr,const f32x16&negm,int r32,int hi){
  const char*kb=Kslot+hi*1024+r32*16;
  #pragma unroll
  for(int d0=0;d0<4;++d0){
    const bf16x8 b0=*reinterpret_cast<const bf16x8*>(kb+d0*2048);
    const bf16x8 b1=*reinterpret_cast<const bf16x8*>(kb+d0*2048+512);
    if(d0==0){p0=__builtin_amdgcn_mfma_f32_32x32x16_bf16(b0,qr[0],negm,0,0,0);p1=__builtin_amdgcn_mfma_f32_32x32x16_bf16(b1,qr[0],negm,0,0,0);}
    else{p0=__builtin_amdgcn_mfma_f32_32x32x16_bf16(b0,qr[d0],p0,0,0,0);p1=__builtin_amdgcn_mfma_f32_32x32x16_bf16(b1,qr[d0],p1,0,0,0);}}
}
typedef __attribute__((address_space(3))) const char* lds_cptr;
typedef short v4i16_t __attribute__((ext_vector_type(4)));
__device__ __forceinline__ void kload8(bf16x8*kf,lds_cptr kp){
  kf[0]=*(const __attribute__((address_space(3))) bf16x8*)(kp);      kf[1]=*(const __attribute__((address_space(3))) bf16x8*)(kp+512);
  kf[2]=*(const __attribute__((address_space(3))) bf16x8*)(kp+2048); kf[3]=*(const __attribute__((address_space(3))) bf16x8*)(kp+2560);
  kf[4]=*(const __attribute__((address_space(3))) bf16x8*)(kp+4096); kf[5]=*(const __attribute__((address_space(3))) bf16x8*)(kp+4608);
  kf[6]=*(const __attribute__((address_space(3))) bf16x8*)(kp+6144); kf[7]=*(const __attribute__((address_space(3))) bf16x8*)(kp+6656);
}
__device__ __forceinline__ void kload2(bf16x8*kf,lds_cptr kp,int j){ kf[2*j]=*(const __attribute__((address_space(3))) bf16x8*)(kp+j*2048); kf[2*j+1]=*(const __attribute__((address_space(3))) bf16x8*)(kp+j*2048+512); }
__device__ __forceinline__ s16x4 vtr(lds_cptr p){ return __builtin_bit_cast(s16x4,__builtin_amdgcn_ds_read_tr16_b64_v4i16((__attribute__((address_space(3))) v4i16_t*)p)); }
__device__ __forceinline__ float rowmax(const f32x16&p0,const f32x16&p1){
  float a=max3f(p0[0],p0[1],p1[0]),b=max3f(p0[2],p0[3],p1[1]);a=max3f(a,p1[2],p1[3]);
  #pragma unroll
  for(int r=4;r<16;r+=4){a=max3f(a,p0[r],p0[r+1]);b=max3f(b,p0[r+2],p0[r+3]);a=max3f(a,p1[r],p1[r+1]);b=max3f(b,p1[r+2],p1[r+3]);}
  const float m=max2f(a,b);
  auto rr=__builtin_amdgcn_permlane32_swap(__float_as_uint(m),__float_as_uint(m),false,false);
  return max2f(__uint_as_float(rr[0]),__uint_as_float(rr[1]));
}
__device__ __forceinline__ void pv(f32x16*o,int vb,bf16x8 pa0,bf16x8 pa1,bf16x8 pa2,bf16x8 pa3){
  #pragma unroll
  for(int d0=0;d0<2;++d0){s16x4 lo[4],hi[4];
    #pragma unroll
    for(int ks=0;ks<4;++ks){
      asm volatile("ds_read_b64_tr_b16 %0,%1 offset:%c2":"=&v"(lo[ks]):"v"(vb),"i"(d0*4096+ks*1024):"memory");
      asm volatile("ds_read_b64_tr_b16 %0,%1 offset:%c2":"=&v"(hi[ks]):"v"(vb),"i"(d0*4096+ks*1024+512):"memory");}
    asm volatile("s_waitcnt lgkmcnt(0)":::"memory");SBAR();
    #define PK(k) (bf16x8){lo[k][0],lo[k][1],lo[k][2],lo[k][3],hi[k][0],hi[k][1],hi[k][2],hi[k][3]}
    o[d0]=__builtin_amdgcn_mfma_f32_32x32x16_bf16(pa0,PK(0),o[d0],0,0,0);
    o[d0]=__builtin_amdgcn_mfma_f32_32x32x16_bf16(pa1,PK(1),o[d0],0,0,0);
    o[d0]=__builtin_amdgcn_mfma_f32_32x32x16_bf16(pa2,PK(2),o[d0],0,0,0);
    o[d0]=__builtin_amdgcn_mfma_f32_32x32x16_bf16(pa3,PK(3),o[d0],0,0,0);
    #undef PK
  }
}

#ifndef ATTN_STORE16
#define ATTN_STORE16(p,v) (*(u32x4*)(p)=(v))
#endif
template<int THRL,bool STATICM> __device__ __forceinline__ void attn_unit(const bf16*Qu,const bf16*__restrict__ Kh,const bf16*__restrict__ Vh,bf16*Ou,const int NT,char*shm,const int tid,const float mref){
  const int lane=tid&63,r32=lane&31,hi=lane>>5; const int wid=__builtin_amdgcn_readfirstlane(tid>>6);
  const bf16*Qw=Qu+(long)(wid*QBLK)*QP;
  const unsigned lds0=(unsigned)(uintptr_t)shm;
  float*wsf=(float*)(shm+LDS_WS)+wid*64;
  const bf16*ksrc=Kh+(long)lane*KP+wid*8;
  const bf16*vsrc=Vh+(long)(16*(wid&3)+(lane>>2))*VP+(wid>>2)*32+(lane&3)*8;
  const unsigned kdst=lds0+LDS_K+wid*1024, vdst=lds0+LDS_V+wid*1024;
  #define DMA_K(t,slot) glds16(ksrc+(long)(t)*KVBLK*KP,(unsigned)__builtin_amdgcn_readfirstlane(kdst+(slot)))
  #define DMA_V(t,slot) glds16(vsrc+(long)(t)*KVBLK*VP,(unsigned)__builtin_amdgcn_readfirstlane(vdst+(slot)))
  const int vb0=(int)(lds0+LDS_V)+((lane>>4)&1)*32+(lane&3)*8+(4*hi+((lane&15)>>2))*64;
  const char*Kbase=shm+LDS_K; bf16x8 kf[8];
  const lds_cptr shm3=(lds_cptr)shm; const lds_cptr kp0=shm3+LDS_K+hi*1024+r32*16; const lds_cptr vp0=shm3+LDS_V+((lane>>4)&1)*32+(lane&3)*8+(4*hi+((lane&15)>>2))*64;
  DMA_K(0,0);DMA_V(0,0);DMA_K(1,SLOTB);
  bf16x8 qr[4];
  #pragma unroll
  for(int d0=0;d0<4;++d0)qr[d0]=*reinterpret_cast<const bf16x8*>(&Qw[(long)r32*QP+d0*16+hi*8]);
  float mhat=0.f,l_reg=0.f;f32x16 o[2];o[0]=f32x16{};o[1]=f32x16{};f32x16 negm=f32x16{};
  if constexpr(STATICM){ mhat=mref; _Pragma("unroll") for(int r=0;r<16;++r)negm[r]=-mref; }
  asm volatile("":"+v"(negm));
  #define CMASK(P0,P1,t) do{}while(0)
  bool resc=false;
  #define START(P0,P1) do{ resc=false; \
    if constexpr(!STATICM){ const float rm=rowmax(P0,P1); const float dl=rm; mhat=fadd_s(mhat,dl); \
      _Pragma("unroll") for(int r=0;r<16;++r){P0[r]=fsub_s(P0[r],dl);P1[r]=fsub_s(P1[r],dl);} \
      _Pragma("unroll") for(int r=0;r<16;++r)negm[r]=-mhat; asm volatile("":"+v"(negm)); } \
    _Pragma("unroll") for(int r=0;r<16;++r)P0[r]=__builtin_amdgcn_exp2f(P0[r]); }while(0)
  #define RESC() do{ if(resc){ asm volatile("s_waitcnt lgkmcnt(0)":::"memory"); \
      _Pragma("unroll") for(int d_=0;d_<2;++d_) _Pragma("unroll") for(int r=0;r<16;++r)o[d_][r]*=wsf[crow(r,hi)]; } }while(0)
  f32x16 pA0,pA1,pB0,pB1;
  int sl_prev=0,sl_cur=0,sl_next=SLOTB;
  #define ROT() do{sl_prev=sl_cur;sl_cur=sl_next;sl_next=(sl_next==(NSLOT-1)*SLOTB)?0:sl_next+SLOTB;}while(0)
  DMA_K(2,2*SLOTB);
  WAIT_BAR(3);
  qkt(pA0,pA1,Kbase,qr,negm,r32,hi);asm volatile("s_nop 15\n\ts_nop 7":"+v"(pA0),"+v"(pA1));CMASK(pA0,pA1,0);
  START(pA0,pA1);
  _Pragma("unroll") for(int r=0;r<16;++r)pA1[r]=__builtin_amdgcn_exp2f(pA1[r]);
  WAIT_BAR(0);
  DMA_K(3,0);DMA_V(1,SLOTB);
  ROT();
  kload8(kf,kp0+sl_cur);
  WAIT_BAR(2);
  s16x4 vlo[8],vhi[8]; u32x4 pw0,pw1,pw2,pw3;
  #define PKW(P,B) cvtpk_s(P[B],P[B+1])
  #define PAF(k) __builtin_bit_cast(bf16x8,pw##k)
  #define VFR(i) (bf16x8){vlo[i][0],vlo[i][1],vlo[i][2],vlo[i][3],vhi[i][0],vhi[i][1],vhi[i][2],vhi[i][3]}
  #define PIN(x) asm volatile("":"+v"(x))
  #define MX3(a,b,c) __builtin_fmaxf(__builtin_fmaxf((a),(b)),(c))
  #define GAPA(MF,A0,A1,A2,A3,W0,W1,PW) do{ MF; sacc+=A0; sacc+=A1; sacc+=A2; sacc+=A3; PIN(sacc); W0; W1; PIN(PW); SBAR(); }while(0)
  #define EX(v) __builtin_amdgcn_exp2f(v)
  #define GAPB(MF,X,B) do{ MF; X[B]=EX(X[B]); X[B+1]=EX(X[B+1]); X[B+2]=EX(X[B+2]); X[B+3]=EX(X[B+3]); PIN(X); SBAR(); }while(0)
  #define VRD(i) do{ vlo[i]=vtr(vp_+(((i)>>2)*4096+((i)&3)*1024)); vhi[i]=vtr(vp_+(((i)>>2)*4096+((i)&3)*1024+512)); }while(0)
  #define KRD(G,j) do{ if(G){ kload2(kf,kp0+sl_next,j); SBAR(); } }while(0)
  #define STEP(C0,C1,P0,P1,t,GK,GV,GL) do{ SBAR(); \
    const lds_cptr vp_=vp0+sl_prev; \
    VRD(0); SBAR(); float sacc=(P0[0]+P0[1]); \
    GAPA(C0=__builtin_amdgcn_mfma_f32_32x32x16_bf16(kf[0],qr[0],negm,0,0,0), P0[2],P0[3],P0[4],P0[5],     pw0[0]=PKW(P0,0), pw0[1]=PKW(P0,2), pw0); \
    VRD(4); SBAR(); GAPA(C1=__builtin_amdgcn_mfma_f32_32x32x16_bf16(kf[1],qr[0],negm,0,0,0), P0[6],P0[7],P0[8],P0[9],     pw0[2]=PKW(P0,4), pw0[3]=PKW(P0,6), pw0); \
    VRD(1); SBAR(); GAPA(C0=__builtin_amdgcn_mfma_f32_32x32x16_bf16(kf[2],qr[1],C0,0,0,0),   P0[10],P0[11],P0[12],P0[13], pw1[0]=PKW(P0,8), pw1[1]=PKW(P0,10), pw1); \
    VRD(5); SBAR(); GAPA(C1=__builtin_amdgcn_mfma_f32_32x32x16_bf16(kf[3],qr[1],C1,0,0,0),   P0[14],P0[15],P1[0],P1[1],   pw1[2]=PKW(P0,12),pw1[3]=PKW(P0,14), pw1); \
    VRD(2); SBAR(); GAPA(C0=__builtin_amdgcn_mfma_f32_32x32x16_bf16(kf[4],qr[2],C0,0,0,0),   P1[2],P1[3],P1[4],P1[5],     pw2[0]=PKW(P1,0), pw2[1]=PKW(P1,2), pw2); \
    VRD(6); SBAR(); GAPA(C1=__builtin_amdgcn_mfma_f32_32x32x16_bf16(kf[5],qr[2],C1,0,0,0),   P1[6],P1[7],P1[8],P1[9],     pw2[2]=PKW(P1,4), pw2[3]=PKW(P1,6), pw2); \
    VRD(3); SBAR(); GAPA(C0=__builtin_amdgcn_mfma_f32_32x32x16_bf16(kf[6],qr[3],C0,0,0,0),   P1[10],P1[11],P1[12],P1[13], pw3[0]=PKW(P1,8), pw3[1]=PKW(P1,10), pw3); \
    VRD(7); SBAR(); GAPA(C1=__builtin_amdgcn_mfma_f32_32x32x16_bf16(kf[7],qr[3],C1,0,0,0),   P1[14],P1[15],0.f,0.f,       pw3[2]=PKW(P1,12),pw3[3]=PKW(P1,14), pw3); \
    l_reg+=sacc; \
    if(GK){DMA_K((t)+3,sl_cur);} if(GV){DMA_V((t)+1,sl_next);} \
    CMASK(C0,C1,t); \
    if constexpr(!STATICM){ float a=MX3(C0[0],C0[1],C1[0]),b=MX3(C0[2],C0[3],C1[1]); a=MX3(a,C1[2],C1[3]); \
      _Pragma("unroll") for(int r=4;r<16;r+=4){a=MX3(a,C0[r],C0[r+1]);b=MX3(b,C0[r+2],C0[r+3]);a=MX3(a,C1[r],C1[r+1]);b=MX3(b,C1[r+2],C1[r+3]);} \
      float rm=__builtin_fmaxf(a,b); { auto rr=__builtin_amdgcn_permlane32_swap(__float_as_uint(rm),__float_as_uint(rm),false,false); rm=__builtin_fmaxf(__uint_as_float(rr[0]),__uint_as_float(rr[1])); } \
      resc=false; \
      if(__builtin_expect(__any(rm>(float)THRL),0)){ const float dl=__builtin_fmaxf(rm,0.f); mhat+=dl; \
        _Pragma("unroll") for(int r=0;r<16;++r){C0[r]-=dl;C1[r]-=dl;} \
        _Pragma("unroll") for(int r=0;r<16;++r)negm[r]=-mhat; asm volatile("":"+v"(negm)); \
        const float f=__builtin_amdgcn_exp2f(-dl); l_reg*=f; if(hi==0)wsf[r32]=f; resc=true; } } \
    SBAR(); \
    GAPB(o[0]=__builtin_amdgcn_mfma_f32_32x32x16_bf16(PAF(0),VFR(0),o[0],0,0,0), C0,0); \
    GAPB(o[1]=__builtin_amdgcn_mfma_f32_32x32x16_bf16(PAF(0),VFR(4),o[1],0,0,0), C0,4); \
    KRD(GL,0); GAPB(o[0]=__builtin_amdgcn_mfma_f32_32x32x16_bf16(PAF(1),VFR(1),o[0],0,0,0), C0,8); \
    KRD(GL,1); GAPB(o[1]=__builtin_amdgcn_mfma_f32_32x32x16_bf16(PAF(1),VFR(5),o[1],0,0,0), C0,12); \
    KRD(GL,2); GAPB(o[0]=__builtin_amdgcn_mfma_f32_32x32x16_bf16(PAF(2),VFR(2),o[0],0,0,0), C1,0); \
    KRD(GL,3); GAPB(o[1]=__builtin_amdgcn_mfma_f32_32x32x16_bf16(PAF(2),VFR(6),o[1],0,0,0), C1,4); \
    GAPB(o[0]=__builtin_amdgcn_mfma_f32_32x32x16_bf16(PAF(3),VFR(3),o[0],0,0,0), C1,8); \
    GAPB(o[1]=__builtin_amdgcn_mfma_f32_32x32x16_bf16(PAF(3),VFR(7),o[1],0,0,0), C1,12); \
    }while(0)
  int t=1;
  #undef CMASK
  #define CMASK(P0,P1,t) do{}while(0)
  for(;t+5<NT;t+=2){
    STEP(pB0,pB1,pA0,pA1,t,true,true,true);     WAIT_BAR(2); RESC(); ROT();
    STEP(pA0,pA1,pB0,pB1,t+1,true,true,true);   WAIT_BAR(2); RESC(); ROT();
  }
  #undef CMASK
  #define CMASK(P0,P1,t) do{}while(0)
  #define ENDW(tt) do{ if((tt)+3<NT){WAIT_BAR(2);} else if((tt)+2<NT){WAIT_BAR(1);} else {WAIT_BAR(0);} }while(0)
  for(;t+1<NT;t+=2){
    STEP(pB0,pB1,pA0,pA1,t,(t+3<NT),(t+1<NT),(t+1<NT));       ENDW(t);   RESC(); ROT();
    STEP(pA0,pA1,pB0,pB1,t+1,(t+4<NT),(t+2<NT),(t+2<NT));     ENDW(t+1); RESC(); ROT();
  }
  STEP(pB0,pB1,pA0,pA1,NT-1,false,false,false); RESC();
  { float sacc=pB0[0]+pB0[1]; _Pragma("unroll") for(int r=2;r<16;++r)sacc+=pB0[r]; _Pragma("unroll") for(int r=0;r<16;++r)sacc+=pB1[r]; l_reg+=sacc;
    pw0=(u32x4){PKW(pB0,0),PKW(pB0,2),PKW(pB0,4),PKW(pB0,6)};pw1=(u32x4){PKW(pB0,8),PKW(pB0,10),PKW(pB0,12),PKW(pB0,14)};pw2=(u32x4){PKW(pB1,0),PKW(pB1,2),PKW(pB1,4),PKW(pB1,6)};pw3=(u32x4){PKW(pB1,8),PKW(pB1,10),PKW(pB1,12),PKW(pB1,14)};
    SBAR(); pv(o,vb0+sl_cur,PAF(0),PAF(1),PAF(2),PAF(3)); }
  #undef PKW
  #undef PAF
  #undef VFR
  #undef PIN
  #undef MX3
  #undef GAPA
  #undef GAPB
  #undef EX
  #undef VRD
  #undef KRD
  #undef STEP
  #undef ENDW
  {auto rr=__builtin_amdgcn_permlane32_swap(__float_as_uint(l_reg),__float_as_uint(l_reg),false,false);l_reg=__uint_as_float(rr[0])+__uint_as_float(rr[1]);}
  if(hi==0)wsf[32+r32]=l_reg;asm volatile("s_waitcnt lgkmcnt(0)":::"memory");
  float rli[16];
  #pragma unroll
  for(int r=0;r<16;++r)rli[r]=__builtin_amdgcn_rcpf(wsf[32+crow(r,hi)]);
  bf16*Ow=Ou+(long)(wid*QBLK)*OP;
  { bf16*stg=(bf16*)(shm+LDS_OST)+wid*2048;
    #pragma unroll
    for(int r=0;r<16;++r){const int orow=crow(r,hi);
      #pragma unroll
      for(int d0=0;d0<2;++d0)stg[orow*64+d0*32+r32]=__float2bfloat16(o[d0][r]*rli[r]);}
    asm volatile("s_waitcnt lgkmcnt(0)":::"memory");
    #pragma unroll
    for(int i=0;i<4;++i){const int row=i*8+(lane>>3),ch=lane&7; const u32x4 v=*(const u32x4*)(stg+row*64+ch*8); ATTN_STORE16(Ow+(long)row*OP+ch*8,v);} }
  asm volatile("s_waitcnt lgkmcnt(0)\n\ts_barrier":::"memory");
  #undef DMA_K
  #undef DMA_V
  #undef CMASK
  #undef START
  #undef RESC
  #undef ROT
}
constexpr int ATTN_LDS_BYTES=LDS_BYTES;
#undef SBAR
#undef WAIT_BAR
}
#ifndef PROBE_K
#define PROBE_K 0
#define PROBE_A 0
#define PROBE_B 0
#endif
constexpr int NWAVES = 8, NTHR = 512;
constexpr int DM = 1024, SEQL = 16384, CTXL = 256, R = SEQL + CTXL;
constexpr int DIN = 2832, NZ = 2816;
constexpr int NEXP = 16, FF = 2048, CAPL = 2048, CAPC = 32, ESLOTS = 2304;
constexpr int NCHUNK = R / 128;
constexpr float EPSN = 1e-6f;
constexpr int ZC_CONVX = 0, ZC_CONVB = 256, ZC_CONVC = 512, ZC_CU = 768, ZC_CV = 1024, ZC_Q = 1280, ZC_K = 1536, ZC_V = 1664, ZC_MQ = 1792, ZC_MK = 2048, ZC_MV = 2304, ZC_MO = 2560;

constexpr size_t MiB = 1u << 20;
constexpr size_t WS_CTL = 0;
constexpr size_t WS_MOD = 1 * MiB;
constexpr size_t WS_ROPE = WS_MOD + 256 * 1024;
constexpr size_t WS_WIN = 2 * MiB;
constexpr size_t WS_WOUT = 14 * MiB;
constexpr size_t WS_W13 = 18 * MiB;
constexpr size_t WS_W2 = 274 * MiB;
constexpr size_t WS_XW = 402 * MiB;
constexpr size_t WS_H = 467 * MiB;
constexpr size_t WS_H2 = 500 * MiB;
constexpr size_t WS_MIX = 533 * MiB;
constexpr size_t WS_Z = 566 * MiB;
constexpr size_t WS_QB = 656 * MiB;
constexpr size_t WS_KB = 665 * MiB;
constexpr size_t WS_VB = 670 * MiB;
constexpr size_t WS_G = 675 * MiB;
constexpr size_t WS_CLOC = 677 * MiB;
constexpr size_t WS_NLOC = 694 * MiB;
constexpr size_t WS_SCAL = WS_NLOC + 512 * 1024;
constexpr size_t WS_AFF = 695 * MiB;
constexpr size_t WS_IDX = 697 * MiB;
constexpr size_t WS_GATE = WS_IDX + 512 * 1024;
constexpr size_t WS_SLOT = 698 * MiB;
constexpr size_t WS_HID = 700 * MiB;
constexpr size_t WS_Y = 844 * MiB;
constexpr size_t WS_END = 916 * MiB;
static_assert(WS_WIN + (size_t)2 * NZ * DM * 2 <= WS_WOUT && WS_Z + (size_t)R * NZ * 2 <= WS_QB && WS_QB + (size_t)R * 256 * 2 <= WS_KB && WS_KB + (size_t)R * 128 * 2 <= WS_VB && WS_VB + (size_t)R * 128 * 2 <= WS_G, "ws map");
static_assert(WS_G + (size_t)R * 16 * 4 <= WS_CLOC && WS_CLOC + (size_t)NCHUNK * 8 * 4096 * 4 <= WS_NLOC && WS_XW + (size_t)R * DM * 4 <= WS_H && WS_H + (size_t)R * DM * 2 <= WS_H2 && WS_MIX + (size_t)R * DM * 2 <= WS_Z, "ws map");
static_assert(WS_HID + (size_t)16 * ESLOTS * FF * 2 <= WS_Y && WS_Y + (size_t)16 * ESLOTS * DM * 2 <= WS_END && WS_AFF + (size_t)16 * R * 4 <= WS_IDX && WS_SLOT + (size_t)R * 16 * 4 <= WS_HID, "ws map");

constexpr int LDS_BYTES = 147456;

typedef unsigned short bf16;
typedef unsigned v4u __attribute__((ext_vector_type(4)));
typedef unsigned v2u __attribute__((ext_vector_type(2)));
typedef float f32x4 __attribute__((ext_vector_type(4)));
typedef float f32x2 __attribute__((ext_vector_type(2)));
typedef short bf16x8 __attribute__((ext_vector_type(8)));
typedef __bf16 bf16x2_t __attribute__((ext_vector_type(2)));

__device__ __forceinline__ unsigned pk2(float lo, float hi) { f32x2 v = {lo, hi}; bf16x2_t b = __builtin_convertvector(v, bf16x2_t); return __builtin_bit_cast(unsigned, b); }
__device__ __forceinline__ float bf_lo(unsigned w) { return __uint_as_float(w << 16); }
__device__ __forceinline__ float bf_hi(unsigned w) { return __uint_as_float(w & 0xffff0000u); }
__device__ __forceinline__ float bf2f(bf16 h) { return __uint_as_float((unsigned)h << 16); }
__device__ __forceinline__ bf16 f2bf(float f) { return (bf16)(pk2(f, 0.f) & 0xffffu); }
template <int CTRL> __device__ __forceinline__ float dppf(float v) { return __int_as_float(__builtin_amdgcn_update_dpp(__float_as_int(v), __float_as_int(v), CTRL, 0xF, 0xF, false)); }
constexpr int DPP_X1 = 0xB1, DPP_X2 = 0x4E, DPP_HMIR = 0x141, DPP_MIR = 0x140, DPP_ROR8 = 0x128;
__device__ __forceinline__ float swap16_sum(float a, float b) { auto r = __builtin_amdgcn_permlane16_swap(__float_as_uint(a), __float_as_uint(b), false, false); return __uint_as_float(r[0]) + __uint_as_float(r[1]); }
__device__ __forceinline__ float swap32_sum(float a, float b) { auto r = __builtin_amdgcn_permlane32_swap(__float_as_uint(a), __float_as_uint(b), false, false); return __uint_as_float(r[0]) + __uint_as_float(r[1]); }
__device__ __forceinline__ float swap16_max(float a) { auto r = __builtin_amdgcn_permlane16_swap(__float_as_uint(a), __float_as_uint(a), false, false); return fmaxf(__uint_as_float(r[0]), __uint_as_float(r[1])); }
__device__ __forceinline__ float swap32_max(float a) { auto r = __builtin_amdgcn_permlane32_swap(__float_as_uint(a), __float_as_uint(a), false, false); return fmaxf(__uint_as_float(r[0]), __uint_as_float(r[1])); }
__device__ __forceinline__ float wave_sum(float v) {
    v += dppf<DPP_X1>(v); v += dppf<DPP_X2>(v); v += dppf<DPP_HMIR>(v); v += dppf<DPP_MIR>(v);
    v = swap16_sum(v, v); v = swap32_sum(v, v); return v;
}
__device__ __forceinline__ float wave_max(float v) {
#pragma unroll
    for (int o = 32; o > 0; o >>= 1) v = fmaxf(v, __shfl_xor(v, o));
    return v;
}

struct Args {
    const float *x, *c, *ctx, *c_ctx, *ada_w, *ada_b, *norm1_g, *w_in, *conv_w, *cmlp_norm_g, *cmlp_ws, *cmlp_bs, *q_norm_g, *k_norm_g, *ml_igate_b, *ml_fgate_b, *ml_norm_g, *w_out, *norm2_g, *router_w, *exp_w1, *exp_w3, *exp_w2, *final_norm_g;
    float* out; unsigned char* ws; int ph_lo, ph_hi;
};
typedef const __attribute__((address_space(4))) Args* KArgs;
struct Ctx { KArgs a; unsigned char* lds; int tid, lane, wave, G, bid, vcu; };
#define BLOCK_SYNC() __syncthreads()

struct CvTile { const float* src; bf16* dst; int ld, K; };
__device__ __forceinline__ void cv_load(const CvTile& T, int lane, f32x4 (&v)[8]) {
#pragma unroll
    for (int i = 0; i < 8; ++i) { const int idx = i * 64 + lane; v[i] = *(const f32x4*)(T.src + (size_t)(idx >> 3) * T.ld + (idx & 7) * 4); }
}
__device__ __forceinline__ void cv_store(const CvTile& T, int lane, const f32x4 (&v)[8], float* scr) {
#pragma unroll
    for (int i = 0; i < 8; ++i) { const int idx = i * 64 + lane; float* p = scr + (idx >> 3) * 33 + (idx & 7) * 4; p[0] = v[i][0]; p[1] = v[i][1]; p[2] = v[i][2]; p[3] = v[i][3]; }
    asm volatile("s_waitcnt lgkmcnt(0)" ::: "memory");
    const int c = lane & 7;
#pragma unroll
    for (int j = 0; j < 4; ++j) { const int n = (lane >> 3) + 8 * j; const float* s = scr + (8 * c) * 33 + n;
        v4u o; o.x = pk2(s[0 * 33], s[1 * 33]); o.y = pk2(s[2 * 33], s[3 * 33]); o.z = pk2(s[4 * 33], s[5 * 33]); o.w = pk2(s[6 * 33], s[7 * 33]);
        *(v4u*)(T.dst + (size_t)n * T.K + 8 * c) = o; }
    asm volatile("s_waitcnt lgkmcnt(0)" ::: "memory");
}
constexpr int CV_WIN = 16 * 88, CV_WOUT = 16 * 32, CV_SMALL = 2 * (CV_WIN + CV_WOUT), CV_EXP = 3072, CV_EXPL = 16 * CV_EXP;
__device__ __forceinline__ CvTile cv_small(const Ctx& C, int q) {
    const int l = q / (CV_WIN + CV_WOUT); int r = q % (CV_WIN + CV_WOUT); CvTile T;
    if (r < CV_WIN) { const int kb = r / 88, nb = r % 88; T.src = C.a->w_in + (size_t)l * DM * DIN + (size_t)(kb * 64) * DIN + nb * 32; T.ld = DIN; T.K = DM; T.dst = ((bf16*)(C.a->ws + WS_WIN)) + (size_t)l * NZ * DM + (size_t)(nb * 32) * DM + kb * 64; }
    else { r -= CV_WIN; const int kb = r / 32, nb = r % 32; T.src = C.a->w_out + (size_t)l * DM * DM + (size_t)(kb * 64) * DM + nb * 32; T.ld = DM; T.K = DM; T.dst = ((bf16*)(C.a->ws + WS_WOUT)) + (size_t)l * DM * DM + (size_t)(nb * 32) * DM + kb * 64; }
    return T;
}
__device__ __forceinline__ CvTile cv_expert(const Ctx& C, int l, int q) {
    const int e = q / CV_EXP, s = q % CV_EXP; const size_t le = (size_t)(l * NEXP + e); CvTile T;
    if (s < 2048) { const int which = s >> 10, r = s & 1023, kb = r / 64, nb = r % 64, n0 = nb * 32;
        T.src = (which ? C.a->exp_w3 : C.a->exp_w1) + le * DM * FF + (size_t)(kb * 64) * FF + n0; T.ld = FF; T.K = DM;
        T.dst = ((bf16*)(C.a->ws + WS_W13)) + le * 4096 * DM + (size_t)((n0 >> 7) * 256 + which * 128 + (n0 & 127)) * DM + kb * 64; }
    else { const int r = s - 2048, kb = r / 32, nb = r % 32; T.src = C.a->exp_w2 + le * FF * DM + (size_t)(kb * 64) * DM + nb * 32; T.ld = DM; T.K = FF; T.dst = ((bf16*)(C.a->ws + WS_W2)) + le * DM * FF + (size_t)(nb * 32) * FF + kb * 64; }
    return T;
}
template <bool EXPERT> __device__ __forceinline__ void convert_stream(const Ctx& C, int l, int first, int stride, int total) {
    float* scr = (float*)C.lds + C.wave * (64 * 33);
    int it = first; if (it >= total) return;
    f32x4 va[8], vb[8], vc[8];
    CvTile Ta = EXPERT ? cv_expert(C, l, it) : cv_small(C, it), Tb = Ta, Tc = Ta;
    cv_load(Ta, C.lane, va);
    if (it + stride < total) { Tb = EXPERT ? cv_expert(C, l, it + stride) : cv_small(C, it + stride); cv_load(Tb, C.lane, vb); }
#pragma unroll 1
    for (;;) {
        if (it + 2 * stride < total) { Tc = EXPERT ? cv_expert(C, l, it + 2 * stride) : cv_small(C, it + 2 * stride); cv_load(Tc, C.lane, vc); }
        cv_store(Ta, C.lane, va, scr); it += stride; if (it >= total) break;
        if (it + 2 * stride < total) { Ta = EXPERT ? cv_expert(C, l, it + 2 * stride) : cv_small(C, it + 2 * stride); cv_load(Ta, C.lane, va); }
        cv_store(Tb, C.lane, vb, scr); it += stride; if (it >= total) break;
        if (it + 2 * stride < total) { Tb = EXPERT ? cv_expert(C, l, it + 2 * stride) : cv_small(C, it + 2 * stride); cv_load(Tb, C.lane, vb); }
        cv_store(Tc, C.lane, vc, scr); it += stride; if (it >= total) break;
    }
}
__device__ __forceinline__ void phase_init(Ctx& C) {
    float* lf = (float*)C.lds;
    for (int m = C.bid; m < 192; m += C.G) {
        const int l = m / 96, j0 = (m % 96) * 64;
        float* sc = lf; float* red = lf + 2048;
        for (int i = C.tid; i < 2048; i += NTHR) { const float v = (i < 1024) ? C.a->c[i] : C.a->c_ctx[i - 1024]; sc[i] = v / (1.0f + __expf(-v)); }
        BLOCK_SYNC();
        const float* W = C.a->ada_w + (size_t)l * DM * 6144 + j0 + C.lane;
        float a0 = 0.f, a1 = 0.f;
#pragma unroll 32
        for (int k = C.wave * 128; k < C.wave * 128 + 128; ++k) { const float w = W[(size_t)k * 6144]; a0 += sc[k] * w; a1 += sc[1024 + k] * w; }
        red[(C.wave * 2 + 0) * 64 + C.lane] = a0; red[(C.wave * 2 + 1) * 64 + C.lane] = a1;
        BLOCK_SYNC();
        if (C.tid < 128) { const int s = C.tid >> 6, j = C.tid & 63; float t = 0.f;
#pragma unroll
            for (int w = 0; w < 8; ++w) t += red[(w * 2 + s) * 64 + j];
            ((float*)(C.a->ws + WS_MOD))[(size_t)(l * 2 + s) * 6144 + j0 + j] = t + C.a->ada_b[l * 6144 + j0 + j]; }
        BLOCK_SYNC();
    }
    if (C.bid == C.G - 1) {
        for (int i = C.tid; i < 4096; i += NTHR) { const int pos = i >> 4, f = i & 15;
            const float inv = powf(10000.0f, -(float)(2 * f) / 32.0f); const float ang = (float)pos * inv;
            ((float*)(C.a->ws + WS_ROPE))[2 * i] = (float)cos((double)ang); ((float*)(C.a->ws + WS_ROPE))[2 * i + 1] = (float)sin((double)ang); }
    }
    BLOCK_SYNC();
    convert_stream<false>(C, 0, C.bid * NWAVES + C.wave, C.G * NWAVES, CV_SMALL);
}
constexpr int CV_BFREE0 = 203, CV_BPW = 10, CV_HPW = 6;
__device__ __forceinline__ int cv_nb(int G) { return (G == 256) ? (256 - CV_BFREE0) * NWAVES * CV_BPW : 0; }
__device__ __forceinline__ int cv_nh(int G, int l) { const int busy = (l == 0) ? 32 : 16; return (G > busy) ? (G - busy) * NWAVES * CV_HPW : 0; }
__device__ __forceinline__ void convert_experts_B(Ctx& C, int l) { if (C.G == 256 && C.bid >= CV_BFREE0) convert_stream<true>(C, l, (C.bid - CV_BFREE0) * NWAVES + C.wave, (256 - CV_BFREE0) * NWAVES, cv_nb(C.G)); }
__device__ __forceinline__ void convert_experts_H(Ctx& C, int l) { const int busy = (l == 0) ? 32 : 16; if (C.bid >= busy) convert_stream<true>(C, l, cv_nb(C.G) + (C.bid - busy) * NWAVES + C.wave, (C.G - busy) * NWAVES, cv_nb(C.G) + cv_nh(C.G, l)); }
__device__ __forceinline__ void convert_experts(Ctx& C, int l) { convert_stream<true>(C, l, cv_nb(C.G) + cv_nh(C.G, l) + C.bid * NWAVES + C.wave, C.G * NWAVES, CV_EXPL); }

__device__ __forceinline__ void stage_m16(Ctx& C, const float* src, int ld, int off, float* M16) {
    for (int c = C.tid; c < 1024; c += NTHR) { const f32x4* p = (const f32x4*)(src + (size_t)c * ld + off);
#pragma unroll
        for (int q = 0; q < 4; ++q) { const f32x4 v = p[q]; M16[(q * 4 + 0) * 1024 + c] = v[0]; M16[(q * 4 + 1) * 1024 + c] = v[1]; M16[(q * 4 + 2) * 1024 + c] = v[2]; M16[(q * 4 + 3) * 1024 + c] = v[3]; } }
    BLOCK_SYNC();
}
__device__ __forceinline__ void stage_mod(Ctx& C, const float* g, int l, int part_shift, float* MV) {
    for (int i = C.tid; i < 2048; i += NTHR) { const int var = i >> 10, c = i & 1023; const float* modp = ((const float*)(C.a->ws + WS_MOD)) + (size_t)(l * 2 + var) * 6144 + part_shift * 1024;
        MV[(var * 2 + 0) * 1024 + c] = g[c] * (1.0f + modp[1024 + c]); MV[(var * 2 + 1) * 1024 + c] = modp[c]; }
}
__device__ __forceinline__ void norm_mod_row(f32x4 (&v)[4], const float* gs, const float* sh, bf16* orow, int lane) {
    float ss = 0.f;
#pragma unroll
    for (int j = 0; j < 4; ++j) ss += (v[j][0] * v[j][0] + v[j][1] * v[j][1]) + (v[j][2] * v[j][2] + v[j][3] * v[j][3]);
    const float rstd = rsqrtf(wave_sum(ss) * (1.0f / 1024.0f) + EPSN);
#pragma unroll
    for (int j = 0; j < 4; ++j) { const int c = 4 * lane + 256 * j;
        const f32x4 gv = *(const f32x4*)(gs + c), sv = *(const f32x4*)(sh + c);
        const f32x4 h = (v[j] * rstd) * gv + sv; v[j] = h;
        v2u w; w.x = pk2(h[0], h[1]); w.y = pk2(h[2], h[3]); *(v2u*)(orow + c) = w; }
}
__device__ __forceinline__ float dot16(const f32x4 (&v)[4], const float* M16_, int lane) {
    unsigned zoff = 0u; asm volatile("" : "+s"(zoff));
    const __attribute__((address_space(3))) float* M16 = (const __attribute__((address_space(3))) float*)M16_ + zoff;
    float p[16];
    f32x4 wb[3][4];
#define D16_LOAD(e_) do { _Pragma("unroll") for (int j = 0; j < 4; ++j) wb[(e_) % 3][j] = *(const __attribute__((address_space(3))) f32x4*)(M16 + (e_) * 1024 + 4 * lane + 256 * j); } while (0)
    D16_LOAD(0); D16_LOAD(1);
#pragma unroll
    for (int e = 0; e < 16; ++e) {
        if (e + 2 < 16) D16_LOAD(e + 2);
        asm volatile("" ::: "memory");
        float s = 0.f;
#pragma unroll
        for (int j = 0; j < 4; ++j) { const f32x4 w = wb[e % 3][j]; s += (v[j][0] * w[0] + v[j][1] * w[1]) + (v[j][2] * w[2] + v[j][3] * w[3]); }
        p[e] = s; asm volatile("" : "+v"(p[e])); }
#undef D16_LOAD
    const bool b3 = (lane & 8) != 0, b2 = (lane & 4) != 0;
#pragma unroll
    for (int e = 0; e < 8; ++e) p[e] = swap32_sum(p[e], p[e + 8]);
#pragma unroll
    for (int e = 0; e < 4; ++e) p[e] = swap16_sum(p[e], p[e + 4]);
#pragma unroll
    for (int e = 0; e < 2; ++e) { const float send = b3 ? p[e] : p[e + 2], keep = b3 ? p[e + 2] : p[e]; p[e] = keep + dppf<DPP_ROR8>(send); }
    { const float send = b2 ? p[0] : p[1], keep = b2 ? p[1] : p[0]; p[0] = keep + dppf<DPP_HMIR>(send); }
    float r = p[0]; r += dppf<DPP_X1>(r); r += dppf<DPP_X2>(r);
    return r;
}
__device__ __forceinline__ const float* row_src0(const Ctx& C, int r) { return (r < CTXL) ? C.a->ctx + (size_t)r * DM : C.a->x + (size_t)(r - CTXL) * DM; }
__device__ __forceinline__ void row_A(Ctx& C, f32x4 (&v)[4], int r, const float* MV, const float* M16) {
    const float* mv = MV + (r < CTXL ? 2048 : 0);
    norm_mod_row(v, mv, mv + 1024, ((bf16*)(C.a->ws + WS_H)) + (size_t)r * DM, C.lane);
    const float o = dot16(v, M16, C.lane);
    if ((C.lane & 3) == 0) ((float*)(C.a->ws + WS_G))[(size_t)r * 16 + (C.lane >> 2)] = o;
}
__device__ __forceinline__ void phase_A0(Ctx& C) {
    const int gw = C.bid * NWAVES + C.wave, NGW = C.G * NWAVES;
    f32x4 va[4], vb[4]; int r = gw;
    if (r < R) { const float* src = row_src0(C, r);
#pragma unroll
        for (int j = 0; j < 4; ++j) va[j] = ((const f32x4*)src)[C.lane + 64 * j]; }
    if (r + NGW < R) { const float* src = row_src0(C, r + NGW);
#pragma unroll
        for (int j = 0; j < 4; ++j) vb[j] = ((const f32x4*)src)[C.lane + 64 * j]; }
    float* M16 = (float*)C.lds; float* MV = M16 + 16 * 1024; stage_mod(C, C.a->norm1_g, 0, 0, MV); stage_m16(C, C.a->w_in, DIN, NZ, M16);
#pragma unroll 1
    for (; r < R; r += NGW) {
        f32x4 v[4];
#pragma unroll
        for (int j = 0; j < 4; ++j) { v[j] = va[j]; va[j] = vb[j]; }
        if (r + 2 * NGW < R) { const float* src = row_src0(C, r + 2 * NGW);
#pragma unroll
            for (int j = 0; j < 4; ++j) vb[j] = ((const f32x4*)src)[C.lane + 64 * j]; }
        row_A(C, v, r, MV, M16);
    }
}
__device__ __forceinline__ void phase_G(Ctx& C, int l) {
    const int gw = C.bid * NWAVES + C.wave, NGW = C.G * NWAVES; const int r0 = (l == 0) ? 0 : CTXL;
    const float* XW = (const float*)(C.a->ws + WS_XW);
    f32x4 va[4], vb[4]; int r = r0 + gw;
    if (r < R) {
#pragma unroll
        for (int j = 0; j < 4; ++j) va[j] = ((const f32x4*)(XW + (size_t)r * DM))[C.lane + 64 * j]; }
    if (r + NGW < R) {
#pragma unroll
        for (int j = 0; j < 4; ++j) vb[j] = ((const f32x4*)(XW + (size_t)(r + NGW) * DM))[C.lane + 64 * j]; }
    float* M16 = (float*)C.lds; float* MV = M16 + 16 * 1024; stage_mod(C, C.a->norm2_g + l * DM, l, 3, MV); stage_m16(C, C.a->router_w + (size_t)l * DM * 16, 16, 0, M16);
#pragma unroll 1
    for (; r < R; r += NGW) {
        f32x4 v[4];
#pragma unroll
        for (int j = 0; j < 4; ++j) { v[j] = va[j]; va[j] = vb[j]; }
        if (r + 2 * NGW < R) {
#pragma unroll
            for (int j = 0; j < 4; ++j) vb[j] = ((const f32x4*)(XW + (size_t)(r + 2 * NGW) * DM))[C.lane + 64 * j]; }
        const float* mv = MV + (r < CTXL ? 2048 : 0);
        norm_mod_row(v, mv, mv + 1024, ((bf16*)(C.a->ws + WS_H2)) + (size_t)r * DM, C.lane);
        const float lg = dot16(v, M16, C.lane);
        float mx = lg;
        mx = fmaxf(mx, dppf<DPP_HMIR>(mx)); mx = fmaxf(mx, dppf<DPP_MIR>(mx)); mx = swap16_max(mx); mx = swap32_max(mx);
        const float o = __expf(lg - mx); float sum = o;
        sum += dppf<DPP_HMIR>(sum); sum += dppf<DPP_MIR>(sum); sum = swap16_sum(sum, sum); sum = swap32_sum(sum, sum);
        if ((C.lane & 3) == 0) ((float*)(C.a->ws + WS_AFF))[(size_t)(C.lane >> 2) * R + r] = o / sum;
    }
}
__device__ __forceinline__ void phase_K(Ctx& C, int l) {
    float* M16 = (float*)C.lds; float* MV = M16 + 16 * 1024; float* GV = MV + 4096;
    for (int i = C.tid; i < 2048; i += NTHR) GV[i] = ((const float*)(C.a->ws + WS_MOD))[(size_t)(l * 2 + (i >> 10)) * 6144 + 5 * 1024 + (i & 1023)];
    for (int i = C.tid; i < 1024; i += NTHR) GV[2048 + i] = C.a->final_norm_g[i];
    if (l == 0) { stage_mod(C, C.a->norm1_g + DM, 1, 0, MV); stage_m16(C, C.a->w_in + (size_t)DM * DIN, DIN, NZ, M16); } else BLOCK_SYNC();
    const int gw = C.bid * NWAVES + C.wave, NGW = C.G * NWAVES; const int r0 = (l == 0) ? 0 : CTXL;
    float* XW = (float*)(C.a->ws + WS_XW); const int* SLOT = (const int*)(C.a->ws + WS_SLOT); const bf16* Y = (const bf16*)(C.a->ws + WS_Y);
    f32x4 vn[4]; int sn = -1; int r = r0 + gw;
    if (r < R) { sn = (C.lane < 16) ? SLOT[(size_t)C.lane * R + r] : -1;
#pragma unroll
        for (int j = 0; j < 4; ++j) vn[j] = ((const f32x4*)(XW + (size_t)r * DM))[C.lane + 64 * j]; }
#pragma unroll 1
    for (; r < R; r += NGW) {
        f32x4 v[4], acc[4]; const int myslot = sn;
#pragma unroll
        for (int j = 0; j < 4; ++j) { v[j] = vn[j]; acc[j] = (f32x4){0.f, 0.f, 0.f, 0.f}; }
        unsigned long long mask = __ballot(myslot >= 0);
        while (mask) {
            const int e0 = __ffsll((long long)mask) - 1; mask &= mask - 1; const int e1 = mask ? (__ffsll((long long)mask) - 1) : -1; if (e1 >= 0) mask &= mask - 1;
            const int s0 = __shfl(myslot, e0), s1 = __shfl(myslot, e1 >= 0 ? e1 : e0);
            const bf16* y0 = Y + ((size_t)e0 * ESLOTS + s0) * DM; const bf16* y1 = Y + ((size_t)(e1 >= 0 ? e1 : e0) * ESLOTS + s1) * DM;
            v2u w0[4], w1[4];
#pragma unroll
            for (int j = 0; j < 4; ++j) { w0[j] = *(const v2u*)(y0 + 4 * C.lane + 256 * j); w1[j] = *(const v2u*)(y1 + 4 * C.lane + 256 * j); }
            const float f1 = (e1 >= 0) ? 1.0f : 0.0f;
#pragma unroll
            for (int j = 0; j < 4; ++j) { acc[j][0] += bf_lo(w0[j].x) + f1 * bf_lo(w1[j].x); acc[j][1] += bf_hi(w0[j].x) + f1 * bf_hi(w1[j].x); acc[j][2] += bf_lo(w0[j].y) + f1 * bf_lo(w1[j].y); acc[j][3] += bf_hi(w0[j].y) + f1 * bf_hi(w1[j].y); }
        }
        if (r + NGW < R) { sn = (C.lane < 16) ? SLOT[(size_t)C.lane * R + (r + NGW)] : -1;
#pragma unroll
            for (int j = 0; j < 4; ++j) vn[j] = ((const f32x4*)(XW + (size_t)(r + NGW) * DM))[C.lane + 64 * j]; }
        const float* g2 = GV + (r < CTXL ? 1024 : 0);
#pragma unroll
        for (int j = 0; j < 4; ++j) { const f32x4 gg = *(const f32x4*)(g2 + 4 * C.lane + 256 * j); v[j] = v[j] + gg * acc[j]; }
        if (l == 0) {
#pragma unroll
            for (int j = 0; j < 4; ++j) ((f32x4*)(XW + (size_t)r * DM))[C.lane + 64 * j] = v[j];
            row_A(C, v, r, MV, M16);
        } else {
            float ss = 0.f;
#pragma unroll
            for (int j = 0; j < 4; ++j) ss += (v[j][0] * v[j][0] + v[j][1] * v[j][1]) + (v[j][2] * v[j][2] + v[j][3] * v[j][3]);
            const float rstd = rsqrtf(wave_sum(ss) * (1.0f / 1024.0f) + EPSN);
#pragma unroll
            for (int j = 0; j < 4; ++j) { const f32x4 gv = *(const f32x4*)(GV + 2048 + 4 * C.lane + 256 * j); ((f32x4*)(C.a->out + (size_t)(r - CTXL) * DM))[C.lane + 64 * j] = v[j] * rstd * gv; }
        }
    }
}
#define MFMA16(a, b, c) __builtin_amdgcn_mfma_f32_16x16x32_bf16(a, b, c, 0, 0, 0)
constexpr float C2Q = 0.125f * 1.4426950408889634f;
constexpr float LOG2E = 1.4426950408889634f;
__device__ __forceinline__ float logsigmoidf(float x) { return fminf(x, 0.f) - __logf(1.0f + __expf(-fabsf(x))); }
__device__ __forceinline__ float ex2(float x) { return __builtin_amdgcn_exp2f(x); }

__device__ __forceinline__ void item_conv_prep(const Ctx& C0, int l, int c) {
    Ctx C = C0; { int t_ = C.tid; asm volatile("" : "+v"(t_)); C.tid = t_; C.lane = t_ & 63; }
    const int rbase = c * 128; const int slo = (rbase < CTXL) ? 0 : CTXL, shi = (rbase < CTXL) ? CTXL : R;
    const float* cw = C.a->conv_w + l * 3 * 256;
    const bf16* Z = (const bf16*)(C.a->ws + WS_Z);
    if (l == 0 || c >= 2) {
        for (int idx = C.tid; idx < 128 * 32; idx += NTHR) {
            const int row = idx >> 5, ch0 = (idx & 31) * 8, r = rbase + row; const bf16* z = Z + (size_t)r * NZ;
            const v4u zero = {0u, 0u, 0u, 0u};
            const bool hm = (r - 1 >= slo), hp = (r + 1 < shi);
            const v4u xm = hm ? *(const v4u*)(z - NZ + ZC_CONVX + ch0) : zero, cm = hm ? *(const v4u*)(z - NZ + ZC_CONVC + ch0) : zero;
            const v4u x0 = *(const v4u*)(z + ZC_CONVX + ch0), c0 = *(const v4u*)(z + ZC_CONVC + ch0), b0 = *(const v4u*)(z + ZC_CONVB + ch0);
            const v4u xp = hp ? *(const v4u*)(z + NZ + ZC_CONVX + ch0) : zero, cp = hp ? *(const v4u*)(z + NZ + ZC_CONVC + ch0) : zero;
            float o[8];
#pragma unroll
            for (int q = 0; q < 4; ++q) {
                const int ch = ch0 + 2 * q;
                const float w0a = cw[ch], w1a = cw[256 + ch], w2a = cw[512 + ch], w0b = cw[ch + 1], w1b = cw[256 + ch + 1], w2b = cw[512 + ch + 1];
                const float ya = w0a * (bf_lo(xm[q]) * bf_lo(cm[q])) + w1a * (bf_lo(x0[q]) * bf_lo(c0[q])) + w2a * (bf_lo(xp[q]) * bf_lo(cp[q]));
                const float yb = w0b * (bf_hi(xm[q]) * bf_hi(cm[q])) + w1b * (bf_hi(x0[q]) * bf_hi(c0[q])) + w2b * (bf_hi(xp[q]) * bf_hi(cp[q]));
                o[2 * q] = bf_lo(b0[q]) * ya; o[2 * q + 1] = bf_hi(b0[q]) * yb; }
            v4u w; w.x = pk2(o[0], o[1]); w.y = pk2(o[2], o[3]); w.z = pk2(o[4], o[5]); w.w = pk2(o[6], o[7]);
            *(v4u*)(((bf16*)(C.a->ws + WS_MIX)) + (size_t)r * DM + ch0) = w;
        }
    }
    for (int it = 0; it < 12; ++it) {
        const int task = it * 64 + (C.tid >> 3), sub = C.tid & 7, row = task / 6, hd = task % 6, r = rbase + row;
        const v4u zx = *(const v4u*)(Z + (size_t)r * NZ + ZC_Q + hd * 64 + sub * 8);
        float y[8];
#pragma unroll
        for (int q = 0; q < 4; ++q) { y[2 * q] = bf_lo(zx[q]); y[2 * q + 1] = bf_hi(zx[q]); }
        float ss = 0.f;
#pragma unroll
        for (int e = 0; e < 8; ++e) ss += y[e] * y[e];
        ss += dppf<DPP_X1>(ss); ss += dppf<DPP_X2>(ss); ss += dppf<DPP_HMIR>(ss);
        const float rstd = rsqrtf(ss * (1.0f / 64.0f) + EPSN);
        const float* gn = ((hd < 4) ? C.a->q_norm_g : C.a->k_norm_g) + l * 64 + sub * 8;
#pragma unroll
        for (int e = 0; e < 8; ++e) y[e] = y[e] * rstd * gn[e];
        float o[8];
        if (r >= CTXL) {
            const int p = r - CTXL, pos = (sub < 4) ? (p >> 6) : (p & 63); const float* rt = ((float*)(C.a->ws + WS_ROPE)) + (size_t)(pos * 16 + 8 * (sub & 1)) * 2; const bool first = ((sub & 2) == 0);
#pragma unroll
            for (int e = 0; e < 8; ++e) { const float pr = dppf<DPP_X2>(y[e]); const float cs = rt[2 * e], sn = rt[2 * e + 1]; o[e] = first ? (y[e] * cs - pr * sn) : (y[e] * cs + pr * sn); }
        } else {
#pragma unroll
            for (int e = 0; e < 8; ++e) o[e] = y[e];
        }
        const float scl = (hd < 4) ? C2Q : 1.0f;
        v4u w; w.x = pk2(o[0] * scl, o[1] * scl); w.y = pk2(o[2] * scl, o[3] * scl); w.z = pk2(o[4] * scl, o[5] * scl); w.w = pk2(o[6] * scl, o[7] * scl);
        if (hd < 4) *(v4u*)(((bf16*)(C.a->ws + WS_QB)) + (size_t)r * 256 + hd * 64 + sub * 8) = w; else *(v4u*)(((bf16*)(C.a->ws + WS_KB)) + (size_t)r * 128 + (hd - 4) * 64 + sub * 8) = w;
    }
    for (int idx = C.tid; idx < 128 * 16; idx += NTHR) { const int row = idx >> 4, ch = (idx & 15) * 8, r = rbase + row; *(v4u*)(((bf16*)(C.a->ws + WS_VB)) + (size_t)r * 128 + ch) = *(const v4u*)(Z + (size_t)r * NZ + ZC_V + ch); }
}

__device__ __forceinline__ v2u quad_pack(const v4u (&x)[4], int e, const float (&sc)[4]) {
    float f[4];
#pragma unroll
    for (int j = 0; j < 4; ++j) { const unsigned w = x[j][e >> 1]; f[j] = ((e & 1) ? bf_hi(w) : bf_lo(w)) * sc[j]; }
    v2u o; o.x = pk2(f[0], f[1]); o.y = pk2(f[2], f[3]); return o;
}

__device__ __forceinline__ void item_cmlp(const Ctx& C0, int l, int c) {
    Ctx C = C0; { int t_ = C.tid; asm volatile("" : "+v"(t_)); C.tid = t_; C.lane = t_ & 63; }
    constexpr int LD = 136;
    bf16* VNT = (bf16*)C.lds;
    bf16* WSB = VNT + 256 * LD;
    float* rs = (float*)(WSB + 128 * LD);
    const int rbase = c * 128; const float* gn = C.a->cmlp_norm_g + l * 256;
    const bf16* Z = (const bf16*)(C.a->ws + WS_Z);
    const int q4 = C.tid & 31, cg = C.tid >> 5;
    v4u xa[4], xb[4];
#pragma unroll
    for (int j = 0; j < 4; ++j) { const bf16* z = Z + (size_t)(rbase + 4 * q4 + j) * NZ + ZC_CV + cg * 16; xa[j] = *(const v4u*)z; xb[j] = *(const v4u*)(z + 8); }
    for (int i = 0; i < 16; ++i) { const int row = C.wave * 16 + i; const v2u w = *(const v2u*)(Z + (size_t)(rbase + row) * NZ + ZC_CV + 4 * C.lane);
        const float a = bf_lo(w.x), b = bf_hi(w.x), cc = bf_lo(w.y), d = bf_hi(w.y);
        const float ss = wave_sum((a * a + b * b) + (cc * cc + d * d)); if (C.lane == 0) rs[row] = rsqrtf(ss * (1.0f / 256.0f) + EPSN); }
    BLOCK_SYNC();
    { float sc[4];
#pragma unroll
        for (int j = 0; j < 4; ++j) sc[j] = rs[4 * q4 + j];
#pragma unroll
        for (int e = 0; e < 8; ++e) { const int ch = cg * 16 + e; const float g = gn[ch]; const float s2[4] = {sc[0] * g, sc[1] * g, sc[2] * g, sc[3] * g}; *(v2u*)(VNT + ch * LD + 4 * q4) = quad_pack(xa, e, s2); }
#pragma unroll
        for (int e = 0; e < 8; ++e) { const int ch = cg * 16 + 8 + e; const float g = gn[ch]; const float s2[4] = {sc[0] * g, sc[1] * g, sc[2] * g, sc[3] * g}; *(v2u*)(VNT + ch * LD + 4 * q4) = quad_pack(xb, e, s2); } }
    for (int h = 0; h < 4; ++h) {
        BLOCK_SYNC();
        const float* wsrc = C.a->cmlp_ws + (size_t)(l * 4 + h) * 128 * 128;
#pragma unroll
        for (int it = 0; it < 8; ++it) { const int idx = (it * NTHR + C.tid) * 4, t = idx >> 7, s = idx & 127; const f32x4 w = *(const f32x4*)(wsrc + idx);
            v2u o; o.x = pk2(w[0], w[1]); o.y = pk2(w[2], w[3]); *(v2u*)(WSB + t * LD + s) = o; }
        BLOCK_SYNC();
        const int t0 = C.wave * 16, fr = C.lane & 15, fq = C.lane >> 4;
        f32x4 acc[4];
#pragma unroll
        for (int n = 0; n < 4; ++n) acc[n] = (f32x4){0.f, 0.f, 0.f, 0.f};
#pragma unroll
        for (int ks = 0; ks < 4; ++ks) { const bf16x8 a = *(const bf16x8*)(WSB + (t0 + fr) * LD + ks * 32 + 8 * fq);
#pragma unroll
            for (int n = 0; n < 4; ++n) { const bf16x8 b = *(const bf16x8*)(VNT + (h * 64 + 16 * n + fr) * LD + ks * 32 + 8 * fq); acc[n] = MFMA16(a, b, acc[n]); } }
        const float* bs = C.a->cmlp_bs + (size_t)(l * 4 + h) * 128;
#pragma unroll
        for (int j = 0; j < 4; ++j) { const int t = t0 + 4 * fq + j, r = rbase + t; const float bb = bs[t];
#pragma unroll
            for (int n = 0; n < 4; ++n) { const int col = h * 64 + 16 * n + fr; const float u = bf2f(Z[(size_t)r * NZ + ZC_CU + col]); ((bf16*)(C.a->ws + WS_MIX))[(size_t)r * DM + 256 + col] = f2bf(u * (acc[n][j] + bb)); } }
    }
}

__device__ __forceinline__ void gate_scan(const Ctx& C, int l, int c, int h, int dir, float* b, float* g, float* pm) {
    const int lane = C.lane; const int t0 = dir ? 127 - 2 * lane : 2 * lane, t1 = dir ? 126 - 2 * lane : 2 * lane + 1;
    const float* G0 = ((const float*)(C.a->ws + WS_G)) + (size_t)(c * 128 + t0) * 16; const float* G1 = ((const float*)(C.a->ws + WS_G)) + (size_t)(c * 128 + t1) * 16;
    const float ib = C.a->ml_igate_b[l * 8 + dir * 4 + h], fb = C.a->ml_fgate_b[l * 8 + dir * 4 + h];
    const float li0 = G0[dir * 4 + h] + ib, li1 = G1[dir * 4 + h] + ib, lf0 = logsigmoidf(G0[8 + dir * 4 + h] + fb), lf1 = logsigmoidf(G1[8 + dir * 4 + h] + fb);
    float s0 = lf0, s1 = lf0 + lf1; float inc = s1;
#pragma unroll
    for (int o = 1; o < 64; o <<= 1) { const float x = __shfl_up(inc, o); if (lane >= o) inc += x; }
    const float exc = inc - s1; s0 += exc; s1 += exc;
    const float g0 = li0 - s0, g1 = li1 - s1;
    float m1 = fmaxf(g0, g1); float minc = m1;
#pragma unroll
    for (int o = 1; o < 64; o <<= 1) { const float x = __shfl_up(minc, o); if (lane >= o) minc = fmaxf(minc, x); }
    float mexc = __shfl_up(minc, 1); if (lane == 0) mexc = -INFINITY;
    b[t0] = s0; b[t1] = s1; g[t0] = g0; g[t1] = g1; pm[t0] = fmaxf(g0, mexc); pm[t1] = fmaxf(m1, mexc);
}

__device__ __forceinline__ void item_mlstate(const Ctx& C0, int l, int c, int h) {
    Ctx C = C0; { int t_ = C.tid; asm volatile("" : "+v"(t_)); C.tid = t_; C.lane = t_ & 63; }
    constexpr int LD = 136;
    bf16* VT = (bf16*)C.lds;
    bf16* KTF = VT + 80 * LD;
    bf16* KTB = KTF + 64 * LD;
    float* fv = (float*)(KTB + 64 * LD);
    float *bF = fv, *gF = fv + 128, *pF = fv + 256, *bB = fv + 384, *gB = fv + 512, *pB = fv + 640;
    const bf16* Z = (const bf16*)(C.a->ws + WS_Z);
    const int q4 = C.tid & 31, dg = (C.tid >> 5) & 7; const bool isv = C.tid >= 256;
    v4u x[4];
#pragma unroll
    for (int j = 0; j < 4; ++j) x[j] = *(const v4u*)(Z + (size_t)(c * 128 + 4 * q4 + j) * NZ + (isv ? ZC_MV : ZC_MK) + h * 64 + dg * 8);
    if (C.wave == 0) gate_scan(C, l, c, h, 0, bF, gF, pF);
    if (C.wave == 1) gate_scan(C, l, c, h, 1, bB, gB, pB);
    for (int i = C.tid; i < 16 * LD; i += NTHR) VT[64 * LD + i] = (i < 128) ? (bf16)0x3F80 : (bf16)0;
    BLOCK_SYNC();
    if (isv) { const float one[4] = {1.f, 1.f, 1.f, 1.f};
#pragma unroll
        for (int e = 0; e < 8; ++e) *(v2u*)(VT + (dg * 8 + e) * LD + 4 * q4) = quad_pack(x, e, one);
    } else { float wf[4], wb[4]; const float gmF = pF[127] , gmB = pB[0];
#pragma unroll
        for (int j = 0; j < 4; ++j) { wf[j] = 0.125f * ex2((gF[4 * q4 + j] - gmF) * LOG2E); wb[j] = 0.125f * ex2((gB[4 * q4 + j] - gmB) * LOG2E); }
#pragma unroll
        for (int e = 0; e < 8; ++e) { *(v2u*)(KTF + (dg * 8 + e) * LD + 4 * q4) = quad_pack(x, e, wf); *(v2u*)(KTB + (dg * 8 + e) * LD + 4 * q4) = quad_pack(x, e, wb); } }
    BLOCK_SYNC();
    const int dir = C.wave >> 2, nq = C.wave & 3, fr = C.lane & 15, fq = C.lane >> 4; const bf16* KT = dir ? KTB : KTF;
    f32x4 acc[5];
#pragma unroll
    for (int m = 0; m < 5; ++m) acc[m] = (f32x4){0.f, 0.f, 0.f, 0.f};
#pragma unroll
    for (int ks = 0; ks < 4; ++ks) { const bf16x8 b = *(const bf16x8*)(KT + (16 * nq + fr) * LD + ks * 32 + 8 * fq);
#pragma unroll
        for (int m = 0; m < 5; ++m) { const bf16x8 a = *(const bf16x8*)(VT + (16 * m + fr) * LD + ks * 32 + 8 * fq); acc[m] = MFMA16(a, b, acc[m]); } }
    const size_t sidx = (size_t)(c * 4 + h) * 2 + dir; float* co = ((float*)(C.a->ws + WS_CLOC)) + sidx * 4096;
#pragma unroll
    for (int m = 0; m < 4; ++m)
#pragma unroll
        for (int j = 0; j < 4; ++j) co[(16 * m + 4 * fq + j) * 64 + 16 * nq + fr] = acc[m][j];
    if (fq == 0) ((float*)(C.a->ws + WS_NLOC))[sidx * 64 + 16 * nq + fr] = acc[4][0];
    if (C.tid < 2) { const size_t si = (size_t)(c * 4 + h) * 2 + C.tid; const float bl = C.tid ? bB[0] : bF[127], gm = C.tid ? pB[0] : pF[127];
        ((float*)(C.a->ws + WS_SCAL))[si] = bl + gm; ((float*)(C.a->ws + (WS_SCAL + 1040 * 4)))[si] = bl; }
}
__device__ __forceinline__ void phase_C(Ctx& C, int l) {
    unsigned* qhead = (unsigned*)(C.a->ws + WS_CTL + 49152) + 64 * l;
    volatile unsigned* bc = (volatile unsigned*)(C.lds + (LDS_BYTES - 64));
    for (;;) {
        if (C.tid == 0) bc[0] = __hip_atomic_fetch_add(qhead, 1u, __ATOMIC_RELAXED, __HIP_MEMORY_SCOPE_AGENT);
        BLOCK_SYNC();
        const int it = (int)bc[0];
        BLOCK_SYNC();
        if (it >= NCHUNK * 6) break;
        if (it < NCHUNK) { if (l == 0 || it >= 2) item_cmlp(C, l, it); }
        else if (it < 2 * NCHUNK) item_conv_prep(C, l, it - NCHUNK);
        else { const int q = it - 2 * NCHUNK; item_mlstate(C, l, q >> 2, q & 3); }
        BLOCK_SYNC();
    }
}

__device__ __forceinline__ int chain_chunk(int dir, int i) { return dir == 0 ? i : (i == 0 ? 1 : (i == 1 ? 0 : NCHUNK + 1 - i)); }
__device__ __forceinline__ void seg_scan(const Ctx& C, float* basep, size_t cstride, bool valid, int h, int dir, int seg, int el, const float* dold, const float* dloc, float* segA, float* segB) {
    const int s0 = (seg < 2) ? seg * 33 : 66 + (seg - 2) * 32, slen = (seg < 2) ? 33 : 32;
    float L[33];
#pragma unroll
    for (int u = 0; u < 33; ++u) { L[u] = 0.f; if (valid && u < slen) { const int c = chain_chunk(dir, s0 + u); L[u] = basep[((size_t)(c * 4 + h) * 2 + dir) * cstride + el]; } }
    float st = 0.f, a = 1.f;
#pragma unroll
    for (int u = 0; u < 33; ++u) { if (u < slen) { const float lv = L[u]; L[u] = st; st = dold[s0 + u] * st + dloc[s0 + u] * lv; a *= dold[s0 + u]; } }
    segA[seg * 128 + el] = a; segB[seg * 128 + el] = st;
    BLOCK_SYNC();
    float s = 0.f;
    for (int j = 0; j < seg; ++j) s = segA[j * 128 + el] * s + segB[j * 128 + el];
    a = 1.f;
#pragma unroll
    for (int u = 0; u < 33; ++u) { if (valid && u < slen) { const int c = chain_chunk(dir, s0 + u); basep[((size_t)(c * 4 + h) * 2 + dir) * cstride + el] = L[u] + a * s; a *= dold[s0 + u]; } }
    BLOCK_SYNC();
}
__device__ __forceinline__ void phase_D(Ctx& C) {
    float* fv = (float*)C.lds; float *bl = fv, *ml = fv + 136, *mp = fv + 272, *dold = fv + 408, *dloc = fv + 544, *segA = fv + 680, *segB = fv + 680 + 512;
    for (int it = C.bid; it < 8 * 32; it += C.G) {
        const int chain = it >> 5, eb = it & 31, h = chain >> 1, dir = chain & 1;
        if (C.tid < NCHUNK) { const int c = chain_chunk(dir, C.tid); const size_t si = (size_t)(c * 4 + h) * 2 + dir; bl[C.tid] = ((float*)(C.a->ws + (WS_SCAL + 1040 * 4)))[si]; ml[C.tid] = ((float*)(C.a->ws + WS_SCAL))[si]; }
        BLOCK_SYNC();
        if (C.wave == 0) {
            const float b0 = bl[C.lane], b1 = bl[64 + C.lane], b2 = bl[128 + (C.lane & 1)], m0 = ml[C.lane], m1 = ml[64 + C.lane], m2 = ml[128 + (C.lane & 1)];
            float m = 0.f, r0 = 0.f, r1 = 0.f, r2 = 0.f;
#pragma unroll 2
            for (int i = 0; i < 64; ++i) { r0 = (C.lane == i) ? m : r0; m = fmaxf(m + __int_as_float(__builtin_amdgcn_readlane(__float_as_int(b0), i)), __int_as_float(__builtin_amdgcn_readlane(__float_as_int(m0), i))); }
#pragma unroll 2
            for (int i = 0; i < 64; ++i) { r1 = (C.lane == i) ? m : r1; m = fmaxf(m + __int_as_float(__builtin_amdgcn_readlane(__float_as_int(b1), i)), __int_as_float(__builtin_amdgcn_readlane(__float_as_int(m1), i))); }
#pragma unroll
            for (int i = 0; i < 2; ++i) { r2 = (C.lane == i) ? m : r2; m = fmaxf(m + __int_as_float(__builtin_amdgcn_readlane(__float_as_int(b2), i)), __int_as_float(__builtin_amdgcn_readlane(__float_as_int(m2), i))); }
            mp[C.lane] = r0; mp[64 + C.lane] = r1; if (C.lane < 2) mp[128 + C.lane] = r2; if (C.lane == 2) mp[130] = m;
        }
        BLOCK_SYNC();
        if (C.tid < NCHUNK) { const int i = C.tid; dold[i] = __expf(bl[i] + mp[i] - mp[i + 1]); dloc[i] = __expf(ml[i] - mp[i + 1]);
            if (eb == 0) { const int c = chain_chunk(dir, i); ((float*)(C.a->ws + (WS_SCAL + 2080 * 4)))[(size_t)(c * 4 + h) * 2 + dir] = mp[i]; } }
        BLOCK_SYNC();
        const int seg = C.wave >> 1, el = (C.wave & 1) * 64 + C.lane;
        seg_scan(C, ((float*)(C.a->ws + WS_CLOC)) + eb * 128, 4096, true, h, dir, seg, el, dold, dloc, segA, segB);
        if (eb == 31) seg_scan(C, ((float*)(C.a->ws + WS_NLOC)), 64, el < 64, h, dir, seg, el, dold, dloc, segA, segB);
    }
}
__device__ __forceinline__ void item_mlout(const Ctx& C0, int l, int c, int h) {
    Ctx C = C0; { int t_ = C.tid; asm volatile("" : "+v"(t_)); C.tid = t_; C.lane = t_ & 63; }
    constexpr int LQ = 72, LA = 264;
    bf16* QS = (bf16*)C.lds;
    bf16* KS = QS + 128 * LQ;
    bf16* A2 = KS + 144 * LQ;
    bf16* B2T = A2 + 128 * LA;
    float* fv = (float*)(B2T + 64 * LA);
    float *bF = fv, *gF = fv + 128, *pF = fv + 256, *bB = fv + 384, *gB = fv + 512, *pB = fv + 640, *wiF = fv + 768, *wiB = fv + 896, *cF = fv + 1024, *cB = fv + 1152;
    float *rowF = pF, *rowB = pB, *emF = bF, *emB = bB;
    static_assert((128 * LQ + 144 * LQ + 128 * LA + 64 * LA) * 2 + 1280 * 4 <= LDS_BYTES - 64, "mlout LDS map");
    const int rbase = c * 128; const size_t siF = (size_t)(c * 4 + h) * 2, siB = siF + 1;
    const bf16* Z = (const bf16*)(C.a->ws + WS_Z);
    const int q4 = C.tid & 31, dg = (C.tid >> 5) & 7;
    v4u xv[4];
    if (C.tid < 256) {
#pragma unroll
        for (int j = 0; j < 4; ++j) xv[j] = *(const v4u*)(Z + (size_t)(rbase + 4 * q4 + j) * NZ + ZC_MV + h * 64 + dg * 8); }
    if (C.wave == 0) gate_scan(C, l, c, h, 0, bF, gF, pF);
    if (C.wave == 1) gate_scan(C, l, c, h, 1, bB, gB, pB);
#pragma unroll
    for (int it = 0; it < 2; ++it) { const int idx = it * NTHR + C.tid, t = idx >> 3, ch = (idx & 7) * 8; const bf16* z = Z + (size_t)(rbase + t) * NZ + h * 64 + ch;
        *(v4u*)(QS + t * LQ + ch) = *(const v4u*)(z + ZC_MQ);
        const v4u kk = *(const v4u*)(z + ZC_MK); v4u ko;
#pragma unroll
        for (int q = 0; q < 4; ++q) ko[q] = pk2(bf_lo(kk[q]) * 0.125f, bf_hi(kk[q]) * 0.125f);
        *(v4u*)(KS + t * LQ + ch) = ko; }
#pragma unroll
    for (int it = 0; it < 4; ++it) { const int idx = (it * NTHR + C.tid) * 4, dir = idx >> 12, e = idx & 4095, v = e >> 6, k = e & 63;
        const f32x4 cv = *(const f32x4*)(((float*)(C.a->ws + WS_CLOC)) + (siF + dir) * 4096 + e); v2u o; o.x = pk2(cv[0], cv[1]); o.y = pk2(cv[2], cv[3]); *(v2u*)(B2T + v * LA + 128 + dir * 64 + k) = o; }
    if (C.tid < 128) KS[(128 + (C.tid >> 6)) * LQ + (C.tid & 63)] = f2bf(((float*)(C.a->ws + WS_NLOC))[siF * 64 + C.tid]);
    for (int i = C.tid; i < 14 * LQ; i += NTHR) KS[130 * LQ + i] = (bf16)0;
    if (C.tid < 256) { const float one[4] = {1.f, 1.f, 1.f, 1.f};
#pragma unroll
        for (int e = 0; e < 8; ++e) *(v2u*)(B2T + (dg * 8 + e) * LA + 4 * q4) = quad_pack(xv, e, one); }
    const float mpF = ((float*)(C.a->ws + (WS_SCAL + 2080 * 4)))[siF], mpB = ((float*)(C.a->ws + (WS_SCAL + 2080 * 4)))[siB];
    BLOCK_SYNC();
    if (C.tid < 128) { const int t = C.tid; const float mx = fmaxf(mpF, pF[t]), bb = bF[t]; rowF[t] = -mx * LOG2E; wiF[t] = ex2((mpF - mx) * LOG2E); emF[t] = ex2(-(bb + mx) * LOG2E); gF[t] *= LOG2E; }
    else if (C.tid < 256) { const int t = C.tid - 128; const float mx = fmaxf(mpB, pB[t]), bb = bB[t]; rowB[t] = -mx * LOG2E; wiB[t] = ex2((mpB - mx) * LOG2E); emB[t] = ex2(-(bb + mx) * LOG2E); gB[t] *= LOG2E; }
    BLOCK_SYNC();
    const int w = C.wave, t0 = w * 16, fr = C.lane & 15, fq = C.lane >> 4;
    {
        f32x4 S[9];
#pragma unroll
        for (int n = 0; n < 9; ++n) S[n] = (f32x4){0.f, 0.f, 0.f, 0.f};
#pragma unroll
        for (int ks = 0; ks < 2; ++ks) { const bf16x8 a = *(const bf16x8*)(QS + (t0 + fr) * LQ + ks * 32 + 8 * fq);
#pragma unroll
            for (int n = 0; n < 9; ++n) { const bf16x8 b = *(const bf16x8*)(KS + (16 * n + fr) * LQ + ks * 32 + 8 * fq); S[n] = MFMA16(a, b, S[n]); } }
#pragma unroll
        for (int j = 0; j < 4; ++j) { const int t = t0 + 4 * fq + j; const float rF_ = rowF[t], rB_ = rowB[t];
            const float nqF = __shfl(S[8][j], (C.lane & 48)), nqB = __shfl(S[8][j], (C.lane & 48) + 1);
            float pf[8], pb[8]; float sF = 0.f, sB = 0.f;
#pragma unroll
            for (int n = 0; n < 8; ++n) { const int s = 16 * n + fr; const float sv = S[n][j]; pf[n] = 0.f; pb[n] = 0.f;
                if (n <= w) { const float e = sv * ex2(rF_ + gF[s]); pf[n] = (n < w || s <= t) ? e : 0.f; }
                if (n >= w) { const float e = sv * ex2(rB_ + gB[s]); pb[n] = (n > w || s >= t) ? e : 0.f; }
                sF += pf[n]; sB += pb[n]; }
#pragma unroll
            for (int o = 0; o < 1; ++o) { sF += dppf<DPP_X1>(sF); sB += dppf<DPP_X1>(sB); sF += dppf<DPP_X2>(sF); sB += dppf<DPP_X2>(sB); sF += dppf<DPP_HMIR>(sF); sB += dppf<DPP_HMIR>(sB); sF += dppf<DPP_MIR>(sF); sB += dppf<DPP_MIR>(sB); }
            const float wf = wiF[t], wb = wiB[t];
            const float denF = sF + wf * nqF, denB = sB + wb * nqB;
            const float rf = 1.0f / fmaxf(fabsf(denF), emF[t]), rb = 1.0f / fmaxf(fabsf(denB), emB[t]);
#pragma unroll
            for (int n = 0; n < 8; ++n) A2[t * LA + 16 * n + fr] = f2bf(pf[n] * rf + pb[n] * rb);
            if (fr == 0) { cF[t] = wf * rf; cB[t] = wb * rb; }
        }
    }
    BLOCK_SYNC();
#pragma unroll
    for (int it = 0; it < 2; ++it) { const int idx = it * NTHR + C.tid, t = idx >> 3, ch = (idx & 7) * 8; const v4u qq = *(const v4u*)(QS + t * LQ + ch); const float sf = cF[t], sb = cB[t]; v4u of, ob;
#pragma unroll
        for (int q = 0; q < 4; ++q) { const float a = bf_lo(qq[q]), b = bf_hi(qq[q]); of[q] = pk2(a * sf, b * sf); ob[q] = pk2(a * sb, b * sb); }
        *(v4u*)(A2 + t * LA + 128 + ch) = of; *(v4u*)(A2 + t * LA + 192 + ch) = ob; }
    BLOCK_SYNC();
    f32x4 acc[4];
#pragma unroll
    for (int n = 0; n < 4; ++n) acc[n] = (f32x4){0.f, 0.f, 0.f, 0.f};
#pragma unroll
    for (int ks = 0; ks < 8; ++ks) { const bf16x8 a = *(const bf16x8*)(A2 + (t0 + fr) * LA + ks * 32 + 8 * fq);
#pragma unroll
        for (int n = 0; n < 4; ++n) { const bf16x8 b = *(const bf16x8*)(B2T + (16 * n + fr) * LA + ks * 32 + 8 * fq); acc[n] = MFMA16(a, b, acc[n]); } }
    const float* ng = C.a->ml_norm_g + l * 256 + h * 64;
#pragma unroll
    for (int j = 0; j < 4; ++j) { const int t = t0 + 4 * fq + j, r = rbase + t; float ss = 0.f;
#pragma unroll
        for (int n = 0; n < 4; ++n) ss += acc[n][j] * acc[n][j];
#pragma unroll
        for (int o = 0; o < 1; ++o) { ss += dppf<DPP_X1>(ss); ss += dppf<DPP_X2>(ss); ss += dppf<DPP_HMIR>(ss); ss += dppf<DPP_MIR>(ss); }
        const float rstd = rsqrtf(ss * (1.0f / 64.0f) + EPSN);
#pragma unroll
        for (int n = 0; n < 4; ++n) { const int d = 16 * n + fr; const float po = bf2f(Z[(size_t)r * NZ + ZC_MO + h * 64 + d]);
            ((bf16*)(C.a->ws + WS_MIX))[(size_t)r * DM + 768 + h * 64 + d] = f2bf(acc[n][j] * rstd * ng[d] / (1.0f + __expf(-po))); } }
}

template <int NB> __device__ __forceinline__ void topk_pick(const Ctx& C, unsigned* hist, unsigned* wtot, unsigned* sh, unsigned kk, unsigned prefix_hi, int shift) {
    constexpr int NBT = NB / NTHR;
    unsigned h[NBT], p[NBT]; unsigned run = 0u;
#pragma unroll
    for (int q = 0; q < NBT; ++q) { h[q] = hist[C.tid * NBT + q]; run += h[q]; p[q] = run; }
    unsigned inc = run;
#pragma unroll
    for (int o = 1; o < 64; o <<= 1) { const unsigned a = __shfl_up(inc, o); if (C.lane >= o) inc += a; }
    if (C.lane == 63) wtot[C.wave] = inc;
    BLOCK_SYNC();
    unsigned off = inc - run, N = 0u;
#pragma unroll
    for (int w = 0; w < NWAVES; ++w) { const unsigned x = wtot[w]; N += x; if (w < C.wave) off += x; }
#pragma unroll
    for (int q = 0; q < NBT; ++q) { const unsigned pin = off + p[q], sex = N - pin, sin = sex + h[q];
        if (sin >= kk && sex < kk) { sh[0] = prefix_hi | ((unsigned)(C.tid * NBT + q) << shift); sh[1] = kk - sex; } }
    BLOCK_SYNC();
}
__device__ __forceinline__ void item_topk(const Ctx& C0, int e, int set) {
    Ctx C = C0; { int t_ = C.tid; asm volatile("" : "+v"(t_)); C.tid = t_; C.lane = t_ & 63; }
    unsigned* lv = (unsigned*)C.lds;
    unsigned* hist = lv + 33 * 512;
    unsigned* sh = hist + 2048;
    unsigned* wtot = sh + 8;
    const int n = set ? CTXL : SEQL, cap = set ? CAPC : CAPL, rowoff = set ? 0 : CTXL;
    const float* aff = ((float*)(C.a->ws + WS_AFF)) + (size_t)e * R + rowoff;
    const int base = C.tid * 32, lbase = C.tid * 33;
#pragma unroll
    for (int q = 0; q < 8; ++q) { const int k4 = (q * NTHR + C.tid) * 4; v4u w = {0u, 0u, 0u, 0u}; if (k4 < n) w = *(const v4u*)(aff + k4);
        unsigned* p = lv + k4 + (k4 >> 5); p[0] = w.x; p[1] = w.y; p[2] = w.z; p[3] = w.w; }
    BLOCK_SYNC();
    unsigned prefix, kk = (unsigned)cap;
    for (int i = C.tid; i < 2048; i += NTHR) hist[i] = 0u;
    BLOCK_SYNC();
#pragma unroll 4
    for (int i = 0; i < 32; ++i) { const unsigned v = lv[lbase + i]; atomicAdd(&hist[v >> 19], 1u); }
    BLOCK_SYNC();
    topk_pick<2048>(C, hist, wtot, sh, kk, 0u, 19);
    prefix = sh[0]; kk = sh[1];
    BLOCK_SYNC();
    for (int i = C.tid; i < 1024; i += NTHR) hist[i] = 0u;
    BLOCK_SYNC();
#pragma unroll 4
    for (int i = 0; i < 32; ++i) { const unsigned v = lv[lbase + i]; if ((v >> 19) == (prefix >> 19)) atomicAdd(&hist[(v >> 9) & 1023u], 1u); }
    BLOCK_SYNC();
    topk_pick<1024>(C, hist, wtot, sh, kk, prefix, 9);
    prefix = sh[0]; kk = sh[1];
    BLOCK_SYNC();
    if (C.tid < 512) hist[C.tid] = 0u;
    BLOCK_SYNC();
#pragma unroll 4
    for (int i = 0; i < 32; ++i) { const unsigned v = lv[lbase + i]; if ((v >> 9) == (prefix >> 9)) atomicAdd(&hist[v & 511u], 1u); }
    BLOCK_SYNC();
    topk_pick<512>(C, hist, wtot, sh, kk, prefix, 0);
    prefix = sh[0]; kk = sh[1];
    BLOCK_SYNC();
    const unsigned T = prefix, need_eq = kk;
    unsigned cgt = 0u, ceq = 0u;
#pragma unroll 4
    for (int i = 0; i < 32; ++i) { const unsigned v = lv[lbase + i]; cgt += (v > T) ? 1u : 0u; ceq += (v == T) ? 1u : 0u; }
    unsigned igt = cgt, ieq = ceq;
#pragma unroll
    for (int o = 1; o < 64; o <<= 1) { const unsigned a = __shfl_up(igt, o), b = __shfl_up(ieq, o); if (C.lane >= o) { igt += a; ieq += b; } }
    if (C.lane == 63) { wtot[C.wave] = igt; wtot[8 + C.wave] = ieq; }
    BLOCK_SYNC();
    unsigned ogt = igt - cgt, oeq = ieq - ceq;
    for (int w = 0; w < C.wave; ++w) { ogt += wtot[w]; oeq += wtot[8 + w]; }
    const int slot0 = set ? CAPL : 0;
    int* IDXp = ((int*)(C.a->ws + WS_IDX)) + e * ESLOTS; float* GATEp = ((float*)(C.a->ws + WS_GATE)) + e * ESLOTS; int* SLOTp = ((int*)(C.a->ws + WS_SLOT)) + (size_t)e * R + rowoff;
#pragma unroll 2
    for (int i = 0; i < 32; ++i) {
        const int tok = base + i; const unsigned v = lv[lbase + i];
        const bool gt = v > T, eq = v == T; const bool sel = gt || (eq && oeq < need_eq);
        int slot = -1;
        if (sel && tok < n) { slot = slot0 + (int)(ogt + (oeq < need_eq ? oeq : need_eq)); IDXp[slot] = rowoff + tok; GATEp[slot] = __uint_as_float(v); }
        lv[lbase + i] = (unsigned)slot;
        ogt += gt ? 1u : 0u; oeq += eq ? 1u : 0u;
    }
    BLOCK_SYNC();
    for (int k = C.tid; k < n; k += NTHR) SLOTp[k] = (int)lv[k + (k >> 5)];
    if (set) { for (int s = CAPL + CAPC + C.tid; s < ESLOTS; s += NTHR) { IDXp[s] = 0; GATEp[s] = 0.f; } }
    BLOCK_SYNC();
}
__device__ __forceinline__ void phase_H(Ctx& C, int l) {
    const int nitems = (l == 0) ? 32 : 16;
    for (int it = C.bid; it < nitems; it += C.G) item_topk(C, it & 15, it >> 4);
    convert_experts_H(C, l);
}
__device__ __forceinline__ void skinny_mma(const bf16* a0, const bf16* a1, const bf16* b0, const bf16* b1, int K, int fq, f32x4 (&acc)[2][2]) {
#pragma unroll 8
    for (int k0 = 0; k0 < K; k0 += 32) {
        const bf16x8 fa0 = *(const bf16x8*)(a0 + k0 + 8 * fq), fa1 = *(const bf16x8*)(a1 + k0 + 8 * fq), fb0 = *(const bf16x8*)(b0 + k0 + 8 * fq), fb1 = *(const bf16x8*)(b1 + k0 + 8 * fq);
        acc[0][0] = MFMA16(fa0, fb0, acc[0][0]); acc[0][1] = MFMA16(fa0, fb1, acc[0][1]); acc[1][0] = MFMA16(fa1, fb0, acc[1][0]); acc[1][1] = MFMA16(fa1, fb1, acc[1][1]);
    }
}
#define SK_ZERO(acc) do { _Pragma("unroll") for (int a_ = 0; a_ < 2; ++a_) _Pragma("unroll") for (int b_ = 0; b_ < 2; ++b_) acc[a_][b_] = (f32x4){0.f, 0.f, 0.f, 0.f}; } while (0)
template <int NS> __device__ __forceinline__ void sk_reduce(const Ctx& C, f32x4 (&acc)[2][2]) {
    float* red = (float*)C.lds;
#pragma unroll
    for (int a = 0; a < 2; ++a)
#pragma unroll
        for (int b = 0; b < 2; ++b)
#pragma unroll
            for (int j = 0; j < 4; ++j) red[(C.wave * 16 + (a * 2 + b) * 4 + j) * 64 + C.lane] = acc[a][b][j];
    BLOCK_SYNC();
    if ((C.wave % NS) == 0) {
#pragma unroll
        for (int a = 0; a < 2; ++a)
#pragma unroll
            for (int b = 0; b < 2; ++b)
#pragma unroll
                for (int j = 0; j < 4; ++j) { float s = acc[a][b][j];
#pragma unroll
                    for (int w = 1; w < NS; ++w) s += red[((C.wave + w) * 16 + (a * 2 + b) * 4 + j) * 64 + C.lane];
                    acc[a][b][j] = s; } }
    BLOCK_SYNC();
}
__device__ __forceinline__ void skinny_F0(const Ctx& C) {
    const int fr = C.lane & 15, fq = C.lane >> 4;
    for (int it = C.bid; it < 8 * 32; it += C.G) {
        const int rb = it >> 5, cb = it & 31, kb = C.wave * 128;
        const bf16* A = ((const bf16*)(C.a->ws + WS_MIX)) + (size_t)(rb * 32 + fr) * DM + kb; const bf16* B = ((const bf16*)(C.a->ws + WS_WOUT)) + (size_t)(cb * 32 + fr) * DM + kb;
        f32x4 acc[2][2]; SK_ZERO(acc);
        skinny_mma(A, A + 16 * DM, B, B + 16 * DM, 128, fq, acc);
        sk_reduce<8>(C, acc);
        if (C.wave == 0) {
            const float* g1 = ((const float*)(C.a->ws + WS_MOD)) + (size_t)1 * 6144 + 2 * 1024;
#pragma unroll
            for (int mi = 0; mi < 2; ++mi)
#pragma unroll
                for (int ni = 0; ni < 2; ++ni)
#pragma unroll
                    for (int j = 0; j < 4; ++j) { const int r = rb * 32 + mi * 16 + 4 * fq + j, c = cb * 32 + ni * 16 + fr;
                        ((float*)(C.a->ws + WS_XW))[(size_t)r * DM + c] = C.a->ctx[(size_t)r * DM + c] + g1[c] * acc[mi][ni][j]; }
        }
    }
}
__device__ __forceinline__ void skinny_J0(const Ctx& C) {
    const int fr = C.lane & 15, fq = C.lane >> 4;
    for (int it0 = C.bid * 2; it0 < 16 * 32; it0 += C.G * 2) {
        const int it = it0 + (C.wave >> 2), e = it >> 5, cb = it & 31, kb = (C.wave & 3) * 512;
        const bf16* A = ((const bf16*)(C.a->ws + WS_HID)) + ((size_t)e * ESLOTS + CAPL + fr) * FF + kb; const bf16* B = ((const bf16*)(C.a->ws + WS_W2)) + ((size_t)e * DM + cb * 32 + fr) * FF + kb;
        f32x4 acc[2][2]; SK_ZERO(acc);
        skinny_mma(A, A + 16 * FF, B, B + 16 * FF, 512, fq, acc);
        sk_reduce<4>(C, acc);
        if ((C.wave & 3) == 0) {
#pragma unroll
            for (int mi = 0; mi < 2; ++mi)
#pragma unroll
                for (int j = 0; j < 4; ++j) { const int slot = CAPL + mi * 16 + 4 * fq + j; const float gt = ((const float*)(C.a->ws + WS_GATE))[e * ESLOTS + slot];
#pragma unroll
                    for (int ni = 0; ni < 2; ++ni) ((bf16*)(C.a->ws + WS_Y))[((size_t)e * ESLOTS + slot) * DM + cb * 32 + ni * 16 + fr] = f2bf(acc[mi][ni][j] * gt); }
        }
    }
}
#define LAS __attribute__((address_space(3)))
#define XB_TMO      128
#define XB_XCNT(j)  (256  + 64 * (j))
#define XB_XSUB(j)  (1280 + 64 * (j))
#define XB_XGEN(j)  (2304 + 64 * (j))
#define XB_TOP      3328
#define XB_TOPGEN   3392
#define XCD_BAR_WORDS 3456
#define XB_SPIN_CAP (1u << 18)

__device__ __forceinline__ unsigned xb_ld(unsigned* p)              { return __hip_atomic_load(p, __ATOMIC_RELAXED, __HIP_MEMORY_SCOPE_AGENT); }
__device__ __forceinline__ unsigned xb_add(unsigned* p, unsigned v) { return __hip_atomic_fetch_add(p, v, __ATOMIC_RELAXED, __HIP_MEMORY_SCOPE_AGENT); }
__device__ __forceinline__ unsigned xb_xcc_id() { return (unsigned)__builtin_amdgcn_s_getreg((3 << 11) | 20) & 0xFu; }
#define XB_SPIN(cond, bar) do { unsigned _sp = 0; while (cond) { __builtin_amdgcn_s_sleep(1); \
    if ((++_sp & 255u) == 0u) { if (xb_ld(&(bar)[XB_TMO])) break; if (_sp > XB_SPIN_CAP) { atomicAdd(&(bar)[XB_TMO], 1u); break; } } } } while (0)

struct XcdBarrier {
    unsigned* bar; unsigned x;
    volatile LAS unsigned* st;
};

__device__ __forceinline__ XcdBarrier xcd_barrier_post(unsigned* bar, volatile LAS unsigned* st) {
    XcdBarrier b; b.bar = bar; b.x = xb_xcc_id(); b.st = st;
    if (threadIdx.x == 0) (void)xb_add(&bar[XB_XCNT(b.x)], 1u);
    return b;
}
__device__ __forceinline__ void xcd_barrier_complete(unsigned* bar, unsigned x, unsigned& nloc, unsigned& nx) {
    const unsigned G = gridDim.x * gridDim.y * gridDim.z;
    unsigned sum, cnt, mine, sp = 0u;
    for (;;) {
        sum = 0u; cnt = 0u; mine = 0u;
#pragma unroll
        for (unsigned j = 0; j < 16; ++j) { const unsigned c = xb_ld(&bar[XB_XCNT(j)]); sum += c; cnt += (c > 0u) ? 1u : 0u; mine = (j == x) ? c : mine; }
        if (sum == G) break;
        __builtin_amdgcn_s_sleep(1);
        if ((++sp & 255u) == 0u) { if (xb_ld(&bar[XB_TMO])) break; if (sp > XB_SPIN_CAP) { atomicAdd(&bar[XB_TMO], 1u); break; } }
    }
    nloc = mine > 0u ? mine : 1u; nx = cnt > 0u ? cnt : 1u;
}

__device__ __forceinline__ void xcd_barrier(const XcdBarrier& b) {
    asm volatile("s_waitcnt vmcnt(0)" ::: "memory");
    __syncthreads();
    if (threadIdx.x == 0) {
        unsigned* bar = b.bar;
        __builtin_amdgcn_s_waitcnt(0);
        unsigned nloc = b.st[0], nx = b.st[1];
        if (nloc == 0u) { xcd_barrier_complete(bar, b.x, nloc, nx); b.st[0] = nloc; b.st[1] = nx; }
        const unsigned old = xb_add(&bar[XB_XSUB(b.x)], 1u);
        const unsigned gen = old / nloc;
        if (old + 1u == (gen + 1u) * nloc) {
            __builtin_amdgcn_fence(__ATOMIC_RELEASE, "agent");
            asm volatile("s_waitcnt vmcnt(0)" ::: "memory");
            const unsigned og = xb_add(&bar[XB_TOP], 1u);
            const unsigned tg = og / nx;
            if (og + 1u == (tg + 1u) * nx) xb_add(&bar[XB_TOPGEN], 1u);
            else XB_SPIN(xb_ld(&bar[XB_TOPGEN]) == tg, bar);
            __builtin_amdgcn_fence(__ATOMIC_ACQUIRE, "agent");
            xb_add(&bar[XB_XGEN(b.x)], 1u);
            asm volatile("s_waitcnt vmcnt(0)" ::: "memory");
        } else {
            XB_SPIN(xb_ld(&bar[XB_XGEN(b.x)]) == gen, bar);
            __builtin_amdgcn_fence(__ATOMIC_ACQUIRE, "agent");
            asm volatile("s_waitcnt vmcnt(0)" ::: "memory");
        }
    }
    __syncthreads();
}

#ifndef ATT_STATICM
#define ATT_STATICM true
#endif
__device__ __forceinline__ void phase_E(Ctx& C, int l) {
    const int c0 = (l == 0) ? 0 : 2;
    const bool cv_first = (C.bid & 1) == 0;
    if (cv_first) { convert_experts(C, l); BLOCK_SYNC(); }
#ifndef NO_MLOUT
    for (int k = 0; k * C.G < (NCHUNK - c0) * 4; ++k) { const int it = k * C.G + ((k & 1) ? C.G - 1 - C.bid : C.bid); if (it < (NCHUNK - c0) * 4) { item_mlout(C, l, c0 + it / 4, it % 4); BLOCK_SYNC(); } }
#endif
    if (PROBE_K > 0 && blockIdx.x == 0 && threadIdx.x == 0) ((volatile unsigned long long*)(C.a->ws + WS_CTL + 32768))[40 + l] = __builtin_amdgcn_s_memrealtime();
#ifndef NO_ATTN
    using abf = attn_body::bf16;
    float mref; { float gq = fabsf(C.a->q_norm_g[l * 64 + C.lane]), gk = fabsf(C.a->k_norm_g[l * 64 + C.lane]);
#pragma unroll
        for (int o = 32; o > 0; o >>= 1) { gq = fmaxf(gq, __shfl_xor(gq, o)); gk = fmaxf(gk, __shfl_xor(gk, o)); }
        mref = 64.0f * C2Q * 1.02f * gq * gk; mref = __int_as_float(__builtin_amdgcn_readfirstlane(__float_as_int(mref))); }
    if (ATT_STATICM && mref < 40.0f) {
        for (int u = C.vcu; u < 256; u += C.G) { const int h = u >> 6, qb = u & 63; const size_t qrow = (size_t)CTXL + (size_t)qb * 256;
            attn_body::attn_unit<8, true>((const abf*)(((bf16*)(C.a->ws + WS_QB)) + qrow * 256 + h * 64), (const abf*)(((bf16*)(C.a->ws + WS_KB)) + (h >> 1) * 64), (const abf*)(((bf16*)(C.a->ws + WS_VB)) + (h >> 1) * 64), (abf*)(((bf16*)(C.a->ws + WS_MIX)) + qrow * DM + 512 + h * 64), R / 64, (char*)C.lds, C.tid, mref); }
        if (l == 0) for (int u = C.bid - 16; u >= 0 && u < 4; u += C.G) { const int h = u;
            attn_body::attn_unit<8, true>((const abf*)(((bf16*)(C.a->ws + WS_QB)) + h * 64), (const abf*)(((bf16*)(C.a->ws + WS_KB)) + (h >> 1) * 64), (const abf*)(((bf16*)(C.a->ws + WS_VB)) + (h >> 1) * 64), (abf*)(((bf16*)(C.a->ws + WS_MIX)) + 512 + h * 64), CTXL / 64, (char*)C.lds, C.tid, mref); }
    } else {
        for (int u = C.vcu; u < 256; u += C.G) { const int h = u >> 6, qb = u & 63; const size_t qrow = (size_t)CTXL + (size_t)qb * 256;
            attn_body::attn_unit<8, false>((const abf*)(((bf16*)(C.a->ws + WS_QB)) + qrow * 256 + h * 64), (const abf*)(((bf16*)(C.a->ws + WS_KB)) + (h >> 1) * 64), (const abf*)(((bf16*)(C.a->ws + WS_VB)) + (h >> 1) * 64), (abf*)(((bf16*)(C.a->ws + WS_MIX)) + qrow * DM + 512 + h * 64), R / 64, (char*)C.lds, C.tid, 0.f); }
        if (l == 0) for (int u = C.bid - 16; u >= 0 && u < 4; u += C.G) { const int h = u;
            attn_body::attn_unit<8, false>((const abf*)(((bf16*)(C.a->ws + WS_QB)) + h * 64), (const abf*)(((bf16*)(C.a->ws + WS_KB)) + (h >> 1) * 64), (const abf*)(((bf16*)(C.a->ws + WS_VB)) + (h >> 1) * 64), (abf*)(((bf16*)(C.a->ws + WS_MIX)) + 512 + h * 64), CTXL / 64, (char*)C.lds, C.tid, 0.f); }
    }
#endif
    if (!cv_first) { BLOCK_SYNC(); convert_experts(C, l); }
}

#ifndef REPEAT_PH
#define REPEAT_PH -1
#endif
#ifndef ONLY_KIND
#define ONLY_KIND -1
#endif
#define KSEL(x) (ONLY_KIND == -1 || ONLY_KIND == (x))
constexpr int N_PHASES = 22;
template <int ph> __device__ __forceinline__ void run_phase(Ctx& C, PG8_LAS unsigned char* ldsg) {
        if constexpr (ph == 0) { if (KSEL(100)) phase_init(C); }
        else if constexpr (ph == 1) { if (KSEL(101)) phase_A0(C); }
        else {
            constexpr int l = (ph - 2) / 10, k = (ph - 2) % 10;
            if constexpr (k == 0) { if (KSEL(0)) {
                pg8::Gemm g{((bf16*)(C.a->ws + WS_H)), ((bf16*)(C.a->ws + WS_WIN)) + (size_t)l * NZ * DM, R, NZ, DM, nullptr}; pg8::StaticOrder S; S.init(R, NZ, C.G, C.bid);
                pg8::EpiBf16 E{((bf16*)(C.a->ws + WS_Z)), NZ};
                pg8::gemm_phase<pg8::EpiBf16, pg8::StaticOrder, true, false>(ldsg, g, S, E, C.tid);
                convert_experts_B(C, l); }
            } else if constexpr (k == 1) { if (KSEL(1)) phase_C(C, l); }
            else if constexpr (k == 2) { if (KSEL(2)) phase_D(C); }
            else if constexpr (k == 3) { if (KSEL(3)) phase_E(C, l); }
            else if constexpr (k == 4) { if (KSEL(4)) {
                const int pm0 = 1; const int rows = R - pm0 * 256;
                pg8::Gemm g{((bf16*)(C.a->ws + WS_MIX)), ((bf16*)(C.a->ws + WS_WOUT)) + (size_t)l * DM * DM, rows, DM, DM, nullptr}; pg8::StaticOrder S; S.init(rows, DM, C.G, C.bid, pm0);
                const float* modL = ((float*)(C.a->ws + WS_MOD)) + (size_t)(l * 2 + 0) * 6144 + 2 * 1024; const float* modC = ((float*)(C.a->ws + WS_MOD)) + (size_t)(l * 2 + 1) * 6144 + 2 * 1024;
                pg8::EpiResid E{(l == 0) ? C.a->ctx : ((float*)(C.a->ws + WS_XW)), (l == 0) ? C.a->x : ((float*)(C.a->ws + WS_XW)) + (size_t)CTXL * DM, ((float*)(C.a->ws + WS_XW)), modC, modL};
                pg8::gemm_phase<pg8::EpiResid, pg8::StaticOrder, true, false>(ldsg, g, S, E, C.tid);
                if (l == 0) skinny_F0(C); }
            } else if constexpr (k == 5) { if (KSEL(5)) phase_G(C, l); }
            else if constexpr (k == 6) { if (KSEL(6)) phase_H(C, l); }
            else if constexpr (k == 7) { if (KSEL(7)) {
                pg8::Gemm g{((bf16*)(C.a->ws + WS_H2)), ((bf16*)(C.a->ws + WS_W13)) + (size_t)l * NEXP * 4096 * DM, NEXP * ESLOTS, NEXP * 4096, DM, ((int*)(C.a->ws + WS_IDX))}; pg8::MoeOrder S; S.init((l == 0) ? 9 : 8, 16, C.G, C.vcu);
                pg8::EpiSwiGLU E{((bf16*)(C.a->ws + WS_HID))};
                pg8::gemm_phase<pg8::EpiSwiGLU, pg8::MoeOrder, true, true>(ldsg, g, S, E, C.tid);
                }
            } else if constexpr (k == 8) { if (KSEL(8)) {
                pg8::Gemm g{((bf16*)(C.a->ws + WS_HID)), ((bf16*)(C.a->ws + WS_W2)) + (size_t)l * NEXP * DM * FF, NEXP * ESLOTS, NEXP * DM, FF, nullptr}; pg8::MoeOrder S; S.init(8, 4, C.G, C.vcu);
                pg8::EpiGateRow E{((bf16*)(C.a->ws + WS_Y)), ((float*)(C.a->ws + WS_GATE))};
                pg8::gemm_phase<pg8::EpiGateRow, pg8::MoeOrder, true, false>(ldsg, g, S, E, C.tid);
                if (l == 0) skinny_J0(C); }
            } else { if (KSEL(9)) phase_K(C, l); }
        }
}
__global__ void __launch_bounds__(NTHR, 2) hybrid_fwd(Args args) {
    extern __shared__ __attribute__((aligned(16))) unsigned char lds[];
    cg::grid_group grid = cg::this_grid();
    Ctx C; C.lds = lds;
    PG8_LAS unsigned char* ldsg = (PG8_LAS unsigned char*)lds;

    const int ph_lo = args.ph_lo, ph_hi = args.ph_hi;
    volatile LAS unsigned* MISC = (volatile LAS unsigned*)((LAS unsigned char*)lds + (LDS_BYTES - 64));
    if (threadIdx.x < 16) MISC[threadIdx.x] = 0u;
    __syncthreads();
    XcdBarrier xbar = xcd_barrier_post((unsigned*)(args.ws + WS_CTL) + 4096, MISC + 8);
    volatile unsigned long long* tstamp = (volatile unsigned long long*)(args.ws + WS_CTL + 32768);
    if (PROBE_K > 0 && blockIdx.x == 0 && threadIdx.x == 0) tstamp[0] = __builtin_amdgcn_s_memrealtime();
#define RUN_PHASE(PH) do { if (ph_lo <= (PH) && (PH) < ph_hi) { constexpr int ph = (PH); \
        { KArgs ka = (KArgs)__builtin_amdgcn_kernarg_segment_ptr(); asm volatile("" : "+s"(ka)); C.a = ka; } \
        { int tid_ = threadIdx.x; asm volatile("" : "+v"(tid_)); C.tid = tid_; C.lane = tid_ & 63; C.wave = __builtin_amdgcn_readfirstlane(tid_ >> 6); } \
        { int g_ = gridDim.x, b_ = blockIdx.x; asm volatile("" : "+s"(g_), "+s"(b_)); C.G = g_; C.bid = b_; C.vcu = (g_ % 8 == 0) ? (b_ % 8) * (g_ / 8) + b_ / 8 : b_; } \
        run_phase<ph>(C, ldsg); if ((PH) == REPEAT_PH) { xcd_barrier(xbar); run_phase<ph>(C, ldsg); } if ((PH) + 1 < ph_hi) { if (ph_hi > 1000) grid.sync(); else xcd_barrier(xbar); }     \
        if (PROBE_K > 0 && blockIdx.x == 0 && threadIdx.x == 0) tstamp[(PH) + 1] = __builtin_amdgcn_s_memrealtime(); } } while (0)
    RUN_PHASE(0); RUN_PHASE(1); RUN_PHASE(2); RUN_PHASE(3); RUN_PHASE(4); RUN_PHASE(5); RUN_PHASE(6); RUN_PHASE(7); RUN_PHASE(8); RUN_PHASE(9); RUN_PHASE(10); RUN_PHASE(11);
    RUN_PHASE(12); RUN_PHASE(13); RUN_PHASE(14); RUN_PHASE(15); RUN_PHASE(16); RUN_PHASE(17); RUN_PHASE(18); RUN_PHASE(19); RUN_PHASE(20); RUN_PHASE(21);
#undef RUN_PHASE
    if (PROBE_K > 0 && blockIdx.x == 0 && threadIdx.x == 0) {
        const unsigned long long dt = tstamp[PROBE_B] - tstamp[PROBE_A], t0 = __builtin_amdgcn_s_memrealtime();
        while (__builtin_amdgcn_s_memrealtime() - t0 < (unsigned long long)PROBE_K * dt) __builtin_amdgcn_s_sleep(8);
    }
}

extern "C" void kernel_launch(void* const* d_in, const int* in_sizes, int n_in, void* d_out, int out_size, void* d_ws, size_t ws_size, hipStream_t stream) {
    static int grid = 0;
    if (grid == 0) {
        if (n_in != 24 || ws_size < WS_END) { fprintf(stderr, "kernel_launch: unexpected inputs (%d) or workspace (%zu < %zu)\n", n_in, ws_size, (size_t)WS_END); grid = -1; return; }
        int dev = 0, cus = 0, per_cu = 0;
        hipGetDevice(&dev); hipDeviceGetAttribute(&cus, hipDeviceAttributeMultiprocessorCount, dev);
        hipFuncSetAttribute((const void*)hybrid_fwd, hipFuncAttributeMaxDynamicSharedMemorySize, LDS_BYTES);
        hipOccupancyMaxActiveBlocksPerMultiprocessor(&per_cu, (const void*)hybrid_fwd, NTHR, LDS_BYTES);
        if (per_cu < 1) { fprintf(stderr, "kernel_launch: occupancy query says %d blocks per CU\n", per_cu); per_cu = 1; }
        (void)hipGetLastError();
        grid = cus;
        if (grid > 256) grid = 256;
    }
    if (grid < 0) return;
    hipMemsetAsync((char*)d_ws + WS_CTL, 0, 64 * 1024, stream);
    Args a{};
    const float** ap = (const float**)&a;
    for (int i = 0; i < 24; ++i) ap[i] = (const float*)d_in[i];
    a.out = (float*)d_out; a.ws = (unsigned char*)d_ws;
#ifndef MK_PER_PHASE
    a.ph_lo = 0; a.ph_hi = N_PHASES;
    void* kargs[] = {&a};
    hipError_t e = hipLaunchCooperativeKernel((const void*)hybrid_fwd, dim3(grid), dim3(NTHR), kargs, LDS_BYTES, stream);
    if (e != hipSuccess) fprintf(stderr, "cooperative launch failed: %s (grid %d)\n", hipGetErrorString(e), grid);
#else
    for (int p = 0; p < N_PHASES; ++p) { a.ph_lo = p; a.ph_hi = p + 1; void* kargs[] = {&a};
        hipError_t e = hipLaunchCooperativeKernel((const void*)hybrid_fwd, dim3(grid), dim3(NTHR), kargs, LDS_BYTES, stream);
        if (e != hipSuccess) { fprintf(stderr, "launch %d failed: %s\n", p, hipGetErrorString(e)); break; } }
#endif
}
```

```cpp
#include <hip/hip_runtime.h>
#include <hip/hip_bf16.h>
#include <hip/hip_cooperative_groups.h>
#include <cstdio>
#include <cstdint>
#include <cmath>
namespace cg = cooperative_groups;
namespace pg8 {
#define PG8_LAS __attribute__((address_space(3)))
typedef unsigned short bf16_t;
typedef short bf16x8 __attribute__((ext_vector_type(8)));
typedef float f32x4 __attribute__((ext_vector_type(4)));
typedef unsigned u32x4 __attribute__((ext_vector_type(4)));
typedef unsigned u32x2 __attribute__((ext_vector_type(2)));
typedef int i32x4 __attribute__((ext_vector_type(4)));
typedef int i32x8 __attribute__((ext_vector_type(8)));
__device__ __forceinline__ i32x8 cat8(bf16x8 a, bf16x8 b) { const i32x4 x = __builtin_bit_cast(i32x4, a), y = __builtin_bit_cast(i32x4, b); return __builtin_shufflevector(x, y, 0, 1, 2, 3, 4, 5, 6, 7); }
__device__ __forceinline__ unsigned pk4_fp8(float a, float b, float c, float d) { unsigned w = __builtin_amdgcn_cvt_pk_fp8_f32(a, b, 0u, false); return __builtin_amdgcn_cvt_pk_fp8_f32(c, d, w, true); }
constexpr int BM = 256, BK = 64, HALF = 128, HTB = HALF * BK * 2, STAGE_BYTES = 8 * HTB, NXCD = 8, WGM = 8;

__host__ __device__ __forceinline__ int lds_byte(int r, int c) { const int st = (r >> 4) * 2 + (c >> 5), rr = r & 15, cc = c & 31, ob = rr * 64 + cc * 2; return st * 1024 + (ob ^ (((ob >> 9) & 1) << 5)); }
__host__ __device__ __forceinline__ void stage_rc(int b, int& R, int& C) { const int st = b / 1024, sb = b % 1024, swz = sb ^ (((sb >> 9) & 1) << 5); R = (st >> 1) * 16 + swz / 64; C = (st & 1) * 32 + (swz % 64) / 2; }
__host__ __device__ __forceinline__ int perm32(int rho) { const int n = rho >> 4, i = rho & 15; return 8 * (i >> 2) + 4 * n + (i & 3); }

struct Unit { int pm, pn; };
struct Gemm { const bf16_t* A; const bf16_t* Bt; int M, N, K; const int* gidx; };

struct StaticOrder {
    int nM, nN, nwg, G, c, pm0;
    __host__ __device__ void init(int M, int N, int G_, int c_, int pm0_ = 0) { nM = M / BM; nN = N / BM; nwg = nM * nN; G = G_; c = c_; pm0 = pm0_; }
    __host__ __device__ bool next(int i, Unit& u) const {
        const long L = (long)i * G + c; if (L >= nwg) return false;
        int wgid = (int)L; { const int q = nwg / NXCD, r = nwg % NXCD, xcd = wgid % NXCD, off = wgid / NXCD; wgid = (xcd < r ? xcd * (q + 1) : r * (q + 1) + (xcd - r) * q) + off; }
        const int nig = WGM * nN, gid = wgid / nig, fm = gid * WGM, gsz = (nM - fm) < WGM ? (nM - fm) : WGM;
        u.pm = pm0 + fm + ((wgid % nig) % gsz); u.pn = (wgid % nig) / gsz; return true;
    }
};
struct MoeOrder {
    int npm, npn, total, G, c;
    __host__ __device__ void init(int npm_, int npn_, int G_, int c_) { npm = npm_; npn = npn_; total = 16 * npm_ * npn_; G = G_; c = c_; }
    __host__ __device__ bool next(int i, Unit& u) const {
        const long L = (long)i * G + c; if (L >= total) return false;
        const int per = npm * npn, e = (int)L / per, rem = (int)L % per, pn = rem / npm, pm = rem % npm;
        u.pm = e * 9 + pm; u.pn = e * npn + pn; return true;
    }
};

__device__ __forceinline__ unsigned cvt_pk_bf16(float lo, float hi) { unsigned r; asm volatile("v_cvt_pk_bf16_f32 %0, %1, %2" : "=v"(r) : "v"(lo), "v"(hi)); return r; }

struct EpiBf16 {
    static constexpr bool PERM = true;
    bf16_t* O; int ldc;
    __device__ __forceinline__ void operator()(const f32x4 (&acc)[2][2][4][2], const Unit& u, int wr, int wc, int fr, int fq) const {
        const int row0 = u.pm * BM + wr * 64 + fr; const int col0 = u.pn * BM + wc * 32 + 8 * fq;
#pragma unroll
        for (int ai = 0; ai < 2; ++ai)
#pragma unroll
            for (int m = 0; m < 4; ++m) { bf16_t* rowp = O + (size_t)(row0 + ai * HALF + m * 16) * ldc + col0;
#pragma unroll
                for (int bj = 0; bj < 2; ++bj) { const f32x4 v0 = acc[ai][bj][m][0], v1 = acc[ai][bj][m][1];
                    u32x4 w; w.x = cvt_pk_bf16(v0[0], v0[1]); w.y = cvt_pk_bf16(v0[2], v0[3]); w.z = cvt_pk_bf16(v1[0], v1[1]); w.w = cvt_pk_bf16(v1[2], v1[3]);
                    *(u32x4*)(rowp + bj * HALF) = w; } }
    }
};
struct EpiResid {
    static constexpr bool PERM = false;
    const float* baseC; const float* baseL; float* out; const float* gateC; const float* gateL;
    __device__ __forceinline__ void operator()(const f32x4 (&acc)[2][2][4][2], const Unit& u, int wr, int wc, int fr, int fq) const {
        const int rl = wr * 64 + fr, col0 = u.pn * BM + wc * 32 + 4 * fq;
        const float* bp = (u.pm == 0) ? baseC : baseL + (size_t)(u.pm - 1) * BM * 1024;
        const float* gp = (u.pm == 0) ? gateC : gateL;
        f32x4 gv[2][2];
#pragma unroll
        for (int bj = 0; bj < 2; ++bj)
#pragma unroll
            for (int n = 0; n < 2; ++n) gv[bj][n] = *(const f32x4*)(gp + col0 + bj * HALF + n * 16);
#pragma unroll
        for (int ai = 0; ai < 2; ++ai)
#pragma unroll
            for (int m = 0; m < 4; ++m) { const int r = rl + ai * HALF + m * 16; const float* brow = bp + (size_t)r * 1024 + col0; float* orow = out + ((size_t)u.pm * BM + r) * 1024 + col0;
#pragma unroll
                for (int bj = 0; bj < 2; ++bj)
#pragma unroll
                    for (int n = 0; n < 2; ++n) { const f32x4 b = *(const f32x4*)(brow + bj * HALF + n * 16); *(f32x4*)(orow + bj * HALF + n * 16) = b + gv[bj][n] * acc[ai][bj][m][n]; } }
    }
};
template <bool F8> struct EpiSwiGLU {
    static constexpr bool PERM = true;
    void* O; float s, so;
    __device__ __forceinline__ void operator()(const f32x4 (&acc)[2][2][4][2], const Unit& u, int wr, int wc, int fr, int fq) const {
        const int row0 = u.pm * BM + wr * 64 + fr; const int col0 = (u.pn & 15) * HALF + wc * 32 + 8 * fq;
#pragma unroll
        for (int ai = 0; ai < 2; ++ai)
#pragma unroll
            for (int m = 0; m < 4; ++m) { float h[8];
#pragma unroll
                for (int n = 0; n < 2; ++n)
#pragma unroll
                    for (int j = 0; j < 4; ++j) { const float a = acc[ai][0][m][n][j] * s, b = acc[ai][1][m][n][j] * s; h[n * 4 + j] = a * b * __builtin_amdgcn_rcpf(1.0f + __builtin_amdgcn_exp2f(-1.4426950408889634f * a)); }
                if constexpr (F8) { u32x2 w; w.x = pk4_fp8(h[0] * so, h[1] * so, h[2] * so, h[3] * so); w.y = pk4_fp8(h[4] * so, h[5] * so, h[6] * so, h[7] * so);
                    *(u32x2*)((unsigned char*)O + (size_t)(row0 + ai * HALF + m * 16) * 2048 + col0) = w; }
                else { u32x4 w; w.x = cvt_pk_bf16(h[0], h[1]); w.y = cvt_pk_bf16(h[2], h[3]); w.z = cvt_pk_bf16(h[4], h[5]); w.w = cvt_pk_bf16(h[6], h[7]);
                    *(u32x4*)((bf16_t*)O + (size_t)(row0 + ai * HALF + m * 16) * 2048 + col0) = w; } }
    }
};
struct EpiGateRow {
    static constexpr bool PERM = true;
    bf16_t* O; const float* gate; float s;
    __device__ __forceinline__ void operator()(const f32x4 (&acc)[2][2][4][2], const Unit& u, int wr, int wc, int fr, int fq) const {
        const int row0 = u.pm * BM + wr * 64 + fr; const int col0 = (u.pn & 3) * BM + wc * 32 + 8 * fq;
#pragma unroll
        for (int ai = 0; ai < 2; ++ai)
#pragma unroll
            for (int m = 0; m < 4; ++m) { const int r = row0 + ai * HALF + m * 16; const float gt = gate[r] * s; bf16_t* rowp = O + (size_t)r * 1024 + col0;
#pragma unroll
                for (int bj = 0; bj < 2; ++bj) { const f32x4 v0 = acc[ai][bj][m][0] * gt, v1 = acc[ai][bj][m][1] * gt;
                    u32x4 w; w.x = cvt_pk_bf16(v0[0], v0[1]); w.y = cvt_pk_bf16(v0[2], v0[3]); w.z = cvt_pk_bf16(v1[0], v1[1]); w.w = cvt_pk_bf16(v1[2], v1[3]);
                    *(u32x4*)(rowp + bj * HALF) = w; } }
    }
};

template <class Epi, class Sched, bool ALIGN_EPI, bool GATHER, bool FP8 = false>
__device__ __forceinline__ void gemm_phase(PG8_LAS unsigned char* lds, const Gemm g, const Sched& S, const Epi& E, const int tid) {
    const int wid = __builtin_amdgcn_readfirstlane(tid >> 6), lane = tid & 63, wr = wid >> 2, wc = wid & 3, fr = lane & 15, fq = lane >> 4;
    const int K = g.K, nt = K / BK;
    unsigned voffA[2], voffB[2]; int RA[2];
#pragma unroll
    for (int i = 0; i < 2; ++i) { int R, C; stage_rc(tid * 16 + i * 8192, R, C); const int Rb = Epi::PERM ? ((R & ~31) + perm32(R & 31)) : R;
        voffA[i] = GATHER ? (unsigned)(C * 2) : (unsigned)(R * K + C) * 2u; voffB[i] = (unsigned)(Rb * K + C) * 2u; RA[i] = R; }
    const size_t kstep = (size_t)(BK * 2);
    const size_t hstep = (size_t)HALF * K * 2;
    const size_t tstep = 2 * hstep;
    const unsigned ldsw = (unsigned)wid * 1024u;
    const int aoff = lds_byte(wr * 64 + fr, fq * 8), boff = lds_byte(wc * 32 + fr, fq * 8);
#define PG8_SA(b, h) (((b) * 2 + (h)) * HTB)
#define PG8_SB(b, h) ((4 + (b) * 2 + (h)) * HTB)
#define PG8_STAGE(bufoff, gbase, voff) do { _Pragma("unroll") for (int _i = 0; _i < 2; ++_i) \
        __builtin_amdgcn_global_load_lds((const unsigned*)((const char*)(gbase) + (voff)[_i]), (PG8_LAS unsigned*)(lds + (bufoff) + ldsw + _i * 8192), 16, 0, 0); } while (0)
#define PG8_LDA(dst, b, h) do { if constexpr (FP8) { _Pragma("unroll") for (int m = 0; m < 4; ++m) { const i32x4 lo_ = *(const PG8_LAS i32x4*)(lds + PG8_SA(b, h) + aoff + m * 2048), hi_ = *(const PG8_LAS i32x4*)(lds + PG8_SA(b, h) + aoff + m * 2048 + 1024); dst##8[m] = __builtin_shufflevector(lo_, hi_, 0, 1, 2, 3, 4, 5, 6, 7); } } \
        else { _Pragma("unroll") for (int m = 0; m < 4; ++m) _Pragma("unroll") for (int k = 0; k < 2; ++k) dst[m][k] = *(const PG8_LAS bf16x8*)(lds + PG8_SA(b, h) + aoff + m * 2048 + k * 1024); } } while (0)
#define PG8_LDB(dst, b, h) do { if constexpr (FP8) { _Pragma("unroll") for (int n = 0; n < 2; ++n) { const i32x4 lo_ = *(const PG8_LAS i32x4*)(lds + PG8_SB(b, h) + boff + n * 2048), hi_ = *(const PG8_LAS i32x4*)(lds + PG8_SB(b, h) + boff + n * 2048 + 1024); dst##8[n] = __builtin_shufflevector(lo_, hi_, 0, 1, 2, 3, 4, 5, 6, 7); } } \
        else { _Pragma("unroll") for (int n = 0; n < 2; ++n) _Pragma("unroll") for (int k = 0; k < 2; ++k) dst[n][k] = *(const PG8_LAS bf16x8*)(lds + PG8_SB(b, h) + boff + n * 2048 + k * 1024); } } while (0)
#define PG8_MMA(ai, bj, At, Bt) do { __builtin_amdgcn_s_setprio(1); \
        if constexpr (FP8) { _Pragma("unroll") for (int m = 0; m < 4; ++m) _Pragma("unroll") for (int n = 0; n < 2; ++n) \
            asm volatile("v_mfma_scale_f32_16x16x128_f8f6f4 %0, %1, %2, %0, %3, %3 op_sel_hi:[0,0,0]" : "+v"(acc[ai][bj][m][n]) : "v"(Bt##8[n]), "v"(At##8[m]), "v"(one_scale)); } \
        else { _Pragma("unroll") for (int m = 0; m < 4; ++m) _Pragma("unroll") for (int n = 0; n < 2; ++n) _Pragma("unroll") for (int k = 0; k < 2; ++k) \
            acc[ai][bj][m][n] = __builtin_amdgcn_mfma_f32_16x16x32_bf16(Bt[n][k], At[m][k], acc[ai][bj][m][n], 0, 0, 0); } \
        __builtin_amdgcn_s_setprio(0); } while (0)
#define PG8_WAIT_V(n) asm volatile("s_waitcnt vmcnt(" #n ")" ::: "memory")
#define PG8_WAIT_L(n) asm volatile("s_waitcnt lgkmcnt(" #n ")" ::: "memory")
#define PG8_BAR __builtin_amdgcn_s_barrier()
#define PG8_SCHED __builtin_amdgcn_sched_barrier(0)
    Unit cur, nxt; int ui = 0;
    if (!S.next(0, cur)) return;
    f32x4 acc[2][2][4][2];
#pragma unroll
    for (int a = 0; a < 2; ++a)
#pragma unroll
        for (int b = 0; b < 2; ++b)
#pragma unroll
            for (int m = 0; m < 4; ++m)
#pragma unroll
                for (int n = 0; n < 2; ++n) acc[a][b][m][n] = (f32x4){0.f, 0.f, 0.f, 0.f};
    int one_scale = 0x7F7F7F7F; asm volatile("" : "+v"(one_scale));
    bf16x8 At[4][2], B0[2][2], B1[2][2]; i32x8 At8[4], B08[2], B18[2];
    unsigned gC0[2], gC1[2], gN0[2], gN1[2];
    const char* cA; const char* cB = (const char*)g.Bt + (size_t)cur.pn * tstep;
    if constexpr (GATHER) {
        cA = (const char*)g.A;
#pragma unroll
        for (int i = 0; i < 2; ++i) { gC0[i] = (unsigned)g.gidx[cur.pm * BM + RA[i]] * (unsigned)(K * 2) + voffA[i]; gC1[i] = (unsigned)g.gidx[cur.pm * BM + HALF + RA[i]] * (unsigned)(K * 2) + voffA[i]; gN0[i] = gC0[i]; gN1[i] = gC1[i]; }
    } else { cA = (const char*)g.A + (size_t)cur.pm * tstep; }
#define PG8_STA0(bufoff, ptr) do { if constexpr (GATHER) PG8_STAGE(bufoff, ptr, gC0); else PG8_STAGE(bufoff, ptr, voffA); } while (0)
#define PG8_STA1(bufoff, ptr) do { if constexpr (GATHER) PG8_STAGE(bufoff, ptr, gC1); else PG8_STAGE(bufoff, (ptr) + hstep, voffA); } while (0)
#define PG8_STX0(bufoff, ptr) do { if constexpr (GATHER) PG8_STAGE(bufoff, ptr, gX0); else PG8_STAGE(bufoff, ptr, voffA); } while (0)
#define PG8_STX1(bufoff, ptr) do { if constexpr (GATHER) PG8_STAGE(bufoff, ptr, gX1); else PG8_STAGE(bufoff, (ptr) + hstep, voffA); } while (0)
    PG8_STAGE(PG8_SB(0, 0), cB, voffB); PG8_STAGE(PG8_SB(0, 1), cB + hstep, voffB); PG8_STA0(PG8_SA(0, 0), cA); PG8_STA1(PG8_SA(0, 1), cA);
    if (wr == 1) PG8_BAR;
    PG8_WAIT_V(2); PG8_BAR;
    PG8_STAGE(PG8_SB(1, 0), cB + kstep, voffB); PG8_STA0(PG8_SA(1, 0), cA + kstep); PG8_STAGE(PG8_SB(1, 1), cB + hstep + kstep, voffB);
    PG8_WAIT_V(6); PG8_BAR;
    for (;;) {
        const bool has_next = S.next(ui + 1, nxt);
        const char* nA; const char* nB = has_next ? (const char*)g.Bt + (size_t)nxt.pn * tstep : cB;
        if constexpr (GATHER) {
            nA = cA;
            if (has_next) {
#pragma unroll
                for (int i = 0; i < 2; ++i) { gN0[i] = (unsigned)g.gidx[nxt.pm * BM + RA[i]] * (unsigned)(K * 2) + voffA[i]; gN1[i] = (unsigned)g.gidx[nxt.pm * BM + HALF + RA[i]] * (unsigned)(K * 2) + voffA[i]; }
            }
        } else { nA = has_next ? (const char*)g.A + (size_t)nxt.pm * tstep : cA; }
        for (int t = 0; t < nt; t += 2) {
            const bool last = (t == nt - 2);
            const char* a1 = cA + (size_t)(t + 1) * kstep;
            const char* a2 = last ? nA : cA + (size_t)(t + 2) * kstep; const char* b2 = last ? nB : cB + (size_t)(t + 2) * kstep;
            const char* a3 = a2 + kstep; const char* b3 = b2 + kstep;
            unsigned gX0[2], gX1[2];
            if constexpr (GATHER) {
#pragma unroll
                for (int i = 0; i < 2; ++i) { gX0[i] = last ? gN0[i] : gC0[i]; gX1[i] = last ? gN1[i] : gC1[i]; }
            }
            PG8_LDB(B0, 0, 0); PG8_LDB(B1, 0, 1); PG8_SCHED; PG8_LDA(At, 0, 0); PG8_STA1(PG8_SA(1, 1), a1);
            PG8_WAIT_V(8); PG8_WAIT_L(0); PG8_BAR; PG8_MMA(0, 0, At, B0); PG8_MMA(0, 1, At, B1); PG8_BAR; PG8_SCHED;
            PG8_LDA(At, 0, 1); PG8_STAGE(PG8_SB(0, 0), b2, voffB); PG8_STAGE(PG8_SB(0, 1), b2 + hstep, voffB); PG8_STX0(PG8_SA(0, 0), a2);
            PG8_WAIT_V(8); PG8_WAIT_L(0); PG8_BAR; PG8_MMA(1, 0, At, B0); PG8_MMA(1, 1, At, B1); PG8_BAR; PG8_SCHED;
            PG8_LDB(B0, 1, 0); PG8_LDB(B1, 1, 1); PG8_SCHED; PG8_LDA(At, 1, 0); PG8_STX1(PG8_SA(0, 1), a2);
            PG8_WAIT_V(8); PG8_WAIT_L(0); PG8_BAR; PG8_MMA(0, 0, At, B0); PG8_MMA(0, 1, At, B1); PG8_BAR; PG8_SCHED;
            PG8_LDA(At, 1, 1); PG8_STAGE(PG8_SB(1, 0), b3, voffB); PG8_STAGE(PG8_SB(1, 1), b3 + hstep, voffB); PG8_STX0(PG8_SA(1, 0), a3);
            PG8_WAIT_V(8); PG8_WAIT_L(0); PG8_BAR; PG8_MMA(1, 0, At, B0); PG8_MMA(1, 1, At, B1); PG8_BAR; PG8_SCHED;
        }
        if constexpr (ALIGN_EPI) { if (wr == 0) PG8_BAR; }
        if constexpr (FP8) asm volatile("s_nop 15\n\ts_nop 7" ::: "memory");
        E(acc, cur, wr, wc, fr, fq);
        if (!has_next) break;
#pragma unroll
        for (int a = 0; a < 2; ++a)
#pragma unroll
            for (int b = 0; b < 2; ++b)
#pragma unroll
                for (int m = 0; m < 4; ++m)
#pragma unroll
                    for (int n = 0; n < 2; ++n) acc[a][b][m][n] = (f32x4){0.f, 0.f, 0.f, 0.f};
        cur = nxt; cA = nA; cB = nB; ++ui;
        if constexpr (GATHER) {
#pragma unroll
            for (int i = 0; i < 2; ++i) { gC0[i] = gN0[i]; gC1[i] = gN1[i]; }
        }
        if constexpr (ALIGN_EPI) { if (wr == 1) PG8_BAR; }
    }
    PG8_WAIT_V(0);
    if constexpr (!ALIGN_EPI) { if (wr == 0) PG8_BAR; }
    PG8_BAR;
#undef PG8_SA
#undef PG8_SB
#undef PG8_STAGE
#undef PG8_STA0
#undef PG8_STA1
#undef PG8_STX0
#undef PG8_STX1
#undef PG8_LDA
#undef PG8_LDB
#undef PG8_MMA
#undef PG8_WAIT_V
#undef PG8_WAIT_L
#undef PG8_BAR
#undef PG8_SCHED
}
}
namespace attn_body {
using bf16=__hip_bfloat16;
using bf16x8=__attribute__((ext_vector_type(8)))short;
using s16x4=__attribute__((ext_vector_type(4)))short;
using f32x16=__attribute__((ext_vector_type(16)))float;
using u32x4=__attribute__((ext_vector_type(4)))unsigned;
constexpr int D=64,QP=256,KP=128,VP=128,OP=1024;
constexpr int NW=8,QBLK=32,QB=QBLK*NW,KVBLK=64;
__device__ __forceinline__ int crow(int r,int hi){return (r&3)+8*(r>>2)+4*hi;}
#define SBAR() __builtin_amdgcn_sched_barrier(0)
__device__ __forceinline__ void cmask(f32x16&p0,f32x16&p1,int jb,int qrel,int hi){
  const float NEG=-INFINITY; int kb=64*jb+4*hi;
  #pragma unroll
  for(int r=0;r<16;++r){int kv=kb+(r&3)+8*(r>>2); if(kv>qrel)p0[r]=NEG; if(kv+32>qrel)p1[r]=NEG;}
}

constexpr int NSLOT=3, SLOTB=8192;
constexpr int LDS_K=0, LDS_V=NSLOT*SLOTB, LDS_WS=2*NSLOT*SLOTB, LDS_OST=LDS_WS+NW*64*4, LDS_BYTES=LDS_OST+NW*4096;
constexpr float C2=0.125f*1.4426950408889634f;
__device__ __forceinline__ void glds16(const void*gsrc,unsigned lds_dst){unsigned keep;
  asm volatile("s_mov_b32 %0, m0\n\ts_mov_b32 m0, %2\n\ts_nop 0\n\tglobal_load_lds_dwordx4 %1, off\n\ts_mov_b32 m0, %0":"=&s"(keep):"v"(gsrc),"s"(lds_dst):"memory");}
__device__ __forceinline__ float max3f(float a,float b,float c){float r;asm("v_max3_f32 %0, %1, %2, %3":"=v"(r):"v"(a),"v"(b),"v"(c));return r;}
__device__ __forceinline__ float max2f(float a,float b){float r;asm("v_max_f32_e32 %0, %1, %2":"=v"(r):"v"(a),"v"(b));return r;}
__device__ __forceinline__ float fadd_s(float a,float b){float r;asm("v_add_f32_e32 %0, %1, %2":"=v"(r):"v"(a),"v"(b));return r;}
__device__ __forceinline__ float fsub_s(float a,float b){float r;asm("v_sub_f32_e32 %0, %1, %2":"=v"(r):"v"(a),"v"(b));return r;}
typedef float f32x2_t __attribute__((ext_vector_type(2))); typedef __bf16 bf16x2_t __attribute__((ext_vector_type(2)));
__device__ __forceinline__ unsigned cvtpk_s(float lo,float hi){f32x2_t v={lo,hi};bf16x2_t b=__builtin_convertvector(v,bf16x2_t);return __builtin_bit_cast(unsigned,b);}
#define WAIT_BAR(N) asm volatile("s_waitcnt vmcnt(" #N ") lgkmcnt(0)\n\ts_barrier":::"memory")

__device__ __forceinline__ void qkt(f32x16&p0,f32x16&p1,const char*Kslot,const bf16x8*qr,const f32x16&negm,int r32,int hi){
  const char*kb=Kslot+hi*1024+r32*16;
  #pragma unroll
  for(int d0=0;d0<4;++d0){
    const bf16x8 b0=*reinterpret_cast<const bf16x8*>(kb+d0*2048);
    const bf16x8 b1=*reinterpret_cast<const bf16x8*>(kb+d0*2048+512);
    if(d0==0){p0=__builtin_amdgcn_mfma_f32_32x32x16_bf16(b0,qr[0],negm,0,0,0);p1=__builtin_amdgcn_mfma_f32_32x32x16_bf16(b1,qr[0],negm,0,0,0);}
    else{p0=__builtin_amdgcn_mfma_f32_32x32x16_bf16(b0,qr[d0],p0,0,0,0);p1=__builtin_amdgcn_mfma_f32_32x32x16_bf16(b1,qr[d0],p1,0,0,0);}}
}
typedef __attribute__((address_space(3))) const char* lds_cptr;
typedef short v4i16_t __attribute__((ext_vector_type(4)));
__device__ __forceinline__ void kload8(bf16x8*kf,lds_cptr kp){
  kf[0]=*(const __attribute__((address_space(3))) bf16x8*)(kp);      kf[1]=*(const __attribute__((address_space(3))) bf16x8*)(kp+512);
  kf[2]=*(const __attribute__((address_space(3))) bf16x8*)(kp+2048); kf[3]=*(const __attribute__((address_space(3))) bf16x8*)(kp+2560);
  kf[4]=*(const __attribute__((address_space(3))) bf16x8*)(kp+4096); kf[5]=*(const __attribute__((address_space(3))) bf16x8*)(kp+4608);
  kf[6]=*(const __attribute__((address_space(3))) bf16x8*)(kp+6144); kf[7]=*(const __attribute__((address_space(3))) bf16x8*)(kp+6656);
}
__device__ __forceinline__ void kload2(bf16x8*kf,lds_cptr kp,int j){ kf[2*j]=*(const __attribute__((address_space(3))) bf16x8*)(kp+j*2048); kf[2*j+1]=*(const __attribute__((address_space(3))) bf16x8*)(kp+j*2048+512); }
__device__ __forceinline__ s16x4 vtr(lds_cptr p){ return __builtin_bit_cast(s16x4,__builtin_amdgcn_ds_read_tr16_b64_v4i16((__attribute__((address_space(3))) v4i16_t*)p)); }
__device__ __forceinline__ float rowmax(const f32x16&p0,const f32x16&p1){
  float a=max3f(p0[0],p0[1],p1[0]),b=max3f(p0[2],p0[3],p1[1]);a=max3f(a,p1[2],p1[3]);
  #pragma unroll
  for(int r=4;r<16;r+=4){a=max3f(a,p0[r],p0[r+1]);b=max3f(b,p0[r+2],p0[r+3]);a=max3f(a,p1[r],p1[r+1]);b=max3f(b,p1[r+2],p1[r+3]);}
  const float m=max2f(a,b);
  auto rr=__builtin_amdgcn_permlane32_swap(__float_as_uint(m),__float_as_uint(m),false,false);
  return max2f(__uint_as_float(rr[0]),__uint_as_float(rr[1]));
}
__device__ __forceinline__ void pv(f32x16*o,int vb,bf16x8 pa0,bf16x8 pa1,bf16x8 pa2,bf16x8 pa3){
  #pragma unroll
  for(int d0=0;d0<2;++d0){s16x4 lo[4],hi[4];
    #pragma unroll
    for(int ks=0;ks<4;++ks){
      asm volatile("ds_read_b64_tr_b16 %0,%1 offset:%c2":"=&v"(lo[ks]):"v"(vb),"i"(d0*4096+ks*1024):"memory");
      asm volatile("ds_read_b64_tr_b16 %0,%1 offset:%c2":"=&v"(hi[ks]):"v"(vb),"i"(d0*4096+ks*1024+512):"memory");}
    asm volatile("s_waitcnt lgkmcnt(0)":::"memory");SBAR();
    #define PK(k) (bf16x8){lo[k][0],lo[k][1],lo[k][2],lo[k][3],hi[k][0],hi[k][1],hi[k][2],hi[k][3]}
    o[d0]=__builtin_amdgcn_mfma_f32_32x32x16_bf16(pa0,PK(0),o[d0],0,0,0);
    o[d0]=__builtin_amdgcn_mfma_f32_32x32x16_bf16(pa1,PK(1),o[d0],0,0,0);
    o[d0]=__builtin_amdgcn_mfma_f32_32x32x16_bf16(pa2,PK(2),o[d0],0,0,0);
    o[d0]=__builtin_amdgcn_mfma_f32_32x32x16_bf16(pa3,PK(3),o[d0],0,0,0);
    #undef PK
  }
}

#ifndef ATTN_STORE16
#define ATTN_STORE16(p,v) (*(u32x4*)(p)=(v))
#endif
template<int THRL,bool STATICM> __device__ __forceinline__ void attn_unit(const bf16*Qu,const bf16*__restrict__ Kh,const bf16*__restrict__ Vh,bf16*Ou,const int NT,char*shm,const int tid,const float mref){
  const int lane=tid&63,r32=lane&31,hi=lane>>5; const int wid=__builtin_amdgcn_readfirstlane(tid>>6);
  const bf16*Qw=Qu+(long)(wid*QBLK)*QP;
  const unsigned lds0=(unsigned)(uintptr_t)shm;
  float*wsf=(float*)(shm+LDS_WS)+wid*64;
  const bf16*ksrc=Kh+(long)lane*KP+wid*8;
  const bf16*vsrc=Vh+(long)(16*(wid&3)+(lane>>2))*VP+(wid>>2)*32+(lane&3)*8;
  const unsigned kdst=lds0+LDS_K+wid*1024, vdst=lds0+LDS_V+wid*1024;
  #define DMA_K(t,slot) glds16(ksrc+(long)(t)*KVBLK*KP,(unsigned)__builtin_amdgcn_readfirstlane(kdst+(slot)))
  #define DMA_V(t,slot) glds16(vsrc+(long)(t)*KVBLK*VP,(unsigned)__builtin_amdgcn_readfirstlane(vdst+(slot)))
  const int vb0=(int)(lds0+LDS_V)+((lane>>4)&1)*32+(lane&3)*8+(4*hi+((lane&15)>>2))*64;
  const char*Kbase=shm+LDS_K; bf16x8 kf[8];
  const lds_cptr shm3=(lds_cptr)shm; const lds_cptr kp0=shm3+LDS_K+hi*1024+r32*16; const lds_cptr vp0=shm3+LDS_V+((lane>>4)&1)*32+(lane&3)*8+(4*hi+((lane&15)>>2))*64;
  DMA_K(0,0);DMA_V(0,0);DMA_K(1,SLOTB);
  bf16x8 qr[4];
  #pragma unroll
  for(int d0=0;d0<4;++d0)qr[d0]=*reinterpret_cast<const bf16x8*>(&Qw[(long)r32*QP+d0*16+hi*8]);
  float mhat=0.f,l_reg=0.f;f32x16 o[2];o[0]=f32x16{};o[1]=f32x16{};f32x16 negm=f32x16{};
  if constexpr(STATICM){ mhat=mref; _Pragma("unroll") for(int r=0;r<16;++r)negm[r]=-mref; }
  asm volatile("":"+v"(negm));
  #define CMASK(P0,P1,t) do{}while(0)
  bool resc=false;
  #define START(P0,P1) do{ resc=false; \
    if constexpr(!STATICM){ const float rm=rowmax(P0,P1); const float dl=rm; mhat=fadd_s(mhat,dl); \
      _Pragma("unroll") for(int r=0;r<16;++r){P0[r]=fsub_s(P0[r],dl);P1[r]=fsub_s(P1[r],dl);} \
      _Pragma("unroll") for(int r=0;r<16;++r)negm[r]=-mhat; asm volatile("":"+v"(negm)); } \
    _Pragma("unroll") for(int r=0;r<16;++r)P0[r]=__builtin_amdgcn_exp2f(P0[r]); }while(0)
  #define RESC() do{ if(resc){ asm volatile("s_waitcnt lgkmcnt(0)":::"memory"); \
      _Pragma("unroll") for(int d_=0;d_<2;++d_) _Pragma("unroll") for(int r=0;r<16;++r)o[d_][r]*=wsf[crow(r,hi)]; } }while(0)
  f32x16 pA0,pA1,pB0,pB1;
  int sl_prev=0,sl_cur=0,sl_next=SLOTB;
  #define ROT() do{sl_prev=sl_cur;sl_cur=sl_next;sl_next=(sl_next==(NSLOT-1)*SLOTB)?0:sl_next+SLOTB;}while(0)
  DMA_K(2,2*SLOTB);
  WAIT_BAR(3);
  qkt(pA0,pA1,Kbase,qr,negm,r32,hi);asm volatile("s_nop 15\n\ts_nop 7":"+v"(pA0),"+v"(pA1));CMASK(pA0,pA1,0);
  START(pA0,pA1);
  _Pragma("unroll") for(int r=0;r<16;++r)pA1[r]=__builtin_amdgcn_exp2f(pA1[r]);
  WAIT_BAR(0);
  DMA_K(3,0);DMA_V(1,SLOTB);
  ROT();
  kload8(kf,kp0+sl_cur);
  WAIT_BAR(2);
  s16x4 vlo[8],vhi[8]; u32x4 pw0,pw1,pw2,pw3;
  #define PKW(P,B) cvtpk_s(P[B],P[B+1])
  #define PAF(k) __builtin_bit_cast(bf16x8,pw##k)
  #define VFR(i) (bf16x8){vlo[i][0],vlo[i][1],vlo[i][2],vlo[i][3],vhi[i][0],vhi[i][1],vhi[i][2],vhi[i][3]}
  #define PIN(x) asm volatile("":"+v"(x))
  #define MX3(a,b,c) __builtin_fmaxf(__builtin_fmaxf((a),(b)),(c))
  #define GAPA(MF,A0,A1,A2,A3,W0,W1,PW) do{ MF; sacc+=A0; sacc+=A1; sacc+=A2; sacc+=A3; PIN(sacc); W0; W1; PIN(PW); SBAR(); }while(0)
  #define EX(v) __builtin_amdgcn_exp2f(v)
  #define GAPB(MF,X,B) do{ MF; X[B]=EX(X[B]); X[B+1]=EX(X[B+1]); X[B+2]=EX(X[B+2]); X[B+3]=EX(X[B+3]); PIN(X); SBAR(); }while(0)
  #define VRD(i) do{ vlo[i]=vtr(vp_+(((i)>>2)*4096+((i)&3)*1024)); vhi[i]=vtr(vp_+(((i)>>2)*4096+((i)&3)*1024+512)); }while(0)
  #define KRD(G,j) do{ if(G){ kload2(kf,kp0+sl_next,j); SBAR(); } }while(0)
  #define STEP(C0,C1,P0,P1,t,GK,GV,GL) do{ SBAR(); \
    const lds_cptr vp_=vp0+sl_prev; \
    VRD(0); SBAR(); float sacc=(P0[0]+P0[1]); \
    GAPA(C0=__builtin_amdgcn_mfma_f32_32x32x16_bf16(kf[0],qr[0],negm,0,0,0), P0[2],P0[3],P0[4],P0[5],     pw0[0]=PKW(P0,0), pw0[1]=PKW(P0,2), pw0); \
    VRD(4); SBAR(); GAPA(C1=__builtin_amdgcn_mfma_f32_32x32x16_bf16(kf[1],qr[0],negm,0,0,0), P0[6],P0[7],P0[8],P0[9],     pw0[2]=PKW(P0,4), pw0[3]=PKW(P0,6), pw0); \
    VRD(1); SBAR(); GAPA(C0=__builtin_amdgcn_mfma_f32_32x32x16_bf16(kf[2],qr[1],C0,0,0,0),   P0[10],P0[11],P0[12],P0[13], pw1[0]=PKW(P0,8), pw1[1]=PKW(P0,10), pw1); \
    VRD(5); SBAR(); GAPA(C1=__builtin_amdgcn_mfma_f32_32x32x16_bf16(kf[3],qr[1],C1,0,0,0),   P0[14],P0[15],P1[0],P1[1],   pw1[2]=PKW(P0,12),pw1[3]=PKW(P0,14), pw1); \
    VRD(2); SBAR(); GAPA(C0=__builtin_amdgcn_mfma_f32_32x32x16_bf16(kf[4],qr[2],C0,0,0,0),   P1[2],P1[3],P1[4],P1[5],     pw2[0]=PKW(P1,0), pw2[1]=PKW(P1,2), pw2); \
    VRD(6); SBAR(); GAPA(C1=__builtin_amdgcn_mfma_f32_32x32x16_bf16(kf[5],qr[2],C1,0,0,0),   P1[6],P1[7],P1[8],P1[9],     pw2[2]=PKW(P1,4), pw2[3]=PKW(P1,6), pw2); \
    VRD(3); SBAR(); GAPA(C0=__builtin_amdgcn_mfma_f32_32x32x16_bf16(kf[6],qr[3],C0,0,0,0),   P1[10],P1[11],P1[12],P1[13], pw3[0]=PKW(P1,8), pw3[1]=PKW(P1,10), pw3); \
    VRD(7); SBAR(); GAPA(C1=__builtin_amdgcn_mfma_f32_32x32x16_bf16(kf[7],qr[3],C1,0,0,0),   P1[14],P1[15],0.f,0.f,       pw3[2]=PKW(P1,12),pw3[3]=PKW(P1,14), pw3); \
    l_reg+=sacc; \
    if(GK){DMA_K((t)+3,sl_cur);} if(GV){DMA_V((t)+1,sl_next);} \
    CMASK(C0,C1,t); \
    if constexpr(!STATICM){ float a=MX3(C0[0],C0[1],C1[0]),b=MX3(C0[2],C0[3],C1[1]); a=MX3(a,C1[2],C1[3]); \
      _Pragma("unroll") for(int r=4;r<16;r+=4){a=MX3(a,C0[r],C0[r+1]);b=MX3(b,C0[r+2],C0[r+3]);a=MX3(a,C1[r],C1[r+1]);b=MX3(b,C1[r+2],C1[r+3]);} \
      float rm=__builtin_fmaxf(a,b); { auto rr=__builtin_amdgcn_permlane32_swap(__float_as_uint(rm),__float_as_uint(rm),false,false); rm=__builtin_fmaxf(__uint_as_float(rr[0]),__uint_as_float(rr[1])); } \
      resc=false; \
      if(__builtin_expect(__any(rm>(float)THRL),0)){ const float dl=__builtin_fmaxf(rm,0.f); mhat+=dl; \
        _Pragma("unroll") for(int r=0;r<16;++r){C0[r]-=dl;C1[r]-=dl;} \
        _Pragma("unroll") for(int r=0;r<16;++r)negm[r]=-mhat; asm volatile("":"+v"(negm)); \
        const float f=__builtin_amdgcn_exp2f(-dl); l_reg*=f; if(hi==0)wsf[r32]=f; resc=true; } } \
    SBAR(); \
    GAPB(o[0]=__builtin_amdgcn_mfma_f32_32x32x16_bf16(PAF(0),VFR(0),o[0],0,0,0), C0,0); \
    GAPB(o[1]=__builtin_amdgcn_mfma_f32_32x32x16_bf16(PAF(0),VFR(4),o[1],0,0,0), C0,4); \
    KRD(GL,0); GAPB(o[0]=__builtin_amdgcn_mfma_f32_32x32x16_bf16(PAF(1),VFR(1),o[0],0,0,0), C0,8); \
    KRD(GL,1); GAPB(o[1]=__builtin_amdgcn_mfma_f32_32x32x16_bf16(PAF(1),VFR(5),o[1],0,0,0), C0,12); \
    KRD(GL,2); GAPB(o[0]=__builtin_amdgcn_mfma_f32_32x32x16_bf16(PAF(2),VFR(2),o[0],0,0,0), C1,0); \
    KRD(GL,3); GAPB(o[1]=__builtin_amdgcn_mfma_f32_32x32x16_bf16(PAF(2),VFR(6),o[1],0,0,0), C1,4); \
    GAPB(o[0]=__builtin_amdgcn_mfma_f32_32x32x16_bf16(PAF(3),VFR(3),o[0],0,0,0), C1,8); \
    GAPB(o[1]=__builtin_amdgcn_mfma_f32_32x32x16_bf16(PAF(3),VFR(7),o[1],0,0,0), C1,12); \
    }while(0)
  int t=1;
  #undef CMASK
  #define CMASK(P0,P1,t) do{}while(0)
  for(;t+5<NT;t+=2){
    STEP(pB0,pB1,pA0,pA1,t,true,true,true);     WAIT_BAR(2); RESC(); ROT();
    STEP(pA0,pA1,pB0,pB1,t+1,true,true,true);   WAIT_BAR(2); RESC(); ROT();
  }
  #undef CMASK
  #define CMASK(P0,P1,t) do{}while(0)
  #define ENDW(tt) do{ if((tt)+3<NT){WAIT_BAR(2);} else if((tt)+2<NT){WAIT_BAR(1);} else {WAIT_BAR(0);} }while(0)
  for(;t+1<NT;t+=2){
    STEP(pB0,pB1,pA0,pA1,t,(t+3<NT),(t+1<NT),(t+1<NT));       ENDW(t);   RESC(); ROT();
    STEP(pA0,pA1,pB0,pB1,t+1,(t+4<NT),(t+2<NT),(t+2<NT));     ENDW(t+1); RESC(); ROT();
  }
  STEP(pB0,pB1,pA0,pA1,NT-1,false,false,false); RESC();
  { float sacc=pB0[0]+pB0[1]; _Pragma("unroll") for(int r=2;r<16;++r)sacc+=pB0[r]; _Pragma("unroll") for(int r=0;r<16;++r)sacc+=pB1[r]; l_reg+=sacc;
    pw0=(u32x4){PKW(pB0,0),PKW(pB0,2),PKW(pB0,4),PKW(pB0,6)};pw1=(u32x4){PKW(pB0,8),PKW(pB0,10),PKW(pB0,12),PKW(pB0,14)};pw2=(u32x4){PKW(pB1,0),PKW(pB1,2),PKW(pB1,4),PKW(pB1,6)};pw3=(u32x4){PKW(pB1,8),PKW(pB1,10),PKW(pB1,12),PKW(pB1,14)};
    SBAR(); pv(o,vb0+sl_cur,PAF(0),PAF(1),PAF(2),PAF(3)); }
  #undef PKW
  #undef PAF
  #undef VFR
  #undef PIN
  #undef MX3
  #undef GAPA
  #undef GAPB
  #undef EX
  #undef VRD
  #undef KRD
  #undef STEP
  #undef ENDW
  {auto rr=__builtin_amdgcn_permlane32_swap(__float_as_uint(l_reg),__float_as_uint(l_reg),false,false);l_reg=__uint_as_float(rr[0])+__uint_as_float(rr[1]);}
  if(hi==0)wsf[32+r32]=l_reg;asm volatile("s_waitcnt lgkmcnt(0)":::"memory");
  float rli[16];
  #pragma unroll
  for(int r=0;r<16;++r)rli[r]=__builtin_amdgcn_rcpf(wsf[32+crow(r,hi)]);
  bf16*Ow=Ou+(long)(wid*QBLK)*OP;
  { bf16*stg=(bf16*)(shm+LDS_OST)+wid*2048;
    #pragma unroll
    for(int r=0;r<16;++r){const int orow=crow(r,hi);
      #pragma unroll
      for(int d0=0;d0<2;++d0)stg[orow*64+d0*32+r32]=__float2bfloat16(o[d0][r]*rli[r]);}
    asm volatile("s_waitcnt lgkmcnt(0)":::"memory");
    #pragma unroll
    for(int i=0;i<4;++i){const int row=i*8+(lane>>3),ch=lane&7; const u32x4 v=*(const u32x4*)(stg+row*64+ch*8); ATTN_STORE16(Ow+(long)row*OP+ch*8,v);} }
  asm volatile("s_waitcnt lgkmcnt(0)\n\ts_barrier":::"memory");
  #undef DMA_K
  #undef DMA_V
  #undef CMASK
  #undef START
  #undef RESC
  #undef ROT
}
constexpr int ATTN_LDS_BYTES=LDS_BYTES;
#undef SBAR
#undef WAIT_BAR
}
#ifndef PROBE_K
#define PROBE_K 0
#define PROBE_A 0
#define PROBE_B 0
#endif
constexpr int NWAVES = 8, NTHR = 512;
constexpr int DM = 1024, SEQL = 16384, CTXL = 256, R = SEQL + CTXL;
constexpr int DIN = 2832, NZ = 2816;
constexpr int NEXP = 16, FF = 2048, CAPL = 2048, CAPC = 32, ESLOTS = 2304;
constexpr int NCHUNK = R / 128;
constexpr float EPSN = 1e-6f;
constexpr int ZC_CONVX = 0, ZC_CONVB = 256, ZC_CONVC = 512, ZC_CU = 768, ZC_CV = 1024, ZC_Q = 1280, ZC_K = 1536, ZC_V = 1664, ZC_MQ = 1792, ZC_MK = 2048, ZC_MV = 2304, ZC_MO = 2560;

constexpr size_t MiB = 1u << 20;
constexpr size_t WS_CTL = 0;
constexpr size_t WS_MOD = 1 * MiB;
constexpr size_t WS_ROPE = WS_MOD + 256 * 1024;
constexpr size_t WS_WIN = 2 * MiB;
constexpr size_t WS_WOUT = 14 * MiB;
constexpr size_t WS_W13 = 18 * MiB;
constexpr size_t WS_W2 = 274 * MiB;
constexpr size_t WS_XW = 402 * MiB;
constexpr size_t WS_H = 467 * MiB;
constexpr size_t WS_H2 = 500 * MiB;
constexpr size_t WS_MIX = 533 * MiB;
constexpr size_t WS_Z = 566 * MiB;
constexpr size_t WS_QB = 656 * MiB;
constexpr size_t WS_KB = 665 * MiB;
constexpr size_t WS_VB = 670 * MiB;
constexpr size_t WS_G = 675 * MiB;
constexpr size_t WS_CLOC = 677 * MiB;
constexpr size_t WS_NLOC = 694 * MiB;
constexpr size_t WS_SCAL = WS_NLOC + 512 * 1024;
constexpr size_t WS_AFF = 695 * MiB;
constexpr size_t WS_IDX = 697 * MiB;
constexpr size_t WS_GATE = WS_IDX + 512 * 1024;
constexpr size_t WS_SLOT = 698 * MiB;
constexpr size_t WS_HID = 700 * MiB;
constexpr size_t WS_Y = 844 * MiB;
constexpr size_t WS_END = 916 * MiB;
static_assert(WS_WIN + (size_t)2 * NZ * DM * 2 <= WS_WOUT && WS_Z + (size_t)R * NZ * 2 <= WS_QB && WS_QB + (size_t)R * 256 * 2 <= WS_KB && WS_KB + (size_t)R * 128 * 2 <= WS_VB && WS_VB + (size_t)R * 128 * 2 <= WS_G, "ws map");
static_assert(WS_G + (size_t)R * 16 * 4 <= WS_CLOC && WS_CLOC + (size_t)NCHUNK * 8 * 4096 * 4 <= WS_NLOC && WS_XW + (size_t)R * DM * 4 <= WS_H && WS_H + (size_t)R * DM * 2 <= WS_H2 && WS_MIX + (size_t)R * DM * 2 <= WS_Z, "ws map");
static_assert(WS_HID + (size_t)16 * ESLOTS * FF * 2 <= WS_Y && WS_Y + (size_t)16 * ESLOTS * DM * 2 <= WS_END && WS_AFF + (size_t)16 * R * 4 <= WS_IDX && WS_SLOT + (size_t)R * 16 * 4 <= WS_HID, "ws map");

#ifndef MOE_FP8
#define MOE_FP8 1
#endif
constexpr float W_F8S = 64.0f, H2_F8S = 2.0f, HID_F8S = 4.0f;
constexpr int LDS_BYTES = 147456;

typedef unsigned short bf16;
typedef unsigned v4u __attribute__((ext_vector_type(4)));
typedef unsigned v2u __attribute__((ext_vector_type(2)));
typedef float f32x4 __attribute__((ext_vector_type(4)));
typedef float f32x2 __attribute__((ext_vector_type(2)));
typedef short bf16x8 __attribute__((ext_vector_type(8)));
typedef __bf16 bf16x2_t __attribute__((ext_vector_type(2)));

__device__ __forceinline__ unsigned pk2(float lo, float hi) { f32x2 v = {lo, hi}; bf16x2_t b = __builtin_convertvector(v, bf16x2_t); return __builtin_bit_cast(unsigned, b); }
__device__ __forceinline__ float bf_lo(unsigned w) { return __uint_as_float(w << 16); }
__device__ __forceinline__ float bf_hi(unsigned w) { return __uint_as_float(w & 0xffff0000u); }
__device__ __forceinline__ float bf2f(bf16 h) { return __uint_as_float((unsigned)h << 16); }
__device__ __forceinline__ bf16 f2bf(float f) { return (bf16)(pk2(f, 0.f) & 0xffffu); }
template <int CTRL> __device__ __forceinline__ float dppf(float v) { return __int_as_float(__builtin_amdgcn_update_dpp(__float_as_int(v), __float_as_int(v), CTRL, 0xF, 0xF, false)); }
constexpr int DPP_X1 = 0xB1, DPP_X2 = 0x4E, DPP_HMIR = 0x141, DPP_MIR = 0x140, DPP_ROR8 = 0x128;
__device__ __forceinline__ float swap16_sum(float a, float b) { auto r = __builtin_amdgcn_permlane16_swap(__float_as_uint(a), __float_as_uint(b), false, false); return __uint_as_float(r[0]) + __uint_as_float(r[1]); }
__device__ __forceinline__ float swap32_sum(float a, float b) { auto r = __builtin_amdgcn_permlane32_swap(__float_as_uint(a), __float_as_uint(b), false, false); return __uint_as_float(r[0]) + __uint_as_float(r[1]); }
__device__ __forceinline__ float swap16_max(float a) { auto r = __builtin_amdgcn_permlane16_swap(__float_as_uint(a), __float_as_uint(a), false, false); return fmaxf(__uint_as_float(r[0]), __uint_as_float(r[1])); }
__device__ __forceinline__ float swap32_max(float a) { auto r = __builtin_amdgcn_permlane32_swap(__float_as_uint(a), __float_as_uint(a), false, false); return fmaxf(__uint_as_float(r[0]), __uint_as_float(r[1])); }
__device__ __forceinline__ float wave_sum(float v) {
    v += dppf<DPP_X1>(v); v += dppf<DPP_X2>(v); v += dppf<DPP_HMIR>(v); v += dppf<DPP_MIR>(v);
    v = swap16_sum(v, v); v = swap32_sum(v, v); return v;
}
__device__ __forceinline__ float wave_max(float v) {
#pragma unroll
    for (int o = 32; o > 0; o >>= 1) v = fmaxf(v, __shfl_xor(v, o));
    return v;
}

struct Args {
    const float *x, *c, *ctx, *c_ctx, *ada_w, *ada_b, *norm1_g, *w_in, *conv_w, *cmlp_norm_g, *cmlp_ws, *cmlp_bs, *q_norm_g, *k_norm_g, *ml_igate_b, *ml_fgate_b, *ml_norm_g, *w_out, *norm2_g, *router_w, *exp_w1, *exp_w3, *exp_w2, *final_norm_g;
    float* out; unsigned char* ws; int ph_lo, ph_hi;
};
typedef const __attribute__((address_space(4))) Args* KArgs;
struct Ctx { KArgs a; unsigned char* lds; int tid, lane, wave, G, bid, vcu; };
#define BLOCK_SYNC() __syncthreads()

struct CvTile { const float* src; bf16* dst; int ld, K; float f8s; };
__device__ __forceinline__ void cv_load(const CvTile& T, int lane, f32x4 (&v)[8]) {
#pragma unroll
    for (int i = 0; i < 8; ++i) { const int idx = i * 64 + lane; v[i] = *(const f32x4*)(T.src + (size_t)(idx >> 3) * T.ld + (idx & 7) * 4); }
}
__device__ __forceinline__ void cv_store(const CvTile& T, int lane, const f32x4 (&v)[8], float* scr) {
#pragma unroll
    for (int i = 0; i < 8; ++i) { const int idx = i * 64 + lane; float* p = scr + (idx >> 3) * 33 + (idx & 7) * 4; p[0] = v[i][0]; p[1] = v[i][1]; p[2] = v[i][2]; p[3] = v[i][3]; }
    asm volatile("s_waitcnt lgkmcnt(0)" ::: "memory");
    const int c = lane & 7;
#pragma unroll
    for (int j = 0; j < 4; ++j) { const int n = (lane >> 3) + 8 * j; const float* s = scr + (8 * c) * 33 + n;
        if (T.f8s != 0.f) { const float q = T.f8s; v2u o; o.x = pg8::pk4_fp8(s[0 * 33] * q, s[1 * 33] * q, s[2 * 33] * q, s[3 * 33] * q); o.y = pg8::pk4_fp8(s[4 * 33] * q, s[5 * 33] * q, s[6 * 33] * q, s[7 * 33] * q);
            *(v2u*)((unsigned char*)T.dst + (size_t)n * T.K + 8 * c) = o; }
        else { v4u o; o.x = pk2(s[0 * 33], s[1 * 33]); o.y = pk2(s[2 * 33], s[3 * 33]); o.z = pk2(s[4 * 33], s[5 * 33]); o.w = pk2(s[6 * 33], s[7 * 33]);
            *(v4u*)(T.dst + (size_t)n * T.K + 8 * c) = o; } }
    asm volatile("s_waitcnt lgkmcnt(0)" ::: "memory");
}
constexpr int CV_WIN = 16 * 88, CV_WOUT = 16 * 32, CV_SMALL = 2 * (CV_WIN + CV_WOUT), CV_EXP = 3072, CV_EXPL = 16 * CV_EXP;
__device__ __forceinline__ CvTile cv_small(const Ctx& C, int q) {
    const int l = q / (CV_WIN + CV_WOUT); int r = q % (CV_WIN + CV_WOUT); CvTile T; T.f8s = 0.f;
    if (r < CV_WIN) { const int kb = r / 88, nb = r % 88; T.src = C.a->w_in + (size_t)l * DM * DIN + (size_t)(kb * 64) * DIN + nb * 32; T.ld = DIN; T.K = DM; T.dst = ((bf16*)(C.a->ws + WS_WIN)) + (size_t)l * NZ * DM + (size_t)(nb * 32) * DM + kb * 64; }
    else { r -= CV_WIN; const int kb = r / 32, nb = r % 32; T.src = C.a->w_out + (size_t)l * DM * DM + (size_t)(kb * 64) * DM + nb * 32; T.ld = DM; T.K = DM; T.dst = ((bf16*)(C.a->ws + WS_WOUT)) + (size_t)l * DM * DM + (size_t)(nb * 32) * DM + kb * 64; }
    return T;
}
__device__ __forceinline__ CvTile cv_expert(const Ctx& C, int l, int q) {
    const int e = q / CV_EXP, s = q % CV_EXP; const size_t le = (size_t)(l * NEXP + e); CvTile T;
#if MOE_FP8
    T.f8s = W_F8S;
    if (s < 2048) { const int which = s >> 10, r = s & 1023, kb = r / 64, nb = r % 64, n0 = nb * 32;
        T.src = (which ? C.a->exp_w3 : C.a->exp_w1) + le * DM * FF + (size_t)(kb * 64) * FF + n0; T.ld = FF; T.K = DM;
        T.dst = (bf16*)((unsigned char*)(C.a->ws + WS_W13) + le * 4096 * DM + (size_t)((n0 >> 7) * 256 + which * 128 + (n0 & 127)) * DM + kb * 64); }
    else { const int r = s - 2048, kb = r / 32, nb = r % 32; T.src = C.a->exp_w2 + le * FF * DM + (size_t)(kb * 64) * DM + nb * 32; T.ld = DM; T.K = FF; T.dst = (bf16*)((unsigned char*)(C.a->ws + WS_W2) + le * DM * FF + (size_t)(nb * 32) * FF + kb * 64); }
#else
    T.f8s = 0.f;
    if (s < 2048) { const int which = s >> 10, r = s & 1023, kb = r / 64, nb = r % 64, n0 = nb * 32;
        T.src = (which ? C.a->exp_w3 : C.a->exp_w1) + le * DM * FF + (size_t)(kb * 64) * FF + n0; T.ld = FF; T.K = DM;
        T.dst = ((bf16*)(C.a->ws + WS_W13)) + le * 4096 * DM + (size_t)((n0 >> 7) * 256 + which * 128 + (n0 & 127)) * DM + kb * 64; }
    else { const int r = s - 2048, kb = r / 32, nb = r % 32; T.src = C.a->exp_w2 + le * FF * DM + (size_t)(kb * 64) * DM + nb * 32; T.ld = DM; T.K = FF; T.dst = ((bf16*)(C.a->ws + WS_W2)) + le * DM * FF + (size_t)(nb * 32) * FF + kb * 64; }
#endif
    return T;
}
template <bool EXPERT> __device__ __forceinline__ void convert_stream(const Ctx& C, int l, int first, int stride, int total) {
    float* scr = (float*)C.lds + C.wave * (64 * 33);
    int it = first; if (it >= total) return;
    f32x4 va[8], vb[8], vc[8];
    CvTile Ta = EXPERT ? cv_expert(C, l, it) : cv_small(C, it), Tb = Ta, Tc = Ta;
    cv_load(Ta, C.lane, va);
    if (it + stride < total) { Tb = EXPERT ? cv_expert(C, l, it + stride) : cv_small(C, it + stride); cv_load(Tb, C.lane, vb); }
#pragma unroll 1
    for (;;) {
        if (it + 2 * stride < total) { Tc = EXPERT ? cv_expert(C, l, it + 2 * stride) : cv_small(C, it + 2 * stride); cv_load(Tc, C.lane, vc); }
        cv_store(Ta, C.lane, va, scr); it += stride; if (it >= total) break;
        if (it + 2 * stride < total) { Ta = EXPERT ? cv_expert(C, l, it + 2 * stride) : cv_small(C, it + 2 * stride); cv_load(Ta, C.lane, va); }
        cv_store(Tb, C.lane, vb, scr); it += stride; if (it >= total) break;
        if (it + 2 * stride < total) { Tb = EXPERT ? cv_expert(C, l, it + 2 * stride) : cv_small(C, it + 2 * stride); cv_load(Tb, C.lane, vb); }
        cv_store(Tc, C.lane, vc, scr); it += stride; if (it >= total) break;
    }
}
__device__ __forceinline__ void phase_init(Ctx& C) {
    float* lf = (float*)C.lds;
    for (int m = C.bid; m < 192; m += C.G) {
        const int l = m / 96, j0 = (m % 96) * 64;
        float* sc = lf; float* red = lf + 2048;
        for (int i = C.tid; i < 2048; i += NTHR) { const float v = (i < 1024) ? C.a->c[i] : C.a->c_ctx[i - 1024]; sc[i] = v / (1.0f + __expf(-v)); }
        BLOCK_SYNC();
        const float* W = C.a->ada_w + (size_t)l * DM * 6144 + j0 + C.lane;
        float a0 = 0.f, a1 = 0.f;
#pragma unroll 32
        for (int k = C.wave * 128; k < C.wave * 128 + 128; ++k) { const float w = W[(size_t)k * 6144]; a0 += sc[k] * w; a1 += sc[1024 + k] * w; }
        red[(C.wave * 2 + 0) * 64 + C.lane] = a0; red[(C.wave * 2 + 1) * 64 + C.lane] = a1;
        BLOCK_SYNC();
        if (C.tid < 128) { const int s = C.tid >> 6, j = C.tid & 63; float t = 0.f;
#pragma unroll
            for (int w = 0; w < 8; ++w) t += red[(w * 2 + s) * 64 + j];
            ((float*)(C.a->ws + WS_MOD))[(size_t)(l * 2 + s) * 6144 + j0 + j] = t + C.a->ada_b[l * 6144 + j0 + j]; }
        BLOCK_SYNC();
    }
    if (C.bid == C.G - 1) {
        for (int i = C.tid; i < 4096; i += NTHR) { const int pos = i >> 4, f = i & 15;
            const float inv = powf(10000.0f, -(float)(2 * f) / 32.0f); const float ang = (float)pos * inv;
            ((float*)(C.a->ws + WS_ROPE))[2 * i] = (float)cos((double)ang); ((float*)(C.a->ws + WS_ROPE))[2 * i + 1] = (float)sin((double)ang); }
    }
    BLOCK_SYNC();
    convert_stream<false>(C, 0, C.bid * NWAVES + C.wave, C.G * NWAVES, CV_SMALL);
}
constexpr int CV_BFREE0 = 203, CV_BPW = 10, CV_HPW = 6;
__device__ __forceinline__ int cv_nb(int G) { return (G == 256) ? (256 - CV_BFREE0) * NWAVES * CV_BPW : 0; }
__device__ __forceinline__ int cv_nh(int G, int l) { const int busy = (l == 0) ? 32 : 16; return (G > busy) ? (G - busy) * NWAVES * CV_HPW : 0; }
__device__ __forceinline__ void convert_experts_B(Ctx& C, int l) { if (C.G == 256 && C.bid >= CV_BFREE0) convert_stream<true>(C, l, (C.bid - CV_BFREE0) * NWAVES + C.wave, (256 - CV_BFREE0) * NWAVES, cv_nb(C.G)); }
__device__ __forceinline__ void convert_experts_H(Ctx& C, int l) { const int busy = (l == 0) ? 32 : 16; if (C.bid >= busy) convert_stream<true>(C, l, cv_nb(C.G) + (C.bid - busy) * NWAVES + C.wave, (C.G - busy) * NWAVES, cv_nb(C.G) + cv_nh(C.G, l)); }
__device__ __forceinline__ void convert_experts(Ctx& C, int l) { convert_stream<true>(C, l, cv_nb(C.G) + cv_nh(C.G, l) + C.bid * NWAVES + C.wave, C.G * NWAVES, CV_EXPL); }

__device__ __forceinline__ void stage_m16(Ctx& C, const float* src, int ld, int off, float* M16) {
    for (int c = C.tid; c < 1024; c += NTHR) { const f32x4* p = (const f32x4*)(src + (size_t)c * ld + off);
#pragma unroll
        for (int q = 0; q < 4; ++q) { const f32x4 v = p[q]; M16[(q * 4 + 0) * 1024 + c] = v[0]; M16[(q * 4 + 1) * 1024 + c] = v[1]; M16[(q * 4 + 2) * 1024 + c] = v[2]; M16[(q * 4 + 3) * 1024 + c] = v[3]; } }
    BLOCK_SYNC();
}
__device__ __forceinline__ void stage_mod(Ctx& C, const float* g, int l, int part_shift, float* MV) {
    for (int i = C.tid; i < 2048; i += NTHR) { const int var = i >> 10, c = i & 1023; const float* modp = ((const float*)(C.a->ws + WS_MOD)) + (size_t)(l * 2 + var) * 6144 + part_shift * 1024;
        MV[(var * 2 + 0) * 1024 + c] = g[c] * (1.0f + modp[1024 + c]); MV[(var * 2 + 1) * 1024 + c] = modp[c]; }
}
template <bool F8 = false> __device__ __forceinline__ void norm_mod_row(f32x4 (&v)[4], const float* gs, const float* sh, bf16* orow, int lane) {
    float ss = 0.f;
#pragma unroll
    for (int j = 0; j < 4; ++j) ss += (v[j][0] * v[j][0] + v[j][1] * v[j][1]) + (v[j][2] * v[j][2] + v[j][3] * v[j][3]);
    const float rstd = rsqrtf(wave_sum(ss) * (1.0f / 1024.0f) + EPSN);
#pragma unroll
    for (int j = 0; j < 4; ++j) { const int c = 4 * lane + 256 * j;
        const f32x4 gv = *(const f32x4*)(gs + c), sv = *(const f32x4*)(sh + c);
        const f32x4 h = (v[j] * rstd) * gv + sv; v[j] = h;
        if constexpr (F8) { *(unsigned*)((unsigned char*)orow + c) = pg8::pk4_fp8(h[0] * H2_F8S, h[1] * H2_F8S, h[2] * H2_F8S, h[3] * H2_F8S); }
        else { v2u w; w.x = pk2(h[0], h[1]); w.y = pk2(h[2], h[3]); *(v2u*)(orow + c) = w; } }
}
__device__ __forceinline__ float dot16(const f32x4 (&v)[4], const float* M16_, int lane) {
    unsigned zoff = 0u; asm volatile("" : "+s"(zoff));
    const __attribute__((address_space(3))) float* M16 = (const __attribute__((address_space(3))) float*)M16_ + zoff;
    float p[16];
    f32x4 wb[3][4];
#define D16_LOAD(e_) do { _Pragma("unroll") for (int j = 0; j < 4; ++j) wb[(e_) % 3][j] = *(const __attribute__((address_space(3))) f32x4*)(M16 + (e_) * 1024 + 4 * lane + 256 * j); } while (0)
    D16_LOAD(0); D16_LOAD(1);
#pragma unroll
    for (int e = 0; e < 16; ++e) {
        if (e + 2 < 16) D16_LOAD(e + 2);
        asm volatile("" ::: "memory");
        float s = 0.f;
#pragma unroll
        for (int j = 0; j < 4; ++j) { const f32x4 w = wb[e % 3][j]; s += (v[j][0] * w[0] + v[j][1] * w[1]) + (v[j][2] * w[2] + v[j][3] * w[3]); }
        p[e] = s; asm volatile("" : "+v"(p[e])); }
#undef D16_LOAD
    const bool b3 = (lane & 8) != 0, b2 = (lane & 4) != 0;
#pragma unroll
    for (int e = 0; e < 8; ++e) p[e] = swap32_sum(p[e], p[e + 8]);
#pragma unroll
    for (int e = 0; e < 4; ++e) p[e] = swap16_sum(p[e], p[e + 4]);
#pragma unroll
    for (int e = 0; e < 2; ++e) { const float send = b3 ? p[e] : p[e + 2], keep = b3 ? p[e + 2] : p[e]; p[e] = keep + dppf<DPP_ROR8>(send); }
    { const float send = b2 ? p[0] : p[1], keep = b2 ? p[1] : p[0]; p[0] = keep + dppf<DPP_HMIR>(send); }
    float r = p[0]; r += dppf<DPP_X1>(r); r += dppf<DPP_X2>(r);
    return r;
}
__device__ __forceinline__ const float* row_src0(const Ctx& C, int r) { return (r < CTXL) ? C.a->ctx + (size_t)r * DM : C.a->x + (size_t)(r - CTXL) * DM; }
__device__ __forceinline__ void row_A(Ctx& C, f32x4 (&v)[4], int r, const float* MV, const float* M16) {
    const float* mv = MV + (r < CTXL ? 2048 : 0);
    norm_mod_row(v, mv, mv + 1024, ((bf16*)(C.a->ws + WS_H)) + (size_t)r * DM, C.lane);
    const float o = dot16(v, M16, C.lane);
    if ((C.lane & 3) == 0) ((float*)(C.a->ws + WS_G))[(size_t)r * 16 + (C.lane >> 2)] = o;
}
__device__ __forceinline__ void phase_A0(Ctx& C) {
    const int gw = C.bid * NWAVES + C.wave, NGW = C.G * NWAVES;
    f32x4 va[4], vb[4]; int r = gw;
    if (r < R) { const float* src = row_src0(C, r);
#pragma unroll
        for (int j = 0; j < 4; ++j) va[j] = ((const f32x4*)src)[C.lane + 64 * j]; }
    if (r + NGW < R) { const float* src = row_src0(C, r + NGW);
#pragma unroll
        for (int j = 0; j < 4; ++j) vb[j] = ((const f32x4*)src)[C.lane + 64 * j]; }
    float* M16 = (float*)C.lds; float* MV = M16 + 16 * 1024; stage_mod(C, C.a->norm1_g, 0, 0, MV); stage_m16(C, C.a->w_in, DIN, NZ, M16);
#pragma unroll 1
    for (; r < R; r += NGW) {
        f32x4 v[4];
#pragma unroll
        for (int j = 0; j < 4; ++j) { v[j] = va[j]; va[j] = vb[j]; }
        if (r + 2 * NGW < R) { const float* src = row_src0(C, r + 2 * NGW);
#pragma unroll
            for (int j = 0; j < 4; ++j) vb[j] = ((const f32x4*)src)[C.lane + 64 * j]; }
        row_A(C, v, r, MV, M16);
    }
}
__device__ __forceinline__ void phase_G(Ctx& C, int l) {
    const int gw = C.bid * NWAVES + C.wave, NGW = C.G * NWAVES; const int r0 = (l == 0) ? 0 : CTXL;
    const float* XW = (const float*)(C.a->ws + WS_XW);
    f32x4 va[4], vb[4]; int r = r0 + gw;
    if (r < R) {
#pragma unroll
        for (int j = 0; j < 4; ++j) va[j] = ((const f32x4*)(XW + (size_t)r * DM))[C.lane + 64 * j]; }
    if (r + NGW < R) {
#pragma unroll
        for (int j = 0; j < 4; ++j) vb[j] = ((const f32x4*)(XW + (size_t)(r + NGW) * DM))[C.lane + 64 * j]; }
    float* M16 = (float*)C.lds; float* MV = M16 + 16 * 1024; stage_mod(C, C.a->norm2_g + l * DM, l, 3, MV); stage_m16(C, C.a->router_w + (size_t)l * DM * 16, 16, 0, M16);
#pragma unroll 1
    for (; r < R; r += NGW) {
        f32x4 v[4];
#pragma unroll
        for (int j = 0; j < 4; ++j) { v[j] = va[j]; va[j] = vb[j]; }
        if (r + 2 * NGW < R) {
#pragma unroll
            for (int j = 0; j < 4; ++j) vb[j] = ((const f32x4*)(XW + (size_t)(r + 2 * NGW) * DM))[C.lane + 64 * j]; }
        const float* mv = MV + (r < CTXL ? 2048 : 0);
#if MOE_FP8
        norm_mod_row<true>(v, mv, mv + 1024, (bf16*)((unsigned char*)(C.a->ws + WS_H2) + (size_t)r * DM), C.lane);
#else
        norm_mod_row(v, mv, mv + 1024, ((bf16*)(C.a->ws + WS_H2)) + (size_t)r * DM, C.lane);
#endif
        const float lg = dot16(v, M16, C.lane);
        float mx = lg;
        mx = fmaxf(mx, dppf<DPP_HMIR>(mx)); mx = fmaxf(mx, dppf<DPP_MIR>(mx)); mx = swap16_max(mx); mx = swap32_max(mx);
        const float o = __expf(lg - mx); float sum = o;
        sum += dppf<DPP_HMIR>(sum); sum += dppf<DPP_MIR>(sum); sum = swap16_sum(sum, sum); sum = swap32_sum(sum, sum);
        if ((C.lane & 3) == 0) ((float*)(C.a->ws + WS_AFF))[(size_t)(C.lane >> 2) * R + r] = o / sum;
    }
}
__device__ __forceinline__ void phase_K(Ctx& C, int l) {
    float* M16 = (float*)C.lds; float* MV = M16 + 16 * 1024; float* GV = MV + 4096;
    for (int i = C.tid; i < 2048; i += NTHR) GV[i] = ((const float*)(C.a->ws + WS_MOD))[(size_t)(l * 2 + (i >> 10)) * 6144 + 5 * 1024 + (i & 1023)];
    for (int i = C.tid; i < 1024; i += NTHR) GV[2048 + i] = C.a->final_norm_g[i];
    if (l == 0) { stage_mod(C, C.a->norm1_g + DM, 1, 0, MV); stage_m16(C, C.a->w_in + (size_t)DM * DIN, DIN, NZ, M16); } else BLOCK_SYNC();
    const int gw = C.bid * NWAVES + C.wave, NGW = C.G * NWAVES; const int r0 = (l == 0) ? 0 : CTXL;
    float* XW = (float*)(C.a->ws + WS_XW); const int* SLOT = (const int*)(C.a->ws + WS_SLOT); const bf16* Y = (const bf16*)(C.a->ws + WS_Y);
    f32x4 vn[4]; int sn = -1; int r = r0 + gw;
    if (r < R) { sn = (C.lane < 16) ? SLOT[(size_t)C.lane * R + r] : -1;
#pragma unroll
        for (int j = 0; j < 4; ++j) vn[j] = ((const f32x4*)(XW + (size_t)r * DM))[C.lane + 64 * j]; }
#pragma unroll 1
    for (; r < R; r += NGW) {
        f32x4 v[4], acc[4]; const int myslot = sn;
#pragma unroll
        for (int j = 0; j < 4; ++j) { v[j] = vn[j]; acc[j] = (f32x4){0.f, 0.f, 0.f, 0.f}; }
        unsigned long long mask = __ballot(myslot >= 0);
        while (mask) {
            const int e0 = __ffsll((long long)mask) - 1; mask &= mask - 1; const int e1 = mask ? (__ffsll((long long)mask) - 1) : -1; if (e1 >= 0) mask &= mask - 1;
            const int s0 = __shfl(myslot, e0), s1 = __shfl(myslot, e1 >= 0 ? e1 : e0);
            const bf16* y0 = Y + ((size_t)e0 * ESLOTS + s0) * DM; const bf16* y1 = Y + ((size_t)(e1 >= 0 ? e1 : e0) * ESLOTS + s1) * DM;
            v2u w0[4], w1[4];
#pragma unroll
            for (int j = 0; j < 4; ++j) { w0[j] = *(const v2u*)(y0 + 4 * C.lane + 256 * j); w1[j] = *(const v2u*)(y1 + 4 * C.lane + 256 * j); }
            const float f1 = (e1 >= 0) ? 1.0f : 0.0f;
#pragma unroll
            for (int j = 0; j < 4; ++j) { acc[j][0] += bf_lo(w0[j].x) + f1 * bf_lo(w1[j].x); acc[j][1] += bf_hi(w0[j].x) + f1 * bf_hi(w1[j].x); acc[j][2] += bf_lo(w0[j].y) + f1 * bf_lo(w1[j].y); acc[j][3] += bf_hi(w0[j].y) + f1 * bf_hi(w1[j].y); }
        }
        if (r + NGW < R) { sn = (C.lane < 16) ? SLOT[(size_t)C.lane * R + (r + NGW)] : -1;
#pragma unroll
            for (int j = 0; j < 4; ++j) vn[j] = ((const f32x4*)(XW + (size_t)(r + NGW) * DM))[C.lane + 64 * j]; }
        const float* g2 = GV + (r < CTXL ? 1024 : 0);
#pragma unroll
        for (int j = 0; j < 4; ++j) { const f32x4 gg = *(const f32x4*)(g2 + 4 * C.lane + 256 * j); v[j] = v[j] + gg * acc[j]; }
        if (l == 0) {
#pragma unroll
            for (int j = 0; j < 4; ++j) ((f32x4*)(XW + (size_t)r * DM))[C.lane + 64 * j] = v[j];
            row_A(C, v, r, MV, M16);
        } else {
            float ss = 0.f;
#pragma unroll
            for (int j = 0; j < 4; ++j) ss += (v[j][0] * v[j][0] + v[j][1] * v[j][1]) + (v[j][2] * v[j][2] + v[j][3] * v[j][3]);
            const float rstd = rsqrtf(wave_sum(ss) * (1.0f / 1024.0f) + EPSN);
#pragma unroll
            for (int j = 0; j < 4; ++j) { const f32x4 gv = *(const f32x4*)(GV + 2048 + 4 * C.lane + 256 * j); ((f32x4*)(C.a->out + (size_t)(r - CTXL) * DM))[C.lane + 64 * j] = v[j] * rstd * gv; }
        }
    }
}
#define MFMA16(a, b, c) __builtin_amdgcn_mfma_f32_16x16x32_bf16(a, b, c, 0, 0, 0)
constexpr float C2Q = 0.125f * 1.4426950408889634f;
constexpr float LOG2E = 1.4426950408889634f;
__device__ __forceinline__ float logsigmoidf(float x) { return fminf(x, 0.f) - __logf(1.0f + __expf(-fabsf(x))); }
__device__ __forceinline__ float ex2(float x) { return __builtin_amdgcn_exp2f(x); }

__device__ __forceinline__ void item_conv_prep(const Ctx& C0, int l, int c) {
    Ctx C = C0; { int t_ = C.tid; asm volatile("" : "+v"(t_)); C.tid = t_; C.lane = t_ & 63; }
    const int rbase = c * 128; const int slo = (rbase < CTXL) ? 0 : CTXL, shi = (rbase < CTXL) ? CTXL : R;
    const float* cw = C.a->conv_w + l * 3 * 256;
    const bf16* Z = (const bf16*)(C.a->ws + WS_Z);
    if (l == 0 || c >= 2) {
        for (int idx = C.tid; idx < 128 * 32; idx += NTHR) {
            const int row = idx >> 5, ch0 = (idx & 31) * 8, r = rbase + row; const bf16* z = Z + (size_t)r * NZ;
            const v4u zero = {0u, 0u, 0u, 0u};
            const bool hm = (r - 1 >= slo), hp = (r + 1 < shi);
            const v4u xm = hm ? *(const v4u*)(z - NZ + ZC_CONVX + ch0) : zero, cm = hm ? *(const v4u*)(z - NZ + ZC_CONVC + ch0) : zero;
            const v4u x0 = *(const v4u*)(z + ZC_CONVX + ch0), c0 = *(const v4u*)(z + ZC_CONVC + ch0), b0 = *(const v4u*)(z + ZC_CONVB + ch0);
            const v4u xp = hp ? *(const v4u*)(z + NZ + ZC_CONVX + ch0) : zero, cp = hp ? *(const v4u*)(z + NZ + ZC_CONVC + ch0) : zero;
            float o[8];
#pragma unroll
            for (int q = 0; q < 4; ++q) {
                const int ch = ch0 + 2 * q;
                const float w0a = cw[ch], w1a = cw[256 + ch], w2a = cw[512 + ch], w0b = cw[ch + 1], w1b = cw[256 + ch + 1], w2b = cw[512 + ch + 1];
                const float ya = w0a * (bf_lo(xm[q]) * bf_lo(cm[q])) + w1a * (bf_lo(x0[q]) * bf_lo(c0[q])) + w2a * (bf_lo(xp[q]) * bf_lo(cp[q]));
                const float yb = w0b * (bf_hi(xm[q]) * bf_hi(cm[q])) + w1b * (bf_hi(x0[q]) * bf_hi(c0[q])) + w2b * (bf_hi(xp[q]) * bf_hi(cp[q]));
                o[2 * q] = bf_lo(b0[q]) * ya; o[2 * q + 1] = bf_hi(b0[q]) * yb; }
            v4u w; w.x = pk2(o[0], o[1]); w.y = pk2(o[2], o[3]); w.z = pk2(o[4], o[5]); w.w = pk2(o[6], o[7]);
            *(v4u*)(((bf16*)(C.a->ws + WS_MIX)) + (size_t)r * DM + ch0) = w;
        }
    }
    for (int it = 0; it < 12; ++it) {
        const int task = it * 64 + (C.tid >> 3), sub = C.tid & 7, row = task / 6, hd = task % 6, r = rbase + row;
        const v4u zx = *(const v4u*)(Z + (size_t)r * NZ + ZC_Q + hd * 64 + sub * 8);
        float y[8];
#pragma unroll
        for (int q = 0; q < 4; ++q) { y[2 * q] = bf_lo(zx[q]); y[2 * q + 1] = bf_hi(zx[q]); }
        float ss = 0.f;
#pragma unroll
        for (int e = 0; e < 8; ++e) ss += y[e] * y[e];
        ss += dppf<DPP_X1>(ss); ss += dppf<DPP_X2>(ss); ss += dppf<DPP_HMIR>(ss);
        const float rstd = rsqrtf(ss * (1.0f / 64.0f) + EPSN);
        const float* gn = ((hd < 4) ? C.a->q_norm_g : C.a->k_norm_g) + l * 64 + sub * 8;
#pragma unroll
        for (int e = 0; e < 8; ++e) y[e] = y[e] * rstd * gn[e];
        float o[8];
        if (r >= CTXL) {
            const int p = r - CTXL, pos = (sub < 4) ? (p >> 6) : (p & 63); const float* rt = ((float*)(C.a->ws + WS_ROPE)) + (size_t)(pos * 16 + 8 * (sub & 1)) * 2; const bool first = ((sub & 2) == 0);
#pragma unroll
            for (int e = 0; e < 8; ++e) { const float pr = dppf<DPP_X2>(y[e]); const float cs = rt[2 * e], sn = rt[2 * e + 1]; o[e] = first ? (y[e] * cs - pr * sn) : (y[e] * cs + pr * sn); }
        } else {
#pragma unroll
            for (int e = 0; e < 8; ++e) o[e] = y[e];
        }
        const float scl = (hd < 4) ? C2Q : 1.0f;
        v4u w; w.x = pk2(o[0] * scl, o[1] * scl); w.y = pk2(o[2] * scl, o[3] * scl); w.z = pk2(o[4] * scl, o[5] * scl); w.w = pk2(o[6] * scl, o[7] * scl);
        if (hd < 4) *(v4u*)(((bf16*)(C.a->ws + WS_QB)) + (size_t)r * 256 + hd * 64 + sub * 8) = w; else *(v4u*)(((bf16*)(C.a->ws + WS_KB)) + (size_t)r * 128 + (hd - 4) * 64 + sub * 8) = w;
    }
    for (int idx = C.tid; idx < 128 * 16; idx += NTHR) { const int row = idx >> 4, ch = (idx & 15) * 8, r = rbase + row; *(v4u*)(((bf16*)(C.a->ws + WS_VB)) + (size_t)r * 128 + ch) = *(const v4u*)(Z + (size_t)r * NZ + ZC_V + ch); }
}

__device__ __forceinline__ v2u quad_pack(const v4u (&x)[4], int e, const float (&sc)[4]) {
    float f[4];
#pragma unroll
    for (int j = 0; j < 4; ++j) { const unsigned w = x[j][e >> 1]; f[j] = ((e & 1) ? bf_hi(w) : bf_lo(w)) * sc[j]; }
    v2u o; o.x = pk2(f[0], f[1]); o.y = pk2(f[2], f[3]); return o;
}

__device__ __forceinline__ void item_cmlp(const Ctx& C0, int l, int c) {
    Ctx C = C0; { int t_ = C.tid; asm volatile("" : "+v"(t_)); C.tid = t_; C.lane = t_ & 63; }
    constexpr int LD = 136;
    bf16* VNT = (bf16*)C.lds;
    bf16* WSB = VNT + 256 * LD;
    float* rs = (float*)(WSB + 128 * LD);
    const int rbase = c * 128; const float* gn = C.a->cmlp_norm_g + l * 256;
    const bf16* Z = (const bf16*)(C.a->ws + WS_Z);
    const int q4 = C.tid & 31, cg = C.tid >> 5;
    v4u xa[4], xb[4];
#pragma unroll
    for (int j = 0; j < 4; ++j) { const bf16* z = Z + (size_t)(rbase + 4 * q4 + j) * NZ + ZC_CV + cg * 16; xa[j] = *(const v4u*)z; xb[j] = *(const v4u*)(z + 8); }
    for (int i = 0; i < 16; ++i) { const int row = C.wave * 16 + i; const v2u w = *(const v2u*)(Z + (size_t)(rbase + row) * NZ + ZC_CV + 4 * C.lane);
        const float a = bf_lo(w.x), b = bf_hi(w.x), cc = bf_lo(w.y), d = bf_hi(w.y);
        const float ss = wave_sum((a * a + b * b) + (cc * cc + d * d)); if (C.lane == 0) rs[row] = rsqrtf(ss * (1.0f / 256.0f) + EPSN); }
    BLOCK_SYNC();
    { float sc[4];
#pragma unroll
        for (int j = 0; j < 4; ++j) sc[j] = rs[4 * q4 + j];
#pragma unroll
        for (int e = 0; e < 8; ++e) { const int ch = cg * 16 + e; const float g = gn[ch]; const float s2[4] = {sc[0] * g, sc[1] * g, sc[2] * g, sc[3] * g}; *(v2u*)(VNT + ch * LD + 4 * q4) = quad_pack(xa, e, s2); }
#pragma unroll
        for (int e = 0; e < 8; ++e) { const int ch = cg * 16 + 8 + e; const float g = gn[ch]; const float s2[4] = {sc[0] * g, sc[1] * g, sc[2] * g, sc[3] * g}; *(v2u*)(VNT + ch * LD + 4 * q4) = quad_pack(xb, e, s2); } }
    for (int h = 0; h < 4; ++h) {
        BLOCK_SYNC();
        const float* wsrc = C.a->cmlp_ws + (size_t)(l * 4 + h) * 128 * 128;
#pragma unroll
        for (int it = 0; it < 8; ++it) { const int idx = (it * NTHR + C.tid) * 4, t = idx >> 7, s = idx & 127; const f32x4 w = *(const f32x4*)(wsrc + idx);
            v2u o; o.x = pk2(w[0], w[1]); o.y = pk2(w[2], w[3]); *(v2u*)(WSB + t * LD + s) = o; }
        BLOCK_SYNC();
        const int t0 = C.wave * 16, fr = C.lane & 15, fq = C.lane >> 4;
        f32x4 acc[4];
#pragma unroll
        for (int n = 0; n < 4; ++n) acc[n] = (f32x4){0.f, 0.f, 0.f, 0.f};
#pragma unroll
        for (int ks = 0; ks < 4; ++ks) { const bf16x8 a = *(const bf16x8*)(WSB + (t0 + fr) * LD + ks * 32 + 8 * fq);
#pragma unroll
            for (int n = 0; n < 4; ++n) { const bf16x8 b = *(const bf16x8*)(VNT + (h * 64 + 16 * n + fr) * LD + ks * 32 + 8 * fq); acc[n] = MFMA16(a, b, acc[n]); } }
        const float* bs = C.a->cmlp_bs + (size_t)(l * 4 + h) * 128;
#pragma unroll
        for (int j = 0; j < 4; ++j) { const int t = t0 + 4 * fq + j, r = rbase + t; const float bb = bs[t];
#pragma unroll
            for (int n = 0; n < 4; ++n) { const int col = h * 64 + 16 * n + fr; const float u = bf2f(Z[(size_t)r * NZ + ZC_CU + col]); ((bf16*)(C.a->ws + WS_MIX))[(size_t)r * DM + 256 + col] = f2bf(u * (acc[n][j] + bb)); } }
    }
}

__device__ __forceinline__ void gate_scan(const Ctx& C, int l, int c, int h, int dir, float* b, float* g, float* pm) {
    const int lane = C.lane; const int t0 = dir ? 127 - 2 * lane : 2 * lane, t1 = dir ? 126 - 2 * lane : 2 * lane + 1;
    const float* G0 = ((const float*)(C.a->ws + WS_G)) + (size_t)(c * 128 + t0) * 16; const float* G1 = ((const float*)(C.a->ws + WS_G)) + (size_t)(c * 128 + t1) * 16;
    const float ib = C.a->ml_igate_b[l * 8 + dir * 4 + h], fb = C.a->ml_fgate_b[l * 8 + dir * 4 + h];
    const float li0 = G0[dir * 4 + h] + ib, li1 = G1[dir * 4 + h] + ib, lf0 = logsigmoidf(G0[8 + dir * 4 + h] + fb), lf1 = logsigmoidf(G1[8 + dir * 4 + h] + fb);
    float s0 = lf0, s1 = lf0 + lf1; float inc = s1;
#pragma unroll
    for (int o = 1; o < 64; o <<= 1) { const float x = __shfl_up(inc, o); if (lane >= o) inc += x; }
    const float exc = inc - s1; s0 += exc; s1 += exc;
    const float g0 = li0 - s0, g1 = li1 - s1;
    float m1 = fmaxf(g0, g1); float minc = m1;
#pragma unroll
    for (int o = 1; o < 64; o <<= 1) { const float x = __shfl_up(minc, o); if (lane >= o) minc = fmaxf(minc, x); }
    float mexc = __shfl_up(minc, 1); if (lane == 0) mexc = -INFINITY;
    b[t0] = s0; b[t1] = s1; g[t0] = g0; g[t1] = g1; pm[t0] = fmaxf(g0, mexc); pm[t1] = fmaxf(m1, mexc);
}

__device__ __forceinline__ void item_mlstate(const Ctx& C0, int l, int c, int h) {
    Ctx C = C0; { int t_ = C.tid; asm volatile("" : "+v"(t_)); C.tid = t_; C.lane = t_ & 63; }
    constexpr int LD = 136;
    bf16* VT = (bf16*)C.lds;
    bf16* KTF = VT + 80 * LD;
    bf16* KTB = KTF + 64 * LD;
    float* fv = (float*)(KTB + 64 * LD);
    float *bF = fv, *gF = fv + 128, *pF = fv + 256, *bB = fv + 384, *gB = fv + 512, *pB = fv + 640;
    const bf16* Z = (const bf16*)(C.a->ws + WS_Z);
    const int q4 = C.tid & 31, dg = (C.tid >> 5) & 7; const bool isv = C.tid >= 256;
    v4u x[4];
#pragma unroll
    for (int j = 0; j < 4; ++j) x[j] = *(const v4u*)(Z + (size_t)(c * 128 + 4 * q4 + j) * NZ + (isv ? ZC_MV : ZC_MK) + h * 64 + dg * 8);
    if (C.wave == 0) gate_scan(C, l, c, h, 0, bF, gF, pF);
    if (C.wave == 1) gate_scan(C, l, c, h, 1, bB, gB, pB);
    for (int i = C.tid; i < 16 * LD; i += NTHR) VT[64 * LD + i] = (i < 128) ? (bf16)0x3F80 : (bf16)0;
    BLOCK_SYNC();
    if (isv) { const float one[4] = {1.f, 1.f, 1.f, 1.f};
#pragma unroll
        for (int e = 0; e < 8; ++e) *(v2u*)(VT + (dg * 8 + e) * LD + 4 * q4) = quad_pack(x, e, one);
    } else { float wf[4], wb[4]; const float gmF = pF[127] , gmB = pB[0];
#pragma unroll
        for (int j = 0; j < 4; ++j) { wf[j] = 0.125f * ex2((gF[4 * q4 + j] - gmF) * LOG2E); wb[j] = 0.125f * ex2((gB[4 * q4 + j] - gmB) * LOG2E); }
#pragma unroll
        for (int e = 0; e < 8; ++e) { *(v2u*)(KTF + (dg * 8 + e) * LD + 4 * q4) = quad_pack(x, e, wf); *(v2u*)(KTB + (dg * 8 + e) * LD + 4 * q4) = quad_pack(x, e, wb); } }
    BLOCK_SYNC();
    const int dir = C.wave >> 2, nq = C.wave & 3, fr = C.lane & 15, fq = C.lane >> 4; const bf16* KT = dir ? KTB : KTF;
    f32x4 acc[5];
#pragma unroll
    for (int m = 0; m < 5; ++m) acc[m] = (f32x4){0.f, 0.f, 0.f, 0.f};
#pragma unroll
    for (int ks = 0; ks < 4; ++ks) { const bf16x8 b = *(const bf16x8*)(KT + (16 * nq + fr) * LD + ks * 32 + 8 * fq);
#pragma unroll
        for (int m = 0; m < 5; ++m) { const bf16x8 a = *(const bf16x8*)(VT + (16 * m + fr) * LD + ks * 32 + 8 * fq); acc[m] = MFMA16(a, b, acc[m]); } }
    const size_t sidx = (size_t)(c * 4 + h) * 2 + dir; float* co = ((float*)(C.a->ws + WS_CLOC)) + sidx * 4096;
#pragma unroll
    for (int m = 0; m < 4; ++m)
#pragma unroll
        for (int j = 0; j < 4; ++j) co[(16 * m + 4 * fq + j) * 64 + 16 * nq + fr] = acc[m][j];
    if (fq == 0) ((float*)(C.a->ws + WS_NLOC))[sidx * 64 + 16 * nq + fr] = acc[4][0];
    if (C.tid < 2) { const size_t si = (size_t)(c * 4 + h) * 2 + C.tid; const float bl = C.tid ? bB[0] : bF[127], gm = C.tid ? pB[0] : pF[127];
        ((float*)(C.a->ws + WS_SCAL))[si] = bl + gm; ((float*)(C.a->ws + (WS_SCAL + 1040 * 4)))[si] = bl; }
}
__device__ __forceinline__ void phase_C(Ctx& C, int l) {
    unsigned* qhead = (unsigned*)(C.a->ws + WS_CTL + 49152) + 64 * l;
    volatile unsigned* bc = (volatile unsigned*)(C.lds + (LDS_BYTES - 64));
    for (;;) {
        if (C.tid == 0) bc[0] = __hip_atomic_fetch_add(qhead, 1u, __ATOMIC_RELAXED, __HIP_MEMORY_SCOPE_AGENT);
        BLOCK_SYNC();
        const int it = (int)bc[0];
        BLOCK_SYNC();
        if (it >= NCHUNK * 6) break;
        if (it < NCHUNK) { if (l == 0 || it >= 2) item_cmlp(C, l, it); }
        else if (it < 2 * NCHUNK) item_conv_prep(C, l, it - NCHUNK);
        else { const int q = it - 2 * NCHUNK; item_mlstate(C, l, q >> 2, q & 3); }
        BLOCK_SYNC();
    }
}

__device__ __forceinline__ int chain_chunk(int dir, int i) { return dir == 0 ? i : (i == 0 ? 1 : (i == 1 ? 0 : NCHUNK + 1 - i)); }
__device__ __forceinline__ void seg_scan(const Ctx& C, float* basep, size_t cstride, bool valid, int h, int dir, int seg, int el, const float* dold, const float* dloc, float* segA, float* segB) {
    const int s0 = (seg < 2) ? seg * 33 : 66 + (seg - 2) * 32, slen = (seg < 2) ? 33 : 32;
    float L[33];
#pragma unroll
    for (int u = 0; u < 33; ++u) { L[u] = 0.f; if (valid && u < slen) { const int c = chain_chunk(dir, s0 + u); L[u] = basep[((size_t)(c * 4 + h) * 2 + dir) * cstride + el]; } }
    float st = 0.f, a = 1.f;
#pragma unroll
    for (int u = 0; u < 33; ++u) { if (u < slen) { const float lv = L[u]; L[u] = st; st = dold[s0 + u] * st + dloc[s0 + u] * lv; a *= dold[s0 + u]; } }
    segA[seg * 128 + el] = a; segB[seg * 128 + el] = st;
    BLOCK_SYNC();
    float s = 0.f;
    for (int j = 0; j < seg; ++j) s = segA[j * 128 + el] * s + segB[j * 128 + el];
    a = 1.f;
#pragma unroll
    for (int u = 0; u < 33; ++u) { if (valid && u < slen) { const int c = chain_chunk(dir, s0 + u); basep[((size_t)(c * 4 + h) * 2 + dir) * cstride + el] = L[u] + a * s; a *= dold[s0 + u]; } }
    BLOCK_SYNC();
}
__device__ __forceinline__ void phase_D(Ctx& C) {
    float* fv = (float*)C.lds; float *bl = fv, *ml = fv + 136, *mp = fv + 272, *dold = fv + 408, *dloc = fv + 544, *segA = fv + 680, *segB = fv + 680 + 512;
    for (int it = C.bid; it < 8 * 32; it += C.G) {
        const int chain = it >> 5, eb = it & 31, h = chain >> 1, dir = chain & 1;
        if (C.tid < NCHUNK) { const int c = chain_chunk(dir, C.tid); const size_t si = (size_t)(c * 4 + h) * 2 + dir; bl[C.tid] = ((float*)(C.a->ws + (WS_SCAL + 1040 * 4)))[si]; ml[C.tid] = ((float*)(C.a->ws + WS_SCAL))[si]; }
        BLOCK_SYNC();
        if (C.wave == 0) {
            const float b0 = bl[C.lane], b1 = bl[64 + C.lane], b2 = bl[128 + (C.lane & 1)], m0 = ml[C.lane], m1 = ml[64 + C.lane], m2 = ml[128 + (C.lane & 1)];
            float m = 0.f, r0 = 0.f, r1 = 0.f, r2 = 0.f;
#pragma unroll 2
            for (int i = 0; i < 64; ++i) { r0 = (C.lane == i) ? m : r0; m = fmaxf(m + __int_as_float(__builtin_amdgcn_readlane(__float_as_int(b0), i)), __int_as_float(__builtin_amdgcn_readlane(__float_as_int(m0), i))); }
#pragma unroll 2
            for (int i = 0; i < 64; ++i) { r1 = (C.lane == i) ? m : r1; m = fmaxf(m + __int_as_float(__builtin_amdgcn_readlane(__float_as_int(b1), i)), __int_as_float(__builtin_amdgcn_readlane(__float_as_int(m1), i))); }
#pragma unroll
            for (int i = 0; i < 2; ++i) { r2 = (C.lane == i) ? m : r2; m = fmaxf(m + __int_as_float(__builtin_amdgcn_readlane(__float_as_int(b2), i)), __int_as_float(__builtin_amdgcn_readlane(__float_as_int(m2), i))); }
            mp[C.lane] = r0; mp[64 + C.lane] = r1; if (C.lane < 2) mp[128 + C.lane] = r2; if (C.lane == 2) mp[130] = m;
        }
        BLOCK_SYNC();
        if (C.tid < NCHUNK) { const int i = C.tid; dold[i] = __expf(bl[i] + mp[i] - mp[i + 1]); dloc[i] = __expf(ml[i] - mp[i + 1]);
            if (eb == 0) { const int c = chain_chunk(dir, i); ((float*)(C.a->ws + (WS_SCAL + 2080 * 4)))[(size_t)(c * 4 + h) * 2 + dir] = mp[i]; } }
        BLOCK_SYNC();
        const int seg = C.wave >> 1, el = (C.wave & 1) * 64 + C.lane;
        seg_scan(C, ((float*)(C.a->ws + WS_CLOC)) + eb * 128, 4096, true, h, dir, seg, el, dold, dloc, segA, segB);
        if (eb == 31) seg_scan(C, ((float*)(C.a->ws + WS_NLOC)), 64, el < 64, h, dir, seg, el, dold, dloc, segA, segB);
    }
}
__device__ __forceinline__ void item_mlout(const Ctx& C0, int l, int c, int h) {
    Ctx C = C0; { int t_ = C.tid; asm volatile("" : "+v"(t_)); C.tid = t_; C.lane = t_ & 63; }
    constexpr int LQ = 72, LA = 264;
    bf16* QS = (bf16*)C.lds;
    bf16* KS = QS + 128 * LQ;
    bf16* A2 = KS + 144 * LQ;
    bf16* B2T = A2 + 128 * LA;
    float* fv = (float*)(B2T + 64 * LA);
    float *bF = fv, *gF = fv + 128, *pF = fv + 256, *bB = fv + 384, *gB = fv + 512, *pB = fv + 640, *wiF = fv + 768, *wiB = fv + 896, *cF = fv + 1024, *cB = fv + 1152;
    float *rowF = pF, *rowB = pB, *emF = bF, *emB = bB;
    static_assert((128 * LQ + 144 * LQ + 128 * LA + 64 * LA) * 2 + 1280 * 4 <= LDS_BYTES - 64, "mlout LDS map");
    const int rbase = c * 128; const size_t siF = (size_t)(c * 4 + h) * 2, siB = siF + 1;
    const bf16* Z = (const bf16*)(C.a->ws + WS_Z);
    const int q4 = C.tid & 31, dg = (C.tid >> 5) & 7;
    v4u xv[4];
    if (C.tid < 256) {
#pragma unroll
        for (int j = 0; j < 4; ++j) xv[j] = *(const v4u*)(Z + (size_t)(rbase + 4 * q4 + j) * NZ + ZC_MV + h * 64 + dg * 8); }
    if (C.wave == 0) gate_scan(C, l, c, h, 0, bF, gF, pF);
    if (C.wave == 1) gate_scan(C, l, c, h, 1, bB, gB, pB);
#pragma unroll
    for (int it = 0; it < 2; ++it) { const int idx = it * NTHR + C.tid, t = idx >> 3, ch = (idx & 7) * 8; const bf16* z = Z + (size_t)(rbase + t) * NZ + h * 64 + ch;
        *(v4u*)(QS + t * LQ + ch) = *(const v4u*)(z + ZC_MQ);
        const v4u kk = *(const v4u*)(z + ZC_MK); v4u ko;
#pragma unroll
        for (int q = 0; q < 4; ++q) ko[q] = pk2(bf_lo(kk[q]) * 0.125f, bf_hi(kk[q]) * 0.125f);
        *(v4u*)(KS + t * LQ + ch) = ko; }
#pragma unroll
    for (int it = 0; it < 4; ++it) { const int idx = (it * NTHR + C.tid) * 4, dir = idx >> 12, e = idx & 4095, v = e >> 6, k = e & 63;
        const f32x4 cv = *(const f32x4*)(((float*)(C.a->ws + WS_CLOC)) + (siF + dir) * 4096 + e); v2u o; o.x = pk2(cv[0], cv[1]); o.y = pk2(cv[2], cv[3]); *(v2u*)(B2T + v * LA + 128 + dir * 64 + k) = o; }
    if (C.tid < 128) KS[(128 + (C.tid >> 6)) * LQ + (C.tid & 63)] = f2bf(((float*)(C.a->ws + WS_NLOC))[siF * 64 + C.tid]);
    for (int i = C.tid; i < 14 * LQ; i += NTHR) KS[130 * LQ + i] = (bf16)0;
    if (C.tid < 256) { const float one[4] = {1.f, 1.f, 1.f, 1.f};
#pragma unroll
        for (int e = 0; e < 8; ++e) *(v2u*)(B2T + (dg * 8 + e) * LA + 4 * q4) = quad_pack(xv, e, one); }
    const float mpF = ((float*)(C.a->ws + (WS_SCAL + 2080 * 4)))[siF], mpB = ((float*)(C.a->ws + (WS_SCAL + 2080 * 4)))[siB];
    BLOCK_SYNC();
    if (C.tid < 128) { const int t = C.tid; const float mx = fmaxf(mpF, pF[t]), bb = bF[t]; rowF[t] = -mx * LOG2E; wiF[t] = ex2((mpF - mx) * LOG2E); emF[t] = ex2(-(bb + mx) * LOG2E); gF[t] *= LOG2E; }
    else if (C.tid < 256) { const int t = C.tid - 128; const float mx = fmaxf(mpB, pB[t]), bb = bB[t]; rowB[t] = -mx * LOG2E; wiB[t] = ex2((mpB - mx) * LOG2E); emB[t] = ex2(-(bb + mx) * LOG2E); gB[t] *= LOG2E; }
    BLOCK_SYNC();
    const int w = C.wave, t0 = w * 16, fr = C.lane & 15, fq = C.lane >> 4;
    {
        f32x4 S[9];
#pragma unroll
        for (int n = 0; n < 9; ++n) S[n] = (f32x4){0.f, 0.f, 0.f, 0.f};
#pragma unroll
        for (int ks = 0; ks < 2; ++ks) { const bf16x8 a = *(const bf16x8*)(QS + (t0 + fr) * LQ + ks * 32 + 8 * fq);
#pragma unroll
            for (int n = 0; n < 9; ++n) { const bf16x8 b = *(const bf16x8*)(KS + (16 * n + fr) * LQ + ks * 32 + 8 * fq); S[n] = MFMA16(a, b, S[n]); } }
#pragma unroll
        for (int j = 0; j < 4; ++j) { const int t = t0 + 4 * fq + j; const float rF_ = rowF[t], rB_ = rowB[t];
            const float nqF = __shfl(S[8][j], (C.lane & 48)), nqB = __shfl(S[8][j], (C.lane & 48) + 1);
            float pf[8], pb[8]; float sF = 0.f, sB = 0.f;
#pragma unroll
            for (int n = 0; n < 8; ++n) { const int s = 16 * n + fr; const float sv = S[n][j]; pf[n] = 0.f; pb[n] = 0.f;
                if (n <= w) { const float e = sv * ex2(rF_ + gF[s]); pf[n] = (n < w || s <= t) ? e : 0.f; }
                if (n >= w) { const float e = sv * ex2(rB_ + gB[s]); pb[n] = (n > w || s >= t) ? e : 0.f; }
                sF += pf[n]; sB += pb[n]; }
#pragma unroll
            for (int o = 0; o < 1; ++o) { sF += dppf<DPP_X1>(sF); sB += dppf<DPP_X1>(sB); sF += dppf<DPP_X2>(sF); sB += dppf<DPP_X2>(sB); sF += dppf<DPP_HMIR>(sF); sB += dppf<DPP_HMIR>(sB); sF += dppf<DPP_MIR>(sF); sB += dppf<DPP_MIR>(sB); }
            const float wf = wiF[t], wb = wiB[t];
            const float denF = sF + wf * nqF, denB = sB + wb * nqB;
            const float rf = 1.0f / fmaxf(fabsf(denF), emF[t]), rb = 1.0f / fmaxf(fabsf(denB), emB[t]);
#pragma unroll
            for (int n = 0; n < 8; ++n) A2[t * LA + 16 * n + fr] = f2bf(pf[n] * rf + pb[n] * rb);
            if (fr == 0) { cF[t] = wf * rf; cB[t] = wb * rb; }
        }
    }
    BLOCK_SYNC();
#pragma unroll
    for (int it = 0; it < 2; ++it) { const int idx = it * NTHR + C.tid, t = idx >> 3, ch = (idx & 7) * 8; const v4u qq = *(const v4u*)(QS + t * LQ + ch); const float sf = cF[t], sb = cB[t]; v4u of, ob;
#pragma unroll
        for (int q = 0; q < 4; ++q) { const float a = bf_lo(qq[q]), b = bf_hi(qq[q]); of[q] = pk2(a * sf, b * sf); ob[q] = pk2(a * sb, b * sb); }
        *(v4u*)(A2 + t * LA + 128 + ch) = of; *(v4u*)(A2 + t * LA + 192 + ch) = ob; }
    BLOCK_SYNC();
    f32x4 acc[4];
#pragma unroll
    for (int n = 0; n < 4; ++n) acc[n] = (f32x4){0.f, 0.f, 0.f, 0.f};
#pragma unroll
    for (int ks = 0; ks < 8; ++ks) { const bf16x8 a = *(const bf16x8*)(A2 + (t0 + fr) * LA + ks * 32 + 8 * fq);
#pragma unroll
        for (int n = 0; n < 4; ++n) { const bf16x8 b = *(const bf16x8*)(B2T + (16 * n + fr) * LA + ks * 32 + 8 * fq); acc[n] = MFMA16(a, b, acc[n]); } }
    const float* ng = C.a->ml_norm_g + l * 256 + h * 64;
#pragma unroll
    for (int j = 0; j < 4; ++j) { const int t = t0 + 4 * fq + j, r = rbase + t; float ss = 0.f;
#pragma unroll
        for (int n = 0; n < 4; ++n) ss += acc[n][j] * acc[n][j];
#pragma unroll
        for (int o = 0; o < 1; ++o) { ss += dppf<DPP_X1>(ss); ss += dppf<DPP_X2>(ss); ss += dppf<DPP_HMIR>(ss); ss += dppf<DPP_MIR>(ss); }
        const float rstd = rsqrtf(ss * (1.0f / 64.0f) + EPSN);
#pragma unroll
        for (int n = 0; n < 4; ++n) { const int d = 16 * n + fr; const float po = bf2f(Z[(size_t)r * NZ + ZC_MO + h * 64 + d]);
            ((bf16*)(C.a->ws + WS_MIX))[(size_t)r * DM + 768 + h * 64 + d] = f2bf(acc[n][j] * rstd * ng[d] / (1.0f + __expf(-po))); } }
}

template <int NB> __device__ __forceinline__ void topk_pick(const Ctx& C, unsigned* hist, unsigned* wtot, unsigned* sh, unsigned kk, unsigned prefix_hi, int shift) {
    constexpr int NBT = NB / NTHR;
    unsigned h[NBT], p[NBT]; unsigned run = 0u;
#pragma unroll
    for (int q = 0; q < NBT; ++q) { h[q] = hist[C.tid * NBT + q]; run += h[q]; p[q] = run; }
    unsigned inc = run;
#pragma unroll
    for (int o = 1; o < 64; o <<= 1) { const unsigned a = __shfl_up(inc, o); if (C.lane >= o) inc += a; }
    if (C.lane == 63) wtot[C.wave] = inc;
    BLOCK_SYNC();
    unsigned off = inc - run, N = 0u;
#pragma unroll
    for (int w = 0; w < NWAVES; ++w) { const unsigned x = wtot[w]; N += x; if (w < C.wave) off += x; }
#pragma unroll
    for (int q = 0; q < NBT; ++q) { const unsigned pin = off + p[q], sex = N - pin, sin = sex + h[q];
        if (sin >= kk && sex < kk) { sh[0] = prefix_hi | ((unsigned)(C.tid * NBT + q) << shift); sh[1] = kk - sex; } }
    BLOCK_SYNC();
}
__device__ __forceinline__ void item_topk(const Ctx& C0, int e, int set) {
    Ctx C = C0; { int t_ = C.tid; asm volatile("" : "+v"(t_)); C.tid = t_; C.lane = t_ & 63; }
    unsigned* lv = (unsigned*)C.lds;
    unsigned* hist = lv + 33 * 512;
    unsigned* sh = hist + 2048;
    unsigned* wtot = sh + 8;
    const int n = set ? CTXL : SEQL, cap = set ? CAPC : CAPL, rowoff = set ? 0 : CTXL;
    const float* aff = ((float*)(C.a->ws + WS_AFF)) + (size_t)e * R + rowoff;
    const int base = C.tid * 32, lbase = C.tid * 33;
#pragma unroll
    for (int q = 0; q < 8; ++q) { const int k4 = (q * NTHR + C.tid) * 4; v4u w = {0u, 0u, 0u, 0u}; if (k4 < n) w = *(const v4u*)(aff + k4);
        unsigned* p = lv + k4 + (k4 >> 5); p[0] = w.x; p[1] = w.y; p[2] = w.z; p[3] = w.w; }
    BLOCK_SYNC();
    unsigned prefix, kk = (unsigned)cap;
    for (int i = C.tid; i < 2048; i += NTHR) hist[i] = 0u;
    BLOCK_SYNC();
#pragma unroll 4
    for (int i = 0; i < 32; ++i) { const unsigned v = lv[lbase + i]; atomicAdd(&hist[v >> 19], 1u); }
    BLOCK_SYNC();
    topk_pick<2048>(C, hist, wtot, sh, kk, 0u, 19);
    prefix = sh[0]; kk = sh[1];
    BLOCK_SYNC();
    for (int i = C.tid; i < 1024; i += NTHR) hist[i] = 0u;
    BLOCK_SYNC();
#pragma unroll 4
    for (int i = 0; i < 32; ++i) { const unsigned v = lv[lbase + i]; if ((v >> 19) == (prefix >> 19)) atomicAdd(&hist[(v >> 9) & 1023u], 1u); }
    BLOCK_SYNC();
    topk_pick<1024>(C, hist, wtot, sh, kk, prefix, 9);
    prefix = sh[0]; kk = sh[1];
    BLOCK_SYNC();
    if (C.tid < 512) hist[C.tid] = 0u;
    BLOCK_SYNC();
#pragma unroll 4
    for (int i = 0; i < 32; ++i) { const unsigned v = lv[lbase + i]; if ((v >> 9) == (prefix >> 9)) atomicAdd(&hist[v & 511u], 1u); }
    BLOCK_SYNC();
    topk_pick<512>(C, hist, wtot, sh, kk, prefix, 0);
    prefix = sh[0]; kk = sh[1];
    BLOCK_SYNC();
    const unsigned T = prefix, need_eq = kk;
    unsigned cgt = 0u, ceq = 0u;
#pragma unroll 4
    for (int i = 0; i < 32; ++i) { const unsigned v = lv[lbase + i]; cgt += (v > T) ? 1u : 0u; ceq += (v == T) ? 1u : 0u; }
    unsigned igt = cgt, ieq = ceq;
#pragma unroll
    for (int o = 1; o < 64; o <<= 1) { const unsigned a = __shfl_up(igt, o), b = __shfl_up(ieq, o); if (C.lane >= o) { igt += a; ieq += b; } }
    if (C.lane == 63) { wtot[C.wave] = igt; wtot[8 + C.wave] = ieq; }
    BLOCK_SYNC();
    unsigned ogt = igt - cgt, oeq = ieq - ceq;
    for (int w = 0; w < C.wave; ++w) { ogt += wtot[w]; oeq += wtot[8 + w]; }
    const int slot0 = set ? CAPL : 0;
    int* IDXp = ((int*)(C.a->ws + WS_IDX)) + e * ESLOTS; float* GATEp = ((float*)(C.a->ws + WS_GATE)) + e * ESLOTS; int* SLOTp = ((int*)(C.a->ws + WS_SLOT)) + (size_t)e * R + rowoff;
#pragma unroll 2
    for (int i = 0; i < 32; ++i) {
        const int tok = base + i; const unsigned v = lv[lbase + i];
        const bool gt = v > T, eq = v == T; const bool sel = gt || (eq && oeq < need_eq);
        int slot = -1;
        if (sel && tok < n) { slot = slot0 + (int)(ogt + (oeq < need_eq ? oeq : need_eq)); IDXp[slot] = rowoff + tok; GATEp[slot] = __uint_as_float(v); }
        lv[lbase + i] = (unsigned)slot;
        ogt += gt ? 1u : 0u; oeq += eq ? 1u : 0u;
    }
    BLOCK_SYNC();
    for (int k = C.tid; k < n; k += NTHR) SLOTp[k] = (int)lv[k + (k >> 5)];
    if (set) { for (int s = CAPL + CAPC + C.tid; s < ESLOTS; s += NTHR) { IDXp[s] = 0; GATEp[s] = 0.f; } }
    BLOCK_SYNC();
}
__device__ __forceinline__ void phase_H(Ctx& C, int l) {
    const int nitems = (l == 0) ? 32 : 16;
    for (int it = C.bid; it < nitems; it += C.G) item_topk(C, it & 15, it >> 4);
    convert_experts_H(C, l);
}
__device__ __forceinline__ void skinny_mma(const bf16* a0, const bf16* a1, const bf16* b0, const bf16* b1, int K, int fq, f32x4 (&acc)[2][2]) {
#pragma unroll 8
    for (int k0 = 0; k0 < K; k0 += 32) {
        const bf16x8 fa0 = *(const bf16x8*)(a0 + k0 + 8 * fq), fa1 = *(const bf16x8*)(a1 + k0 + 8 * fq), fb0 = *(const bf16x8*)(b0 + k0 + 8 * fq), fb1 = *(const bf16x8*)(b1 + k0 + 8 * fq);
        acc[0][0] = MFMA16(fa0, fb0, acc[0][0]); acc[0][1] = MFMA16(fa0, fb1, acc[0][1]); acc[1][0] = MFMA16(fa1, fb0, acc[1][0]); acc[1][1] = MFMA16(fa1, fb1, acc[1][1]);
    }
}
#define SK_ZERO(acc) do { _Pragma("unroll") for (int a_ = 0; a_ < 2; ++a_) _Pragma("unroll") for (int b_ = 0; b_ < 2; ++b_) acc[a_][b_] = (f32x4){0.f, 0.f, 0.f, 0.f}; } while (0)
template <int NS> __device__ __forceinline__ void sk_reduce(const Ctx& C, f32x4 (&acc)[2][2]) {
    float* red = (float*)C.lds;
#pragma unroll
    for (int a = 0; a < 2; ++a)
#pragma unroll
        for (int b = 0; b < 2; ++b)
#pragma unroll
            for (int j = 0; j < 4; ++j) red[(C.wave * 16 + (a * 2 + b) * 4 + j) * 64 + C.lane] = acc[a][b][j];
    BLOCK_SYNC();
    if ((C.wave % NS) == 0) {
#pragma unroll
        for (int a = 0; a < 2; ++a)
#pragma unroll
            for (int b = 0; b < 2; ++b)
#pragma unroll
                for (int j = 0; j < 4; ++j) { float s = acc[a][b][j];
#pragma unroll
                    for (int w = 1; w < NS; ++w) s += red[((C.wave + w) * 16 + (a * 2 + b) * 4 + j) * 64 + C.lane];
                    acc[a][b][j] = s; } }
    BLOCK_SYNC();
}
__device__ __forceinline__ void skinny_F0(const Ctx& C) {
    const int fr = C.lane & 15, fq = C.lane >> 4;
    for (int it = C.bid; it < 8 * 32; it += C.G) {
        const int rb = it >> 5, cb = it & 31, kb = C.wave * 128;
        const bf16* A = ((const bf16*)(C.a->ws + WS_MIX)) + (size_t)(rb * 32 + fr) * DM + kb; const bf16* B = ((const bf16*)(C.a->ws + WS_WOUT)) + (size_t)(cb * 32 + fr) * DM + kb;
        f32x4 acc[2][2]; SK_ZERO(acc);
        skinny_mma(A, A + 16 * DM, B, B + 16 * DM, 128, fq, acc);
        sk_reduce<8>(C, acc);
        if (C.wave == 0) {
            const float* g1 = ((const float*)(C.a->ws + WS_MOD)) + (size_t)1 * 6144 + 2 * 1024;
#pragma unroll
            for (int mi = 0; mi < 2; ++mi)
#pragma unroll
                for (int ni = 0; ni < 2; ++ni)
#pragma unroll
                    for (int j = 0; j < 4; ++j) { const int r = rb * 32 + mi * 16 + 4 * fq + j, c = cb * 32 + ni * 16 + fr;
                        ((float*)(C.a->ws + WS_XW))[(size_t)r * DM + c] = C.a->ctx[(size_t)r * DM + c] + g1[c] * acc[mi][ni][j]; }
        }
    }
}
__device__ __forceinline__ void skinny_J0(const Ctx& C) {
    const int fr = C.lane & 15, fq = C.lane >> 4;
    for (int it0 = C.bid * 2; it0 < 16 * 32; it0 += C.G * 2) {
        const int it = it0 + (C.wave >> 2), e = it >> 5, cb = it & 31, kb = (C.wave & 3) * 512;
        f32x4 acc[2][2]; SK_ZERO(acc);
#if MOE_FP8
        {
            const unsigned char* A = (const unsigned char*)(C.a->ws + WS_HID) + ((size_t)e * ESLOTS + CAPL + fr) * FF + kb + 32 * fq; const unsigned char* B = (const unsigned char*)(C.a->ws + WS_W2) + ((size_t)e * DM + cb * 32 + fr) * FF + kb + 32 * fq;
#pragma unroll
            for (int st = 0; st < 4; ++st) {
                const pg8::i32x8 a0 = *(const pg8::i32x8*)(A + st * 128), a1 = *(const pg8::i32x8*)(A + 16 * FF + st * 128), b0 = *(const pg8::i32x8*)(B + st * 128), b1 = *(const pg8::i32x8*)(B + 16 * FF + st * 128);
                acc[0][0] = __builtin_amdgcn_mfma_scale_f32_16x16x128_f8f6f4(a0, b0, acc[0][0], 0, 0, 0, 0x7F7F7F7F, 0, 0x7F7F7F7F); acc[0][1] = __builtin_amdgcn_mfma_scale_f32_16x16x128_f8f6f4(a0, b1, acc[0][1], 0, 0, 0, 0x7F7F7F7F, 0, 0x7F7F7F7F);
                acc[1][0] = __builtin_amdgcn_mfma_scale_f32_16x16x128_f8f6f4(a1, b0, acc[1][0], 0, 0, 0, 0x7F7F7F7F, 0, 0x7F7F7F7F); acc[1][1] = __builtin_amdgcn_mfma_scale_f32_16x16x128_f8f6f4(a1, b1, acc[1][1], 0, 0, 0, 0x7F7F7F7F, 0, 0x7F7F7F7F); }
        }
        const float osc = 1.0f / (HID_F8S * W_F8S);
#else
        { const bf16* A = ((const bf16*)(C.a->ws + WS_HID)) + ((size_t)e * ESLOTS + CAPL + fr) * FF + kb; const bf16* B = ((const bf16*)(C.a->ws + WS_W2)) + ((size_t)e * DM + cb * 32 + fr) * FF + kb;
          skinny_mma(A, A + 16 * FF, B, B + 16 * FF, 512, fq, acc); }
        const float osc = 1.0f;
#endif
        sk_reduce<4>(C, acc);
        if ((C.wave & 3) == 0) {
#pragma unroll
            for (int mi = 0; mi < 2; ++mi)
#pragma unroll
                for (int j = 0; j < 4; ++j) { const int slot = CAPL + mi * 16 + 4 * fq + j; const float gt = ((const float*)(C.a->ws + WS_GATE))[e * ESLOTS + slot] * osc;
#pragma unroll
                    for (int ni = 0; ni < 2; ++ni) ((bf16*)(C.a->ws + WS_Y))[((size_t)e * ESLOTS + slot) * DM + cb * 32 + ni * 16 + fr] = f2bf(acc[mi][ni][j] * gt); }
        }
    }
}
#define LAS __attribute__((address_space(3)))
#define XB_TMO      128
#define XB_XCNT(j)  (256  + 64 * (j))
#define XB_XSUB(j)  (1280 + 64 * (j))
#define XB_XGEN(j)  (2304 + 64 * (j))
#define XB_TOP      3328
#define XB_TOPGEN   3392
#define XCD_BAR_WORDS 3456
#define XB_SPIN_CAP (1u << 18)

__device__ __forceinline__ unsigned xb_ld(unsigned* p)              { return __hip_atomic_load(p, __ATOMIC_RELAXED, __HIP_MEMORY_SCOPE_AGENT); }
__device__ __forceinline__ unsigned xb_add(unsigned* p, unsigned v) { return __hip_atomic_fetch_add(p, v, __ATOMIC_RELAXED, __HIP_MEMORY_SCOPE_AGENT); }
__device__ __forceinline__ unsigned xb_xcc_id() { return (unsigned)__builtin_amdgcn_s_getreg((3 << 11) | 20) & 0xFu; }
#define XB_SPIN(cond, bar) do { unsigned _sp = 0; while (cond) { __builtin_amdgcn_s_sleep(1); \
    if ((++_sp & 255u) == 0u) { if (xb_ld(&(bar)[XB_TMO])) break; if (_sp > XB_SPIN_CAP) { atomicAdd(&(bar)[XB_TMO], 1u); break; } } } } while (0)

struct XcdBarrier {
    unsigned* bar; unsigned x;
    volatile LAS unsigned* st;
};

__device__ __forceinline__ XcdBarrier xcd_barrier_post(unsigned* bar, volatile LAS unsigned* st) {
    XcdBarrier b; b.bar = bar; b.x = xb_xcc_id(); b.st = st;
    if (threadIdx.x == 0) (void)xb_add(&bar[XB_XCNT(b.x)], 1u);
    return b;
}
__device__ __forceinline__ void xcd_barrier_complete(unsigned* bar, unsigned x, unsigned& nloc, unsigned& nx) {
    const unsigned G = gridDim.x * gridDim.y * gridDim.z;
    unsigned sum, cnt, mine, sp = 0u;
    for (;;) {
        sum = 0u; cnt = 0u; mine = 0u;
#pragma unroll
        for (unsigned j = 0; j < 16; ++j) { const unsigned c = xb_ld(&bar[XB_XCNT(j)]); sum += c; cnt += (c > 0u) ? 1u : 0u; mine = (j == x) ? c : mine; }
        if (sum == G) break;
        __builtin_amdgcn_s_sleep(1);
        if ((++sp & 255u) == 0u) { if (xb_ld(&bar[XB_TMO])) break; if (sp > XB_SPIN_CAP) { atomicAdd(&bar[XB_TMO], 1u); break; } }
    }
    nloc = mine > 0u ? mine : 1u; nx = cnt > 0u ? cnt : 1u;
}

__device__ __forceinline__ void xcd_barrier(const XcdBarrier& b) {
    asm volatile("s_waitcnt vmcnt(0)" ::: "memory");
    __syncthreads();
    if (threadIdx.x == 0) {
        unsigned* bar = b.bar;
        __builtin_amdgcn_s_waitcnt(0);
        unsigned nloc = b.st[0], nx = b.st[1];
        if (nloc == 0u) { xcd_barrier_complete(bar, b.x, nloc, nx); b.st[0] = nloc; b.st[1] = nx; }
        const unsigned old = xb_add(&bar[XB_XSUB(b.x)], 1u);
        const unsigned gen = old / nloc;
        if (old + 1u == (gen + 1u) * nloc) {
            __builtin_amdgcn_fence(__ATOMIC_RELEASE, "agent");
            asm volatile("s_waitcnt vmcnt(0)" ::: "memory");
            const unsigned og = xb_add(&bar[XB_TOP], 1u);
            const unsigned tg = og / nx;
            if (og + 1u == (tg + 1u) * nx) xb_add(&bar[XB_TOPGEN], 1u);
            else XB_SPIN(xb_ld(&bar[XB_TOPGEN]) == tg, bar);
            __builtin_amdgcn_fence(__ATOMIC_ACQUIRE, "agent");
            xb_add(&bar[XB_XGEN(b.x)], 1u);
            asm volatile("s_waitcnt vmcnt(0)" ::: "memory");
        } else {
            XB_SPIN(xb_ld(&bar[XB_XGEN(b.x)]) == gen, bar);
            __builtin_amdgcn_fence(__ATOMIC_ACQUIRE, "agent");
            asm volatile("s_waitcnt vmcnt(0)" ::: "memory");
        }
    }
    __syncthreads();
}

#ifndef ATT_STATICM
#define ATT_STATICM true
#endif
__device__ __forceinline__ void phase_E(Ctx& C, int l) {
    const int c0 = (l == 0) ? 0 : 2;
    const bool cv_first = (C.bid & 1) == 0;
    if (cv_first) { convert_experts(C, l); BLOCK_SYNC(); }
#ifndef NO_MLOUT
    for (int k = 0; k * C.G < (NCHUNK - c0) * 4; ++k) { const int it = k * C.G + ((k & 1) ? C.G - 1 - C.bid : C.bid); if (it < (NCHUNK - c0) * 4) { item_mlout(C, l, c0 + it / 4, it % 4); BLOCK_SYNC(); } }
#endif
    if (PROBE_K > 0 && blockIdx.x == 0 && threadIdx.x == 0) ((volatile unsigned long long*)(C.a->ws + WS_CTL + 32768))[40 + l] = __builtin_amdgcn_s_memrealtime();
#ifndef NO_ATTN
    using abf = attn_body::bf16;
    float mref; { float gq = fabsf(C.a->q_norm_g[l * 64 + C.lane]), gk = fabsf(C.a->k_norm_g[l * 64 + C.lane]);
#pragma unroll
        for (int o = 32; o > 0; o >>= 1) { gq = fmaxf(gq, __shfl_xor(gq, o)); gk = fmaxf(gk, __shfl_xor(gk, o)); }
        mref = 64.0f * C2Q * 1.02f * gq * gk; mref = __int_as_float(__builtin_amdgcn_readfirstlane(__float_as_int(mref))); }
    if (ATT_STATICM && mref < 40.0f) {
        for (int u = C.vcu; u < 256; u += C.G) { const int h = u >> 6, qb = u & 63; const size_t qrow = (size_t)CTXL + (size_t)qb * 256;
            attn_body::attn_unit<8, true>((const abf*)(((bf16*)(C.a->ws + WS_QB)) + qrow * 256 + h * 64), (const abf*)(((bf16*)(C.a->ws + WS_KB)) + (h >> 1) * 64), (const abf*)(((bf16*)(C.a->ws + WS_VB)) + (h >> 1) * 64), (abf*)(((bf16*)(C.a->ws + WS_MIX)) + qrow * DM + 512 + h * 64), R / 64, (char*)C.lds, C.tid, mref); }
        if (l == 0) for (int u = C.bid - 16; u >= 0 && u < 4; u += C.G) { const int h = u;
            attn_body::attn_unit<8, true>((const abf*)(((bf16*)(C.a->ws + WS_QB)) + h * 64), (const abf*)(((bf16*)(C.a->ws + WS_KB)) + (h >> 1) * 64), (const abf*)(((bf16*)(C.a->ws + WS_VB)) + (h >> 1) * 64), (abf*)(((bf16*)(C.a->ws + WS_MIX)) + 512 + h * 64), CTXL / 64, (char*)C.lds, C.tid, mref); }
    } else {
        for (int u = C.vcu; u < 256; u += C.G) { const int h = u >> 6, qb = u & 63; const size_t qrow = (size_t)CTXL + (size_t)qb * 256;
            attn_body::attn_unit<8, false>((const abf*)(((bf16*)(C.a->ws + WS_QB)) + qrow * 256 + h * 64), (const abf*)(((bf16*)(C.a->ws + WS_KB)) + (h >> 1) * 64), (const abf*)(((bf16*)(C.a->ws + WS_VB)) + (h >> 1) * 64), (abf*)(((bf16*)(C.a->ws + WS_MIX)) + qrow * DM + 512 + h * 64), R / 64, (char*)C.lds, C.tid, 0.f); }
        if (l == 0) for (int u = C.bid - 16; u >= 0 && u < 4; u += C.G) { const int h = u;
            attn_body::attn_unit<8, false>((const abf*)(((bf16*)(C.a->ws + WS_QB)) + h * 64), (const abf*)(((bf16*)(C.a->ws + WS_KB)) + (h >> 1) * 64), (const abf*)(((bf16*)(C.a->ws + WS_VB)) + (h >> 1) * 64), (abf*)(((bf16*)(C.a->ws + WS_MIX)) + 512 + h * 64), CTXL / 64, (char*)C.lds, C.tid, 0.f); }
    }
#endif
    if (!cv_first) { BLOCK_SYNC(); convert_experts(C, l); }
}

#ifndef REPEAT_PH
#define REPEAT_PH -1
#endif
#ifndef ONLY_KIND
#define ONLY_KIND -1
#endif
#define KSEL(x) (ONLY_KIND == -1 || ONLY_KIND == (x))
constexpr int N_PHASES = 22;
template <int ph> __device__ __forceinline__ void run_phase(Ctx& C, PG8_LAS unsigned char* ldsg) {
        if constexpr (ph == 0) { if (KSEL(100)) phase_init(C); }
        else if constexpr (ph == 1) { if (KSEL(101)) phase_A0(C); }
        else {
            constexpr int l = (ph - 2) / 10, k = (ph - 2) % 10;
            if constexpr (k == 0) { if (KSEL(0)) {
                pg8::Gemm g{((bf16*)(C.a->ws + WS_H)), ((bf16*)(C.a->ws + WS_WIN)) + (size_t)l * NZ * DM, R, NZ, DM, nullptr}; pg8::StaticOrder S; S.init(R, NZ, C.G, C.bid);
                pg8::EpiBf16 E{((bf16*)(C.a->ws + WS_Z)), NZ};
                pg8::gemm_phase<pg8::EpiBf16, pg8::StaticOrder, true, false>(ldsg, g, S, E, C.tid);
                convert_experts_B(C, l); }
            } else if constexpr (k == 1) { if (KSEL(1)) phase_C(C, l); }
            else if constexpr (k == 2) { if (KSEL(2)) phase_D(C); }
            else if constexpr (k == 3) { if (KSEL(3)) phase_E(C, l); }
            else if constexpr (k == 4) { if (KSEL(4)) {
                const int pm0 = 1; const int rows = R - pm0 * 256;
                pg8::Gemm g{((bf16*)(C.a->ws + WS_MIX)), ((bf16*)(C.a->ws + WS_WOUT)) + (size_t)l * DM * DM, rows, DM, DM, nullptr}; pg8::StaticOrder S; S.init(rows, DM, C.G, C.bid, pm0);
                const float* modL = ((float*)(C.a->ws + WS_MOD)) + (size_t)(l * 2 + 0) * 6144 + 2 * 1024; const float* modC = ((float*)(C.a->ws + WS_MOD)) + (size_t)(l * 2 + 1) * 6144 + 2 * 1024;
                pg8::EpiResid E{(l == 0) ? C.a->ctx : ((float*)(C.a->ws + WS_XW)), (l == 0) ? C.a->x : ((float*)(C.a->ws + WS_XW)) + (size_t)CTXL * DM, ((float*)(C.a->ws + WS_XW)), modC, modL};
                pg8::gemm_phase<pg8::EpiResid, pg8::StaticOrder, true, false>(ldsg, g, S, E, C.tid);
                if (l == 0) skinny_F0(C); }
            } else if constexpr (k == 5) { if (KSEL(5)) phase_G(C, l); }
            else if constexpr (k == 6) { if (KSEL(6)) phase_H(C, l); }
            else if constexpr (k == 7) { if (KSEL(7)) {
#if MOE_FP8
                pg8::Gemm g{((bf16*)(C.a->ws + WS_H2)), (bf16*)((unsigned char*)(C.a->ws + WS_W13) + (size_t)l * NEXP * 4096 * DM), NEXP * ESLOTS, NEXP * 4096, DM / 2, ((int*)(C.a->ws + WS_IDX))}; pg8::MoeOrder S; S.init((l == 0) ? 9 : 8, 16, C.G, C.vcu);
                pg8::EpiSwiGLU<true> E{(void*)(C.a->ws + WS_HID), 1.0f / (H2_F8S * W_F8S), HID_F8S};
                pg8::gemm_phase<pg8::EpiSwiGLU<true>, pg8::MoeOrder, true, true, true>(ldsg, g, S, E, C.tid);
#else
                pg8::Gemm g{((bf16*)(C.a->ws + WS_H2)), ((bf16*)(C.a->ws + WS_W13)) + (size_t)l * NEXP * 4096 * DM, NEXP * ESLOTS, NEXP * 4096, DM, ((int*)(C.a->ws + WS_IDX))}; pg8::MoeOrder S; S.init((l == 0) ? 9 : 8, 16, C.G, C.vcu);
                pg8::EpiSwiGLU<false> E{(void*)(C.a->ws + WS_HID), 1.0f, 1.0f};
                pg8::gemm_phase<pg8::EpiSwiGLU<false>, pg8::MoeOrder, true, true, false>(ldsg, g, S, E, C.tid);
#endif
                }
            } else if constexpr (k == 8) { if (KSEL(8)) {
#if MOE_FP8
                pg8::Gemm g{((bf16*)(C.a->ws + WS_HID)), (bf16*)((unsigned char*)(C.a->ws + WS_W2) + (size_t)l * NEXP * DM * FF), NEXP * ESLOTS, NEXP * DM, FF / 2, nullptr}; pg8::MoeOrder S; S.init(8, 4, C.G, C.vcu);
                pg8::EpiGateRow E{((bf16*)(C.a->ws + WS_Y)), ((float*)(C.a->ws + WS_GATE)), 1.0f / (HID_F8S * W_F8S)};
                pg8::gemm_phase<pg8::EpiGateRow, pg8::MoeOrder, true, false, true>(ldsg, g, S, E, C.tid);
#else
                pg8::Gemm g{((bf16*)(C.a->ws + WS_HID)), ((bf16*)(C.a->ws + WS_W2)) + (size_t)l * NEXP * DM * FF, NEXP * ESLOTS, NEXP * DM, FF, nullptr}; pg8::MoeOrder S; S.init(8, 4, C.G, C.vcu);
                pg8::EpiGateRow E{((bf16*)(C.a->ws + WS_Y)), ((float*)(C.a->ws + WS_GATE)), 1.0f};
                pg8::gemm_phase<pg8::EpiGateRow, pg8::MoeOrder, true, false, false>(ldsg, g, S, E, C.tid);
#endif
                if (l == 0) skinny_J0(C); }
            } else { if (KSEL(9)) phase_K(C, l); }
        }
}
__global__ void __launch_bounds__(NTHR, 2) hybrid_fwd(Args args) {
    extern __shared__ __attribute__((aligned(16))) unsigned char lds[];
    cg::grid_group grid = cg::this_grid();
    Ctx C; C.lds = lds;
    PG8_LAS unsigned char* ldsg = (PG8_LAS unsigned char*)lds;

    const int ph_lo = args.ph_lo, ph_hi = args.ph_hi;
    volatile LAS unsigned* MISC = (volatile LAS unsigned*)((LAS unsigned char*)lds + (LDS_BYTES - 64));
    if (threadIdx.x < 16) MISC[threadIdx.x] = 0u;
    __syncthreads();
    XcdBarrier xbar = xcd_barrier_post((unsigned*)(args.ws + WS_CTL) + 4096, MISC + 8);
    volatile unsigned long long* tstamp = (volatile unsigned long long*)(args.ws + WS_CTL + 32768);
    if (PROBE_K > 0 && blockIdx.x == 0 && threadIdx.x == 0) tstamp[0] = __builtin_amdgcn_s_memrealtime();
#define RUN_PHASE(PH) do { if (ph_lo <= (PH) && (PH) < ph_hi) { constexpr int ph = (PH); \
        { KArgs ka = (KArgs)__builtin_amdgcn_kernarg_segment_ptr(); asm volatile("" : "+s"(ka)); C.a = ka; } \
        { int tid_ = threadIdx.x; asm volatile("" : "+v"(tid_)); C.tid = tid_; C.lane = tid_ & 63; C.wave = __builtin_amdgcn_readfirstlane(tid_ >> 6); } \
        { int g_ = gridDim.x, b_ = blockIdx.x; asm volatile("" : "+s"(g_), "+s"(b_)); C.G = g_; C.bid = b_; C.vcu = (g_ % 8 == 0) ? (b_ % 8) * (g_ / 8) + b_ / 8 : b_; } \
        run_phase<ph>(C, ldsg); if ((PH) == REPEAT_PH) { xcd_barrier(xbar); run_phase<ph>(C, ldsg); } if ((PH) + 1 < ph_hi) { if (ph_hi > 1000) grid.sync(); else xcd_barrier(xbar); }     \
        if (PROBE_K > 0 && blockIdx.x == 0 && threadIdx.x == 0) tstamp[(PH) + 1] = __builtin_amdgcn_s_memrealtime(); } } while (0)
    RUN_PHASE(0); RUN_PHASE(1); RUN_PHASE(2); RUN_PHASE(3); RUN_PHASE(4); RUN_PHASE(5); RUN_PHASE(6); RUN_PHASE(7); RUN_PHASE(8); RUN_PHASE(9); RUN_PHASE(10); RUN_PHASE(11);
    RUN_PHASE(12); RUN_PHASE(13); RUN_PHASE(14); RUN_PHASE(15); RUN_PHASE(16); RUN_PHASE(17); RUN_PHASE(18); RUN_PHASE(19); RUN_PHASE(20); RUN_PHASE(21);
#undef RUN_PHASE
    if (PROBE_K > 0 && blockIdx.x == 0 && threadIdx.x == 0) {
        const unsigned long long dt = tstamp[PROBE_B] - tstamp[PROBE_A], t0 = __builtin_amdgcn_s_memrealtime();
        while (__builtin_amdgcn_s_memrealtime() - t0 < (unsigned long long)PROBE_K * dt) __builtin_amdgcn_s_sleep(8);
    }
}

extern "C" void kernel_launch(void* const* d_in, const int* in_sizes, int n_in, void* d_out, int out_size, void* d_ws, size_t ws_size, hipStream_t stream) {
    static int grid = 0;
    if (grid == 0) {
        if (n_in != 24 || ws_size < WS_END) { fprintf(stderr, "kernel_launch: unexpected inputs (%d) or workspace (%zu < %zu)\n", n_in, ws_size, (size_t)WS_END); grid = -1; return; }
        int dev = 0, cus = 0, per_cu = 0;
        hipGetDevice(&dev); hipDeviceGetAttribute(&cus, hipDeviceAttributeMultiprocessorCount, dev);
        hipFuncSetAttribute((const void*)hybrid_fwd, hipFuncAttributeMaxDynamicSharedMemorySize, LDS_BYTES);
        hipOccupancyMaxActiveBlocksPerMultiprocessor(&per_cu, (const void*)hybrid_fwd, NTHR, LDS_BYTES);
        if (per_cu < 1) { fprintf(stderr, "kernel_launch: occupancy query says %d blocks per CU\n", per_cu); per_cu = 1; }
        (void)hipGetLastError();
        grid = cus;
        if (grid > 256) grid = 256;
    }
    if (grid < 0) return;
    hipMemsetAsync((char*)d_ws + WS_CTL, 0, 64 * 1024, stream);
    Args a{};
    const float** ap = (const float**)&a;
    for (int i = 0; i < 24; ++i) ap[i] = (const float*)d_in[i];
    a.out = (float*)d_out; a.ws = (unsigned char*)d_ws;
#ifndef MK_PER_PHASE
    a.ph_lo = 0; a.ph_hi = N_PHASES;
    void* kargs[] = {&a};
    hipError_t e = hipLaunchCooperativeKernel((const void*)hybrid_fwd, dim3(grid), dim3(NTHR), kargs, LDS_BYTES, stream);
    if (e != hipSuccess) fprintf(stderr, "cooperative launch failed: %s (grid %d)\n", hipGetErrorString(e), grid);
#else
    for (int p = 0; p < N_PHASES; ++p) { a.ph_lo = p; a.ph_hi = p + 1; void* kargs[] = {&a};
        hipError_t e = hipLaunchCooperativeKernel((const void*)hybrid_fwd, dim3(grid), dim3(NTHR), kargs, LDS_BYTES, stream);
        if (e != hipSuccess) { fprintf(stderr, "launch %d failed: %s\n", p, hipGetErrorString(e)); break; } }
#endif
}
```

```cpp
#include <hip/hip_runtime.h>
#include <hip/hip_bf16.h>
#include <hip/hip_cooperative_groups.h>
#include <cstdio>
#include <cstdint>
#include <cmath>
namespace cg = cooperative_groups;
namespace pg8 {
#define PG8_LAS __attribute__((address_space(3)))
typedef unsigned short bf16_t;
typedef short bf16x8 __attribute__((ext_vector_type(8)));
typedef float f32x4 __attribute__((ext_vector_type(4)));
typedef unsigned u32x4 __attribute__((ext_vector_type(4)));
typedef unsigned u32x2 __attribute__((ext_vector_type(2)));
typedef int i32x4 __attribute__((ext_vector_type(4)));
typedef int i32x8 __attribute__((ext_vector_type(8)));
__device__ __forceinline__ i32x8 cat8(bf16x8 a, bf16x8 b) { const i32x4 x = __builtin_bit_cast(i32x4, a), y = __builtin_bit_cast(i32x4, b); return __builtin_shufflevector(x, y, 0, 1, 2, 3, 4, 5, 6, 7); }
__device__ __forceinline__ float sat8(float x) { return __builtin_amdgcn_fmed3f(x, -448.0f, 448.0f); }
__device__ __forceinline__ unsigned pk4_fp8(float a, float b, float c, float d) { unsigned w = __builtin_amdgcn_cvt_pk_fp8_f32(sat8(a), sat8(b), 0u, false); return __builtin_amdgcn_cvt_pk_fp8_f32(sat8(c), sat8(d), w, true); }
constexpr int BM = 256, BK = 64, HALF = 128, HTB = HALF * BK * 2, STAGE_BYTES = 8 * HTB, NXCD = 8, WGM = 8;

__host__ __device__ __forceinline__ int lds_byte(int r, int c) { const int st = (r >> 4) * 2 + (c >> 5), rr = r & 15, cc = c & 31, ob = rr * 64 + cc * 2; return st * 1024 + (ob ^ (((ob >> 9) & 1) << 5)); }
__host__ __device__ __forceinline__ void stage_rc(int b, int& R, int& C) { const int st = b / 1024, sb = b % 1024, swz = sb ^ (((sb >> 9) & 1) << 5); R = (st >> 1) * 16 + swz / 64; C = (st & 1) * 32 + (swz % 64) / 2; }
__host__ __device__ __forceinline__ int perm32(int rho) { const int n = rho >> 4, i = rho & 15; return 8 * (i >> 2) + 4 * n + (i & 3); }

struct Unit { int pm, pn; };
struct Gemm { const bf16_t* A; const bf16_t* Bt; int M, N, K; const int* gidx; };

struct StaticOrder {
    int nM, nN, nwg, G, c, pm0;
    __host__ __device__ void init(int M, int N, int G_, int c_, int pm0_ = 0) { nM = M / BM; nN = N / BM; nwg = nM * nN; G = G_; c = c_; pm0 = pm0_; }
    __host__ __device__ bool next(int i, Unit& u) const {
        const long L = (long)i * G + c; if (L >= nwg) return false;
        int wgid = (int)L; { const int q = nwg / NXCD, r = nwg % NXCD, xcd = wgid % NXCD, off = wgid / NXCD; wgid = (xcd < r ? xcd * (q + 1) : r * (q + 1) + (xcd - r) * q) + off; }
        const int nig = WGM * nN, gid = wgid / nig, fm = gid * WGM, gsz = (nM - fm) < WGM ? (nM - fm) : WGM;
        u.pm = pm0 + fm + ((wgid % nig) % gsz); u.pn = (wgid % nig) / gsz; return true;
    }
};
struct MoeOrder {
    int npm, npn, total, G, c;
    __host__ __device__ void init(int npm_, int npn_, int G_, int c_) { npm = npm_; npn = npn_; total = 16 * npm_ * npn_; G = G_; c = c_; }
    __host__ __device__ bool next(int i, Unit& u) const {
        const long L = (long)i * G + c; if (L >= total) return false;
        const int per = npm * npn, e = (int)L / per, rem = (int)L % per, pn = rem / npm, pm = rem % npm;
        u.pm = e * 9 + pm; u.pn = e * npn + pn; return true;
    }
};

__device__ __forceinline__ unsigned cvt_pk_bf16(float lo, float hi) { unsigned r; asm volatile("v_cvt_pk_bf16_f32 %0, %1, %2" : "=v"(r) : "v"(lo), "v"(hi)); return r; }

struct EpiBf16 {
    static constexpr bool PERM = true;
    bf16_t* O; int ldc;
    __device__ __forceinline__ void operator()(const f32x4 (&acc)[2][2][4][2], const Unit& u, int wr, int wc, int fr, int fq) const {
        const int row0 = u.pm * BM + wr * 64 + fr; const int col0 = u.pn * BM + wc * 32 + 8 * fq;
#pragma unroll
        for (int ai = 0; ai < 2; ++ai)
#pragma unroll
            for (int m = 0; m < 4; ++m) { bf16_t* rowp = O + (size_t)(row0 + ai * HALF + m * 16) * ldc + col0;
#pragma unroll
                for (int bj = 0; bj < 2; ++bj) { const f32x4 v0 = acc[ai][bj][m][0], v1 = acc[ai][bj][m][1];
                    u32x4 w; w.x = cvt_pk_bf16(v0[0], v0[1]); w.y = cvt_pk_bf16(v0[2], v0[3]); w.z = cvt_pk_bf16(v1[0], v1[1]); w.w = cvt_pk_bf16(v1[2], v1[3]);
                    *(u32x4*)(rowp + bj * HALF) = w; } }
    }
};
template <bool RB16> struct EpiResid {
    static constexpr bool PERM = true;
    const void* baseC; const void* baseL; bf16_t* out; const float* gateC; const float* gateL;
    __device__ __forceinline__ void operator()(const f32x4 (&acc)[2][2][4][2], const Unit& u, int wr, int wc, int fr, int fq) const {
        const int rl = wr * 64 + fr, col0 = u.pn * BM + wc * 32 + 8 * fq;
        constexpr size_t ESZ = RB16 ? 2 : 4;
        const char* bp = (u.pm == 0) ? (const char*)baseC : (const char*)baseL + (size_t)(u.pm - 1) * BM * 1024 * ESZ;
        const float* gp = (u.pm == 0) ? gateC : gateL;
        f32x4 gv[2][2];
#pragma unroll
        for (int bj = 0; bj < 2; ++bj)
#pragma unroll
            for (int n = 0; n < 2; ++n) gv[bj][n] = *(const f32x4*)(gp + col0 + bj * HALF + n * 4);
        u32x4 rb[2][4]; f32x4 rf[2][4][2];
#define PG8_RLOAD(b_) do { constexpr int ai_ = (b_) >> 1, bj_ = (b_) & 1; _Pragma("unroll") for (int m = 0; m < 4; ++m) { const int r = rl + ai_ * HALF + m * 16; const char* brow = bp + ((size_t)r * 1024 + col0) * ESZ; \
            if constexpr (RB16) rb[(b_) & 1][m] = *(const u32x4*)(brow + bj_ * HALF * 2); \
            else { rf[(b_) & 1][m][0] = *(const f32x4*)(brow + bj_ * HALF * 4); rf[(b_) & 1][m][1] = *(const f32x4*)(brow + bj_ * HALF * 4 + 16); } } } while (0)
#define PG8_RSTORE(b_) do { constexpr int ai_ = (b_) >> 1, bj_ = (b_) & 1; _Pragma("unroll") for (int m = 0; m < 4; ++m) { const int r = rl + ai_ * HALF + m * 16; bf16_t* orow = out + ((size_t)u.pm * BM + r) * 1024 + col0; f32x4 b0, b1; \
            if constexpr (RB16) { const u32x4 w = rb[(b_) & 1][m]; \
                b0 = (f32x4){__uint_as_float(w.x << 16), __uint_as_float(w.x & 0xffff0000u), __uint_as_float(w.y << 16), __uint_as_float(w.y & 0xffff0000u)}; \
                b1 = (f32x4){__uint_as_float(w.z << 16), __uint_as_float(w.z & 0xffff0000u), __uint_as_float(w.w << 16), __uint_as_float(w.w & 0xffff0000u)}; } \
            else { b0 = rf[(b_) & 1][m][0]; b1 = rf[(b_) & 1][m][1]; } \
            const f32x4 o0 = b0 + gv[bj_][0] * acc[ai_][bj_][m][0], o1 = b1 + gv[bj_][1] * acc[ai_][bj_][m][1]; \
            u32x4 w; w.x = cvt_pk_bf16(o0[0], o0[1]); w.y = cvt_pk_bf16(o0[2], o0[3]); w.z = cvt_pk_bf16(o1[0], o1[1]); w.w = cvt_pk_bf16(o1[2], o1[3]); \
            *(u32x4*)(orow + bj_ * HALF) = w; } } while (0)
        if constexpr (RB16) { PG8_RLOAD(0); PG8_RLOAD(1); PG8_RSTORE(0); PG8_RLOAD(2); PG8_RSTORE(1); PG8_RLOAD(3); PG8_RSTORE(2); PG8_RSTORE(3); }
        else { PG8_RLOAD(0); PG8_RSTORE(0); PG8_RLOAD(1); PG8_RSTORE(1); PG8_RLOAD(2); PG8_RSTORE(2); PG8_RLOAD(3); PG8_RSTORE(3); }
#undef PG8_RLOAD
#undef PG8_RSTORE
    }
};
template <bool F8> struct EpiSwiGLU {
    static constexpr bool PERM = true;
    void* O; float s, so;
    __device__ __forceinline__ void operator()(const f32x4 (&acc)[2][2][4][2], const Unit& u, int wr, int wc, int fr, int fq) const {
        const int row0 = u.pm * BM + wr * 64 + fr; const int col0 = (u.pn & 15) * HALF + wc * 32 + 8 * fq;
        const float sso = s * s * so, nls = -1.4426950408889634f * s;
#pragma unroll
        for (int ai = 0; ai < 2; ++ai)
#pragma unroll
            for (int m = 0; m < 4; ++m) { float h[8];
#pragma unroll
                for (int n = 0; n < 2; ++n)
#pragma unroll
                    for (int j = 0; j < 4; ++j) { const float a = acc[ai][0][m][n][j], b = acc[ai][1][m][n][j]; h[n * 4 + j] = (a * b) * (sso * __builtin_amdgcn_rcpf(1.0f + __builtin_amdgcn_exp2f(nls * a))); }
                if constexpr (F8) { u32x2 w; w.x = pk4_fp8(h[0], h[1], h[2], h[3]); w.y = pk4_fp8(h[4], h[5], h[6], h[7]);
                    *(u32x2*)((unsigned char*)O + (size_t)(row0 + ai * HALF + m * 16) * 2048 + col0) = w; }
                else { u32x4 w; w.x = cvt_pk_bf16(h[0], h[1]); w.y = cvt_pk_bf16(h[2], h[3]); w.z = cvt_pk_bf16(h[4], h[5]); w.w = cvt_pk_bf16(h[6], h[7]);
                    *(u32x4*)((bf16_t*)O + (size_t)(row0 + ai * HALF + m * 16) * 2048 + col0) = w; } }
    }
};
struct EpiGateRow {
    static constexpr bool PERM = true;
    bf16_t* O; const float* gate; float s;
    __device__ __forceinline__ void operator()(const f32x4 (&acc)[2][2][4][2], const Unit& u, int wr, int wc, int fr, int fq) const {
        const int row0 = u.pm * BM + wr * 64 + fr; const int col0 = (u.pn & 3) * BM + wc * 32 + 8 * fq;
#pragma unroll
        for (int ai = 0; ai < 2; ++ai)
#pragma unroll
            for (int m = 0; m < 4; ++m) { const int r = row0 + ai * HALF + m * 16; const float gt = gate[r] * s; bf16_t* rowp = O + (size_t)r * 1024 + col0;
#pragma unroll
                for (int bj = 0; bj < 2; ++bj) { const f32x4 v0 = acc[ai][bj][m][0] * gt, v1 = acc[ai][bj][m][1] * gt;
                    u32x4 w; w.x = cvt_pk_bf16(v0[0], v0[1]); w.y = cvt_pk_bf16(v0[2], v0[3]); w.z = cvt_pk_bf16(v1[0], v1[1]); w.w = cvt_pk_bf16(v1[2], v1[3]);
                    *(u32x4*)(rowp + bj * HALF) = w; } }
    }
};

template <class Epi, class Sched, bool ALIGN_EPI, bool GATHER, bool FP8 = false>
__device__ __forceinline__ void gemm_phase(PG8_LAS unsigned char* lds, const Gemm g, const Sched& S, const Epi& E, const int tid) {
    const int wid = __builtin_amdgcn_readfirstlane(tid >> 6), lane = tid & 63, wr = wid >> 2, wc = wid & 3, fr = lane & 15, fq = lane >> 4;
    const int K = g.K, nt = K / BK;
    unsigned voffA[2], voffB[2]; int RA[2];
#pragma unroll
    for (int i = 0; i < 2; ++i) { int R, C; stage_rc(tid * 16 + i * 8192, R, C); const int Rb = Epi::PERM ? ((R & ~31) + perm32(R & 31)) : R;
        voffA[i] = GATHER ? (unsigned)(C * 2) : (unsigned)(R * K + C) * 2u; voffB[i] = (unsigned)(Rb * K + C) * 2u; RA[i] = R; }
    const size_t kstep = (size_t)(BK * 2);
    const size_t hstep = (size_t)HALF * K * 2;
    const size_t tstep = 2 * hstep;
    const unsigned ldsw = (unsigned)wid * 1024u;
    const int aoff = lds_byte(wr * 64 + fr, fq * 8), boff = lds_byte(wc * 32 + fr, fq * 8);
#define PG8_SA(b, h) (((b) * 2 + (h)) * HTB)
#define PG8_SB(b, h) ((4 + (b) * 2 + (h)) * HTB)
#define PG8_STAGE(bufoff, gbase, voff) do { _Pragma("unroll") for (int _i = 0; _i < 2; ++_i) \
        __builtin_amdgcn_global_load_lds((const unsigned*)((const char*)(gbase) + (voff)[_i]), (PG8_LAS unsigned*)(lds + (bufoff) + ldsw + _i * 8192), 16, 0, 0); } while (0)
#define PG8_LDA(dst, b, h) do { if constexpr (FP8) { _Pragma("unroll") for (int m = 0; m < 4; ++m) { const i32x4 lo_ = *(const PG8_LAS i32x4*)(lds + PG8_SA(b, h) + aoff + m * 2048), hi_ = *(const PG8_LAS i32x4*)(lds + PG8_SA(b, h) + aoff + m * 2048 + 1024); dst##8[m] = __builtin_shufflevector(lo_, hi_, 0, 1, 2, 3, 4, 5, 6, 7); } } \
        else { _Pragma("unroll") for (int m = 0; m < 4; ++m) _Pragma("unroll") for (int k = 0; k < 2; ++k) dst[m][k] = *(const PG8_LAS bf16x8*)(lds + PG8_SA(b, h) + aoff + m * 2048 + k * 1024); } } while (0)
#define PG8_LDB(dst, b, h) do { if constexpr (FP8) { _Pragma("unroll") for (int n = 0; n < 2; ++n) { const i32x4 lo_ = *(const PG8_LAS i32x4*)(lds + PG8_SB(b, h) + boff + n * 2048), hi_ = *(const PG8_LAS i32x4*)(lds + PG8_SB(b, h) + boff + n * 2048 + 1024); dst##8[n] = __builtin_shufflevector(lo_, hi_, 0, 1, 2, 3, 4, 5, 6, 7); } } \
        else { _Pragma("unroll") for (int n = 0; n < 2; ++n) _Pragma("unroll") for (int k = 0; k < 2; ++k) dst[n][k] = *(const PG8_LAS bf16x8*)(lds + PG8_SB(b, h) + boff + n * 2048 + k * 1024); } } while (0)
#define PG8_MMA(ai, bj, At, Bt) do { __builtin_amdgcn_s_setprio(1); \
        if constexpr (FP8) { _Pragma("unroll") for (int m = 0; m < 4; ++m) _Pragma("unroll") for (int n = 0; n < 2; ++n) \
            asm volatile("v_mfma_scale_f32_16x16x128_f8f6f4 %0, %1, %2, %0, %3, %3 op_sel_hi:[0,0,0]" : "+v"(acc[ai][bj][m][n]) : "v"(Bt##8[n]), "v"(At##8[m]), "v"(one_scale)); } \
        else { _Pragma("unroll") for (int m = 0; m < 4; ++m) _Pragma("unroll") for (int n = 0; n < 2; ++n) _Pragma("unroll") for (int k = 0; k < 2; ++k) \
            acc[ai][bj][m][n] = __builtin_amdgcn_mfma_f32_16x16x32_bf16(Bt[n][k], At[m][k], acc[ai][bj][m][n], 0, 0, 0); } \
        __builtin_amdgcn_s_setprio(0); } while (0)
#define PG8_WAIT_V(n) asm volatile("s_waitcnt vmcnt(" #n ")" ::: "memory")
#define PG8_WAIT_L(n) asm volatile("s_waitcnt lgkmcnt(" #n ")" ::: "memory")
#define PG8_BAR __builtin_amdgcn_s_barrier()
#define PG8_SCHED __builtin_amdgcn_sched_barrier(0)
    Unit cur, nxt; int ui = 0;
    if (!S.next(0, cur)) return;
    f32x4 acc[2][2][4][2];
#pragma unroll
    for (int a = 0; a < 2; ++a)
#pragma unroll
        for (int b = 0; b < 2; ++b)
#pragma unroll
            for (int m = 0; m < 4; ++m)
#pragma unroll
                for (int n = 0; n < 2; ++n) acc[a][b][m][n] = (f32x4){0.f, 0.f, 0.f, 0.f};
    int one_scale = 0x7F7F7F7F; asm volatile("" : "+v"(one_scale));
    bf16x8 At[4][2], B0[2][2], B1[2][2]; i32x8 At8[4], B08[2], B18[2];
    unsigned gC0[2], gC1[2], gN0[2], gN1[2];
    const char* cA; const char* cB = (const char*)g.Bt + (size_t)cur.pn * tstep;
    if constexpr (GATHER) {
        cA = (const char*)g.A;
#pragma unroll
        for (int i = 0; i < 2; ++i) { gC0[i] = (unsigned)g.gidx[cur.pm * BM + RA[i]] * (unsigned)(K * 2) + voffA[i]; gC1[i] = (unsigned)g.gidx[cur.pm * BM + HALF + RA[i]] * (unsigned)(K * 2) + voffA[i]; gN0[i] = gC0[i]; gN1[i] = gC1[i]; }
    } else { cA = (const char*)g.A + (size_t)cur.pm * tstep; }
#define PG8_STA0(bufoff, ptr) do { if constexpr (GATHER) PG8_STAGE(bufoff, ptr, gC0); else PG8_STAGE(bufoff, ptr, voffA); } while (0)
#define PG8_STA1(bufoff, ptr) do { if constexpr (GATHER) PG8_STAGE(bufoff, ptr, gC1); else PG8_STAGE(bufoff, (ptr) + hstep, voffA); } while (0)
#define PG8_STX0(bufoff, ptr) do { if constexpr (GATHER) PG8_STAGE(bufoff, ptr, gX0); else PG8_STAGE(bufoff, ptr, voffA); } while (0)
#define PG8_STX1(bufoff, ptr) do { if constexpr (GATHER) PG8_STAGE(bufoff, ptr, gX1); else PG8_STAGE(bufoff, (ptr) + hstep, voffA); } while (0)
    PG8_STAGE(PG8_SB(0, 0), cB, voffB); PG8_STAGE(PG8_SB(0, 1), cB + hstep, voffB); PG8_STA0(PG8_SA(0, 0), cA); PG8_STA1(PG8_SA(0, 1), cA);
    if (wr == 1) PG8_BAR;
    PG8_WAIT_V(2); PG8_BAR;
    PG8_STAGE(PG8_SB(1, 0), cB + kstep, voffB); PG8_STA0(PG8_SA(1, 0), cA + kstep); PG8_STAGE(PG8_SB(1, 1), cB + hstep + kstep, voffB);
    PG8_WAIT_V(6); PG8_BAR;
    for (;;) {
        const bool has_next = S.next(ui + 1, nxt);
        const char* nA; const char* nB = has_next ? (const char*)g.Bt + (size_t)nxt.pn * tstep : cB;
        if constexpr (GATHER) {
            nA = cA;
            if (has_next) {
#pragma unroll
                for (int i = 0; i < 2; ++i) { gN0[i] = (unsigned)g.gidx[nxt.pm * BM + RA[i]] * (unsigned)(K * 2) + voffA[i]; gN1[i] = (unsigned)g.gidx[nxt.pm * BM + HALF + RA[i]] * (unsigned)(K * 2) + voffA[i]; }
            }
        } else { nA = has_next ? (const char*)g.A + (size_t)nxt.pm * tstep : cA; }
        for (int t = 0; t < nt; t += 2) {
            const bool last = (t == nt - 2);
            const char* a1 = cA + (size_t)(t + 1) * kstep;
            const char* a2 = last ? nA : cA + (size_t)(t + 2) * kstep; const char* b2 = last ? nB : cB + (size_t)(t + 2) * kstep;
            const char* a3 = a2 + kstep; const char* b3 = b2 + kstep;
            unsigned gX0[2], gX1[2];
            if constexpr (GATHER) {
#pragma unroll
                for (int i = 0; i < 2; ++i) { gX0[i] = last ? gN0[i] : gC0[i]; gX1[i] = last ? gN1[i] : gC1[i]; }
            }
            PG8_LDB(B0, 0, 0); PG8_LDB(B1, 0, 1); PG8_SCHED; PG8_LDA(At, 0, 0); PG8_STA1(PG8_SA(1, 1), a1);
            PG8_WAIT_V(8); PG8_WAIT_L(0); PG8_BAR; PG8_MMA(0, 0, At, B0); PG8_MMA(0, 1, At, B1); PG8_BAR; PG8_SCHED;
            PG8_LDA(At, 0, 1); PG8_STAGE(PG8_SB(0, 0), b2, voffB); PG8_STAGE(PG8_SB(0, 1), b2 + hstep, voffB); PG8_STX0(PG8_SA(0, 0), a2);
            PG8_WAIT_V(8); PG8_WAIT_L(0); PG8_BAR; PG8_MMA(1, 0, At, B0); PG8_MMA(1, 1, At, B1); PG8_BAR; PG8_SCHED;
            PG8_LDB(B0, 1, 0); PG8_LDB(B1, 1, 1); PG8_SCHED; PG8_LDA(At, 1, 0); PG8_STX1(PG8_SA(0, 1), a2);
            PG8_WAIT_V(8); PG8_WAIT_L(0); PG8_BAR; PG8_MMA(0, 0, At, B0); PG8_MMA(0, 1, At, B1); PG8_BAR; PG8_SCHED;
            PG8_LDA(At, 1, 1); PG8_STAGE(PG8_SB(1, 0), b3, voffB); PG8_STAGE(PG8_SB(1, 1), b3 + hstep, voffB); PG8_STX0(PG8_SA(1, 0), a3);
            PG8_WAIT_V(8); PG8_WAIT_L(0); PG8_BAR; PG8_MMA(1, 0, At, B0); PG8_MMA(1, 1, At, B1); PG8_BAR; PG8_SCHED;
        }
        if constexpr (ALIGN_EPI) { if (wr == 0) PG8_BAR; }
        if constexpr (FP8) asm volatile("s_nop 15\n\ts_nop 7" ::: "memory");
        E(acc, cur, wr, wc, fr, fq);
        if (!has_next) break;
#pragma unroll
        for (int a = 0; a < 2; ++a)
#pragma unroll
            for (int b = 0; b < 2; ++b)
#pragma unroll
                for (int m = 0; m < 4; ++m)
#pragma unroll
                    for (int n = 0; n < 2; ++n) acc[a][b][m][n] = (f32x4){0.f, 0.f, 0.f, 0.f};
        cur = nxt; cA = nA; cB = nB; ++ui;
        if constexpr (GATHER) {
#pragma unroll
            for (int i = 0; i < 2; ++i) { gC0[i] = gN0[i]; gC1[i] = gN1[i]; }
        }
        if constexpr (ALIGN_EPI) { if (wr == 1) PG8_BAR; }
    }
    PG8_WAIT_V(0);
    if constexpr (!ALIGN_EPI) { if (wr == 0) PG8_BAR; }
    PG8_BAR;
#undef PG8_SA
#undef PG8_SB
#undef PG8_STAGE
#undef PG8_STA0
#undef PG8_STA1
#undef PG8_STX0
#undef PG8_STX1
#undef PG8_LDA
#undef PG8_LDB
#undef PG8_MMA
#undef PG8_WAIT_V
#undef PG8_WAIT_L
#undef PG8_BAR
#undef PG8_SCHED
}
}
namespace attn_body {
using bf16=__hip_bfloat16;
using bf16x8=__attribute__((ext_vector_type(8)))short;
using s16x4=__attribute__((ext_vector_type(4)))short;
using f32x16=__attribute__((ext_vector_type(16)))float;
using u32x4=__attribute__((ext_vector_type(4)))unsigned;
constexpr int D=64,QP=256,KP=128,VP=128,OP=1024;
constexpr int NW=8,QBLK=32,QB=QBLK*NW,KVBLK=64;
__device__ __forceinline__ int crow(int r,int hi){return (r&3)+8*(r>>2)+4*hi;}
#define SBAR() __builtin_amdgcn_sched_barrier(0)
__device__ __forceinline__ void cmask(f32x16&p0,f32x16&p1,int jb,int qrel,int hi){
  const float NEG=-INFINITY; int kb=64*jb+4*hi;
  #pragma unroll
  for(int r=0;r<16;++r){int kv=kb+(r&3)+8*(r>>2); if(kv>qrel)p0[r]=NEG; if(kv+32>qrel)p1[r]=NEG;}
}

constexpr int NSLOT=3, SLOTB=8192;
constexpr int LDS_K=0, LDS_V=NSLOT*SLOTB, LDS_WS=2*NSLOT*SLOTB, LDS_OST=LDS_WS+NW*64*4, LDS_BYTES=LDS_OST+NW*4096;
constexpr float C2=0.125f*1.4426950408889634f;
__device__ __forceinline__ void glds16(const void*gsrc,unsigned lds_dst){unsigned keep;
  asm volatile("s_mov_b32 %0, m0\n\ts_mov_b32 m0, %2\n\ts_nop 0\n\tglobal_load_lds_dwordx4 %1, off\n\ts_mov_b32 m0, %0":"=&s"(keep):"v"(gsrc),"s"(lds_dst):"memory");}
__device__ __forceinline__ float max3f(float a,float b,float c){float r;asm("v_max3_f32 %0, %1, %2, %3":"=v"(r):"v"(a),"v"(b),"v"(c));return r;}
__device__ __forceinline__ float max2f(float a,float b){float r;asm("v_max_f32_e32 %0, %1, %2":"=v"(r):"v"(a),"v"(b));return r;}
__device__ __forceinline__ float fadd_s(float a,float b){float r;asm("v_add_f32_e32 %0, %1, %2":"=v"(r):"v"(a),"v"(b));return r;}
__device__ __forceinline__ float fsub_s(float a,float b){float r;asm("v_sub_f32_e32 %0, %1, %2":"=v"(r):"v"(a),"v"(b));return r;}
typedef float f32x2_t __attribute__((ext_vector_type(2))); typedef __bf16 bf16x2_t __attribute__((ext_vector_type(2)));
__device__ __forceinline__ unsigned cvtpk_s(float lo,float hi){f32x2_t v={lo,hi};bf16x2_t b=__builtin_convertvector(v,bf16x2_t);return __builtin_bit_cast(unsigned,b);}
#define WAIT_BAR(N) asm volatile("s_waitcnt vmcnt(" #N ") lgkmcnt(0)\n\ts_barrier":::"memory")

__device__ __forceinline__ void qkt(f32x16&p0,f32x16&p1,const char*Kslot,const bf16x8*qr,const f32x16&negm,int r32,int hi){
  const char*kb=Kslot+hi*1024+r32*16;
  #pragma unroll
  for(int d0=0;d0<4;++d0){
    const bf16x8 b0=*reinterpret_cast<const bf16x8*>(kb+d0*2048);
    const bf16x8 b1=*reinterpret_cast<const bf16x8*>(kb+d0*2048+512);
    if(d0==0){p0=__builtin_amdgcn_mfma_f32_32x32x16_bf16(b0,qr[0],negm,0,0,0);p1=__builtin_amdgcn_mfma_f32_32x32x16_bf16(b1,qr[0],negm,0,0,0);}
    else{p0=__builtin_amdgcn_mfma_f32_32x32x16_bf16(b0,qr[d0],p0,0,0,0);p1=__builtin_amdgcn_mfma_f32_32x32x16_bf16(b1,qr[d0],p1,0,0,0);}}
}
typedef __attribute__((address_space(3))) const char* lds_cptr;
typedef short v4i16_t __attribute__((ext_vector_type(4)));
__device__ __forceinline__ void kload8(bf16x8*kf,lds_cptr kp){
  kf[0]=*(const __attribute__((address_space(3))) bf16x8*)(kp);      kf[1]=*(const __attribute__((address_space(3))) bf16x8*)(kp+512);
  kf[2]=*(const __attribute__((address_space(3))) bf16x8*)(kp+2048); kf[3]=*(const __attribute__((address_space(3))) bf16x8*)(kp+2560);
  kf[4]=*(const __attribute__((address_space(3))) bf16x8*)(kp+4096); kf[5]=*(const __attribute__((address_space(3))) bf16x8*)(kp+4608);
  kf[6]=*(const __attribute__((address_space(3))) bf16x8*)(kp+6144); kf[7]=*(const __attribute__((address_space(3))) bf16x8*)(kp+6656);
}
__device__ __forceinline__ void kload2(bf16x8*kf,lds_cptr kp,int j){ kf[2*j]=*(const __attribute__((address_space(3))) bf16x8*)(kp+j*2048); kf[2*j+1]=*(const __attribute__((address_space(3))) bf16x8*)(kp+j*2048+512); }
__device__ __forceinline__ s16x4 vtr(lds_cptr p){ return __builtin_bit_cast(s16x4,__builtin_amdgcn_ds_read_tr16_b64_v4i16((__attribute__((address_space(3))) v4i16_t*)p)); }
__device__ __forceinline__ float rowmax(const f32x16&p0,const f32x16&p1){
  float a=max3f(p0[0],p0[1],p1[0]),b=max3f(p0[2],p0[3],p1[1]);a=max3f(a,p1[2],p1[3]);
  #pragma unroll
  for(int r=4;r<16;r+=4){a=max3f(a,p0[r],p0[r+1]);b=max3f(b,p0[r+2],p0[r+3]);a=max3f(a,p1[r],p1[r+1]);b=max3f(b,p1[r+2],p1[r+3]);}
  const float m=max2f(a,b);
  auto rr=__builtin_amdgcn_permlane32_swap(__float_as_uint(m),__float_as_uint(m),false,false);
  return max2f(__uint_as_float(rr[0]),__uint_as_float(rr[1]));
}
__device__ __forceinline__ void pv(f32x16*o,int vb,bf16x8 pa0,bf16x8 pa1,bf16x8 pa2,bf16x8 pa3){
  #pragma unroll
  for(int d0=0;d0<2;++d0){s16x4 lo[4],hi[4];
    #pragma unroll
    for(int ks=0;ks<4;++ks){
      asm volatile("ds_read_b64_tr_b16 %0,%1 offset:%c2":"=&v"(lo[ks]):"v"(vb),"i"(d0*4096+ks*1024):"memory");
      asm volatile("ds_read_b64_tr_b16 %0,%1 offset:%c2":"=&v"(hi[ks]):"v"(vb),"i"(d0*4096+ks*1024+512):"memory");}
    asm volatile("s_waitcnt lgkmcnt(0)":::"memory");SBAR();
    #define PK(k) (bf16x8){lo[k][0],lo[k][1],lo[k][2],lo[k][3],hi[k][0],hi[k][1],hi[k][2],hi[k][3]}
    o[d0]=__builtin_amdgcn_mfma_f32_32x32x16_bf16(pa0,PK(0),o[d0],0,0,0);
    o[d0]=__builtin_amdgcn_mfma_f32_32x32x16_bf16(pa1,PK(1),o[d0],0,0,0);
    o[d0]=__builtin_amdgcn_mfma_f32_32x32x16_bf16(pa2,PK(2),o[d0],0,0,0);
    o[d0]=__builtin_amdgcn_mfma_f32_32x32x16_bf16(pa3,PK(3),o[d0],0,0,0);
    #undef PK
  }
}

#ifndef ATTN_STORE16
#define ATTN_STORE16(p,v) (*(u32x4*)(p)=(v))
#endif
template<int THRL,bool STATICM> __device__ __forceinline__ void attn_unit(const bf16*Qu,const bf16*__restrict__ Kh,const bf16*__restrict__ Vh,bf16*Ou,const int NT,char*shm,const int tid,const float mref){
  const int lane=tid&63,r32=lane&31,hi=lane>>5; const int wid=__builtin_amdgcn_readfirstlane(tid>>6);
  const bf16*Qw=Qu+(long)(wid*QBLK)*QP;
  const unsigned lds0=(unsigned)(uintptr_t)shm;
  float*wsf=(float*)(shm+LDS_WS)+wid*64;
  const bf16*ksrc=Kh+(long)lane*KP+wid*8;
  const bf16*vsrc=Vh+(long)(16*(wid&3)+(lane>>2))*VP+(wid>>2)*32+(lane&3)*8;
  const unsigned kdst=lds0+LDS_K+wid*1024, vdst=lds0+LDS_V+wid*1024;
  #define DMA_K(t,slot) glds16(ksrc+(long)(t)*KVBLK*KP,(unsigned)__builtin_amdgcn_readfirstlane(kdst+(slot)))
  #define DMA_V(t,slot) glds16(vsrc+(long)(t)*KVBLK*VP,(unsigned)__builtin_amdgcn_readfirstlane(vdst+(slot)))
  const int vb0=(int)(lds0+LDS_V)+((lane>>4)&1)*32+(lane&3)*8+(4*hi+((lane&15)>>2))*64;
  const char*Kbase=shm+LDS_K; bf16x8 kf[8];
  const lds_cptr shm3=(lds_cptr)shm; const lds_cptr kp0=shm3+LDS_K+hi*1024+r32*16; const lds_cptr vp0=shm3+LDS_V+((lane>>4)&1)*32+(lane&3)*8+(4*hi+((lane&15)>>2))*64;
  DMA_K(0,0);DMA_V(0,0);DMA_K(1,SLOTB);
  bf16x8 qr[4];
  #pragma unroll
  for(int d0=0;d0<4;++d0)qr[d0]=*reinterpret_cast<const bf16x8*>(&Qw[(long)r32*QP+d0*16+hi*8]);
  float mhat=0.f,l_reg=0.f;f32x16 o[2];o[0]=f32x16{};o[1]=f32x16{};f32x16 negm=f32x16{};
  if constexpr(STATICM){ mhat=mref; _Pragma("unroll") for(int r=0;r<16;++r)negm[r]=-mref; }
  asm volatile("":"+v"(negm));
  #define CMASK(P0,P1,t) do{}while(0)
  bool resc=false;
  #define START(P0,P1) do{ resc=false; \
    if constexpr(!STATICM){ const float rm=rowmax(P0,P1); const float dl=rm; mhat=fadd_s(mhat,dl); \
      _Pragma("unroll") for(int r=0;r<16;++r){P0[r]=fsub_s(P0[r],dl);P1[r]=fsub_s(P1[r],dl);} \
      _Pragma("unroll") for(int r=0;r<16;++r)negm[r]=-mhat; asm volatile("":"+v"(negm)); } \
    _Pragma("unroll") for(int r=0;r<16;++r)P0[r]=__builtin_amdgcn_exp2f(P0[r]); }while(0)
  #define RESC() do{ if(resc){ asm volatile("s_waitcnt lgkmcnt(0)":::"memory"); \
      _Pragma("unroll") for(int d_=0;d_<2;++d_) _Pragma("unroll") for(int r=0;r<16;++r)o[d_][r]*=wsf[crow(r,hi)]; } }while(0)
  f32x16 pA0,pA1,pB0,pB1;
  int sl_prev=0,sl_cur=0,sl_next=SLOTB;
  #define ROT() do{sl_prev=sl_cur;sl_cur=sl_next;sl_next=(sl_next==(NSLOT-1)*SLOTB)?0:sl_next+SLOTB;}while(0)
  DMA_K(2,2*SLOTB);
  WAIT_BAR(3);
  qkt(pA0,pA1,Kbase,qr,negm,r32,hi);asm volatile("s_nop 15\n\ts_nop 7":"+v"(pA0),"+v"(pA1));CMASK(pA0,pA1,0);
  START(pA0,pA1);
  _Pragma("unroll") for(int r=0;r<16;++r)pA1[r]=__builtin_amdgcn_exp2f(pA1[r]);
  WAIT_BAR(0);
  DMA_K(3,0);DMA_V(1,SLOTB);
  ROT();
  kload8(kf,kp0+sl_cur);
  WAIT_BAR(2);
  s16x4 vlo[8],vhi[8]; u32x4 pw0,pw1,pw2,pw3;
  #define PKW(P,B) cvtpk_s(P[B],P[B+1])
  #define PAF(k) __builtin_bit_cast(bf16x8,pw##k)
  #define VFR(i) (bf16x8){vlo[i][0],vlo[i][1],vlo[i][2],vlo[i][3],vhi[i][0],vhi[i][1],vhi[i][2],vhi[i][3]}
  #define PIN(x) asm volatile("":"+v"(x))
  #define MX3(a,b,c) __builtin_fmaxf(__builtin_fmaxf((a),(b)),(c))
  #define GAPA(MF,A0,A1,A2,A3,W0,W1,PW) do{ MF; sacc+=A0; sacc+=A1; sacc+=A2; sacc+=A3; PIN(sacc); W0; W1; PIN(PW); SBAR(); }while(0)
  #define EX(v) __builtin_amdgcn_exp2f(v)
  #define GAPB(MF,X,B) do{ MF; X[B]=EX(X[B]); X[B+1]=EX(X[B+1]); X[B+2]=EX(X[B+2]); X[B+3]=EX(X[B+3]); PIN(X); SBAR(); }while(0)
  #define VRD(i) do{ vlo[i]=vtr(vp_+(((i)>>2)*4096+((i)&3)*1024)); vhi[i]=vtr(vp_+(((i)>>2)*4096+((i)&3)*1024+512)); }while(0)
  #define KRD(G,j) do{ if(G){ kload2(kf,kp0+sl_next,j); SBAR(); } }while(0)
  #define STEP(C0,C1,P0,P1,t,GK,GV,GL) do{ SBAR(); \
    const lds_cptr vp_=vp0+sl_prev; \
    VRD(0); SBAR(); float sacc=(P0[0]+P0[1]); \
    GAPA(C0=__builtin_amdgcn_mfma_f32_32x32x16_bf16(kf[0],qr[0],negm,0,0,0), P0[2],P0[3],P0[4],P0[5],     pw0[0]=PKW(P0,0), pw0[1]=PKW(P0,2), pw0); \
    VRD(4); SBAR(); GAPA(C1=__builtin_amdgcn_mfma_f32_32x32x16_bf16(kf[1],qr[0],negm,0,0,0), P0[6],P0[7],P0[8],P0[9],     pw0[2]=PKW(P0,4), pw0[3]=PKW(P0,6), pw0); \
    VRD(1); SBAR(); GAPA(C0=__builtin_amdgcn_mfma_f32_32x32x16_bf16(kf[2],qr[1],C0,0,0,0),   P0[10],P0[11],P0[12],P0[13], pw1[0]=PKW(P0,8), pw1[1]=PKW(P0,10), pw1); \
    VRD(5); SBAR(); GAPA(C1=__builtin_amdgcn_mfma_f32_32x32x16_bf16(kf[3],qr[1],C1,0,0,0),   P0[14],P0[15],P1[0],P1[1],   pw1[2]=PKW(P0,12),pw1[3]=PKW(P0,14), pw1); \
    VRD(2); SBAR(); GAPA(C0=__builtin_amdgcn_mfma_f32_32x32x16_bf16(kf[4],qr[2],C0,0,0,0),   P1[2],P1[3],P1[4],P1[5],     pw2[0]=PKW(P1,0), pw2[1]=PKW(P1,2), pw2); \
    VRD(6); SBAR(); GAPA(C1=__builtin_amdgcn_mfma_f32_32x32x16_bf16(kf[5],qr[2],C1,0,0,0),   P1[6],P1[7],P1[8],P1[9],     pw2[2]=PKW(P1,4), pw2[3]=PKW(P1,6), pw2); \
    VRD(3); SBAR(); GAPA(C0=__builtin_amdgcn_mfma_f32_32x32x16_bf16(kf[6],qr[3],C0,0,0,0),   P1[10],P1[11],P1[12],P1[13], pw3[0]=PKW(P1,8), pw3[1]=PKW(P1,10), pw3); \
    VRD(7); SBAR(); GAPA(C1=__builtin_amdgcn_mfma_f32_32x32x16_bf16(kf[7],qr[3],C1,0,0,0),   P1[14],P1[15],0.f,0.f,       pw3[2]=PKW(P1,12),pw3[3]=PKW(P1,14), pw3); \
    l_reg+=sacc; \
    if(GK){DMA_K((t)+3,sl_cur);} if(GV){DMA_V((t)+1,sl_next);} \
    CMASK(C0,C1,t); \
    if constexpr(!STATICM){ float a=MX3(C0[0],C0[1],C1[0]),b=MX3(C0[2],C0[3],C1[1]); a=MX3(a,C1[2],C1[3]); \
      _Pragma("unroll") for(int r=4;r<16;r+=4){a=MX3(a,C0[r],C0[r+1]);b=MX3(b,C0[r+2],C0[r+3]);a=MX3(a,C1[r],C1[r+1]);b=MX3(b,C1[r+2],C1[r+3]);} \
      float rm=__builtin_fmaxf(a,b); { auto rr=__builtin_amdgcn_permlane32_swap(__float_as_uint(rm),__float_as_uint(rm),false,false); rm=__builtin_fmaxf(__uint_as_float(rr[0]),__uint_as_float(rr[1])); } \
      resc=false; \
      if(__builtin_expect(__any(rm>(float)THRL),0)){ const float dl=__builtin_fmaxf(rm,0.f); mhat+=dl; \
        _Pragma("unroll") for(int r=0;r<16;++r){C0[r]-=dl;C1[r]-=dl;} \
        _Pragma("unroll") for(int r=0;r<16;++r)negm[r]=-mhat; asm volatile("":"+v"(negm)); \
        const float f=__builtin_amdgcn_exp2f(-dl); l_reg*=f; if(hi==0)wsf[r32]=f; resc=true; } } \
    SBAR(); \
    GAPB(o[0]=__builtin_amdgcn_mfma_f32_32x32x16_bf16(PAF(0),VFR(0),o[0],0,0,0), C0,0); \
    GAPB(o[1]=__builtin_amdgcn_mfma_f32_32x32x16_bf16(PAF(0),VFR(4),o[1],0,0,0), C0,4); \
    KRD(GL,0); GAPB(o[0]=__builtin_amdgcn_mfma_f32_32x32x16_bf16(PAF(1),VFR(1),o[0],0,0,0), C0,8); \
    KRD(GL,1); GAPB(o[1]=__builtin_amdgcn_mfma_f32_32x32x16_bf16(PAF(1),VFR(5),o[1],0,0,0), C0,12); \
    KRD(GL,2); GAPB(o[0]=__builtin_amdgcn_mfma_f32_32x32x16_bf16(PAF(2),VFR(2),o[0],0,0,0), C1,0); \
    KRD(GL,3); GAPB(o[1]=__builtin_amdgcn_mfma_f32_32x32x16_bf16(PAF(2),VFR(6),o[1],0,0,0), C1,4); \
    GAPB(o[0]=__builtin_amdgcn_mfma_f32_32x32x16_bf16(PAF(3),VFR(3),o[0],0,0,0), C1,8); \
    GAPB(o[1]=__builtin_amdgcn_mfma_f32_32x32x16_bf16(PAF(3),VFR(7),o[1],0,0,0), C1,12); \
    }while(0)
  int t=1;
  #undef CMASK
  #define CMASK(P0,P1,t) do{}while(0)
  for(;t+5<NT;t+=2){
    STEP(pB0,pB1,pA0,pA1,t,true,true,true);     WAIT_BAR(2); RESC(); ROT();
    STEP(pA0,pA1,pB0,pB1,t+1,true,true,true);   WAIT_BAR(2); RESC(); ROT();
  }
  #undef CMASK
  #define CMASK(P0,P1,t) do{}while(0)
  #define ENDW(tt) do{ if((tt)+3<NT){WAIT_BAR(2);} else if((tt)+2<NT){WAIT_BAR(1);} else {WAIT_BAR(0);} }while(0)
  for(;t+1<NT;t+=2){
    STEP(pB0,pB1,pA0,pA1,t,(t+3<NT),(t+1<NT),(t+1<NT));       ENDW(t);   RESC(); ROT();
    STEP(pA0,pA1,pB0,pB1,t+1,(t+4<NT),(t+2<NT),(t+2<NT));     ENDW(t+1); RESC(); ROT();
  }
  STEP(pB0,pB1,pA0,pA1,NT-1,false,false,false); RESC();
  { float sacc=pB0[0]+pB0[1]; _Pragma("unroll") for(int r=2;r<16;++r)sacc+=pB0[r]; _Pragma("unroll") for(int r=0;r<16;++r)sacc+=pB1[r]; l_reg+=sacc;
    pw0=(u32x4){PKW(pB0,0),PKW(pB0,2),PKW(pB0,4),PKW(pB0,6)};pw1=(u32x4){PKW(pB0,8),PKW(pB0,10),PKW(pB0,12),PKW(pB0,14)};pw2=(u32x4){PKW(pB1,0),PKW(pB1,2),PKW(pB1,4),PKW(pB1,6)};pw3=(u32x4){PKW(pB1,8),PKW(pB1,10),PKW(pB1,12),PKW(pB1,14)};
    SBAR(); pv(o,vb0+sl_cur,PAF(0),PAF(1),PAF(2),PAF(3)); }
  #undef PKW
  #undef PAF
  #undef VFR
  #undef PIN
  #undef MX3
  #undef GAPA
  #undef GAPB
  #undef EX
  #undef VRD
  #undef KRD
  #undef STEP
  #undef ENDW
  {auto rr=__builtin_amdgcn_permlane32_swap(__float_as_uint(l_reg),__float_as_uint(l_reg),false,false);l_reg=__uint_as_float(rr[0])+__uint_as_float(rr[1]);}
  if(hi==0)wsf[32+r32]=l_reg;asm volatile("s_waitcnt lgkmcnt(0)":::"memory");
  float rli[16];
  #pragma unroll
  for(int r=0;r<16;++r)rli[r]=__builtin_amdgcn_rcpf(wsf[32+crow(r,hi)]);
  bf16*Ow=Ou+(long)(wid*QBLK)*OP;
  { bf16*stg=(bf16*)(shm+LDS_OST)+wid*2048;
    #pragma unroll
    for(int r=0;r<16;++r){const int orow=crow(r,hi);
      #pragma unroll
      for(int d0=0;d0<2;++d0)stg[orow*64+d0*32+r32]=__float2bfloat16(o[d0][r]*rli[r]);}
    asm volatile("s_waitcnt lgkmcnt(0)":::"memory");
    #pragma unroll
    for(int i=0;i<4;++i){const int row=i*8+(lane>>3),ch=lane&7; const u32x4 v=*(const u32x4*)(stg+row*64+ch*8); ATTN_STORE16(Ow+(long)row*OP+ch*8,v);} }
  asm volatile("s_waitcnt lgkmcnt(0)\n\ts_barrier":::"memory");
  #undef DMA_K
  #undef DMA_V
  #undef CMASK
  #undef START
  #undef RESC
  #undef ROT
}
constexpr int ATTN_LDS_BYTES=LDS_BYTES;
#undef SBAR
#undef WAIT_BAR
}
#ifndef PROBE_K
#define PROBE_K 0
#define PROBE_A 0
#define PROBE_B 0
#endif
constexpr int NWAVES = 8, NTHR = 512;
constexpr int DM = 1024, SEQL = 16384, CTXL = 256, R = SEQL + CTXL;
constexpr int DIN = 2832, NZ = 2816;
constexpr int NEXP = 16, FF = 2048, CAPL = 2048, CAPC = 32, ESLOTS = 2304;
constexpr int NCHUNK = R / 128;
constexpr float EPSN = 1e-6f;
constexpr int ZC_CONVX = 0, ZC_CONVB = 256, ZC_CONVC = 512, ZC_CU = 768, ZC_CV = 1024, ZC_Q = 1280, ZC_K = 1536, ZC_V = 1664, ZC_MQ = 1792, ZC_MK = 2048, ZC_MV = 2304, ZC_MO = 2560;

constexpr size_t MiB = 1u << 20;
constexpr size_t WS_CTL = 0;
constexpr size_t WS_MOD = 1 * MiB;
constexpr size_t WS_ROPE = WS_MOD + 256 * 1024;
constexpr size_t WS_WG = WS_MOD + 128 * 1024;
constexpr size_t WS_CWS = WS_MOD + 512 * 1024;
constexpr size_t WS_WIN = 2 * MiB;
constexpr size_t WS_WOUT = 14 * MiB;
constexpr size_t WS_W13 = 18 * MiB;
constexpr size_t WS_W2 = 274 * MiB;
constexpr size_t WS_XW = 402 * MiB;
constexpr size_t WS_H = 467 * MiB;
constexpr size_t WS_H2 = 500 * MiB;
constexpr size_t WS_MIX = 533 * MiB;
constexpr size_t WS_Z = 566 * MiB;
constexpr size_t WS_QB = 656 * MiB;
constexpr size_t WS_KB = 665 * MiB;
constexpr size_t WS_VB = 670 * MiB;
constexpr size_t WS_G = 675 * MiB;
constexpr size_t WS_CLOC = 677 * MiB;
constexpr size_t WS_NLOC = 694 * MiB;
constexpr size_t WS_SCAL = WS_NLOC + 512 * 1024;
constexpr size_t WS_AFF = 695 * MiB;
constexpr size_t WS_IDX = 697 * MiB;
constexpr size_t WS_GATE = WS_IDX + 512 * 1024;
constexpr size_t WS_SLOT = 698 * MiB;
constexpr size_t WS_HID = 700 * MiB;
constexpr size_t WS_Y = 844 * MiB;
constexpr size_t WS_END = 916 * MiB;
static_assert(WS_WIN + (size_t)2 * NZ * DM * 2 <= WS_WOUT && WS_Z + (size_t)R * NZ * 2 <= WS_QB && WS_QB + (size_t)R * 256 * 2 <= WS_KB && WS_KB + (size_t)R * 128 * 2 <= WS_VB && WS_VB + (size_t)R * 128 * 2 <= WS_G, "ws map");
static_assert(WS_G + (size_t)R * 16 * 4 <= WS_CLOC && WS_CLOC + (size_t)NCHUNK * 8 * 4096 * 4 <= WS_NLOC && WS_XW + (size_t)R * DM * 4 <= WS_H && WS_H + (size_t)R * DM * 2 <= WS_H2 && WS_MIX + (size_t)R * DM * 2 <= WS_Z, "ws map");
static_assert(WS_HID + (size_t)16 * ESLOTS * FF * 2 <= WS_Y && WS_Y + (size_t)16 * ESLOTS * DM * 2 <= WS_END && WS_AFF + (size_t)16 * R * 4 <= WS_IDX && WS_SLOT + (size_t)R * 16 * 4 <= WS_HID, "ws map");

#ifndef MOE_FP8
#define MOE_FP8 1
#endif
constexpr float W_F8S = 64.0f, H2_F8S = 2.0f, HID_F8S = 4.0f;
constexpr int LDS_BYTES = 147456;

typedef unsigned short bf16;
typedef unsigned v4u __attribute__((ext_vector_type(4)));
typedef unsigned v2u __attribute__((ext_vector_type(2)));
typedef float f32x4 __attribute__((ext_vector_type(4)));
typedef float f32x2 __attribute__((ext_vector_type(2)));
typedef short bf16x8 __attribute__((ext_vector_type(8)));
typedef __bf16 bf16x2_t __attribute__((ext_vector_type(2)));

__device__ __forceinline__ unsigned pk2(float lo, float hi) { f32x2 v = {lo, hi}; bf16x2_t b = __builtin_convertvector(v, bf16x2_t); return __builtin_bit_cast(unsigned, b); }
__device__ __forceinline__ float bf_lo(unsigned w) { return __uint_as_float(w << 16); }
__device__ __forceinline__ float bf_hi(unsigned w) { return __uint_as_float(w & 0xffff0000u); }
__device__ __forceinline__ float bf2f(bf16 h) { return __uint_as_float((unsigned)h << 16); }
__device__ __forceinline__ bf16 f2bf(float f) { return (bf16)(pk2(f, 0.f) & 0xffffu); }
template <int CTRL> __device__ __forceinline__ float dppf(float v) { return __int_as_float(__builtin_amdgcn_update_dpp(__float_as_int(v), __float_as_int(v), CTRL, 0xF, 0xF, false)); }
constexpr int DPP_X1 = 0xB1, DPP_X2 = 0x4E, DPP_HMIR = 0x141, DPP_MIR = 0x140, DPP_ROR8 = 0x128;
__device__ __forceinline__ float swap16_sum(float a, float b) { auto r = __builtin_amdgcn_permlane16_swap(__float_as_uint(a), __float_as_uint(b), false, false); return __uint_as_float(r[0]) + __uint_as_float(r[1]); }
__device__ __forceinline__ float swap32_sum(float a, float b) { auto r = __builtin_amdgcn_permlane32_swap(__float_as_uint(a), __float_as_uint(b), false, false); return __uint_as_float(r[0]) + __uint_as_float(r[1]); }
__device__ __forceinline__ float swap16_max(float a) { auto r = __builtin_amdgcn_permlane16_swap(__float_as_uint(a), __float_as_uint(a), false, false); return fmaxf(__uint_as_float(r[0]), __uint_as_float(r[1])); }
__device__ __forceinline__ float swap32_max(float a) { auto r = __builtin_amdgcn_permlane32_swap(__float_as_uint(a), __float_as_uint(a), false, false); return fmaxf(__uint_as_float(r[0]), __uint_as_float(r[1])); }
__device__ __forceinline__ float wave_sum(float v) {
    v += dppf<DPP_X1>(v); v += dppf<DPP_X2>(v); v += dppf<DPP_HMIR>(v); v += dppf<DPP_MIR>(v);
    v = swap16_sum(v, v); v = swap32_sum(v, v); return v;
}
__device__ __forceinline__ float wave_max(float v) {
#pragma unroll
    for (int o = 32; o > 0; o >>= 1) v = fmaxf(v, __shfl_xor(v, o));
    return v;
}

struct Args {
    const float *x, *c, *ctx, *c_ctx, *ada_w, *ada_b, *norm1_g, *w_in, *conv_w, *cmlp_norm_g, *cmlp_ws, *cmlp_bs, *q_norm_g, *k_norm_g, *ml_igate_b, *ml_fgate_b, *ml_norm_g, *w_out, *norm2_g, *router_w, *exp_w1, *exp_w3, *exp_w2, *final_norm_g;
    float* out; unsigned char* ws; int ph_lo, ph_hi;
};
typedef const __attribute__((address_space(4))) Args* KArgs;
struct Ctx { KArgs a; unsigned char* lds; int tid, lane, wave, G, bid, vcu; };
#define BLOCK_SYNC() __syncthreads()

struct CvTile { const float* src; bf16* dst; int ld, K; float f8s; };
__device__ __forceinline__ void cv_load(const CvTile& T, int lane, f32x4 (&v)[8]) {
#pragma unroll
    for (int i = 0; i < 8; ++i) { const int idx = i * 64 + lane; v[i] = __builtin_nontemporal_load((const f32x4*)(T.src + (size_t)(idx >> 3) * T.ld + (idx & 7) * 4)); }
}
__device__ __forceinline__ void cv_store(const CvTile& T, int lane, const f32x4 (&v)[8], float* scr) {
#pragma unroll
    for (int i = 0; i < 8; ++i) { const int idx = i * 64 + lane; float* p = scr + (idx >> 3) * 33 + (idx & 7) * 4; p[0] = v[i][0]; p[1] = v[i][1]; p[2] = v[i][2]; p[3] = v[i][3]; }
    asm volatile("s_waitcnt lgkmcnt(0)" ::: "memory");
    const int c = lane & 7;
#pragma unroll
    for (int j = 0; j < 4; ++j) { const int n = (lane >> 3) + 8 * j; const float* s = scr + (8 * c) * 33 + n;
        if (T.f8s != 0.f) { const float q = T.f8s; v2u o; o.x = pg8::pk4_fp8(s[0 * 33] * q, s[1 * 33] * q, s[2 * 33] * q, s[3 * 33] * q); o.y = pg8::pk4_fp8(s[4 * 33] * q, s[5 * 33] * q, s[6 * 33] * q, s[7 * 33] * q);
            __builtin_nontemporal_store(o, (v2u*)((unsigned char*)T.dst + (size_t)n * T.K + 8 * c)); }
        else { v4u o; o.x = pk2(s[0 * 33], s[1 * 33]); o.y = pk2(s[2 * 33], s[3 * 33]); o.z = pk2(s[4 * 33], s[5 * 33]); o.w = pk2(s[6 * 33], s[7 * 33]);
            *(v4u*)(T.dst + (size_t)n * T.K + 8 * c) = o; } }
    asm volatile("s_waitcnt lgkmcnt(0)" ::: "memory");
}
constexpr int CV_WIN = 16 * 88, CV_WOUT = 16 * 32, CV_SMALL = 2 * (CV_WIN + CV_WOUT), CV_EXP = 3072, CV_EXPL = 16 * CV_EXP;
__device__ __forceinline__ CvTile cv_small(const Ctx& C, int q) {
    const int l = q / (CV_WIN + CV_WOUT); int r = q % (CV_WIN + CV_WOUT); CvTile T; T.f8s = 0.f;
    if (r < CV_WIN) { const int kb = r / 88, nb = r % 88; T.src = C.a->w_in + (size_t)l * DM * DIN + (size_t)(kb * 64) * DIN + nb * 32; T.ld = DIN; T.K = DM; T.dst = ((bf16*)(C.a->ws + WS_WIN)) + (size_t)l * NZ * DM + (size_t)(nb * 32) * DM + kb * 64; }
    else { r -= CV_WIN; const int kb = r / 32, nb = r % 32; T.src = C.a->w_out + (size_t)l * DM * DM + (size_t)(kb * 64) * DM + nb * 32; T.ld = DM; T.K = DM; T.dst = ((bf16*)(C.a->ws + WS_WOUT)) + (size_t)l * DM * DM + (size_t)(nb * 32) * DM + kb * 64; }
    return T;
}
__device__ __forceinline__ CvTile cv_expert(const Ctx& C, int l, int q) {
    const int e = (q < 16384) ? (q >> 10) : ((q - 16384) >> 11), s = (q < 16384) ? (2048 + (q & 1023)) : ((q - 16384) & 2047); const size_t le = (size_t)(l * NEXP + e); CvTile T;
#if MOE_FP8
    T.f8s = W_F8S;
    if (s < 2048) { const int which = s >> 10, r = s & 1023, kb = r / 64, nb = r % 64, n0 = nb * 32;
        T.src = (which ? C.a->exp_w3 : C.a->exp_w1) + le * DM * FF + (size_t)(kb * 64) * FF + n0; T.ld = FF; T.K = DM;
        T.dst = (bf16*)((unsigned char*)(C.a->ws + WS_W13) + le * 4096 * DM + (size_t)((n0 >> 7) * 256 + which * 128 + (n0 & 127)) * DM + kb * 64); }
    else { const int r = s - 2048, kb = r / 32, nb = r % 32; T.src = C.a->exp_w2 + le * FF * DM + (size_t)(kb * 64) * DM + nb * 32; T.ld = DM; T.K = FF; T.dst = (bf16*)((unsigned char*)(C.a->ws + WS_W2) + le * DM * FF + (size_t)(nb * 32) * FF + kb * 64); }
#else
    T.f8s = 0.f;
    if (s < 2048) { const int which = s >> 10, r = s & 1023, kb = r / 64, nb = r % 64, n0 = nb * 32;
        T.src = (which ? C.a->exp_w3 : C.a->exp_w1) + le * DM * FF + (size_t)(kb * 64) * FF + n0; T.ld = FF; T.K = DM;
        T.dst = ((bf16*)(C.a->ws + WS_W13)) + le * 4096 * DM + (size_t)((n0 >> 7) * 256 + which * 128 + (n0 & 127)) * DM + kb * 64; }
    else { const int r = s - 2048, kb = r / 32, nb = r % 32; T.src = C.a->exp_w2 + le * FF * DM + (size_t)(kb * 64) * DM + nb * 32; T.ld = DM; T.K = FF; T.dst = ((bf16*)(C.a->ws + WS_W2)) + le * DM * FF + (size_t)(nb * 32) * FF + kb * 64; }
#endif
    return T;
}
template <bool EXPERT> __device__ __forceinline__ void convert_stream(const Ctx& C, int l, int first, int stride, int total) {
    float* scr = (float*)C.lds + C.wave * (64 * 33);
    int it = first; if (it >= total) return;
    f32x4 va[8], vb[8], vc[8], vd[8], ve[8];
    CvTile Ta = EXPERT ? cv_expert(C, l, it) : cv_small(C, it), Tb = Ta, Tc = Ta, Td = Ta, Te = Ta;
#define CV_TILE(q_) (EXPERT ? cv_expert(C, l, (q_)) : cv_small(C, (q_)))
#define CV_AHEAD(T_, v_, n_) if (it + (n_) * stride < total) { T_ = CV_TILE(it + (n_) * stride); cv_load(T_, C.lane, v_); }
    cv_load(Ta, C.lane, va);
    CV_AHEAD(Tb, vb, 1) CV_AHEAD(Tc, vc, 2) CV_AHEAD(Td, vd, 3)
#pragma unroll 1
    for (;;) {
        CV_AHEAD(Te, ve, 4) cv_store(Ta, C.lane, va, scr); it += stride; if (it >= total) break;
        CV_AHEAD(Ta, va, 4) cv_store(Tb, C.lane, vb, scr); it += stride; if (it >= total) break;
        CV_AHEAD(Tb, vb, 4) cv_store(Tc, C.lane, vc, scr); it += stride; if (it >= total) break;
        CV_AHEAD(Tc, vc, 4) cv_store(Td, C.lane, vd, scr); it += stride; if (it >= total) break;
        CV_AHEAD(Td, vd, 4) cv_store(Te, C.lane, ve, scr); it += stride; if (it >= total) break;
    }
#undef CV_AHEAD
#undef CV_TILE
}
__device__ __forceinline__ void phase_init(Ctx& C) {
    float* lf = (float*)C.lds;
    for (int m = C.bid; m < 192; m += C.G) {
        const int l = m / 96, j0 = (m % 96) * 64;
        float* sc = lf; float* red = lf + 2048;
        for (int i = C.tid; i < 2048; i += NTHR) { const float v = (i < 1024) ? C.a->c[i] : C.a->c_ctx[i - 1024]; sc[i] = v / (1.0f + __expf(-v)); }
        BLOCK_SYNC();
        const float* W = C.a->ada_w + (size_t)l * DM * 6144 + j0 + C.lane;
        float a0 = 0.f, a1 = 0.f;
#pragma unroll 32
        for (int k = C.wave * 128; k < C.wave * 128 + 128; ++k) { const float w = W[(size_t)k * 6144]; a0 += sc[k] * w; a1 += sc[1024 + k] * w; }
        red[(C.wave * 2 + 0) * 64 + C.lane] = a0; red[(C.wave * 2 + 1) * 64 + C.lane] = a1;
        BLOCK_SYNC();
        if (C.tid < 128) { const int s = C.tid >> 6, j = C.tid & 63; float t = 0.f;
#pragma unroll
            for (int w = 0; w < 8; ++w) t += red[(w * 2 + s) * 64 + j];
            ((float*)(C.a->ws + WS_MOD))[(size_t)(l * 2 + s) * 6144 + j0 + j] = t + C.a->ada_b[l * 6144 + j0 + j]; }
        BLOCK_SYNC();
    }
    if (C.bid == C.G - 1) {
        for (int i = C.tid; i < 4096; i += NTHR) { const int pos = i >> 4, f = i & 15;
            const float inv = powf(10000.0f, -(float)(2 * f) / 32.0f); const float ang = (float)pos * inv;
            ((float*)(C.a->ws + WS_ROPE))[2 * i] = (float)cos((double)ang); ((float*)(C.a->ws + WS_ROPE))[2 * i + 1] = (float)sin((double)ang); }
    }
    BLOCK_SYNC();
    for (int i = C.bid * NTHR + C.tid; i < 2 * 16 * 1024; i += C.G * NTHR) { const int l = i >> 14, e = (i >> 10) & 15, c = i & 1023; ((float*)(C.a->ws + WS_WG))[i] = C.a->w_in[(size_t)l * DM * DIN + (size_t)c * DIN + NZ + e]; }
    for (int i = (C.bid * NTHR + C.tid) * 4; i < 2 * 4 * 128 * 128; i += C.G * NTHR * 4) { const f32x4 w = *(const f32x4*)(C.a->cmlp_ws + i); v2u o; o.x = pk2(w[0], w[1]); o.y = pk2(w[2], w[3]); *(v2u*)(((bf16*)(C.a->ws + WS_CWS)) + i) = o; }
    convert_stream<false>(C, 0, C.bid * NWAVES + C.wave, C.G * NWAVES, CV_SMALL);
}
constexpr int CV_BFREE0 = 203, CV_BPW = 0, CV_HPW = 13;
__device__ __forceinline__ int cv_nb(int G) { return (G == 256) ? (256 - CV_BFREE0) * NWAVES * CV_BPW : 0; }
__device__ __forceinline__ int cv_nh(int G, int l) { const int busy = (l == 0) ? 32 : 16; return (G > busy) ? 16384 : 0; }
__device__ __forceinline__ void convert_experts_B(Ctx& C, int l) { if (C.G == 256 && C.bid >= CV_BFREE0) convert_stream<true>(C, l, (C.bid - CV_BFREE0) * NWAVES + C.wave, (256 - CV_BFREE0) * NWAVES, cv_nb(C.G)); }
__device__ __forceinline__ void convert_experts_H(Ctx& C, int l) { const int busy = (l == 0) ? 32 : 16; if (C.bid >= busy) convert_stream<true>(C, l, cv_nb(C.G) + (C.bid - busy) * NWAVES + C.wave, (C.G - busy) * NWAVES, cv_nb(C.G) + cv_nh(C.G, l)); }
__device__ __forceinline__ void convert_experts(Ctx& C, int l) {
    int rank = C.bid, n = C.G;
    if (l == 0 && C.G > 20) { if (C.bid < 8 || (C.bid >= 16 && C.bid < 20)) return; rank = C.bid - 8 - (C.bid >= 20 ? 4 : 0); n = C.G - 12; }
    convert_stream<true>(C, l, cv_nb(C.G) + cv_nh(C.G, l) + rank * NWAVES + C.wave, n * NWAVES, CV_EXPL);
}

__device__ __forceinline__ void stage_m16(Ctx& C, const float* src, int ld, int off, float* M16, const int nthr = NTHR, const bool sync = true) {
    for (int c = C.tid; c < 1024; c += nthr) { const f32x4* p = (const f32x4*)(src + (size_t)c * ld + off);
#pragma unroll
        for (int q = 0; q < 4; ++q) { const f32x4 v = p[q]; M16[(q * 4 + 0) * 1024 + c] = v[0]; M16[(q * 4 + 1) * 1024 + c] = v[1]; M16[(q * 4 + 2) * 1024 + c] = v[2]; M16[(q * 4 + 3) * 1024 + c] = v[3]; } }
    if (sync) BLOCK_SYNC();
}
__device__ __forceinline__ void stage_mod(Ctx& C, const float* g, int l, int part_shift, float* MV, const int nthr = NTHR) {
    for (int i = C.tid; i < 2048; i += nthr) { const int var = i >> 10, c = i & 1023; const float* modp = ((const float*)(C.a->ws + WS_MOD)) + (size_t)(l * 2 + var) * 6144 + part_shift * 1024;
        MV[(var * 2 + 0) * 1024 + c] = g[c] * (1.0f + modp[1024 + c]); MV[(var * 2 + 1) * 1024 + c] = modp[c]; }
}
__device__ __forceinline__ void stage_copy16(Ctx& C, const float* src, float* M16, const int nthr = NTHR, const bool sync = true) {
    for (int i = C.tid * 4; i < 16 * 1024; i += nthr * 4) *(f32x4*)(M16 + i) = *(const f32x4*)(src + i);
    if (sync) BLOCK_SYNC();
}
template <bool F8 = false> __device__ __forceinline__ void norm_mod_row(f32x4 (&v)[4], const float* gs, const float* sh, bf16* orow, int lane) {
    float ss = 0.f;
#pragma unroll
    for (int j = 0; j < 4; ++j) ss += (v[j][0] * v[j][0] + v[j][1] * v[j][1]) + (v[j][2] * v[j][2] + v[j][3] * v[j][3]);
    const float rstd = rsqrtf(wave_sum(ss) * (1.0f / 1024.0f) + EPSN);
#pragma unroll
    for (int j = 0; j < 4; ++j) { const int c = 4 * lane + 256 * j;
        const f32x4 gv = *(const f32x4*)(gs + c), sv = *(const f32x4*)(sh + c);
        const f32x4 h = (v[j] * rstd) * gv + sv; v[j] = h;
        if constexpr (F8) { *(unsigned*)((unsigned char*)orow + c) = pg8::pk4_fp8(h[0] * H2_F8S, h[1] * H2_F8S, h[2] * H2_F8S, h[3] * H2_F8S); }
        else { v2u w; w.x = pk2(h[0], h[1]); w.y = pk2(h[2], h[3]); *(v2u*)(orow + c) = w; } }
}
__device__ __forceinline__ float dot16(const f32x4 (&v)[4], const float* M16_, int lane) {
    unsigned zoff = 0u; asm volatile("" : "+s"(zoff));
    const __attribute__((address_space(3))) float* M16 = (const __attribute__((address_space(3))) float*)M16_ + zoff;
    float p[16];
    f32x4 wb[3][4];
#define D16_LOAD(e_) do { _Pragma("unroll") for (int j = 0; j < 4; ++j) wb[(e_) % 3][j] = *(const __attribute__((address_space(3))) f32x4*)(M16 + (e_) * 1024 + 4 * lane + 256 * j); } while (0)
    D16_LOAD(0); D16_LOAD(1);
#pragma unroll
    for (int e = 0; e < 16; ++e) {
        if (e + 2 < 16) D16_LOAD(e + 2);
        asm volatile("" ::: "memory");
        f32x2 s2 = {0.f, 0.f};
#pragma unroll
        for (int j = 0; j < 4; ++j) { const f32x4 w = wb[e % 3][j]; s2 = __builtin_elementwise_fma((f32x2){v[j][0], v[j][1]}, (f32x2){w[0], w[1]}, s2); s2 = __builtin_elementwise_fma((f32x2){v[j][2], v[j][3]}, (f32x2){w[2], w[3]}, s2); }
        p[e] = s2[0] + s2[1]; asm volatile("" : "+v"(p[e])); }
#undef D16_LOAD
    const bool b3 = (lane & 8) != 0, b2 = (lane & 4) != 0;
#pragma unroll
    for (int e = 0; e < 8; ++e) p[e] = swap32_sum(p[e], p[e + 8]);
#pragma unroll
    for (int e = 0; e < 4; ++e) p[e] = swap16_sum(p[e], p[e + 4]);
#pragma unroll
    for (int e = 0; e < 2; ++e) { const float send = b3 ? p[e] : p[e + 2], keep = b3 ? p[e + 2] : p[e]; p[e] = keep + dppf<DPP_ROR8>(send); }
    { const float send = b2 ? p[0] : p[1], keep = b2 ? p[1] : p[0]; p[0] = keep + dppf<DPP_HMIR>(send); }
    float r = p[0]; r += dppf<DPP_X1>(r); r += dppf<DPP_X2>(r);
    return r;
}
__device__ __forceinline__ const float* row_src0(const Ctx& C, int r) { return (r < CTXL) ? C.a->ctx + (size_t)r * DM : C.a->x + (size_t)(r - CTXL) * DM; }
__device__ __forceinline__ void row_A(Ctx& C, f32x4 (&v)[4], int r, const float* MV, const float* M16) {
    const float* mv = MV + (r < CTXL ? 2048 : 0);
    norm_mod_row(v, mv, mv + 1024, ((bf16*)(C.a->ws + WS_H)) + (size_t)r * DM, C.lane);
    const float o = dot16(v, M16, C.lane);
    if ((C.lane & 3) == 0) ((float*)(C.a->ws + WS_G))[(size_t)r * 16 + (C.lane >> 2)] = o;
}
__device__ __forceinline__ void phase_A0(Ctx& C) {
    const int gw = C.bid * NWAVES + C.wave, NGW = C.G * NWAVES;
    f32x4 va[4], vb[4]; int r = gw;
    if (r < R) { const float* src = row_src0(C, r);
#pragma unroll
        for (int j = 0; j < 4; ++j) va[j] = __builtin_nontemporal_load((const f32x4*)src + C.lane + 64 * j); }
    if (r + NGW < R) { const float* src = row_src0(C, r + NGW);
#pragma unroll
        for (int j = 0; j < 4; ++j) vb[j] = __builtin_nontemporal_load((const f32x4*)src + C.lane + 64 * j); }
    float* M16 = (float*)C.lds; float* MV = M16 + 16 * 1024; stage_mod(C, C.a->norm1_g, 0, 0, MV); stage_copy16(C, (const float*)(C.a->ws + WS_WG), M16);
#pragma unroll 1
    for (; r < R; r += NGW) {
        f32x4 v[4];
#pragma unroll
        for (int j = 0; j < 4; ++j) { v[j] = va[j]; va[j] = vb[j]; }
        if (r + 2 * NGW < R) { const float* src = row_src0(C, r + 2 * NGW);
#pragma unroll
            for (int j = 0; j < 4; ++j) vb[j] = __builtin_nontemporal_load((const f32x4*)src + C.lane + 64 * j); }
        row_A(C, v, r, MV, M16);
    }
}
__device__ __forceinline__ void stage_G(Ctx& C, int l, const int nthr) {
    float* M16 = (float*)C.lds; float* MV = M16 + 16 * 1024; stage_mod(C, C.a->norm2_g + l * DM, l, 3, MV, nthr); stage_m16(C, C.a->router_w + (size_t)l * DM * 16, 16, 0, M16, nthr, false);
}
__device__ __forceinline__ f32x4 bf4_f32(const v2u w) { return (f32x4){bf_lo(w.x), bf_hi(w.x), bf_lo(w.y), bf_hi(w.y)}; }
__device__ __forceinline__ void phase_G(Ctx& C, int l) {
    const int gw = C.bid * NWAVES + C.wave, NGW = C.G * NWAVES; const int r0 = (l == 0) ? 0 : CTXL;
    const bf16* XW = (const bf16*)(C.a->ws + WS_XW);
    v2u va[4], vb[4]; int r = r0 + gw;
    if (r < R) {
#pragma unroll
        for (int j = 0; j < 4; ++j) va[j] = ((const v2u*)(XW + (size_t)r * DM))[C.lane + 64 * j]; }
    if (r + NGW < R) {
#pragma unroll
        for (int j = 0; j < 4; ++j) vb[j] = ((const v2u*)(XW + (size_t)(r + NGW) * DM))[C.lane + 64 * j]; }
    float* M16 = (float*)C.lds; float* MV = M16 + 16 * 1024;
#pragma unroll 1
    for (; r < R; r += NGW) {
        f32x4 v[4];
#pragma unroll
        for (int j = 0; j < 4; ++j) { v[j] = bf4_f32(va[j]); va[j] = vb[j]; }
        if (r + 2 * NGW < R) {
#pragma unroll
            for (int j = 0; j < 4; ++j) vb[j] = ((const v2u*)(XW + (size_t)(r + 2 * NGW) * DM))[C.lane + 64 * j]; }
        const float* mv = MV + (r < CTXL ? 2048 : 0);
#if MOE_FP8
        norm_mod_row<true>(v, mv, mv + 1024, (bf16*)((unsigned char*)(C.a->ws + WS_H2) + (size_t)r * DM), C.lane);
#else
        norm_mod_row(v, mv, mv + 1024, ((bf16*)(C.a->ws + WS_H2)) + (size_t)r * DM, C.lane);
#endif
        const float lg = dot16(v, M16, C.lane);
        float mx = lg;
        mx = fmaxf(mx, dppf<DPP_HMIR>(mx)); mx = fmaxf(mx, dppf<DPP_MIR>(mx)); mx = swap16_max(mx); mx = swap32_max(mx);
        const float o = __expf(lg - mx); float sum = o;
        sum += dppf<DPP_HMIR>(sum); sum += dppf<DPP_MIR>(sum); sum = swap16_sum(sum, sum); sum = swap32_sum(sum, sum);
        if ((C.lane & 3) == 0) ((float*)(C.a->ws + WS_AFF))[(size_t)(C.lane >> 2) * R + r] = o / sum;
    }
}
__device__ __forceinline__ void stage_K(Ctx& C, int l, const int nthr) {
    float* M16 = (float*)C.lds; float* MV = M16 + 16 * 1024; float* GV = MV + 4096;
    for (int i = C.tid; i < 2048; i += nthr) GV[i] = ((const float*)(C.a->ws + WS_MOD))[(size_t)(l * 2 + (i >> 10)) * 6144 + 5 * 1024 + (i & 1023)];
    for (int i = C.tid; i < 1024; i += nthr) GV[2048 + i] = C.a->final_norm_g[i];
    if (l == 0) { stage_mod(C, C.a->norm1_g + DM, 1, 0, MV, nthr); stage_copy16(C, (const float*)(C.a->ws + WS_WG) + 16 * 1024, M16, nthr, false); }
}
__device__ __forceinline__ void phase_K(Ctx& C, int l) {
    float* M16 = (float*)C.lds; float* MV = M16 + 16 * 1024; float* GV = MV + 4096;
    const int gw = C.bid * NWAVES + C.wave, NGW = C.G * NWAVES; const int r0 = (l == 0) ? 0 : CTXL;
    bf16* XW = (bf16*)(C.a->ws + WS_XW); const int* SLOT = (const int*)(C.a->ws + WS_SLOT); const bf16* Y = (const bf16*)(C.a->ws + WS_Y);
    v2u vn[4]; int sn = -1; int r = r0 + gw;
    if (r < R) { sn = (C.lane < 16) ? SLOT[(size_t)C.lane * R + r] : -1;
#pragma unroll
        for (int j = 0; j < 4; ++j) vn[j] = __builtin_nontemporal_load((const v2u*)(XW + (size_t)r * DM) + C.lane + 64 * j); }
#pragma unroll 1
    for (; r < R; r += NGW) {
        f32x4 v[4], acc[4]; const int myslot = sn;
#pragma unroll
        for (int j = 0; j < 4; ++j) { v[j] = bf4_f32(vn[j]); acc[j] = (f32x4){0.f, 0.f, 0.f, 0.f}; }
        unsigned long long mask = __ballot(myslot >= 0);
        while (mask) {
            const int e0 = __ffsll((long long)mask) - 1; mask &= mask - 1; const int e1 = mask ? (__ffsll((long long)mask) - 1) : -1; if (e1 >= 0) mask &= mask - 1;
            const int s0 = __shfl(myslot, e0), s1 = __shfl(myslot, e1 >= 0 ? e1 : e0);
            const bf16* y0 = Y + ((size_t)e0 * ESLOTS + s0) * DM; const bf16* y1 = Y + ((size_t)(e1 >= 0 ? e1 : e0) * ESLOTS + s1) * DM;
            v2u w0[4], w1[4];
#pragma unroll
            for (int j = 0; j < 4; ++j) { w0[j] = __builtin_nontemporal_load((const v2u*)(y0 + 4 * C.lane + 256 * j)); w1[j] = __builtin_nontemporal_load((const v2u*)(y1 + 4 * C.lane + 256 * j)); }
            const float f1 = (e1 >= 0) ? 1.0f : 0.0f;
#pragma unroll
            for (int j = 0; j < 4; ++j) { acc[j][0] += bf_lo(w0[j].x) + f1 * bf_lo(w1[j].x); acc[j][1] += bf_hi(w0[j].x) + f1 * bf_hi(w1[j].x); acc[j][2] += bf_lo(w0[j].y) + f1 * bf_lo(w1[j].y); acc[j][3] += bf_hi(w0[j].y) + f1 * bf_hi(w1[j].y); }
        }
        if (r + NGW < R) { sn = (C.lane < 16) ? SLOT[(size_t)C.lane * R + (r + NGW)] : -1;
#pragma unroll
            for (int j = 0; j < 4; ++j) vn[j] = __builtin_nontemporal_load((const v2u*)(XW + (size_t)(r + NGW) * DM) + C.lane + 64 * j); }
        const float* g2 = GV + (r < CTXL ? 1024 : 0);
#pragma unroll
        for (int j = 0; j < 4; ++j) { const f32x4 gg = *(const f32x4*)(g2 + 4 * C.lane + 256 * j); v[j] = v[j] + gg * acc[j]; }
        if (l == 0) {
#pragma unroll
            for (int j = 0; j < 4; ++j) { v2u o; o.x = pk2(v[j][0], v[j][1]); o.y = pk2(v[j][2], v[j][3]); ((v2u*)(XW + (size_t)r * DM))[C.lane + 64 * j] = o; }
            row_A(C, v, r, MV, M16);
        } else {
            float ss = 0.f;
#pragma unroll
            for (int j = 0; j < 4; ++j) ss += (v[j][0] * v[j][0] + v[j][1] * v[j][1]) + (v[j][2] * v[j][2] + v[j][3] * v[j][3]);
            const float rstd = rsqrtf(wave_sum(ss) * (1.0f / 1024.0f) + EPSN);
#pragma unroll
            for (int j = 0; j < 4; ++j) { const f32x4 gv = *(const f32x4*)(GV + 2048 + 4 * C.lane + 256 * j); __builtin_nontemporal_store(v[j] * rstd * gv, (f32x4*)(C.a->out + (size_t)(r - CTXL) * DM) + C.lane + 64 * j); }
        }
    }
}
#define MFMA16(a, b, c) __builtin_amdgcn_mfma_f32_16x16x32_bf16(a, b, c, 0, 0, 0)
constexpr float C2Q = 0.125f * 1.4426950408889634f;
constexpr float LOG2E = 1.4426950408889634f;
__device__ __forceinline__ float logsigmoidf(float x) { return fminf(x, 0.f) - __logf(1.0f + __expf(-fabsf(x))); }
__device__ __forceinline__ float ex2(float x) { return __builtin_amdgcn_exp2f(x); }

__device__ __forceinline__ void item_conv_prep(const Ctx& C0, int l, int c) {
    Ctx C = C0; { int t_ = C.tid; asm volatile("" : "+v"(t_)); C.tid = t_; C.lane = t_ & 63; }
    const int rbase = c * 128; const int slo = (rbase < CTXL) ? 0 : CTXL, shi = (rbase < CTXL) ? CTXL : R;
    float* cwL = (float*)C.lds;
    float* gL = cwL + 768;
    float* rR = gL + 128;
    float* rC = rR + 64;
    const int pr0 = (rbase >= CTXL) ? ((rbase - CTXL) >> 6) : 0;
    for (int i = C.tid; i < 768; i += NTHR) cwL[i] = C.a->conv_w[l * 768 + i];
    if (C.tid < 128) gL[C.tid] = (C.tid < 64) ? C.a->q_norm_g[l * 64 + C.tid] : C.a->k_norm_g[l * 64 + C.tid - 64];
    if (C.tid < 64) rR[C.tid] = ((const float*)(C.a->ws + WS_ROPE))[(size_t)pr0 * 32 + C.tid];
    for (int i = C.tid; i < 2048; i += NTHR) rC[i] = ((const float*)(C.a->ws + WS_ROPE))[i];
    BLOCK_SYNC();
    const bf16* Z = (const bf16*)(C.a->ws + WS_Z);
    if (l == 0 || c >= 2) {
        for (int idx = C.tid; idx < 128 * 32; idx += NTHR) {
            const int row = idx >> 5, ch0 = (idx & 31) * 8, r = rbase + row; const bf16* z = Z + (size_t)r * NZ;
            const v4u zero = {0u, 0u, 0u, 0u};
            const bool hm = (r - 1 >= slo), hp = (r + 1 < shi);
            const v4u xm = hm ? *(const v4u*)(z - NZ + ZC_CONVX + ch0) : zero, cm = hm ? *(const v4u*)(z - NZ + ZC_CONVC + ch0) : zero;
            const v4u x0 = *(const v4u*)(z + ZC_CONVX + ch0), c0 = *(const v4u*)(z + ZC_CONVC + ch0), b0 = *(const v4u*)(z + ZC_CONVB + ch0);
            const v4u xp = hp ? *(const v4u*)(z + NZ + ZC_CONVX + ch0) : zero, cp = hp ? *(const v4u*)(z + NZ + ZC_CONVC + ch0) : zero;
            float w0[8], w1[8], w2[8];
#pragma unroll
            for (int q = 0; q < 2; ++q) { const f32x4 a = *(const f32x4*)(cwL + ch0 + 4 * q), b = *(const f32x4*)(cwL + 256 + ch0 + 4 * q), d = *(const f32x4*)(cwL + 512 + ch0 + 4 * q);
#pragma unroll
                for (int e = 0; e < 4; ++e) { w0[4 * q + e] = a[e]; w1[4 * q + e] = b[e]; w2[4 * q + e] = d[e]; } }
            float o[8];
#pragma unroll
            for (int q = 0; q < 4; ++q) {
                const float ya = w0[2 * q] * (bf_lo(xm[q]) * bf_lo(cm[q])) + w1[2 * q] * (bf_lo(x0[q]) * bf_lo(c0[q])) + w2[2 * q] * (bf_lo(xp[q]) * bf_lo(cp[q]));
                const float yb = w0[2 * q + 1] * (bf_hi(xm[q]) * bf_hi(cm[q])) + w1[2 * q + 1] * (bf_hi(x0[q]) * bf_hi(c0[q])) + w2[2 * q + 1] * (bf_hi(xp[q]) * bf_hi(cp[q]));
                o[2 * q] = bf_lo(b0[q]) * ya; o[2 * q + 1] = bf_hi(b0[q]) * yb; }
            v4u w; w.x = pk2(o[0], o[1]); w.y = pk2(o[2], o[3]); w.z = pk2(o[4], o[5]); w.w = pk2(o[6], o[7]);
            *(v4u*)(((bf16*)(C.a->ws + WS_MIX)) + (size_t)r * DM + ch0) = w;
        }
    }
    for (int it = 0; it < 12; ++it) {
        const int task = it * 64 + (C.tid >> 3), sub = C.tid & 7, row = task / 6, hd = task % 6, r = rbase + row;
        const v4u zx = *(const v4u*)(Z + (size_t)r * NZ + ZC_Q + hd * 64 + sub * 8);
        float y[8];
#pragma unroll
        for (int q = 0; q < 4; ++q) { y[2 * q] = bf_lo(zx[q]); y[2 * q + 1] = bf_hi(zx[q]); }
        float ss = 0.f;
#pragma unroll
        for (int e = 0; e < 8; ++e) ss += y[e] * y[e];
        ss += dppf<DPP_X1>(ss); ss += dppf<DPP_X2>(ss); ss += dppf<DPP_HMIR>(ss);
        const float rstd = rsqrtf(ss * (1.0f / 64.0f) + EPSN);
        const float* gn = gL + ((hd < 4) ? 0 : 64) + sub * 8;
        { const f32x4 g0 = *(const f32x4*)gn, g1 = *(const f32x4*)(gn + 4);
#pragma unroll
            for (int e = 0; e < 4; ++e) { y[e] = y[e] * rstd * g0[e]; y[4 + e] = y[4 + e] * rstd * g1[e]; } }
        float o[8];
        if (r >= CTXL) {
            const int p = r - CTXL; const float* rt = ((sub < 4) ? rR + ((p >> 6) - pr0) * 32 : rC + (p & 63) * 32) + 16 * (sub & 1); const bool first = ((sub & 2) == 0);
            float cs[8], sn[8];
#pragma unroll
            for (int q = 0; q < 4; ++q) { const f32x4 v = *(const f32x4*)(rt + 4 * q); cs[2 * q] = v[0]; sn[2 * q] = v[1]; cs[2 * q + 1] = v[2]; sn[2 * q + 1] = v[3]; }
#pragma unroll
            for (int e = 0; e < 8; ++e) { const float pr = dppf<DPP_X2>(y[e]); o[e] = first ? (y[e] * cs[e] - pr * sn[e]) : (y[e] * cs[e] + pr * sn[e]); }
        } else {
#pragma unroll
            for (int e = 0; e < 8; ++e) o[e] = y[e];
        }
        const float scl = (hd < 4) ? C2Q : 1.0f;
        v4u w; w.x = pk2(o[0] * scl, o[1] * scl); w.y = pk2(o[2] * scl, o[3] * scl); w.z = pk2(o[4] * scl, o[5] * scl); w.w = pk2(o[6] * scl, o[7] * scl);
        if (hd < 4) *(v4u*)(((bf16*)(C.a->ws + WS_QB)) + (size_t)r * 256 + hd * 64 + sub * 8) = w; else *(v4u*)(((bf16*)(C.a->ws + WS_KB)) + (size_t)r * 128 + (hd - 4) * 64 + sub * 8) = w;
    }
    for (int idx = C.tid; idx < 128 * 16; idx += NTHR) { const int row = idx >> 4, ch = (idx & 15) * 8, r = rbase + row; *(v4u*)(((bf16*)(C.a->ws + WS_VB)) + (size_t)r * 128 + ch) = *(const v4u*)(Z + (size_t)r * NZ + ZC_V + ch); }
}

__device__ __forceinline__ v2u quad_pack(const v4u (&x)[4], int e, const float (&sc)[4]) {
    float f[4];
#pragma unroll
    for (int j = 0; j < 4; ++j) { const unsigned w = x[j][e >> 1]; f[j] = ((e & 1) ? bf_hi(w) : bf_lo(w)) * sc[j]; }
    v2u o; o.x = pk2(f[0], f[1]); o.y = pk2(f[2], f[3]); return o;
}

__device__ __forceinline__ void item_cmlp(const Ctx& C0, int l, int c) {
    Ctx C = C0; { int t_ = C.tid; asm volatile("" : "+v"(t_)); C.tid = t_; C.lane = t_ & 63; }
    constexpr int LD = 136, LU = 72;
    bf16* VNT = (bf16*)C.lds;
    bf16* WSB = VNT + 256 * LD;
    bf16* UL = WSB + 128 * LD;
    float* rs = (float*)(UL + 128 * LU);
    const int rbase = c * 128; const float* gn = C.a->cmlp_norm_g + l * 256;
    const bf16* Z = (const bf16*)(C.a->ws + WS_Z);
    const int q4 = C.tid & 31, cg = C.tid >> 5;
    v4u xa[4], xb[4];
#pragma unroll
    for (int j = 0; j < 4; ++j) { const bf16* z = Z + (size_t)(rbase + 4 * q4 + j) * NZ + ZC_CV + cg * 16; xa[j] = *(const v4u*)z; xb[j] = *(const v4u*)(z + 8); }
    for (int i = 0; i < 16; ++i) { const int row = C.wave * 16 + i; const v2u w = *(const v2u*)(Z + (size_t)(rbase + row) * NZ + ZC_CV + 4 * C.lane);
        const float a = bf_lo(w.x), b = bf_hi(w.x), cc = bf_lo(w.y), d = bf_hi(w.y);
        const float ss = wave_sum((a * a + b * b) + (cc * cc + d * d)); if (C.lane == 0) rs[row] = rsqrtf(ss * (1.0f / 256.0f) + EPSN); }
    BLOCK_SYNC();
    { float sc[4];
#pragma unroll
        for (int j = 0; j < 4; ++j) sc[j] = rs[4 * q4 + j];
#pragma unroll
        for (int e = 0; e < 8; ++e) { const int ch = cg * 16 + e; const float g = gn[ch]; const float s2[4] = {sc[0] * g, sc[1] * g, sc[2] * g, sc[3] * g}; *(v2u*)(VNT + ch * LD + 4 * q4) = quad_pack(xa, e, s2); }
#pragma unroll
        for (int e = 0; e < 8; ++e) { const int ch = cg * 16 + 8 + e; const float g = gn[ch]; const float s2[4] = {sc[0] * g, sc[1] * g, sc[2] * g, sc[3] * g}; *(v2u*)(VNT + ch * LD + 4 * q4) = quad_pack(xb, e, s2); } }
    const int t0 = C.wave * 16, fr = C.lane & 15, fq = C.lane >> 4;
    v4u wreg[4], ureg[2]; float bbn[4];
#define CMLP_FETCH(h_) do { const bf16* wsrc = ((const bf16*)(C.a->ws + WS_CWS)) + (size_t)(l * 4 + (h_)) * 128 * 128; const float* bs = C.a->cmlp_bs + (size_t)(l * 4 + (h_)) * 128; \
        _Pragma("unroll") for (int it = 0; it < 4; ++it) wreg[it] = *(const v4u*)(wsrc + (it * NTHR + C.tid) * 8); \
        _Pragma("unroll") for (int it = 0; it < 2; ++it) { const int idx = it * NTHR + C.tid, t = idx >> 3, ch = (idx & 7) * 8; ureg[it] = *(const v4u*)(Z + (size_t)(rbase + t) * NZ + ZC_CU + (h_) * 64 + ch); } \
        _Pragma("unroll") for (int j = 0; j < 4; ++j) bbn[j] = bs[t0 + 4 * fq + j]; } while (0)
    CMLP_FETCH(0);
    for (int h = 0; h < 4; ++h) {
        BLOCK_SYNC();
#pragma unroll
        for (int it = 0; it < 4; ++it) { const int idx = (it * NTHR + C.tid) * 8, t = idx >> 7, s = idx & 127; *(v4u*)(WSB + t * LD + s) = wreg[it]; }
#pragma unroll
        for (int it = 0; it < 2; ++it) { const int idx = it * NTHR + C.tid, t = idx >> 3, ch = (idx & 7) * 8; *(v4u*)(UL + t * LU + ch) = ureg[it]; }
        float bbh[4];
#pragma unroll
        for (int j = 0; j < 4; ++j) bbh[j] = bbn[j];
        if (h < 3) CMLP_FETCH(h + 1);
        BLOCK_SYNC();
        f32x4 acc[4];
#pragma unroll
        for (int n = 0; n < 4; ++n) acc[n] = (f32x4){0.f, 0.f, 0.f, 0.f};
#pragma unroll
        for (int ks = 0; ks < 4; ++ks) { const bf16x8 a = *(const bf16x8*)(WSB + (t0 + fr) * LD + ks * 32 + 8 * fq);
#pragma unroll
            for (int n = 0; n < 4; ++n) { const bf16x8 b = *(const bf16x8*)(VNT + (h * 64 + 16 * n + fr) * LD + ks * 32 + 8 * fq); acc[n] = MFMA16(a, b, acc[n]); } }
#pragma unroll
        for (int j = 0; j < 4; ++j) { const int t = t0 + 4 * fq + j; const float bb = bbh[j];
#pragma unroll
            for (int n = 0; n < 4; ++n) { bf16* up = UL + t * LU + 16 * n + fr; *up = f2bf(bf2f(*up) * (acc[n][j] + bb)); } }
        BLOCK_SYNC();
#pragma unroll
        for (int it = 0; it < 2; ++it) { const int idx = it * NTHR + C.tid, t = idx >> 3, ch = (idx & 7) * 8; *(v4u*)(((bf16*)(C.a->ws + WS_MIX)) + (size_t)(rbase + t) * DM + 256 + h * 64 + ch) = *(const v4u*)(UL + t * LU + ch); }
    }
#undef CMLP_FETCH
}

__device__ __forceinline__ void gate_scan(const Ctx& C, int l, int c, int h, int dir, float* b, float* g, float* pm) {
    const int lane = C.lane; const int t0 = dir ? 127 - 2 * lane : 2 * lane, t1 = dir ? 126 - 2 * lane : 2 * lane + 1;
    const float* G0 = ((const float*)(C.a->ws + WS_G)) + (size_t)(c * 128 + t0) * 16; const float* G1 = ((const float*)(C.a->ws + WS_G)) + (size_t)(c * 128 + t1) * 16;
    const float ib = C.a->ml_igate_b[l * 8 + dir * 4 + h], fb = C.a->ml_fgate_b[l * 8 + dir * 4 + h];
    const float li0 = G0[dir * 4 + h] + ib, li1 = G1[dir * 4 + h] + ib, lf0 = logsigmoidf(G0[8 + dir * 4 + h] + fb), lf1 = logsigmoidf(G1[8 + dir * 4 + h] + fb);
    float s0 = lf0, s1 = lf0 + lf1; float inc = s1;
#pragma unroll
    for (int o = 1; o < 64; o <<= 1) { const float x = __shfl_up(inc, o); if (lane >= o) inc += x; }
    const float exc = inc - s1; s0 += exc; s1 += exc;
    const float g0 = li0 - s0, g1 = li1 - s1;
    float m1 = fmaxf(g0, g1); float minc = m1;
#pragma unroll
    for (int o = 1; o < 64; o <<= 1) { const float x = __shfl_up(minc, o); if (lane >= o) minc = fmaxf(minc, x); }
    float mexc = __shfl_up(minc, 1); if (lane == 0) mexc = -INFINITY;
    b[t0] = s0; b[t1] = s1; g[t0] = g0; g[t1] = g1; pm[t0] = fmaxf(g0, mexc); pm[t1] = fmaxf(m1, mexc);
}

__device__ __forceinline__ void item_mlstate(const Ctx& C0, int l, int c, int h) {
    Ctx C = C0; { int t_ = C.tid; asm volatile("" : "+v"(t_)); C.tid = t_; C.lane = t_ & 63; }
    constexpr int LD = 136;
    bf16* VT = (bf16*)C.lds;
    bf16* KTF = VT + 80 * LD;
    bf16* KTB = KTF + 64 * LD;
    float* fv = (float*)(KTB + 64 * LD);
    float *bF = fv, *gF = fv + 128, *pF = fv + 256, *bB = fv + 384, *gB = fv + 512, *pB = fv + 640;
    const bf16* Z = (const bf16*)(C.a->ws + WS_Z);
    const int q4 = C.tid & 31, dg = (C.tid >> 5) & 7; const bool isv = C.tid >= 256;
    v4u x[4];
#pragma unroll
    for (int j = 0; j < 4; ++j) x[j] = *(const v4u*)(Z + (size_t)(c * 128 + 4 * q4 + j) * NZ + (isv ? ZC_MV : ZC_MK) + h * 64 + dg * 8);
    if (C.wave == 0) gate_scan(C, l, c, h, 0, bF, gF, pF);
    if (C.wave == 1) gate_scan(C, l, c, h, 1, bB, gB, pB);
    for (int i = C.tid; i < 16 * LD; i += NTHR) VT[64 * LD + i] = (i < 128) ? (bf16)0x3F80 : (bf16)0;
    BLOCK_SYNC();
    if (isv) { const float one[4] = {1.f, 1.f, 1.f, 1.f};
#pragma unroll
        for (int e = 0; e < 8; ++e) *(v2u*)(VT + (dg * 8 + e) * LD + 4 * q4) = quad_pack(x, e, one);
    } else { float wf[4], wb[4]; const float gmF = pF[127] , gmB = pB[0];
#pragma unroll
        for (int j = 0; j < 4; ++j) { wf[j] = 0.125f * ex2((gF[4 * q4 + j] - gmF) * LOG2E); wb[j] = 0.125f * ex2((gB[4 * q4 + j] - gmB) * LOG2E); }
#pragma unroll
        for (int e = 0; e < 8; ++e) { *(v2u*)(KTF + (dg * 8 + e) * LD + 4 * q4) = quad_pack(x, e, wf); *(v2u*)(KTB + (dg * 8 + e) * LD + 4 * q4) = quad_pack(x, e, wb); } }
    BLOCK_SYNC();
    const int dir = C.wave >> 2, nq = C.wave & 3, fr = C.lane & 15, fq = C.lane >> 4; const bf16* KT = dir ? KTB : KTF;
    f32x4 acc[5];
#pragma unroll
    for (int m = 0; m < 5; ++m) acc[m] = (f32x4){0.f, 0.f, 0.f, 0.f};
#pragma unroll
    for (int ks = 0; ks < 4; ++ks) { const bf16x8 b = *(const bf16x8*)(KT + (16 * nq + fr) * LD + ks * 32 + 8 * fq);
#pragma unroll
        for (int m = 0; m < 5; ++m) { const bf16x8 a = *(const bf16x8*)(VT + (16 * m + fr) * LD + ks * 32 + 8 * fq); acc[m] = MFMA16(a, b, acc[m]); } }
    const size_t sidx = (size_t)(c * 4 + h) * 2 + dir; float* co = ((float*)(C.a->ws + WS_CLOC)) + sidx * 4096;
#pragma unroll
    for (int m = 0; m < 4; ++m)
#pragma unroll
        for (int j = 0; j < 4; ++j) co[(16 * m + 4 * fq + j) * 64 + 16 * nq + fr] = acc[m][j];
    if (fq == 0) ((float*)(C.a->ws + WS_NLOC))[sidx * 64 + 16 * nq + fr] = acc[4][0];
    if (C.tid < 2) { const size_t si = (size_t)(c * 4 + h) * 2 + C.tid; const float bl = C.tid ? bB[0] : bF[127], gm = C.tid ? pB[0] : pF[127];
        ((float*)(C.a->ws + WS_SCAL))[si] = bl + gm; ((float*)(C.a->ws + (WS_SCAL + 1040 * 4)))[si] = bl; }
}
__device__ __forceinline__ void phase_C(Ctx& C, int l) {
    unsigned* qhead = (unsigned*)(C.a->ws + WS_CTL + 49152) + 64 * l;
    volatile unsigned* bc = (volatile unsigned*)(C.lds + (LDS_BYTES - 64));
    for (;;) {
        if (C.tid == 0) bc[0] = __hip_atomic_fetch_add(qhead, 1u, __ATOMIC_RELAXED, __HIP_MEMORY_SCOPE_AGENT);
        BLOCK_SYNC();
        const int it = (int)bc[0];
        BLOCK_SYNC();
        if (it >= NCHUNK * 6) break;
        if (it < NCHUNK) { if (l == 0 || it >= 2) item_cmlp(C, l, it); }
        else if (it < 2 * NCHUNK) item_conv_prep(C, l, it - NCHUNK);
        else { const int q = it - 2 * NCHUNK; item_mlstate(C, l, q >> 2, q & 3); }
        BLOCK_SYNC();
    }
}

__device__ __forceinline__ int chain_chunk(int dir, int i) { return dir == 0 ? i : (i == 0 ? 1 : (i == 1 ? 0 : NCHUNK + 1 - i)); }
__device__ __forceinline__ void seg_load(const float* basep, size_t cstride, bool valid, int h, int dir, int seg, int el, float (&L)[33]) {
    const int s0 = (seg < 2) ? seg * 33 : 66 + (seg - 2) * 32, slen = (seg < 2) ? 33 : 32;
#pragma unroll
    for (int u = 0; u < 33; ++u) { L[u] = 0.f; if (valid && u < slen) { const int c = chain_chunk(dir, s0 + u); L[u] = basep[((size_t)(c * 4 + h) * 2 + dir) * cstride + el]; } }
}
__device__ __forceinline__ void seg_rest(float* basep, size_t cstride, bool valid, int h, int dir, int seg, int el, const float* dold, const float* dloc, float* segA, float* segB, float (&L)[33]) {
    const int s0 = (seg < 2) ? seg * 33 : 66 + (seg - 2) * 32, slen = (seg < 2) ? 33 : 32;
    float st = 0.f, a = 1.f;
#pragma unroll
    for (int u = 0; u < 33; ++u) { if (u < slen) { const float lv = L[u]; L[u] = st; st = dold[s0 + u] * st + dloc[s0 + u] * lv; a *= dold[s0 + u]; } }
    segA[seg * 128 + el] = a; segB[seg * 128 + el] = st;
    BLOCK_SYNC();
    float s = 0.f;
    for (int j = 0; j < seg; ++j) s = segA[j * 128 + el] * s + segB[j * 128 + el];
    a = 1.f;
#pragma unroll
    for (int u = 0; u < 33; ++u) { if (valid && u < slen) { const int c = chain_chunk(dir, s0 + u); basep[((size_t)(c * 4 + h) * 2 + dir) * cstride + el] = L[u] + a * s; a *= dold[s0 + u]; } }
    BLOCK_SYNC();
}
__device__ __forceinline__ void phase_D(Ctx& C) {
    float* fv = (float*)C.lds; float *bl = fv, *ml = fv + 136, *mp = fv + 272, *dold = fv + 408, *dloc = fv + 544, *segA = fv + 680, *segB = fv + 680 + 512;
    for (int it = C.bid; it < 8 * 32; it += C.G) {
        const int chain = it >> 5, eb = it & 31, h = chain >> 1, dir = chain & 1;
        const int seg = C.wave >> 1, el = (C.wave & 1) * 64 + C.lane;
        float L[33]; seg_load(((const float*)(C.a->ws + WS_CLOC)) + eb * 128, 4096, true, h, dir, seg, el, L);
        if (C.tid < NCHUNK) { const int c = chain_chunk(dir, C.tid); const size_t si = (size_t)(c * 4 + h) * 2 + dir; bl[C.tid] = ((float*)(C.a->ws + (WS_SCAL + 1040 * 4)))[si]; ml[C.tid] = ((float*)(C.a->ws + WS_SCAL))[si]; }
        BLOCK_SYNC();
        if (C.wave == 0) {
            const float b0 = bl[C.lane], b1 = bl[64 + C.lane], b2 = bl[128 + (C.lane & 1)], m0 = ml[C.lane], m1 = ml[64 + C.lane], m2 = ml[128 + (C.lane & 1)];
            float m = 0.f, r0 = 0.f, r1 = 0.f, r2 = 0.f;
#pragma unroll 2
            for (int i = 0; i < 64; ++i) { r0 = (C.lane == i) ? m : r0; m = fmaxf(m + __int_as_float(__builtin_amdgcn_readlane(__float_as_int(b0), i)), __int_as_float(__builtin_amdgcn_readlane(__float_as_int(m0), i))); }
#pragma unroll 2
            for (int i = 0; i < 64; ++i) { r1 = (C.lane == i) ? m : r1; m = fmaxf(m + __int_as_float(__builtin_amdgcn_readlane(__float_as_int(b1), i)), __int_as_float(__builtin_amdgcn_readlane(__float_as_int(m1), i))); }
#pragma unroll
            for (int i = 0; i < 2; ++i) { r2 = (C.lane == i) ? m : r2; m = fmaxf(m + __int_as_float(__builtin_amdgcn_readlane(__float_as_int(b2), i)), __int_as_float(__builtin_amdgcn_readlane(__float_as_int(m2), i))); }
            mp[C.lane] = r0; mp[64 + C.lane] = r1; if (C.lane < 2) mp[128 + C.lane] = r2; if (C.lane == 2) mp[130] = m;
        }
        BLOCK_SYNC();
        if (C.tid < NCHUNK) { const int i = C.tid; dold[i] = __expf(bl[i] + mp[i] - mp[i + 1]); dloc[i] = __expf(ml[i] - mp[i + 1]);
            if (eb == 0) { const int c = chain_chunk(dir, i); ((float*)(C.a->ws + (WS_SCAL + 2080 * 4)))[(size_t)(c * 4 + h) * 2 + dir] = mp[i]; } }
        BLOCK_SYNC();
        seg_rest(((float*)(C.a->ws + WS_CLOC)) + eb * 128, 4096, true, h, dir, seg, el, dold, dloc, segA, segB, L);
        if (eb == 31) { seg_load(((const float*)(C.a->ws + WS_NLOC)), 64, el < 64, h, dir, seg, el, L); seg_rest(((float*)(C.a->ws + WS_NLOC)), 64, el < 64, h, dir, seg, el, dold, dloc, segA, segB, L); }
    }
}
__device__ __forceinline__ void item_mlout(const Ctx& C0, int l, int c, int h) {
    Ctx C = C0; { int t_ = C.tid; asm volatile("" : "+v"(t_)); C.tid = t_; C.lane = t_ & 63; }
    constexpr int LQ = 72, LA = 264;
    bf16* QS = (bf16*)C.lds;
    bf16* KS = QS + 128 * LQ;
    bf16* A2 = KS + 144 * LQ;
    bf16* B2T = A2 + 128 * LA;
    float* fv = (float*)(B2T + 64 * LA);
    float *bF = fv, *gF = fv + 128, *pF = fv + 256, *bB = fv + 384, *gB = fv + 512, *pB = fv + 640, *wiF = fv + 768, *wiB = fv + 896, *cF = fv + 1024, *cB = fv + 1152;
    float *rowF = pF, *rowB = pB, *emF = bF, *emB = bB;
    float* ngL = fv + 1280;
    static_assert((128 * LQ + 144 * LQ + 128 * LA + 64 * LA) * 2 + 1344 * 4 <= LDS_BYTES - 64, "mlout LDS map");
    const int rbase = c * 128; const size_t siF = (size_t)(c * 4 + h) * 2, siB = siF + 1;
    const bf16* Z = (const bf16*)(C.a->ws + WS_Z);
    const int q4 = C.tid & 31, dg = (C.tid >> 5) & 7;
    v4u xv[4];
    if (C.tid < 256) {
#pragma unroll
        for (int j = 0; j < 4; ++j) xv[j] = *(const v4u*)(Z + (size_t)(rbase + 4 * q4 + j) * NZ + ZC_MV + h * 64 + dg * 8); }
    if (C.wave == 0) gate_scan(C, l, c, h, 0, bF, gF, pF);
    if (C.wave == 1) gate_scan(C, l, c, h, 1, bB, gB, pB);
    v4u poz[2];
    if (C.tid < 64) ngL[C.tid] = C.a->ml_norm_g[l * 256 + h * 64 + C.tid];
#pragma unroll
    for (int it = 0; it < 2; ++it) { const int idx = it * NTHR + C.tid, t = idx >> 3, ch = (idx & 7) * 8; const bf16* z = Z + (size_t)(rbase + t) * NZ + h * 64 + ch;
        poz[it] = *(const v4u*)(z + ZC_MO);
        *(v4u*)(QS + t * LQ + ch) = *(const v4u*)(z + ZC_MQ);
        const v4u kk = *(const v4u*)(z + ZC_MK); v4u ko;
#pragma unroll
        for (int q = 0; q < 4; ++q) ko[q] = pk2(bf_lo(kk[q]) * 0.125f, bf_hi(kk[q]) * 0.125f);
        *(v4u*)(KS + t * LQ + ch) = ko; }
#pragma unroll
    for (int it = 0; it < 4; ++it) { const int idx = (it * NTHR + C.tid) * 4, dir = idx >> 12, e = idx & 4095, v = e >> 6, k = e & 63;
        const f32x4 cv = *(const f32x4*)(((float*)(C.a->ws + WS_CLOC)) + (siF + dir) * 4096 + e); v2u o; o.x = pk2(cv[0], cv[1]); o.y = pk2(cv[2], cv[3]); *(v2u*)(B2T + v * LA + 128 + dir * 64 + k) = o; }
    if (C.tid < 128) KS[(128 + (C.tid >> 6)) * LQ + (C.tid & 63)] = f2bf(((float*)(C.a->ws + WS_NLOC))[siF * 64 + C.tid]);
    for (int i = C.tid; i < 14 * LQ; i += NTHR) KS[130 * LQ + i] = (bf16)0;
    if (C.tid < 256) { const float one[4] = {1.f, 1.f, 1.f, 1.f};
#pragma unroll
        for (int e = 0; e < 8; ++e) *(v2u*)(B2T + (dg * 8 + e) * LA + 4 * q4) = quad_pack(xv, e, one); }
    const float mpF = ((float*)(C.a->ws + (WS_SCAL + 2080 * 4)))[siF], mpB = ((float*)(C.a->ws + (WS_SCAL + 2080 * 4)))[siB];
    BLOCK_SYNC();
    if (C.tid < 128) { const int t = C.tid; const float mx = fmaxf(mpF, pF[t]), bb = bF[t]; rowF[t] = -mx * LOG2E; wiF[t] = ex2((mpF - mx) * LOG2E); emF[t] = ex2(-(bb + mx) * LOG2E); gF[t] *= LOG2E; }
    else if (C.tid < 256) { const int t = C.tid - 128; const float mx = fmaxf(mpB, pB[t]), bb = bB[t]; rowB[t] = -mx * LOG2E; wiB[t] = ex2((mpB - mx) * LOG2E); emB[t] = ex2(-(bb + mx) * LOG2E); gB[t] *= LOG2E; }
    BLOCK_SYNC();
    const int w = C.wave, t0 = w * 16, fr = C.lane & 15, fq = C.lane >> 4;
    {
        f32x4 S[9];
#pragma unroll
        for (int n = 0; n < 9; ++n) S[n] = (f32x4){0.f, 0.f, 0.f, 0.f};
#pragma unroll
        for (int ks = 0; ks < 2; ++ks) { const bf16x8 a = *(const bf16x8*)(QS + (t0 + fr) * LQ + ks * 32 + 8 * fq);
#pragma unroll
            for (int n = 0; n < 9; ++n) { const bf16x8 b = *(const bf16x8*)(KS + (16 * n + fr) * LQ + ks * 32 + 8 * fq); S[n] = MFMA16(a, b, S[n]); } }
#pragma unroll
        for (int j = 0; j < 4; ++j) { const int t = t0 + 4 * fq + j; const float rF_ = rowF[t], rB_ = rowB[t];
            const float nqF = __shfl(S[8][j], (C.lane & 48)), nqB = __shfl(S[8][j], (C.lane & 48) + 1);
            float pf[8], pb[8]; float sF = 0.f, sB = 0.f;
#pragma unroll
            for (int n = 0; n < 8; ++n) { const int s = 16 * n + fr; const float sv = S[n][j]; pf[n] = 0.f; pb[n] = 0.f;
                if (n <= w) { const float e = sv * ex2(rF_ + gF[s]); pf[n] = (n < w || s <= t) ? e : 0.f; }
                if (n >= w) { const float e = sv * ex2(rB_ + gB[s]); pb[n] = (n > w || s >= t) ? e : 0.f; }
                sF += pf[n]; sB += pb[n]; }
#pragma unroll
            for (int o = 0; o < 1; ++o) { sF += dppf<DPP_X1>(sF); sB += dppf<DPP_X1>(sB); sF += dppf<DPP_X2>(sF); sB += dppf<DPP_X2>(sB); sF += dppf<DPP_HMIR>(sF); sB += dppf<DPP_HMIR>(sB); sF += dppf<DPP_MIR>(sF); sB += dppf<DPP_MIR>(sB); }
            const float wf = wiF[t], wb = wiB[t];
            const float denF = sF + wf * nqF, denB = sB + wb * nqB;
            const float rf = 1.0f / fmaxf(fabsf(denF), emF[t]), rb = 1.0f / fmaxf(fabsf(denB), emB[t]);
#pragma unroll
            for (int n = 0; n < 8; ++n) A2[t * LA + 16 * n + fr] = f2bf(pf[n] * rf + pb[n] * rb);
            if (fr == 0) { cF[t] = wf * rf; cB[t] = wb * rb; }
        }
    }
    BLOCK_SYNC();
#pragma unroll
    for (int it = 0; it < 2; ++it) { const int idx = it * NTHR + C.tid, t = idx >> 3, ch = (idx & 7) * 8; const v4u qq = *(const v4u*)(QS + t * LQ + ch); const float sf = cF[t], sb = cB[t]; v4u of, ob;
#pragma unroll
        for (int q = 0; q < 4; ++q) { const float a = bf_lo(qq[q]), b = bf_hi(qq[q]); of[q] = pk2(a * sf, b * sf); ob[q] = pk2(a * sb, b * sb); }
        *(v4u*)(A2 + t * LA + 128 + ch) = of; *(v4u*)(A2 + t * LA + 192 + ch) = ob;
        *(v4u*)(KS + t * LQ + ch) = poz[it]; }
    BLOCK_SYNC();
    f32x4 acc[4];
#pragma unroll
    for (int n = 0; n < 4; ++n) acc[n] = (f32x4){0.f, 0.f, 0.f, 0.f};
#pragma unroll
    for (int ks = 0; ks < 8; ++ks) { const bf16x8 a = *(const bf16x8*)(A2 + (t0 + fr) * LA + ks * 32 + 8 * fq);
#pragma unroll
        for (int n = 0; n < 4; ++n) { const bf16x8 b = *(const bf16x8*)(B2T + (16 * n + fr) * LA + ks * 32 + 8 * fq); acc[n] = MFMA16(a, b, acc[n]); } }
#pragma unroll
    for (int j = 0; j < 4; ++j) { const int t = t0 + 4 * fq + j; float ss = 0.f;
#pragma unroll
        for (int n = 0; n < 4; ++n) ss += acc[n][j] * acc[n][j];
        ss += dppf<DPP_X1>(ss); ss += dppf<DPP_X2>(ss); ss += dppf<DPP_HMIR>(ss); ss += dppf<DPP_MIR>(ss);
        const float rstd = rsqrtf(ss * (1.0f / 64.0f) + EPSN);
#pragma unroll
        for (int n = 0; n < 4; ++n) { const int dd = 16 * n + fr; const float po = bf2f(KS[t * LQ + dd]);
            QS[t * LQ + dd] = f2bf(acc[n][j] * rstd * ngL[dd] / (1.0f + __expf(-po))); } }
    BLOCK_SYNC();
#pragma unroll
    for (int it = 0; it < 2; ++it) { const int idx = it * NTHR + C.tid, t = idx >> 3, ch = (idx & 7) * 8; *(v4u*)(((bf16*)(C.a->ws + WS_MIX)) + (size_t)(rbase + t) * DM + 768 + h * 64 + ch) = *(const v4u*)(QS + t * LQ + ch); }
}

template <int NB> __device__ __forceinline__ void topk_pick(const Ctx& C, unsigned* hist, unsigned* wtot, unsigned* sh, unsigned kk, unsigned prefix_hi, int shift) {
    constexpr int NBT = NB / NTHR;
    unsigned h[NBT], p[NBT]; unsigned run = 0u;
#pragma unroll
    for (int q = 0; q < NBT; ++q) { h[q] = hist[C.tid * NBT + q]; run += h[q]; p[q] = run; }
    unsigned inc = run;
#pragma unroll
    for (int o = 1; o < 64; o <<= 1) { const unsigned a = __shfl_up(inc, o); if (C.lane >= o) inc += a; }
    if (C.lane == 63) wtot[C.wave] = inc;
    BLOCK_SYNC();
    unsigned off = inc - run, N = 0u;
#pragma unroll
    for (int w = 0; w < NWAVES; ++w) { const unsigned x = wtot[w]; N += x; if (w < C.wave) off += x; }
#pragma unroll
    for (int q = 0; q < NBT; ++q) { const unsigned pin = off + p[q], sex = N - pin, sin = sex + h[q];
        if (sin >= kk && sex < kk) { sh[0] = prefix_hi | ((unsigned)(C.tid * NBT + q) << shift); sh[1] = kk - sex; } }
    BLOCK_SYNC();
}
__device__ __forceinline__ void item_topk(const Ctx& C0, int e, int set) {
    Ctx C = C0; { int t_ = C.tid; asm volatile("" : "+v"(t_)); C.tid = t_; C.lane = t_ & 63; }
    unsigned* lv = (unsigned*)C.lds;
    unsigned* hist = lv + 33 * 512;
    unsigned* sh = hist + 2048;
    unsigned* wtot = sh + 8;
    const int n = set ? CTXL : SEQL, cap = set ? CAPC : CAPL, rowoff = set ? 0 : CTXL;
    const float* aff = ((float*)(C.a->ws + WS_AFF)) + (size_t)e * R + rowoff;
    const int base = C.tid * 32, lbase = C.tid * 33;
#pragma unroll
    for (int q = 0; q < 8; ++q) { const int k4 = (q * NTHR + C.tid) * 4; v4u w = {0u, 0u, 0u, 0u}; if (k4 < n) w = *(const v4u*)(aff + k4);
        unsigned* p = lv + k4 + (k4 >> 5); p[0] = w.x; p[1] = w.y; p[2] = w.z; p[3] = w.w; }
    BLOCK_SYNC();
    unsigned prefix, kk = (unsigned)cap;
    for (int i = C.tid; i < 2048; i += NTHR) hist[i] = 0u;
    BLOCK_SYNC();
#pragma unroll 4
    for (int i = 0; i < 32; ++i) { const unsigned v = lv[lbase + i]; atomicAdd(&hist[v >> 19], 1u); }
    BLOCK_SYNC();
    topk_pick<2048>(C, hist, wtot, sh, kk, 0u, 19);
    prefix = sh[0]; kk = sh[1];
    BLOCK_SYNC();
    for (int i = C.tid; i < 1024; i += NTHR) hist[i] = 0u;
    BLOCK_SYNC();
#pragma unroll 4
    for (int i = 0; i < 32; ++i) { const unsigned v = lv[lbase + i]; if ((v >> 19) == (prefix >> 19)) atomicAdd(&hist[(v >> 9) & 1023u], 1u); }
    BLOCK_SYNC();
    topk_pick<1024>(C, hist, wtot, sh, kk, prefix, 9);
    prefix = sh[0]; kk = sh[1];
    BLOCK_SYNC();
    if (C.tid < 512) hist[C.tid] = 0u;
    BLOCK_SYNC();
#pragma unroll 4
    for (int i = 0; i < 32; ++i) { const unsigned v = lv[lbase + i]; if ((v >> 9) == (prefix >> 9)) atomicAdd(&hist[v & 511u], 1u); }
    BLOCK_SYNC();
    topk_pick<512>(C, hist, wtot, sh, kk, prefix, 0);
    prefix = sh[0]; kk = sh[1];
    BLOCK_SYNC();
    const unsigned T = prefix, need_eq = kk;
    unsigned cgt = 0u, ceq = 0u;
#pragma unroll 4
    for (int i = 0; i < 32; ++i) { const unsigned v = lv[lbase + i]; cgt += (v > T) ? 1u : 0u; ceq += (v == T) ? 1u : 0u; }
    unsigned igt = cgt, ieq = ceq;
#pragma unroll
    for (int o = 1; o < 64; o <<= 1) { const unsigned a = __shfl_up(igt, o), b = __shfl_up(ieq, o); if (C.lane >= o) { igt += a; ieq += b; } }
    if (C.lane == 63) { wtot[C.wave] = igt; wtot[8 + C.wave] = ieq; }
    BLOCK_SYNC();
    unsigned ogt = igt - cgt, oeq = ieq - ceq;
    for (int w = 0; w < C.wave; ++w) { ogt += wtot[w]; oeq += wtot[8 + w]; }
    const int slot0 = set ? CAPL : 0;
    int* IDXp = ((int*)(C.a->ws + WS_IDX)) + e * ESLOTS; float* GATEp = ((float*)(C.a->ws + WS_GATE)) + e * ESLOTS; int* SLOTp = ((int*)(C.a->ws + WS_SLOT)) + (size_t)e * R + rowoff;
#pragma unroll 2
    for (int i = 0; i < 32; ++i) {
        const int tok = base + i; const unsigned v = lv[lbase + i];
        const bool gt = v > T, eq = v == T; const bool sel = gt || (eq && oeq < need_eq);
        int slot = -1;
        if (sel && tok < n) { slot = slot0 + (int)(ogt + (oeq < need_eq ? oeq : need_eq)); IDXp[slot] = rowoff + tok; GATEp[slot] = __uint_as_float(v); }
        lv[lbase + i] = (unsigned)slot;
        ogt += gt ? 1u : 0u; oeq += eq ? 1u : 0u;
    }
    BLOCK_SYNC();
    for (int k = C.tid; k < n; k += NTHR) SLOTp[k] = (int)lv[k + (k >> 5)];
    if (set) { for (int s = CAPL + CAPC + C.tid; s < ESLOTS; s += NTHR) { IDXp[s] = 0; GATEp[s] = 0.f; } }
    BLOCK_SYNC();
}
__device__ __forceinline__ void phase_H(Ctx& C, int l) {
    const int nitems = (l == 0) ? 32 : 16;
    for (int it = C.bid; it < nitems; it += C.G) item_topk(C, it & 15, it >> 4);
    convert_experts_H(C, l);
}
__device__ __forceinline__ void skinny_mma(const bf16* a0, const bf16* a1, const bf16* b0, const bf16* b1, int K, int fq, f32x4 (&acc)[2][2]) {
#pragma unroll 8
    for (int k0 = 0; k0 < K; k0 += 32) {
        const bf16x8 fa0 = *(const bf16x8*)(a0 + k0 + 8 * fq), fa1 = *(const bf16x8*)(a1 + k0 + 8 * fq), fb0 = *(const bf16x8*)(b0 + k0 + 8 * fq), fb1 = *(const bf16x8*)(b1 + k0 + 8 * fq);
        acc[0][0] = MFMA16(fa0, fb0, acc[0][0]); acc[0][1] = MFMA16(fa0, fb1, acc[0][1]); acc[1][0] = MFMA16(fa1, fb0, acc[1][0]); acc[1][1] = MFMA16(fa1, fb1, acc[1][1]);
    }
}
#define SK_ZERO(acc) do { _Pragma("unroll") for (int a_ = 0; a_ < 2; ++a_) _Pragma("unroll") for (int b_ = 0; b_ < 2; ++b_) acc[a_][b_] = (f32x4){0.f, 0.f, 0.f, 0.f}; } while (0)
template <int NS> __device__ __forceinline__ void sk_reduce(const Ctx& C, f32x4 (&acc)[2][2]) {
    float* red = (float*)C.lds;
#pragma unroll
    for (int a = 0; a < 2; ++a)
#pragma unroll
        for (int b = 0; b < 2; ++b)
#pragma unroll
            for (int j = 0; j < 4; ++j) red[(C.wave * 16 + (a * 2 + b) * 4 + j) * 64 + C.lane] = acc[a][b][j];
    BLOCK_SYNC();
    if ((C.wave % NS) == 0) {
#pragma unroll
        for (int a = 0; a < 2; ++a)
#pragma unroll
            for (int b = 0; b < 2; ++b)
#pragma unroll
                for (int j = 0; j < 4; ++j) { float s = acc[a][b][j];
#pragma unroll
                    for (int w = 1; w < NS; ++w) s += red[((C.wave + w) * 16 + (a * 2 + b) * 4 + j) * 64 + C.lane];
                    acc[a][b][j] = s; } }
    BLOCK_SYNC();
}
__device__ __forceinline__ void skinny_F0(const Ctx& C) {
    const int fr = C.lane & 15, fq = C.lane >> 4;
    for (int it = C.bid; it < 8 * 32; it += C.G) {
        const int rb = it >> 5, cb = it & 31, kb = C.wave * 128;
        const bf16* A = ((const bf16*)(C.a->ws + WS_MIX)) + (size_t)(rb * 32 + fr) * DM + kb; const bf16* B = ((const bf16*)(C.a->ws + WS_WOUT)) + (size_t)(cb * 32 + fr) * DM + kb;
        f32x4 acc[2][2]; SK_ZERO(acc);
        skinny_mma(A, A + 16 * DM, B, B + 16 * DM, 128, fq, acc);
        sk_reduce<8>(C, acc);
        if (C.wave == 0) {
            const float* g1 = ((const float*)(C.a->ws + WS_MOD)) + (size_t)1 * 6144 + 2 * 1024;
#pragma unroll
            for (int mi = 0; mi < 2; ++mi)
#pragma unroll
                for (int ni = 0; ni < 2; ++ni)
#pragma unroll
                    for (int j = 0; j < 4; ++j) { const int r = rb * 32 + mi * 16 + 4 * fq + j, c = cb * 32 + ni * 16 + fr;
                        ((bf16*)(C.a->ws + WS_XW))[(size_t)r * DM + c] = f2bf(C.a->ctx[(size_t)r * DM + c] + g1[c] * acc[mi][ni][j]); }
        }
    }
}
__device__ __forceinline__ void skinny_J0(const Ctx& C) {
    const int fr = C.lane & 15, fq = C.lane >> 4;
    for (int it0 = C.bid * 2; it0 < 16 * 32; it0 += C.G * 2) {
        const int it = it0 + (C.wave >> 2), e = it >> 5, cb = it & 31, kb = (C.wave & 3) * 512;
        f32x4 acc[2][2]; SK_ZERO(acc);
#if MOE_FP8
        {
            const unsigned char* A = (const unsigned char*)(C.a->ws + WS_HID) + ((size_t)e * ESLOTS + CAPL + fr) * FF + kb + 32 * fq; const unsigned char* B = (const unsigned char*)(C.a->ws + WS_W2) + ((size_t)e * DM + cb * 32 + fr) * FF + kb + 32 * fq;
#pragma unroll
            for (int st = 0; st < 4; ++st) {
                const pg8::i32x8 a0 = *(const pg8::i32x8*)(A + st * 128), a1 = *(const pg8::i32x8*)(A + 16 * FF + st * 128), b0 = *(const pg8::i32x8*)(B + st * 128), b1 = *(const pg8::i32x8*)(B + 16 * FF + st * 128);
                acc[0][0] = __builtin_amdgcn_mfma_scale_f32_16x16x128_f8f6f4(a0, b0, acc[0][0], 0, 0, 0, 0x7F7F7F7F, 0, 0x7F7F7F7F); acc[0][1] = __builtin_amdgcn_mfma_scale_f32_16x16x128_f8f6f4(a0, b1, acc[0][1], 0, 0, 0, 0x7F7F7F7F, 0, 0x7F7F7F7F);
                acc[1][0] = __builtin_amdgcn_mfma_scale_f32_16x16x128_f8f6f4(a1, b0, acc[1][0], 0, 0, 0, 0x7F7F7F7F, 0, 0x7F7F7F7F); acc[1][1] = __builtin_amdgcn_mfma_scale_f32_16x16x128_f8f6f4(a1, b1, acc[1][1], 0, 0, 0, 0x7F7F7F7F, 0, 0x7F7F7F7F); }
        }
        const float osc = 1.0f / (HID_F8S * W_F8S);
#else
        { const bf16* A = ((const bf16*)(C.a->ws + WS_HID)) + ((size_t)e * ESLOTS + CAPL + fr) * FF + kb; const bf16* B = ((const bf16*)(C.a->ws + WS_W2)) + ((size_t)e * DM + cb * 32 + fr) * FF + kb;
          skinny_mma(A, A + 16 * FF, B, B + 16 * FF, 512, fq, acc); }
        const float osc = 1.0f;
#endif
        sk_reduce<4>(C, acc);
        if ((C.wave & 3) == 0) {
#pragma unroll
            for (int mi = 0; mi < 2; ++mi)
#pragma unroll
                for (int j = 0; j < 4; ++j) { const int slot = CAPL + mi * 16 + 4 * fq + j; const float gt = ((const float*)(C.a->ws + WS_GATE))[e * ESLOTS + slot] * osc;
#pragma unroll
                    for (int ni = 0; ni < 2; ++ni) ((bf16*)(C.a->ws + WS_Y))[((size_t)e * ESLOTS + slot) * DM + cb * 32 + ni * 16 + fr] = f2bf(acc[mi][ni][j] * gt); }
        }
    }
}
#define LAS __attribute__((address_space(3)))
#define XB_TMO      128
#define XB_XCNT(j)  (256  + 64 * (j))
#define XB_XSUB(j)  (1280 + 64 * (j))
#define XB_XGEN(j)  (2304 + 64 * (j))
#define XB_TOP      3328
#define XB_TOPGEN   3392
#define XCD_BAR_WORDS 3456
#define XB_SPIN_CAP (1u << 18)

__device__ __forceinline__ unsigned xb_ld(unsigned* p)              { return __hip_atomic_load(p, __ATOMIC_RELAXED, __HIP_MEMORY_SCOPE_AGENT); }
__device__ __forceinline__ unsigned xb_add(unsigned* p, unsigned v) { return __hip_atomic_fetch_add(p, v, __ATOMIC_RELAXED, __HIP_MEMORY_SCOPE_AGENT); }
__device__ __forceinline__ unsigned xb_xcc_id() { return (unsigned)__builtin_amdgcn_s_getreg((3 << 11) | 20) & 0xFu; }
#define XB_SPIN(cond, bar) do { unsigned _sp = 0; while (cond) { __builtin_amdgcn_s_sleep(1); \
    if ((++_sp & 255u) == 0u) { if (xb_ld(&(bar)[XB_TMO])) break; if (_sp > XB_SPIN_CAP) { atomicAdd(&(bar)[XB_TMO], 1u); break; } } } } while (0)

struct XcdBarrier {
    unsigned* bar; unsigned x;
    volatile LAS unsigned* st;
};

__device__ __forceinline__ XcdBarrier xcd_barrier_post(unsigned* bar, volatile LAS unsigned* st) {
    XcdBarrier b; b.bar = bar; b.x = xb_xcc_id(); b.st = st;
    if (threadIdx.x == 0) (void)xb_add(&bar[XB_XCNT(b.x)], 1u);
    return b;
}
__device__ __forceinline__ void xcd_barrier_complete(unsigned* bar, unsigned x, unsigned& nloc, unsigned& nx) {
    const unsigned G = gridDim.x * gridDim.y * gridDim.z;
    unsigned sum, cnt, mine, sp = 0u;
    for (;;) {
        sum = 0u; cnt = 0u; mine = 0u;
#pragma unroll
        for (unsigned j = 0; j < 16; ++j) { const unsigned c = xb_ld(&bar[XB_XCNT(j)]); sum += c; cnt += (c > 0u) ? 1u : 0u; mine = (j == x) ? c : mine; }
        if (sum == G) break;
        __builtin_amdgcn_s_sleep(1);
        if ((++sp & 255u) == 0u) { if (xb_ld(&bar[XB_TMO])) break; if (sp > XB_SPIN_CAP) { atomicAdd(&bar[XB_TMO], 1u); break; } }
    }
    nloc = mine > 0u ? mine : 1u; nx = cnt > 0u ? cnt : 1u;
}

__device__ __forceinline__ void xcd_barrier(const XcdBarrier& b) {
    asm volatile("s_waitcnt vmcnt(0)" ::: "memory");
    __syncthreads();
    if (threadIdx.x == 0) {
        unsigned* bar = b.bar;
        __builtin_amdgcn_s_waitcnt(0);
        unsigned nloc = b.st[0], nx = b.st[1];
        if (nloc == 0u) { xcd_barrier_complete(bar, b.x, nloc, nx); b.st[0] = nloc; b.st[1] = nx; }
        const unsigned old = xb_add(&bar[XB_XSUB(b.x)], 1u);
        const unsigned gen = old / nloc;
        if (old + 1u == (gen + 1u) * nloc) {
            __builtin_amdgcn_fence(__ATOMIC_RELEASE, "agent");
            asm volatile("s_waitcnt vmcnt(0)" ::: "memory");
            const unsigned og = xb_add(&bar[XB_TOP], 1u);
            const unsigned tg = og / nx;
            if (og + 1u == (tg + 1u) * nx) xb_add(&bar[XB_TOPGEN], 1u);
            else XB_SPIN(xb_ld(&bar[XB_TOPGEN]) == tg, bar);
            __builtin_amdgcn_fence(__ATOMIC_ACQUIRE, "agent");
            xb_add(&bar[XB_XGEN(b.x)], 1u);
            asm volatile("s_waitcnt vmcnt(0)" ::: "memory");
        } else {
            XB_SPIN(xb_ld(&bar[XB_XGEN(b.x)]) == gen, bar);
            __builtin_amdgcn_fence(__ATOMIC_ACQUIRE, "agent");
            asm volatile("s_waitcnt vmcnt(0)" ::: "memory");
        }
    }
    __syncthreads();
}


template <class Hook> __device__ __forceinline__ void xcd_barrier_shadow(const XcdBarrier& b, Hook&& hook) {
    asm volatile("s_waitcnt vmcnt(0)" ::: "memory");
    __syncthreads();
    if (threadIdx.x == 0) {
        unsigned* bar = b.bar;
        __builtin_amdgcn_s_waitcnt(0);
        unsigned nloc = b.st[0], nx = b.st[1];
        if (nloc == 0u) { xcd_barrier_complete(bar, b.x, nloc, nx); b.st[0] = nloc; b.st[1] = nx; }
        const unsigned old = xb_add(&bar[XB_XSUB(b.x)], 1u);
        const unsigned gen = old / nloc;
        if (old + 1u == (gen + 1u) * nloc) {
            __builtin_amdgcn_fence(__ATOMIC_RELEASE, "agent");
            asm volatile("s_waitcnt vmcnt(0)" ::: "memory");
            const unsigned og = xb_add(&bar[XB_TOP], 1u);
            const unsigned tg = og / nx;
            if (og + 1u == (tg + 1u) * nx) xb_add(&bar[XB_TOPGEN], 1u);
            else XB_SPIN(xb_ld(&bar[XB_TOPGEN]) == tg, bar);
            __builtin_amdgcn_fence(__ATOMIC_ACQUIRE, "agent");
            xb_add(&bar[XB_XGEN(b.x)], 1u);
            asm volatile("s_waitcnt vmcnt(0)" ::: "memory");
        } else {
            XB_SPIN(xb_ld(&bar[XB_XGEN(b.x)]) == gen, bar);
            __builtin_amdgcn_fence(__ATOMIC_ACQUIRE, "agent");
            asm volatile("s_waitcnt vmcnt(0)" ::: "memory");
        }
    }
    if (threadIdx.x >= 64) hook();
    __syncthreads();
}

#ifndef ATT_STATICM
#define ATT_STATICM true
#endif
__device__ __forceinline__ void ho_publish(Ctx& C, int slot) {
    asm volatile("s_waitcnt vmcnt(0)" ::: "memory");
    BLOCK_SYNC();
    if (C.tid == 0) { __builtin_amdgcn_fence(__ATOMIC_RELEASE, "agent"); asm volatile("s_waitcnt vmcnt(0)" ::: "memory");
        __hip_atomic_fetch_add((unsigned*)(C.a->ws + WS_CTL + 49152 + 2048) + 64 * slot, 1u, __ATOMIC_RELAXED, __HIP_MEMORY_SCOPE_AGENT); }
}
__device__ __forceinline__ void ho_wait(Ctx& C, int slot, unsigned need) {
    if (C.tid == 0) { unsigned* cnt = (unsigned*)(C.a->ws + WS_CTL + 49152 + 2048) + 64 * slot; unsigned sp = 0u;
        while (__hip_atomic_load(cnt, __ATOMIC_RELAXED, __HIP_MEMORY_SCOPE_AGENT) < need) { __builtin_amdgcn_s_sleep(2); if (++sp > (1u << 22)) break; }
        __builtin_amdgcn_fence(__ATOMIC_ACQUIRE, "agent"); asm volatile("s_waitcnt vmcnt(0)" ::: "memory"); }
    BLOCK_SYNC();
}
__device__ __forceinline__ void de_publish(Ctx& C, int l) { ho_publish(C, 2 * l); }
__device__ __forceinline__ void de_wait(Ctx& C, int l) { ho_wait(C, 2 * l, (unsigned)C.G); }
__device__ __forceinline__ void phase_E(Ctx& C, int l) {
    phase_D(C); de_publish(C, l);
    const int c0 = (l == 0) ? 0 : 2;
    const int pos = C.bid % 3;
    if (pos == 0) { convert_experts(C, l); BLOCK_SYNC(); }
#ifndef NO_ATTN
    using abf = attn_body::bf16;
    float mref; { float gq = fabsf(C.a->q_norm_g[l * 64 + C.lane]), gk = fabsf(C.a->k_norm_g[l * 64 + C.lane]);
#pragma unroll
        for (int o = 32; o > 0; o >>= 1) { gq = fmaxf(gq, __shfl_xor(gq, o)); gk = fmaxf(gk, __shfl_xor(gk, o)); }
        mref = 64.0f * C2Q * 1.02f * gq * gk; mref = __int_as_float(__builtin_amdgcn_readfirstlane(__float_as_int(mref))); }
    if (ATT_STATICM && mref < 40.0f) {
        for (int u = C.vcu; u < 256; u += C.G) { const int h = u >> 6, qb = u & 63; const size_t qrow = (size_t)CTXL + (size_t)qb * 256;
            attn_body::attn_unit<8, true>((const abf*)(((bf16*)(C.a->ws + WS_QB)) + qrow * 256 + h * 64), (const abf*)(((bf16*)(C.a->ws + WS_KB)) + (h >> 1) * 64), (const abf*)(((bf16*)(C.a->ws + WS_VB)) + (h >> 1) * 64), (abf*)(((bf16*)(C.a->ws + WS_MIX)) + qrow * DM + 512 + h * 64), R / 64, (char*)C.lds, C.tid, mref); }
        if (l == 0) for (int u = C.bid - 16; u >= 0 && u < 4; u += C.G) { const int h = u;
            attn_body::attn_unit<8, true>((const abf*)(((bf16*)(C.a->ws + WS_QB)) + h * 64), (const abf*)(((bf16*)(C.a->ws + WS_KB)) + (h >> 1) * 64), (const abf*)(((bf16*)(C.a->ws + WS_VB)) + (h >> 1) * 64), (abf*)(((bf16*)(C.a->ws + WS_MIX)) + 512 + h * 64), CTXL / 64, (char*)C.lds, C.tid, mref); }
    } else {
        for (int u = C.vcu; u < 256; u += C.G) { const int h = u >> 6, qb = u & 63; const size_t qrow = (size_t)CTXL + (size_t)qb * 256;
            attn_body::attn_unit<8, false>((const abf*)(((bf16*)(C.a->ws + WS_QB)) + qrow * 256 + h * 64), (const abf*)(((bf16*)(C.a->ws + WS_KB)) + (h >> 1) * 64), (const abf*)(((bf16*)(C.a->ws + WS_VB)) + (h >> 1) * 64), (abf*)(((bf16*)(C.a->ws + WS_MIX)) + qrow * DM + 512 + h * 64), R / 64, (char*)C.lds, C.tid, 0.f); }
        if (l == 0) for (int u = C.bid - 16; u >= 0 && u < 4; u += C.G) { const int h = u;
            attn_body::attn_unit<8, false>((const abf*)(((bf16*)(C.a->ws + WS_QB)) + h * 64), (const abf*)(((bf16*)(C.a->ws + WS_KB)) + (h >> 1) * 64), (const abf*)(((bf16*)(C.a->ws + WS_VB)) + (h >> 1) * 64), (abf*)(((bf16*)(C.a->ws + WS_MIX)) + 512 + h * 64), CTXL / 64, (char*)C.lds, C.tid, 0.f); }
    }
#endif
    BLOCK_SYNC();
    if (pos == 1) { convert_experts(C, l); BLOCK_SYNC(); }
    de_wait(C, l);
#ifndef NO_MLOUT
    for (int k = 0; k * C.G < (NCHUNK - c0) * 4; ++k) { const int it = k * C.G + ((k & 1) ? C.G - 1 - C.bid : C.bid); if (it < (NCHUNK - c0) * 4) { item_mlout(C, l, c0 + it / 4, it % 4); BLOCK_SYNC(); } }
#endif
    if (pos == 2) { convert_experts(C, l); }
}

template <int ph> __device__ __forceinline__ void seam(const XcdBarrier& xb, const Ctx& C0) {
    constexpr int k = (ph >= 2) ? (ph - 2) % 10 : -1, l = (ph >= 2) ? (ph - 2) / 10 : 0;
    if constexpr (k == 4 || k == 8) {
        xcd_barrier_shadow(xb, [&] { Ctx C = C0; C.tid = (int)threadIdx.x - 64; if constexpr (k == 4) stage_G(C, l, NTHR - 64); else stage_K(C, l, NTHR - 64); });
    } else xcd_barrier(xb);
}
#ifndef REPEAT_PH
#define REPEAT_PH -1
#endif
#ifndef ONLY_KIND
#define ONLY_KIND -1
#endif
#define KSEL(x) (ONLY_KIND == -1 || ONLY_KIND == (x))
constexpr int N_PHASES = 22;
template <int ph> __device__ __forceinline__ void run_phase(Ctx& C, PG8_LAS unsigned char* ldsg) {
        if constexpr (ph == 0) { if (KSEL(100)) phase_init(C); }
        else if constexpr (ph == 1) { if (KSEL(101)) phase_A0(C); }
        else {
            constexpr int l = (ph - 2) / 10, k = (ph - 2) % 10;
            if constexpr (k == 0) { if (KSEL(0)) {
                pg8::Gemm g{((bf16*)(C.a->ws + WS_H)), ((bf16*)(C.a->ws + WS_WIN)) + (size_t)l * NZ * DM, R, NZ, DM, nullptr}; pg8::StaticOrder S; S.init(R, NZ, C.G, C.bid);
                pg8::EpiBf16 E{((bf16*)(C.a->ws + WS_Z)), NZ};
                pg8::gemm_phase<pg8::EpiBf16, pg8::StaticOrder, true, false>(ldsg, g, S, E, C.tid);
                convert_experts_B(C, l); }
            } else if constexpr (k == 1) { if (KSEL(1)) phase_C(C, l); }
            else if constexpr (k == 2) { }
            else if constexpr (k == 3) { if (KSEL(3)) phase_E(C, l); }
            else if constexpr (k == 4) { if (KSEL(4)) {
                const int pm0 = 1; const int rows = R - pm0 * 256;
                pg8::Gemm g{((bf16*)(C.a->ws + WS_MIX)), ((bf16*)(C.a->ws + WS_WOUT)) + (size_t)l * DM * DM, rows, DM, DM, nullptr}; pg8::StaticOrder S; S.init(rows, DM, C.G, C.bid, pm0);
                const float* modL = ((float*)(C.a->ws + WS_MOD)) + (size_t)(l * 2 + 0) * 6144 + 2 * 1024; const float* modC = ((float*)(C.a->ws + WS_MOD)) + (size_t)(l * 2 + 1) * 6144 + 2 * 1024;
                bf16* XWb = (bf16*)(C.a->ws + WS_XW);
                pg8::EpiResid<(l != 0)> E{(l == 0) ? (const void*)C.a->ctx : (const void*)XWb, (l == 0) ? (const void*)C.a->x : (const void*)(XWb + (size_t)CTXL * DM), XWb, modC, modL};
                pg8::gemm_phase<pg8::EpiResid<(l != 0)>, pg8::StaticOrder, true, false>(ldsg, g, S, E, C.tid);
                if (l == 0) skinny_F0(C); }
            } else if constexpr (k == 5) { if (KSEL(5)) phase_G(C, l); }
            else if constexpr (k == 6) { }
            else if constexpr (k == 7) { if (KSEL(7)) {
                { const int nitems = (l == 0) ? 32 : 16; phase_H(C, l); if (C.bid < nitems) ho_publish(C, 2 * l + 1); ho_wait(C, 2 * l + 1, (unsigned)(C.G < nitems ? C.G : nitems)); }
#if MOE_FP8
                pg8::Gemm g{((bf16*)(C.a->ws + WS_H2)), (bf16*)((unsigned char*)(C.a->ws + WS_W13) + (size_t)l * NEXP * 4096 * DM), NEXP * ESLOTS, NEXP * 4096, DM / 2, ((int*)(C.a->ws + WS_IDX))}; pg8::MoeOrder S; S.init((l == 0) ? 9 : 8, 16, C.G, C.vcu);
                pg8::EpiSwiGLU<true> E{(void*)(C.a->ws + WS_HID), 1.0f / (H2_F8S * W_F8S), HID_F8S};
                pg8::gemm_phase<pg8::EpiSwiGLU<true>, pg8::MoeOrder, true, true, true>(ldsg, g, S, E, C.tid);
#else
                pg8::Gemm g{((bf16*)(C.a->ws + WS_H2)), ((bf16*)(C.a->ws + WS_W13)) + (size_t)l * NEXP * 4096 * DM, NEXP * ESLOTS, NEXP * 4096, DM, ((int*)(C.a->ws + WS_IDX))}; pg8::MoeOrder S; S.init((l == 0) ? 9 : 8, 16, C.G, C.vcu);
                pg8::EpiSwiGLU<false> E{(void*)(C.a->ws + WS_HID), 1.0f, 1.0f};
                pg8::gemm_phase<pg8::EpiSwiGLU<false>, pg8::MoeOrder, true, true, false>(ldsg, g, S, E, C.tid);
#endif
                }
            } else if constexpr (k == 8) { if (KSEL(8)) {
#if MOE_FP8
                pg8::Gemm g{((bf16*)(C.a->ws + WS_HID)), (bf16*)((unsigned char*)(C.a->ws + WS_W2) + (size_t)l * NEXP * DM * FF), NEXP * ESLOTS, NEXP * DM, FF / 2, nullptr}; pg8::MoeOrder S; S.init(8, 4, C.G, C.vcu);
                pg8::EpiGateRow E{((bf16*)(C.a->ws + WS_Y)), ((float*)(C.a->ws + WS_GATE)), 1.0f / (HID_F8S * W_F8S)};
                pg8::gemm_phase<pg8::EpiGateRow, pg8::MoeOrder, true, false, true>(ldsg, g, S, E, C.tid);
#else
                pg8::Gemm g{((bf16*)(C.a->ws + WS_HID)), ((bf16*)(C.a->ws + WS_W2)) + (size_t)l * NEXP * DM * FF, NEXP * ESLOTS, NEXP * DM, FF, nullptr}; pg8::MoeOrder S; S.init(8, 4, C.G, C.vcu);
                pg8::EpiGateRow E{((bf16*)(C.a->ws + WS_Y)), ((float*)(C.a->ws + WS_GATE)), 1.0f};
                pg8::gemm_phase<pg8::EpiGateRow, pg8::MoeOrder, true, false, false>(ldsg, g, S, E, C.tid);
#endif
                if (l == 0) skinny_J0(C); }
            } else { if (KSEL(9)) phase_K(C, l); }
        }
}
__global__ void __launch_bounds__(NTHR, 2) hybrid_fwd(Args args) {
    extern __shared__ __attribute__((aligned(16))) unsigned char lds[];
    cg::grid_group grid = cg::this_grid();
    Ctx C; C.lds = lds;
    PG8_LAS unsigned char* ldsg = (PG8_LAS unsigned char*)lds;

    const int ph_lo = args.ph_lo, ph_hi = args.ph_hi;
    volatile LAS unsigned* MISC = (volatile LAS unsigned*)((LAS unsigned char*)lds + (LDS_BYTES - 64));
    if (threadIdx.x < 16) MISC[threadIdx.x] = 0u;
    __syncthreads();
    XcdBarrier xbar = xcd_barrier_post((unsigned*)(args.ws + WS_CTL) + 4096, MISC + 8);
    volatile unsigned long long* tstamp = (volatile unsigned long long*)(args.ws + WS_CTL + 32768);
    if (PROBE_K > 0 && blockIdx.x == 0 && threadIdx.x == 0) tstamp[0] = __builtin_amdgcn_s_memrealtime();
#define RUN_PHASE(PH) do { if (ph_lo <= (PH) && (PH) < ph_hi && !((PH) >= 2 && (((PH) - 2) % 10 == 2 || ((PH) - 2) % 10 == 6))) { constexpr int ph = (PH); \
        { KArgs ka = (KArgs)__builtin_amdgcn_kernarg_segment_ptr(); asm volatile("" : "+s"(ka)); C.a = ka; } \
        { int tid_ = threadIdx.x; asm volatile("" : "+v"(tid_)); C.tid = tid_; C.lane = tid_ & 63; C.wave = __builtin_amdgcn_readfirstlane(tid_ >> 6); } \
        { int g_ = gridDim.x, b_ = blockIdx.x; asm volatile("" : "+s"(g_), "+s"(b_)); C.G = g_; C.bid = b_; C.vcu = (g_ % 8 == 0) ? (b_ % 8) * (g_ / 8) + b_ / 8 : b_; } \
        run_phase<ph>(C, ldsg); if ((PH) == REPEAT_PH) { xcd_barrier(xbar); run_phase<ph>(C, ldsg); } if ((PH) + 1 < ph_hi) { if (ph_hi > 1000) grid.sync(); else seam<ph>(xbar, C); }     \
        if (PROBE_K > 0 && blockIdx.x == 0 && threadIdx.x == 0) tstamp[(PH) + 1] = __builtin_amdgcn_s_memrealtime(); } } while (0)
    RUN_PHASE(0); RUN_PHASE(1); RUN_PHASE(2); RUN_PHASE(3); RUN_PHASE(4); RUN_PHASE(5); RUN_PHASE(6); RUN_PHASE(7); RUN_PHASE(8); RUN_PHASE(9); RUN_PHASE(10); RUN_PHASE(11);
    RUN_PHASE(12); RUN_PHASE(13); RUN_PHASE(14); RUN_PHASE(15); RUN_PHASE(16); RUN_PHASE(17); RUN_PHASE(18); RUN_PHASE(19); RUN_PHASE(20); RUN_PHASE(21);
#undef RUN_PHASE
    if (PROBE_K > 0 && blockIdx.x == 0 && threadIdx.x == 0) {
        const unsigned long long dt = tstamp[PROBE_B] - tstamp[PROBE_A], t0 = __builtin_amdgcn_s_memrealtime();
        while (__builtin_amdgcn_s_memrealtime() - t0 < (unsigned long long)PROBE_K * dt) __builtin_amdgcn_s_sleep(8);
    }
}

extern "C" void kernel_launch(void* const* d_in, const int* in_sizes, int n_in, void* d_out, int out_size, void* d_ws, size_t ws_size, hipStream_t stream) {
    static int grid = 0;
    if (grid == 0) {
        if (n_in != 24 || ws_size < WS_END) { fprintf(stderr, "kernel_launch: unexpected inputs (%d) or workspace (%zu < %zu)\n", n_in, ws_size, (size_t)WS_END); grid = -1; return; }
        int dev = 0, cus = 0, per_cu = 0;
        hipGetDevice(&dev); hipDeviceGetAttribute(&cus, hipDeviceAttributeMultiprocessorCount, dev);
        hipFuncSetAttribute((const void*)hybrid_fwd, hipFuncAttributeMaxDynamicSharedMemorySize, LDS_BYTES);
        hipOccupancyMaxActiveBlocksPerMultiprocessor(&per_cu, (const void*)hybrid_fwd, NTHR, LDS_BYTES);
        if (per_cu < 1) { fprintf(stderr, "kernel_launch: occupancy query says %d blocks per CU\n", per_cu); per_cu = 1; }
        (void)hipGetLastError();
        grid = cus;
        if (grid > 256) grid = 256;
    }
    if (grid < 0) return;
    hipMemsetAsync((char*)d_ws + WS_CTL, 0, 64 * 1024, stream);
    Args a{};
    const float** ap = (const float**)&a;
    for (int i = 0; i < 24; ++i) ap[i] = (const float*)d_in[i];
    a.out = (float*)d_out; a.ws = (unsigned char*)d_ws;
#ifndef MK_PER_PHASE
    a.ph_lo = 0; a.ph_hi = N_PHASES;
    void* kargs[] = {&a};
    hipError_t e = hipLaunchCooperativeKernel((const void*)hybrid_fwd, dim3(grid), dim3(NTHR), kargs, LDS_BYTES, stream);
    if (e != hipSuccess) fprintf(stderr, "cooperative launch failed: %s (grid %d)\n", hipGetErrorString(e), grid);
#else
    for (int p = 0; p < N_PHASES; ++p) { a.ph_lo = p; a.ph_hi = p + 1; void* kargs[] = {&a};
        hipError_t e = hipLaunchCooperativeKernel((const void*)hybrid_fwd, dim3(grid), dim3(NTHR), kargs, LDS_BYTES, stream);
        if (e != hipSuccess) { fprintf(stderr, "launch %d failed: %s\n", p, hipGetErrorString(e)); break; } }
#endif
}
```
